# Optimizing an MI355X kernel written in HIP

```python
import math
import jax, jax.numpy as jnp
from jax import lax
import numpy as np

D_MODEL = 2048
BATCH = 2
SEQ = 4096
DEPTH = 1

GRID_W = 64
NA_HEADS = 8
NA_DH = 128
NA_KR_MAX = 8
NA_KW = 16
DF_HEADS = 8
DF_DQ = 64
DF_DV = 2 * DF_DQ
Q_BLOCK = 128
FFN_HID = int(math.ceil(8 * D_MODEL / 3 / 256) * 256)
PLE_DIM = 256
ROPE_THETA = 10000.0
EPS = 1e-6

NA_W = NA_HEADS * NA_DH
DF_QW = DF_HEADS * 2 * DF_DQ
DF_VW = DF_HEADS * DF_DV
IN_COLS = 3 * NA_W + 2 * DF_QW + DF_VW + 2 * D_MODEL

kernel_name = "hybrid_natten_diffattn_gated_encoder"


def rmsnorm(x, g):
    xf = x.astype(jnp.float32)
    y = xf * lax.rsqrt(jnp.mean(xf * xf, axis=-1, keepdims=True) + EPS)
    return (y * g.astype(jnp.float32)).astype(x.dtype)


def rope_tables(S, d):
    inv = 1.0 / (ROPE_THETA ** (jnp.arange(0, d, 2, dtype=jnp.float32) / d))
    ang = jnp.arange(S, dtype=jnp.float32)[:, None] * inv[None, :]
    return jnp.cos(ang), jnp.sin(ang)


def apply_rope(x, cos, sin):
    c = cos.astype(x.dtype)
    s = sin.astype(x.dtype)
    x1, x2 = jnp.split(x, 2, axis=-1)
    return jnp.concatenate([x1 * c - x2 * s, x1 * s + x2 * c], axis=-1)


def neighbourhood_attention(q, k, v, rpb):
    B, S, H, dh = q.shape
    rows = S // GRID_W
    kr = min(NA_KR_MAX, rows)
    scale = dh ** -0.5
    qg = q.transpose(0, 2, 1, 3).reshape(B, H, rows, GRID_W, dh)
    kg = k.transpose(0, 2, 1, 3).reshape(B, H, rows, GRID_W, dh)
    vg = v.transpose(0, 2, 1, 3).reshape(B, H, rows, GRID_W, dh)
    c = np.arange(GRID_W)
    cs = np.clip(c - NA_KW // 2, 0, GRID_W - NA_KW)
    col_idx = cs[:, None] + np.arange(NA_KW)[None, :]
    dc = col_idx - c[:, None] + (NA_KW - 1)

    def one_row(r):
        rs = jnp.clip(r - kr // 2, 0, rows - kr)
        k_band = lax.dynamic_slice_in_dim(kg, rs, kr, axis=2)
        v_band = lax.dynamic_slice_in_dim(vg, rs, kr, axis=2)
        q_row = lax.dynamic_index_in_dim(qg, r, axis=2, keepdims=False)
        k_sel = k_band[:, :, :, col_idx, :]
        v_sel = v_band[:, :, :, col_idx, :]
        dr = rs + jnp.arange(kr) - r + (NA_KR_MAX - 1)
        bias = rpb[:, dr[None, :, None], dc[:, None, :]]
        s = jnp.einsum('bhcd,bhrckd->bhcrk', q_row, k_sel).astype(jnp.float32) * scale
        s = s + bias.astype(jnp.float32)[None]
        pm = jax.nn.softmax(s.reshape(B, H, GRID_W, kr * NA_KW), axis=-1)
        pm = pm.reshape(B, H, GRID_W, kr, NA_KW).astype(v.dtype)
        return jnp.einsum('bhcrk,bhrckd->bhcd', pm, v_sel)

    o = lax.map(one_row, jnp.arange(rows))
    return o.transpose(1, 0, 3, 2, 4).reshape(B, S, H * dh)


def differential_attention(q, k, v, lam):
    B, S, H, _, dq = q.shape
    nb = S // Q_BLOCK
    scale = dq ** -0.5
    q_t = q.transpose(0, 2, 3, 1, 4)
    k_t = k.transpose(0, 2, 3, 1, 4)
    v_t = v.transpose(0, 2, 1, 3)
    q_blocks = q_t.reshape(B, H, 2, nb, Q_BLOCK, dq).transpose(3, 0, 1, 2, 4, 5)

    def one_block(qb):
        s = jnp.einsum('bhmqd,bhmkd->bhmqk', qb, k_t).astype(jnp.float32) * scale
        pm = jax.nn.softmax(s, axis=-1)
        a = pm[:, :, 0] - lam * pm[:, :, 1]
        return jnp.einsum('bhqk,bhkd->bhqd', a.astype(v_t.dtype), v_t)

    o = lax.map(one_block, q_blocks)
    return o.transpose(1, 0, 3, 2, 4).reshape(B, S, H, v.shape[-1])


def setup_inputs(seed: int = 0) -> dict:
    key = jax.random.key(seed)
    ks = jax.random.split(key, 24)
    L = DEPTH
    n = lambda k, shape, s: jax.random.normal(k, shape, jnp.float32) * s
    gain = lambda k, d: 1.0 + 0.02 * jax.random.normal(k, (L, d), jnp.float32)
    return {
        "x": n(ks[0], (BATCH, SEQ, D_MODEL), 1.0),
        "p": n(ks[1], (DEPTH, BATCH, SEQ, PLE_DIM), 1.0),
        "g_mix": gain(ks[2], D_MODEL),
        "w_in": n(ks[3], (L, D_MODEL, IN_COLS), D_MODEL ** -0.5),
        "g_na_q": gain(ks[4], NA_DH),
        "g_na_k": gain(ks[5], NA_DH),
        "na_rpb": n(ks[6], (L, NA_HEADS, 2 * NA_KR_MAX - 1, 2 * NA_KW - 1), 0.1),
        "g_df_q": gain(ks[7], DF_DQ),
        "g_df_k": gain(ks[8], DF_DQ),
        "lam_q1": n(ks[9], (L, DF_DQ), 0.1),
        "lam_k1": n(ks[10], (L, DF_DQ), 0.1),
        "lam_q2": n(ks[11], (L, DF_DQ), 0.1),
        "lam_k2": n(ks[12], (L, DF_DQ), 0.1),
        "g_df_sub": gain(ks[13], DF_DV),
        "w_na_out": n(ks[14], (L, NA_W, D_MODEL), NA_W ** -0.5),
        "w_df_out": n(ks[15], (L, DF_VW, D_MODEL), DF_VW ** -0.5),
        "w_o": n(ks[16], (L, D_MODEL, D_MODEL), D_MODEL ** -0.5),
        "g_ffn": gain(ks[17], D_MODEL),
        "w_gate": n(ks[18], (L, D_MODEL, FFN_HID), D_MODEL ** -0.5),
        "w_up": n(ks[19], (L, D_MODEL, FFN_HID), D_MODEL ** -0.5),
        "w_down": n(ks[20], (L, FFN_HID, D_MODEL), FFN_HID ** -0.5),
        "g_ple": gain(ks[21], D_MODEL),
        "w_ple_gate": n(ks[22], (L, D_MODEL, D_MODEL), D_MODEL ** -0.5),
        "w_ple_proj": n(ks[23], (L, PLE_DIM, D_MODEL), PLE_DIM ** -0.5),
    }


def reference(x, p, g_mix, w_in, g_na_q, g_na_k, na_rpb, g_df_q, g_df_k,
              lam_q1, lam_k1, lam_q2, lam_k2, g_df_sub, w_na_out, w_df_out, w_o,
              g_ffn, w_gate, w_up, w_down, g_ple, w_ple_gate, w_ple_proj):
    B, S, D = x.shape
    cos, sin = rope_tables(S, DF_DQ)
    cos_b = cos[None, :, None, None, :]
    sin_b = sin[None, :, None, None, :]
    splits = np.cumsum([NA_W, NA_W, NA_W, DF_QW, DF_QW, DF_VW, D_MODEL])
    for i in range(DEPTH):
        lam_init = 0.8 - 0.6 * math.exp(-0.3 * i)
        h = rmsnorm(x, g_mix[i])
        proj = h @ w_in[i]
        na_q, na_k, na_v, df_q, df_k, df_v, gate_a, gate_b = jnp.split(proj, splits, axis=-1)

        na_q = rmsnorm(na_q.reshape(B, S, NA_HEADS, NA_DH), g_na_q[i])
        na_k = rmsnorm(na_k.reshape(B, S, NA_HEADS, NA_DH), g_na_k[i])
        na_v = na_v.reshape(B, S, NA_HEADS, NA_DH)
        y_a = neighbourhood_attention(na_q, na_k, na_v, na_rpb[i]) @ w_na_out[i]

        df_q = apply_rope(rmsnorm(df_q.reshape(B, S, DF_HEADS, 2, DF_DQ), g_df_q[i]), cos_b, sin_b)
        df_k = apply_rope(rmsnorm(df_k.reshape(B, S, DF_HEADS, 2, DF_DQ), g_df_k[i]), cos_b, sin_b)
        df_v = df_v.reshape(B, S, DF_HEADS, DF_DV)
        lam = (jnp.exp(jnp.sum(lam_q1[i].astype(jnp.float32) * lam_k1[i].astype(jnp.float32)))
               - jnp.exp(jnp.sum(lam_q2[i].astype(jnp.float32) * lam_k2[i].astype(jnp.float32)))
               + lam_init)
        o_b = differential_attention(df_q, df_k, df_v, lam)
        o_b = rmsnorm(o_b, g_df_sub[i]) * (1.0 - lam_init)
        y_b = o_b.reshape(B, S, DF_VW) @ w_df_out[i]

        merged = jax.nn.sigmoid(gate_a) * y_a + jax.nn.sigmoid(gate_b) * y_b
        x = x + merged @ w_o[i]

        hf = rmsnorm(x, g_ffn[i])
        x = x + (jax.nn.silu(hf @ w_gate[i]) * (hf @ w_up[i])) @ w_down[i]

        hp = rmsnorm(x, g_ple[i])
        x = x + jax.nn.sigmoid(hp @ w_ple_gate[i]) * (p[i] @ w_ple_proj[i])
    return x
```

```cpp
#include <hip/hip_runtime.h>
#include <hip/hip_cooperative_groups.h>
#include <cstdio>
#include <cstdint>
namespace cg = cooperative_groups;
namespace pg8 {
#define PG8_LAS __attribute__((address_space(3)))
typedef unsigned short bf16_t;
typedef short bf16x8 __attribute__((ext_vector_type(8)));
typedef float f32x4 __attribute__((ext_vector_type(4)));
typedef unsigned u32x4 __attribute__((ext_vector_type(4)));
constexpr int BM = 256, BK = 64, HALF = 128, HTB = HALF * BK * 2  , STAGE_BYTES = 8 * HTB, NXCD = 8, WGM = 8;

__host__ __device__ __forceinline__ int lds_byte(int r, int c) { const int st = (r >> 4) * 2 + (c >> 5), rr = r & 15, cc = c & 31, ob = rr * 64 + cc * 2; return st * 1024 + (ob ^ (((ob >> 9) & 1) << 5)); }
__host__ __device__ __forceinline__ void stage_rc(int b, int& R, int& C) { const int st = b / 1024, sb = b % 1024, swz = sb ^ (((sb >> 9) & 1) << 5); R = (st >> 1) * 16 + swz / 64; C = (st & 1) * 32 + (swz % 64) / 2; }
__host__ __device__ __forceinline__ int perm32(int rho) { const int n = rho >> 4, i = rho & 15; return 8 * (i >> 2) + 4 * n + (i & 3); }

struct Unit { int pm, pn; };
struct Gemm { const bf16_t* A; const bf16_t* Bt; int M, N, K; };

struct StaticOrder {
    int nM, nN, nwg, G, c;
    __host__ __device__ void init(int M, int N, int G_, int c_) { nM = M / BM; nN = N / BM; nwg = nM * nN; G = G_; c = c_; }
    __host__ __device__ bool next(int i, Unit& u) const {
        const long L = (long)i * G + c; if (L >= nwg) return false;
        int wgid = (int)L; { const int q = nwg / NXCD, r = nwg % NXCD, xcd = wgid % NXCD, off = wgid / NXCD; wgid = (xcd < r ? xcd * (q + 1) : r * (q + 1) + (xcd - r) * q) + off; }
        const int nig = WGM * nN, gid = wgid / nig, fm = gid * WGM, gsz = (nM - fm) < WGM ? (nM - fm) : WGM;
        u.pm = fm + ((wgid % nig) % gsz); u.pn = (wgid % nig) / gsz; return true;
    }
    __device__ __forceinline__ void a_ready(const Unit&) const {}
    __device__ __forceinline__ void done(const Unit&) const {}
};

__device__ __forceinline__ unsigned cvt_pk_bf16(float lo, float hi) { unsigned r; asm volatile("v_cvt_pk_bf16_f32 %0, %1, %2" : "=v"(r) : "v"(lo), "v"(hi)); return r; }
__device__ __forceinline__ float bf_lo(unsigned w) { return __uint_as_float(w << 16); }
__device__ __forceinline__ float bf_hi(unsigned w) { return __uint_as_float(w & 0xffff0000u); }
__device__ __forceinline__ float sigmoidf_(float x) { return __builtin_amdgcn_rcpf(1.0f + __expf(-x)); }
typedef unsigned u32x2 __attribute__((ext_vector_type(2)));
#define EPI_FENCE() asm volatile("" ::: "memory")
#define EPI_ROWS(...) _Pragma("unroll") for (int ai = 0; ai < 2; ++ai) _Pragma("unroll") for (int m = 0; m < 4; ++m) { const int row = u.pm * BM + ai * HALF + wr * 64 + m * 16 + fr; __VA_ARGS__ }

struct EpiQKG {
    static constexpr bool PERM = true, AFTER_DRAIN = false;
    bf16_t* O; int ldc;
    __device__ __forceinline__ void operator()(const f32x4 (&acc)[2][2][4][2], const Unit& u, int wr, int wc, int fr, int fq) const {
        const bool gate = u.pn >= 16; const int col0 = u.pn * BM + wc * 32 + 8 * fq;
        EPI_ROWS(
            bf16_t* rowp = O + (size_t)row * ldc + col0;
            _Pragma("unroll") for (int bj = 0; bj < 2; ++bj) { f32x4 v0 = acc[ai][bj][m][0], v1 = acc[ai][bj][m][1];
                if (gate) { _Pragma("unroll") for (int j = 0; j < 4; ++j) { v0[j] = sigmoidf_(v0[j]); v1[j] = sigmoidf_(v1[j]); } }
                u32x4 w; w.x = cvt_pk_bf16(v0[0], v0[1]); w.y = cvt_pk_bf16(v0[2], v0[3]); w.z = cvt_pk_bf16(v1[0], v1[1]); w.w = cvt_pk_bf16(v1[2], v1[3]);
                *(u32x4*)(rowp + bj * HALF) = w; }
            EPI_FENCE();
        )
    }
};
struct EpiVT {
    static constexpr bool PERM = true, AFTER_DRAIN = false;
    bf16_t* O; int ldc;
    __device__ __forceinline__ void operator()(const f32x4 (&acc)[2][2][4][2], const Unit& u, int wr, int wc, int fr, int fq) const {
        const int cbase = u.pn * BM + wc * 32 + 16 * (fq >> 1) + 4 * (fq & 1);
        EPI_ROWS(
            bf16_t* rowp = O + (size_t)row * ldc + cbase;
            _Pragma("unroll") for (int bj = 0; bj < 2; ++bj) _Pragma("unroll") for (int n = 0; n < 2; ++n) { const f32x4 v = acc[ai][bj][m][n];
                u32x2 w; w.x = cvt_pk_bf16(v[0], v[1]); w.y = cvt_pk_bf16(v[2], v[3]); *(u32x2*)(rowp + bj * HALF + 8 * n) = w; }
            EPI_FENCE();
        )
    }
};
struct EpiGateMul {
    static constexpr bool PERM = true, AFTER_DRAIN = false;
    const bf16_t* G; int ldg; float* T; int ldc;
    __device__ __forceinline__ void operator()(const f32x4 (&acc)[2][2][4][2], const Unit& u, int wr, int wc, int fr, int fq) const {
        const int col0 = u.pn * BM + wc * 32 + 8 * fq;
        EPI_ROWS(
            _Pragma("unroll") for (int bj = 0; bj < 2; ++bj) { const u32x4 g = *(const u32x4*)(G + (size_t)row * ldg + col0 + bj * HALF);
                f32x4 v0 = acc[ai][bj][m][0], v1 = acc[ai][bj][m][1];
                v0[0] *= bf_lo(g.x); v0[1] *= bf_hi(g.x); v0[2] *= bf_lo(g.y); v0[3] *= bf_hi(g.y); v1[0] *= bf_lo(g.z); v1[1] *= bf_hi(g.z); v1[2] *= bf_lo(g.w); v1[3] *= bf_hi(g.w);
                float* tp = T + (size_t)row * ldc + col0 + bj * HALF; *(f32x4*)tp = v0; *(f32x4*)(tp + 4) = v1; }
            EPI_FENCE();
        )
    }
};
struct EpiGateMulAdd {
    static constexpr bool PERM = true, AFTER_DRAIN = false;
    const bf16_t* G; int ldg; const float* T; int ldc; bf16_t* O;
    __device__ __forceinline__ void operator()(const f32x4 (&acc)[2][2][4][2], const Unit& u, int wr, int wc, int fr, int fq) const {
        const int col0 = u.pn * BM + wc * 32 + 8 * fq;
        EPI_ROWS(
            _Pragma("unroll") for (int bj = 0; bj < 2; ++bj) { const u32x4 g = *(const u32x4*)(G + (size_t)row * ldg + col0 + bj * HALF);
                const float* tp = T + (size_t)row * ldc + col0 + bj * HALF; f32x4 t0 = *(const f32x4*)tp, t1 = *(const f32x4*)(tp + 4);
                f32x4 v0 = acc[ai][bj][m][0], v1 = acc[ai][bj][m][1];
                v0[0] = t0[0] + v0[0] * bf_lo(g.x); v0[1] = t0[1] + v0[1] * bf_hi(g.x); v0[2] = t0[2] + v0[2] * bf_lo(g.y); v0[3] = t0[3] + v0[3] * bf_hi(g.y);
                v1[0] = t1[0] + v1[0] * bf_lo(g.z); v1[1] = t1[1] + v1[1] * bf_hi(g.z); v1[2] = t1[2] + v1[2] * bf_lo(g.w); v1[3] = t1[3] + v1[3] * bf_hi(g.w);
                u32x4 w; w.x = cvt_pk_bf16(v0[0], v0[1]); w.y = cvt_pk_bf16(v0[2], v0[3]); w.z = cvt_pk_bf16(v1[0], v1[1]); w.w = cvt_pk_bf16(v1[2], v1[3]);
                *(u32x4*)(O + (size_t)row * ldc + col0 + bj * HALF) = w; }
            EPI_FENCE();
        )
    }
};
struct EpiResid {
    static constexpr bool PERM = true, AFTER_DRAIN = false;
    const float* base; float* out; bf16_t* ob; float* rowss; int ldc;
    __device__ __forceinline__ void operator()(const f32x4 (&acc)[2][2][4][2], const Unit& u, int wr, int wc, int fr, int fq) const {
        const int col0 = u.pn * BM + wc * 32 + 8 * fq;
        EPI_ROWS(
            float ss = 0.f;
            _Pragma("unroll") for (int bj = 0; bj < 2; ++bj) { const size_t off = (size_t)row * ldc + col0 + bj * HALF;
                const f32x4 b0 = *(const f32x4*)(base + off), b1 = *(const f32x4*)(base + off + 4);
                const f32x4 v0 = acc[ai][bj][m][0] + b0, v1 = acc[ai][bj][m][1] + b1;
                ss += (v0[0] * v0[0] + v0[1] * v0[1]) + (v0[2] * v0[2] + v0[3] * v0[3]) + (v1[0] * v1[0] + v1[1] * v1[1]) + (v1[2] * v1[2] + v1[3] * v1[3]);
                *(f32x4*)(out + off) = v0; *(f32x4*)(out + off + 4) = v1;
                u32x4 w; w.x = cvt_pk_bf16(v0[0], v0[1]); w.y = cvt_pk_bf16(v0[2], v0[3]); w.z = cvt_pk_bf16(v1[0], v1[1]); w.w = cvt_pk_bf16(v1[2], v1[3]);
                *(u32x4*)(ob + off) = w; }
            ss += __shfl_xor(ss, 16); ss += __shfl_xor(ss, 32);
            if (fq == 0) atomicAdd(rowss + row, ss);
            EPI_FENCE();
        )
    }
};
struct EpiSwiGLU {
    static constexpr bool PERM = true, AFTER_DRAIN = false;
    const float* rowss; bf16_t* H; int ldh; float inv_d, eps;
    __device__ __forceinline__ void operator()(const f32x4 (&acc)[2][2][4][2], const Unit& u, int wr, int wc, int fr, int fq) const {
        const int col0 = u.pn * HALF + wc * 32 + 8 * fq;
        EPI_ROWS(
            const float rs = __builtin_amdgcn_rsqf(rowss[row] * inv_d + eps);
            float hv[8];
            _Pragma("unroll") for (int n = 0; n < 2; ++n) _Pragma("unroll") for (int j = 0; j < 4; ++j) { const float g = acc[ai][0][m][n][j] * rs, up = acc[ai][1][m][n][j] * rs; hv[n * 4 + j] = g * sigmoidf_(g) * up; }
            u32x4 w; w.x = cvt_pk_bf16(hv[0], hv[1]); w.y = cvt_pk_bf16(hv[2], hv[3]); w.z = cvt_pk_bf16(hv[4], hv[5]); w.w = cvt_pk_bf16(hv[6], hv[7]);
            *(u32x4*)(H + (size_t)row * ldh + col0) = w;
            EPI_FENCE();
        )
    }
};
struct EpiStoreF32 {
    static constexpr bool PERM = true, AFTER_DRAIN = false;
    float* T; int ldc;
    __device__ __forceinline__ void operator()(const f32x4 (&acc)[2][2][4][2], const Unit& u, int wr, int wc, int fr, int fq) const {
        const int col0 = u.pn * BM + wc * 32 + 8 * fq;
        EPI_ROWS(
            _Pragma("unroll") for (int bj = 0; bj < 2; ++bj) { float* tp = T + (size_t)row * ldc + col0 + bj * HALF; *(f32x4*)tp = acc[ai][bj][m][0]; *(f32x4*)(tp + 4) = acc[ai][bj][m][1]; }
            EPI_FENCE();
        )
    }
};
struct EpiPle {
    static constexpr bool PERM = true, AFTER_DRAIN = false;
    const float* rowss; const float* T; float* out; int ldc; float inv_d, eps;
    __device__ __forceinline__ void operator()(const f32x4 (&acc)[2][2][4][2], const Unit& u, int wr, int wc, int fr, int fq) const {
        const int col0 = u.pn * BM + wc * 32 + 8 * fq;
        EPI_ROWS(
            const float rs = __builtin_amdgcn_rsqf(rowss[row] * inv_d + eps);
            _Pragma("unroll") for (int bj = 0; bj < 2; ++bj) { const size_t off = (size_t)row * ldc + col0 + bj * HALF;
                const f32x4 t0 = *(const f32x4*)(T + off), t1 = *(const f32x4*)(T + off + 4); f32x4 x0 = *(const f32x4*)(out + off), x1 = *(const f32x4*)(out + off + 4);
                _Pragma("unroll") for (int j = 0; j < 4; ++j) { x0[j] += sigmoidf_(acc[ai][bj][m][0][j] * rs) * t0[j]; x1[j] += sigmoidf_(acc[ai][bj][m][1][j] * rs) * t1[j]; }
                *(f32x4*)(out + off) = x0; *(f32x4*)(out + off + 4) = x1; EPI_FENCE(); }
        )
    }
};
template <class Epi, class Sched, bool ALIGN_EPI = false, bool SP2 = false>
__device__ __forceinline__ void gemm_phase(PG8_LAS unsigned char* lds, const Gemm g, const Sched& S, const Epi& E) {
    int tid_ = threadIdx.x; asm volatile("" : "+v"(tid_));
    const int tid = tid_, wid = __builtin_amdgcn_readfirstlane(tid >> 6), lane = tid & 63, wr = wid >> 2, wc = wid & 3, fr = lane & 15, fq = lane >> 4;
    const int K = g.K, nt = K / BK;
    unsigned voffA[2], voffB[2];
#pragma unroll
    for (int i = 0; i < 2; ++i) { int R, C; stage_rc(tid * 16 + i * 8192, R, C); const int Rb = Epi::PERM ? ((R & ~31) + perm32(R & 31)) : R;
        voffA[i] = (unsigned)(R * K + C) * 2u; voffB[i] = (unsigned)(Rb * K + C) * 2u; }
    const size_t kstep = (size_t)(BK * 2);
    const size_t hstep = (size_t)HALF * K * 2;
    const size_t tstep = 2 * hstep;
    const unsigned ldsw = (unsigned)wid * 1024u;
    const int aoff = lds_byte(wr * 64 + fr, fq * 8), boff = lds_byte(wc * 32 + fr, fq * 8);
#define PG8_SA(b, h) (((b) * 2 + (h)) * HTB)
#define PG8_SB(b, h) ((4 + (b) * 2 + (h)) * HTB)
#define PG8_STAGE(bufoff, gbase, voff) do { _Pragma("unroll") for (int _i = 0; _i < 2; ++_i) \
        __builtin_amdgcn_global_load_lds((const unsigned*)((const char*)(gbase) + (voff)[_i]), (PG8_LAS unsigned*)(lds + (bufoff) + ldsw + _i * 8192), 16, 0, 0); } while (0)
#define PG8_LDA(dst, b, h) do { _Pragma("unroll") for (int m = 0; m < 4; ++m) _Pragma("unroll") for (int k = 0; k < 2; ++k) dst[m][k] = *(const PG8_LAS bf16x8*)(lds + PG8_SA(b, h) + aoff + m * 2048 + k * 1024); } while (0)
#define PG8_LDB(dst, b, h) do { _Pragma("unroll") for (int n = 0; n < 2; ++n) _Pragma("unroll") for (int k = 0; k < 2; ++k) dst[n][k] = *(const PG8_LAS bf16x8*)(lds + PG8_SB(b, h) + boff + n * 2048 + k * 1024); } while (0)
#define PG8_MMA(ai, bj, At, Bt) do { __builtin_amdgcn_s_setprio(1); _Pragma("unroll") for (int m = 0; m < 4; ++m) _Pragma("unroll") for (int n = 0; n < 2; ++n) _Pragma("unroll") for (int k = 0; k < 2; ++k) \
        acc[ai][bj][m][n] = __builtin_amdgcn_mfma_f32_16x16x32_bf16(Bt[n][k], At[m][k], acc[ai][bj][m][n], 0, 0, 0); __builtin_amdgcn_s_setprio(0); } while (0)
#define PG8_WAIT_V(n) asm volatile("s_waitcnt vmcnt(" #n ")" ::: "memory")
#define PG8_WAIT_L(n) asm volatile("s_waitcnt lgkmcnt(" #n ")" ::: "memory")
#define PG8_BAR __builtin_amdgcn_s_barrier()
#define PG8_SCHED __builtin_amdgcn_sched_barrier(0)
    Unit cur, nxt; int ui = 0;
    if (!S.next(0, cur)) return;
    f32x4 acc[2][2][4][2];
#pragma unroll
    for (int a = 0; a < 2; ++a)
#pragma unroll
        for (int b = 0; b < 2; ++b)
#pragma unroll
            for (int m = 0; m < 4; ++m)
#pragma unroll
                for (int n = 0; n < 2; ++n) acc[a][b][m][n] = (f32x4){0.f, 0.f, 0.f, 0.f};
    bf16x8 At[4][2], B0[2][2], B1[2][2];
    const char* cA = (const char*)g.A + (size_t)cur.pm * tstep; const char* cB = (const char*)g.Bt + (size_t)cur.pn * tstep;
    S.a_ready(cur);
    if constexpr (SP2) {
        PG8_STAGE(PG8_SB(0, 0), cB, voffB); PG8_STAGE(PG8_SB(0, 1), cB + hstep, voffB); PG8_STAGE(PG8_SA(0, 0), cA, voffA); PG8_STAGE(PG8_SA(0, 1), cA + hstep, voffA);
        if (wr == 1) PG8_BAR;
        PG8_WAIT_V(2); PG8_BAR;
        PG8_STAGE(PG8_SB(1, 0), cB + kstep, voffB); PG8_STAGE(PG8_SA(1, 0), cA + kstep, voffA); PG8_STAGE(PG8_SB(1, 1), cB + hstep + kstep, voffB);
        PG8_WAIT_V(6); PG8_BAR;
    } else {
        PG8_STAGE(PG8_SB(0, 0), cB, voffB); PG8_STAGE(PG8_SA(0, 0), cA, voffA); PG8_STAGE(PG8_SB(0, 1), cB + hstep, voffB); PG8_STAGE(PG8_SA(0, 1), cA + hstep, voffA);
        if (wr == 1) PG8_BAR;
        PG8_WAIT_V(4); PG8_BAR;
        PG8_STAGE(PG8_SB(1, 0), cB + kstep, voffB); PG8_STAGE(PG8_SA(1, 0), cA + kstep, voffA); PG8_STAGE(PG8_SB(1, 1), cB + hstep + kstep, voffB);
        PG8_WAIT_V(6); PG8_BAR;
    }
    for (;;) {
        const bool has_next = S.next(ui + 1, nxt);
        const char* nA = has_next ? (const char*)g.A + (size_t)nxt.pm * tstep : cA; const char* nB = has_next ? (const char*)g.Bt + (size_t)nxt.pn * tstep : cB;
        for (int t = 0; t < nt; t += 2) {
            const bool last = (t == nt - 2);
            const char* a1 = cA + (size_t)(t + 1) * kstep;
            const char* a2 = last ? nA : cA + (size_t)(t + 2) * kstep; const char* b2 = last ? nB : cB + (size_t)(t + 2) * kstep;
            const char* a3 = a2 + kstep; const char* b3 = b2 + kstep;
            if (last && has_next) S.a_ready(nxt);
            if constexpr (SP2) {
            PG8_LDB(B0, 0, 0); PG8_LDB(B1, 0, 1); PG8_SCHED; PG8_LDA(At, 0, 0); PG8_STAGE(PG8_SA(1, 1), a1 + hstep, voffA);
            PG8_WAIT_V(8); PG8_WAIT_L(0); PG8_BAR; PG8_MMA(0, 0, At, B0); PG8_MMA(0, 1, At, B1); PG8_BAR; PG8_SCHED;
            PG8_LDA(At, 0, 1); PG8_STAGE(PG8_SB(0, 0), b2, voffB); PG8_STAGE(PG8_SB(0, 1), b2 + hstep, voffB); PG8_STAGE(PG8_SA(0, 0), a2, voffA);
            PG8_WAIT_V(8); PG8_WAIT_L(0); PG8_BAR; PG8_MMA(1, 0, At, B0); PG8_MMA(1, 1, At, B1); PG8_BAR; PG8_SCHED;
            PG8_LDB(B0, 1, 0); PG8_LDB(B1, 1, 1); PG8_SCHED; PG8_LDA(At, 1, 0); PG8_STAGE(PG8_SA(0, 1), a2 + hstep, voffA);
            PG8_WAIT_V(8); PG8_WAIT_L(0); PG8_BAR; PG8_MMA(0, 0, At, B0); PG8_MMA(0, 1, At, B1); PG8_BAR; PG8_SCHED;
            PG8_LDA(At, 1, 1); PG8_STAGE(PG8_SB(1, 0), b3, voffB); PG8_STAGE(PG8_SB(1, 1), b3 + hstep, voffB); PG8_STAGE(PG8_SA(1, 0), a3, voffA);
            PG8_WAIT_V(8); PG8_WAIT_L(0); PG8_BAR; PG8_MMA(1, 0, At, B0); PG8_MMA(1, 1, At, B1); PG8_BAR; PG8_SCHED;
            } else {
            PG8_LDB(B0, 0, 0); PG8_SCHED; PG8_LDA(At, 0, 0); PG8_STAGE(PG8_SA(1, 1), a1 + hstep, voffA);
            PG8_WAIT_L(8); PG8_BAR; PG8_WAIT_L(0); PG8_MMA(0, 0, At, B0); PG8_BAR; PG8_SCHED;
            PG8_LDB(B1, 0, 1); PG8_STAGE(PG8_SB(0, 0), b2, voffB);
            PG8_BAR; PG8_WAIT_L(0); PG8_MMA(0, 1, At, B1); PG8_BAR;
            PG8_LDA(At, 0, 1); PG8_STAGE(PG8_SA(0, 0), a2, voffA);
            PG8_BAR; PG8_WAIT_L(0); PG8_MMA(1, 0, At, B0); PG8_BAR; PG8_SCHED;
            PG8_STAGE(PG8_SB(0, 1), b2 + hstep, voffB);
            PG8_WAIT_V(6); PG8_BAR; PG8_MMA(1, 1, At, B1); PG8_BAR;
            PG8_LDB(B0, 1, 0); PG8_SCHED; PG8_LDA(At, 1, 0); PG8_STAGE(PG8_SA(0, 1), a2 + hstep, voffA);
            PG8_WAIT_L(8); PG8_BAR; PG8_WAIT_L(0); PG8_MMA(0, 0, At, B0); PG8_BAR; PG8_SCHED;
            PG8_LDB(B1, 1, 1); PG8_STAGE(PG8_SB(1, 0), b3, voffB);
            PG8_BAR; PG8_WAIT_L(0); PG8_MMA(0, 1, At, B1); PG8_BAR;
            PG8_LDA(At, 1, 1); PG8_STAGE(PG8_SA(1, 0), a3, voffA);
            PG8_BAR; PG8_WAIT_L(0); PG8_MMA(1, 0, At, B0); PG8_BAR; PG8_SCHED;
            PG8_STAGE(PG8_SB(1, 1), b3 + hstep, voffB);
            PG8_WAIT_V(6); PG8_BAR; PG8_MMA(1, 1, At, B1); PG8_BAR;
            }
        }
        if constexpr (ALIGN_EPI) { if (wr == 0) PG8_BAR; }
        if constexpr (!Epi::AFTER_DRAIN) { E(acc, cur, wr, wc, fr, fq); S.done(cur); }
        if (!has_next) break;
#pragma unroll
        for (int a = 0; a < 2; ++a)
#pragma unroll
            for (int b = 0; b < 2; ++b)
#pragma unroll
                for (int m = 0; m < 4; ++m)
#pragma unroll
                    for (int n = 0; n < 2; ++n) acc[a][b][m][n] = (f32x4){0.f, 0.f, 0.f, 0.f};
        cur = nxt; cA = nA; cB = nB; ++ui;
        if constexpr (ALIGN_EPI) { if (wr == 1) PG8_BAR; }
    }
    PG8_WAIT_V(0);
    if constexpr (!ALIGN_EPI) { if (wr == 0) PG8_BAR; }
    PG8_BAR;
    if constexpr (Epi::AFTER_DRAIN) { E.fused(acc, cur, wr, wc, fr, fq, lds, wid, lane); S.done(cur); }
#undef PG8_SA
#undef PG8_SB
#undef PG8_STAGE
#undef PG8_LDA
#undef PG8_LDB
#undef PG8_MMA
#undef PG8_WAIT_V
#undef PG8_WAIT_L
#undef PG8_BAR
#undef PG8_SCHED
}
}
constexpr int D = 2048, BATCH = 2, SEQ = 4096, M = BATCH * SEQ, GW = 64, GROWS = SEQ / GW, FF = 5632, PLE = 256;
constexpr int NA_H = 8, NA_DH = 128, DF_H = 8, DF_DQ = 64, DF_DV = 128;
constexpr int NQKG = 8192;
constexpr int QC_NAQ = 0, QC_NAK = 1024, QC_DFQ = 2048, QC_DFK = 3072, QC_GA = 4096, QC_GB = 6144;
constexpr float EPS = 1e-6f, LOG2E = 1.4426950408889634f;
constexpr float LAM_INIT = 0.2f;
constexpr int NWAVES = 8, NTHREADS = 512;
constexpr size_t MiB = 1u << 20;
constexpr size_t WS_RS1 = 64 * 1024, WS_RS2 = 128 * 1024, WS_ROPE = 1 * MiB;
constexpr size_t WS_W1 = 2 * MiB, WS_WNA = 42 * MiB, WS_WDF = 46 * MiB, WS_WO = 50 * MiB, WS_WGU = 58 * MiB, WS_WDN = 102 * MiB, WS_WPG = 124 * MiB, WS_WPP = 132 * MiB;
constexpr size_t WS_A = 133 * MiB;
constexpr size_t WS_B = 261 * MiB;
constexpr size_t WS_C = 293 * MiB;
constexpr size_t WS_PB = 325 * MiB;
constexpr size_t WS_END = 329 * MiB;
constexpr int LDS_BYTES = 147456;
#define LAS __attribute__((address_space(3)))
typedef unsigned short bf16;
typedef unsigned u32x4 __attribute__((ext_vector_type(4)));
typedef unsigned u32x2 __attribute__((ext_vector_type(2)));
typedef float f32x4 __attribute__((ext_vector_type(4)));
typedef float f32x2 __attribute__((ext_vector_type(2)));
typedef float f32x16 __attribute__((ext_vector_type(16)));
typedef short bf16x8 __attribute__((ext_vector_type(8)));
using pg8::cvt_pk_bf16; using pg8::bf_lo; using pg8::bf_hi;

__device__ __forceinline__ float wave_sum(float v) {
#pragma unroll
    for (int o = 1; o < 64; o <<= 1) v += __shfl_xor(v, o);
    return v;
}
__device__ __forceinline__ float wave_max(float v) {
#pragma unroll
    for (int o = 1; o < 64; o <<= 1) v = fmaxf(v, __shfl_xor(v, o));
    return v;
}
__device__ __forceinline__ int crow(int r, int hi) { return (r & 3) + 8 * (r >> 2) + 4 * hi; }

__device__ __forceinline__ int rowmap(int mode, int n0) {
    if (mode == 0) return n0;
    if (mode == 1) {
        if (n0 < 2048) return n0;
        if (n0 < 3072) return 8192 + (n0 - 2048);
        if (n0 < 4096) return 2048 + (n0 - 3072);
        if (n0 < 5120) return 3072 + (n0 - 4096);
        if (n0 < 6144) return 9216 + (n0 - 5120);
        return 4096 + (n0 - 6144);
    }
    return 256 * (n0 >> 7) + (n0 & 127) + (mode == 3 ? 128 : 0);
}
__device__ __forceinline__ void p0_transpose_item(const float* W, int K, int N, bf16* WT, int mode, const float* gk, LAS float* scr, int item, int lane) {
    const int nblk = N / 32, kb = item / nblk, nb = item % nblk, k0 = 64 * kb, n0 = 32 * nb;
    const int r0 = rowmap(mode, n0);
#pragma unroll 8
    for (int i = 0; i < 32; ++i) { const int kk = 2 * i + (lane >> 5); float v = W[(size_t)(k0 + kk) * N + n0 + (lane & 31)]; if (gk) v *= gk[k0 + kk]; scr[kk * 33 + (lane & 31)] = v; }
    asm volatile("s_waitcnt lgkmcnt(0)" ::: "memory");
    const int c = lane & 7;
#pragma unroll
    for (int j = 0; j < 4; ++j) { const int n = (lane >> 3) + 8 * j; const LAS float* s = scr + (8 * c) * 33 + n;
        u32x4 o; o.x = cvt_pk_bf16(s[0 * 33], s[1 * 33]); o.y = cvt_pk_bf16(s[2 * 33], s[3 * 33]); o.z = cvt_pk_bf16(s[4 * 33], s[5 * 33]); o.w = cvt_pk_bf16(s[6 * 33], s[7 * 33]);
        *(u32x4*)(WT + (size_t)(r0 + n) * K + k0 + 8 * c) = o; }
    asm volatile("s_waitcnt lgkmcnt(0)" ::: "memory");
}
struct Args {
    const float *x, *p, *g_mix, *w_in, *g_na_q, *g_na_k, *na_rpb, *g_df_q, *g_df_k, *lam_q1, *lam_k1, *lam_q2, *lam_k2, *g_df_sub,
                *w_na_out, *w_df_out, *w_o, *g_ffn, *w_gate, *w_up, *w_down, *g_ple, *w_ple_gate, *w_ple_proj;
    float* out; unsigned char* ws; int ph_lo, ph_hi;
};

__device__ __forceinline__ void na_wave_unit(const bf16* QKG, const bf16* VT, const float* rpb, bf16* NAO, float M2, int b, int h, int r, int half) {
    int tid_ = threadIdx.x; asm volatile("" : "+v"(tid_)); const int lane = tid_ & 63;
    const int q = lane & 31, hi = lane >> 5, c = 32 * half + q;
    const size_t tokq = (size_t)b * SEQ + r * GW + c;
    bf16x8 qf[8];
#pragma unroll
    for (int d0 = 0; d0 < 8; ++d0) qf[d0] = *(const bf16x8*)(QKG + tokq * NQKG + QC_NAQ + h * NA_DH + 16 * d0 + 8 * hi);
    int rs = r - 4; rs = rs < 0 ? 0 : (rs > GROWS - 8 ? GROWS - 8 : rs);
    int cs = c - 8; cs = cs < 0 ? 0 : (cs > GW - 16 ? GW - 16 : cs);
    f32x16 o[4];
#pragma unroll
    for (int i = 0; i < 4; ++i) o[i] = (f32x16){};
    float l = 0.f;
    for (int kr = 0; kr < 8; ++kr) {
        const int krow = rs + kr, dr = krow - r + 7;
        const float* brow = rpb + (h * 15 + dr) * 31;
#pragma unroll
        for (int kb = 0; kb < 2; ++kb) {
            f32x16 s = (f32x16){};
            const bf16* kp = QKG + ((size_t)b * SEQ + krow * GW + 32 * kb + q) * NQKG + QC_NAK + h * NA_DH + 8 * hi;
#pragma unroll
            for (int d0 = 0; d0 < 8; ++d0) { const bf16x8 kf = *(const bf16x8*)(kp + 16 * d0); s = __builtin_amdgcn_mfma_f32_32x32x16_bf16(kf, qf[d0], s, 0, 0, 0); }
            float pv[16];
#pragma unroll
            for (int i = 0; i < 16; ++i) { const int kc = 32 * kb + crow(i, hi); const bool in = (kc >= cs) && (kc < cs + 16); const int dc = in ? (kc - c + 15) : 0;
                const float bias = brow[dc] * LOG2E - M2; const float e = __builtin_amdgcn_exp2f(s[i] + bias); pv[i] = in ? e : 0.f; l += pv[i]; }
            u32x4 w0, w1;
            w0.x = cvt_pk_bf16(pv[0], pv[1]); w0.y = cvt_pk_bf16(pv[2], pv[3]); w0.z = cvt_pk_bf16(pv[4], pv[5]); w0.w = cvt_pk_bf16(pv[6], pv[7]);
            w1.x = cvt_pk_bf16(pv[8], pv[9]); w1.y = cvt_pk_bf16(pv[10], pv[11]); w1.z = cvt_pk_bf16(pv[12], pv[13]); w1.w = cvt_pk_bf16(pv[14], pv[15]);
            const bf16x8 p0 = __builtin_bit_cast(bf16x8, w0), p1 = __builtin_bit_cast(bf16x8, w1);
            const bf16* vp = VT + (size_t)(h * NA_DH + q) * M + (size_t)b * SEQ + krow * GW + 32 * kb + 8 * hi;
#pragma unroll
            for (int db = 0; db < 4; ++db) {
                const bf16x8 v0 = *(const bf16x8*)(vp + (size_t)(32 * db) * M), v1 = *(const bf16x8*)(vp + (size_t)(32 * db) * M + 16);
                o[db] = __builtin_amdgcn_mfma_f32_32x32x16_bf16(v0, p0, o[db], 0, 0, 0);
                o[db] = __builtin_amdgcn_mfma_f32_32x32x16_bf16(v1, p1, o[db], 0, 0, 0);
            }
        }
    }
    l += __shfl_xor(l, 32);
    const float rl = 1.0f / l;
    bf16* op = NAO + tokq * 1024 + h * NA_DH + 4 * hi;
#pragma unroll
    for (int db = 0; db < 4; ++db)
#pragma unroll
        for (int g = 0; g < 4; ++g) { u32x2 w; w.x = cvt_pk_bf16(o[db][4 * g] * rl, o[db][4 * g + 1] * rl); w.y = cvt_pk_bf16(o[db][4 * g + 2] * rl, o[db][4 * g + 3] * rl);
            *(u32x2*)(op + 32 * db + 8 * g) = w; }
}

__device__ __forceinline__ void df_unit(LAS unsigned char* lds, const bf16* QKG, const bf16* VT, bf16* DFO, const float* g_sub, float lam, float M2, int b, int h, int qb) {
    int tid_ = threadIdx.x; asm volatile("" : "+v"(tid_));
    const int tid = tid_, lane = tid & 63, w = __builtin_amdgcn_readfirstlane(tid >> 6), q = lane & 31, hi = lane >> 5;
    const int mm = w & 1, qg = w >> 1;
    const int q0 = qb * 256 + qg * 64;
    bf16x8 qf[2][4];
#pragma unroll
    for (int qb2 = 0; qb2 < 2; ++qb2)
#pragma unroll
        for (int d0 = 0; d0 < 4; ++d0) qf[qb2][d0] = *(const bf16x8*)(QKG + ((size_t)b * SEQ + q0 + 32 * qb2 + q) * NQKG + QC_DFQ + h * 128 + mm * 64 + 16 * d0 + 8 * hi);
    const bf16* ksrc[2]; const bf16* vsrc[2];
#pragma unroll
    for (int i = 0; i < 2; ++i) {
        const int piece = w * 2 + i;
        { const int row = piece * 4 + (lane >> 4), ph = lane & 15, ch = ph ^ (row & 15); ksrc[i] = QKG + ((size_t)b * SEQ + row) * NQKG + QC_DFK + h * 128 + ch * 8; }
        { const int row = piece * 8 + (lane >> 3), ph = lane & 7, ch = ph ^ ((row >> 1) & 7); vsrc[i] = VT + (size_t)(1024 + h * 128 + row) * M + (size_t)b * SEQ + ch * 8; }
    }
#define DF_DMA(kt, buf) do { _Pragma("unroll") for (int _i = 0; _i < 2; ++_i) { \
        __builtin_amdgcn_global_load_lds((const unsigned*)(ksrc[_i] + (size_t)(kt) * 64 * NQKG), (LAS unsigned*)(lds + (buf) * 32768 + (w * 2 + _i) * 1024), 16, 0, 0); \
        __builtin_amdgcn_global_load_lds((const unsigned*)(vsrc[_i] + (size_t)(kt) * 64), (LAS unsigned*)(lds + (buf) * 32768 + 16384 + (w * 2 + _i) * 1024), 16, 0, 0); } } while (0)
    f32x16 o[2][4];
#pragma unroll
    for (int a = 0; a < 2; ++a)
#pragma unroll
        for (int i = 0; i < 4; ++i) o[a][i] = (f32x16){};
    float l[2] = {0.f, 0.f};
    const float shift = (M2 > 60.0f) ? M2 : 0.0f;
    DF_DMA(0, 0);
    asm volatile("s_waitcnt vmcnt(0)" ::: "memory");
    __syncthreads();
    constexpr int NT = SEQ / 64;
    for (int kt = 0; kt < NT; ++kt) {
        const int buf = kt & 1;
        if (kt + 1 < NT) DF_DMA(kt + 1, buf ^ 1);
        const LAS unsigned char* Kb = lds + buf * 32768; const LAS unsigned char* Vb = Kb + 16384;
#pragma unroll 1
        for (int kb = 0; kb < 2; ++kb) {
            bf16x8 kf[4];
            { const int row = 32 * kb + q;
#pragma unroll
              for (int d0 = 0; d0 < 4; ++d0) { const int ch = mm * 8 + 2 * d0 + hi; kf[d0] = *(const LAS bf16x8*)(Kb + row * 256 + ((ch ^ (row & 15)) * 16)); } }
            bf16x8 pk[2][2];
#pragma unroll
            for (int qb2 = 0; qb2 < 2; ++qb2) {
                f32x16 s = (f32x16){};
#pragma unroll
                for (int d0 = 0; d0 < 4; ++d0) s = __builtin_amdgcn_mfma_f32_32x32x16_bf16(kf[d0], qf[qb2][d0], s, 0, 0, 0);
                float ls = 0.f;
                if (shift != 0.f) {
#pragma unroll
                    for (int i = 0; i < 16; ++i) s[i] -= shift;
                }
#pragma unroll
                for (int i = 0; i < 16; ++i) { s[i] = __builtin_amdgcn_exp2f(s[i]); ls += s[i]; }
                l[qb2] += ls;
                u32x4 w0, w1;
                w0.x = cvt_pk_bf16(s[0], s[1]); w0.y = cvt_pk_bf16(s[2], s[3]); w0.z = cvt_pk_bf16(s[4], s[5]); w0.w = cvt_pk_bf16(s[6], s[7]);
                w1.x = cvt_pk_bf16(s[8], s[9]); w1.y = cvt_pk_bf16(s[10], s[11]); w1.z = cvt_pk_bf16(s[12], s[13]); w1.w = cvt_pk_bf16(s[14], s[15]);
                pk[qb2][0] = __builtin_bit_cast(bf16x8, w0); pk[qb2][1] = __builtin_bit_cast(bf16x8, w1);
                __builtin_amdgcn_sched_barrier(0);
            }
#pragma unroll
            for (int jj = 0; jj < 2; ++jj)
#pragma unroll
                for (int db = 0; db < 4; ++db) { const int row = 32 * db + q, ch = 2 * (2 * kb + jj) + hi;
                    const bf16x8 vf = *(const LAS bf16x8*)(Vb + row * 128 + ((ch ^ ((row >> 1) & 7)) * 16));
                    o[0][db] = __builtin_amdgcn_mfma_f32_32x32x16_bf16(vf, pk[0][jj], o[0][db], 0, 0, 0);
                    o[1][db] = __builtin_amdgcn_mfma_f32_32x32x16_bf16(vf, pk[1][jj], o[1][db], 0, 0, 0); }
        }
        asm volatile("s_waitcnt vmcnt(0)" ::: "memory");
        __syncthreads();
    }
#undef DF_DMA
#ifndef DF_NO_COMBINE
    LAS float* xch = (LAS float*)lds;
#pragma unroll
    for (int qb2 = 0; qb2 < 2; ++qb2) {
        float lt = l[qb2]; lt += __shfl_xor(lt, 32);
        const float sc = (mm == 1 ? lam : 1.0f) / lt;
#pragma unroll
        for (int db = 0; db < 4; ++db)
#pragma unroll
            for (int i = 0; i < 16; ++i) o[qb2][db][i] *= sc;
    }
    if (mm == 1) {
#pragma unroll
        for (int qb2 = 0; qb2 < 2; ++qb2)
#pragma unroll
            for (int db = 0; db < 4; ++db)
#pragma unroll
                for (int i = 0; i < 16; ++i) xch[((qg * 2 + qb2) * 64 + db * 16 + i) * 64 + lane] = o[qb2][db][i];
    }
    __syncthreads();
    if (mm == 0) {
#pragma unroll
        for (int qb2 = 0; qb2 < 2; ++qb2) {
            float ss = 0.f;
#pragma unroll
            for (int db = 0; db < 4; ++db)
#pragma unroll
                for (int i = 0; i < 16; ++i) { const float v = o[qb2][db][i] - xch[((qg * 2 + qb2) * 64 + db * 16 + i) * 64 + lane]; o[qb2][db][i] = v; ss += v * v; }
            ss += __shfl_xor(ss, 32);
            const float rn = __builtin_amdgcn_rsqf(ss * (1.0f / 128.0f) + EPS) * (1.0f - LAM_INIT);
            bf16* op = DFO + ((size_t)b * SEQ + q0 + 32 * qb2 + q) * 1024 + h * 128 + 4 * hi;
#pragma unroll
            for (int db = 0; db < 4; ++db)
#pragma unroll
                for (int g = 0; g < 4; ++g) { const f32x4 gs = *(const f32x4*)(g_sub + 32 * db + 8 * g + 4 * hi);
                    u32x2 wv; wv.x = cvt_pk_bf16(o[qb2][db][4 * g] * rn * gs[0], o[qb2][db][4 * g + 1] * rn * gs[1]); wv.y = cvt_pk_bf16(o[qb2][db][4 * g + 2] * rn * gs[2], o[qb2][db][4 * g + 3] * rn * gs[3]);
                    *(u32x2*)(op + 32 * db + 8 * g) = wv; }
        }
    }
    __syncthreads();
#else
    { float t = l[0] + l[1]; for (int a = 0; a < 2; ++a) for (int i = 0; i < 4; ++i) for (int j = 0; j < 16; ++j) t += o[a][i][j]; DFO[tid] = (bf16)t; }
#endif
}
__device__ __forceinline__ void qknorm_token(bf16* row, int pos, const float* gnq, const float* gnk, const float* gdq, const float* gdk, const f32x2* rope, int lane) {
    const float QS_NA = 0.08838834764831845f * LOG2E, QS_DF = 0.125f * LOG2E;
#pragma unroll
    for (int j = 0; j < 4; ++j) {
        bf16* p = row + 512 * j + 8 * lane; const u32x4 w = *(const u32x4*)p;
        float v[8] = {bf_lo(w.x), bf_hi(w.x), bf_lo(w.y), bf_hi(w.y), bf_lo(w.z), bf_hi(w.z), bf_lo(w.w), bf_hi(w.w)};
        float ss = 0.f;
#pragma unroll
        for (int i = 0; i < 8; ++i) ss += v[i] * v[i];
        ss += __shfl_xor(ss, 1); ss += __shfl_xor(ss, 2); ss += __shfl_xor(ss, 4); ss += __shfl_xor(ss, 8);
        const float rs = __builtin_amdgcn_rsqf(ss * (1.0f / 128.0f) + EPS) * (j < 2 ? QS_NA : 1.0f);
        const float* g = (j < 2 ? gnq : gnk) + 8 * (lane & 15);
#pragma unroll
        for (int i = 0; i < 8; ++i) v[i] = v[i] * rs * g[i];
        u32x4 o; o.x = cvt_pk_bf16(v[0], v[1]); o.y = cvt_pk_bf16(v[2], v[3]); o.z = cvt_pk_bf16(v[4], v[5]); o.w = cvt_pk_bf16(v[6], v[7]);
        *(u32x4*)p = o;
    }
#pragma unroll
    for (int j = 0; j < 2; ++j) {
        bf16* p1 = row + 2048 + 1024 * j + 64 * (lane >> 2) + 8 * (lane & 3); bf16* p2 = p1 + 32;
        const u32x4 wa = *(const u32x4*)p1, wb = *(const u32x4*)p2;
        float a[8] = {bf_lo(wa.x), bf_hi(wa.x), bf_lo(wa.y), bf_hi(wa.y), bf_lo(wa.z), bf_hi(wa.z), bf_lo(wa.w), bf_hi(wa.w)};
        float c[8] = {bf_lo(wb.x), bf_hi(wb.x), bf_lo(wb.y), bf_hi(wb.y), bf_lo(wb.z), bf_hi(wb.z), bf_lo(wb.w), bf_hi(wb.w)};
        float ss = 0.f;
#pragma unroll
        for (int i = 0; i < 8; ++i) ss += a[i] * a[i] + c[i] * c[i];
        ss += __shfl_xor(ss, 1); ss += __shfl_xor(ss, 2);
        const float rs = __builtin_amdgcn_rsqf(ss * (1.0f / 64.0f) + EPS);
        const float* g = (j == 0 ? gdq : gdk) + 8 * (lane & 3);
        const f32x2* rp = rope + pos * 32 + 8 * (lane & 3);
        const float qs = (j == 0 ? QS_DF : 1.0f);
        float o1[8], o2[8];
#pragma unroll
        for (int i = 0; i < 8; ++i) { const float x1 = a[i] * rs * g[i], x2 = c[i] * rs * g[32 + i]; const f32x2 cs = rp[i]; o1[i] = (x1 * cs.x - x2 * cs.y) * qs; o2[i] = (x1 * cs.y + x2 * cs.x) * qs; }
        u32x4 oa, ob; oa.x = cvt_pk_bf16(o1[0], o1[1]); oa.y = cvt_pk_bf16(o1[2], o1[3]); oa.z = cvt_pk_bf16(o1[4], o1[5]); oa.w = cvt_pk_bf16(o1[6], o1[7]);
        ob.x = cvt_pk_bf16(o2[0], o2[1]); ob.y = cvt_pk_bf16(o2[2], o2[3]); ob.z = cvt_pk_bf16(o2[4], o2[5]); ob.w = cvt_pk_bf16(o2[6], o2[7]);
        *(u32x4*)p1 = oa; *(u32x4*)p2 = ob;
    }
}

constexpr int NPHASE = 9;
__global__ void __launch_bounds__(NTHREADS, 2) fwd_megakernel(Args a) {
    extern __shared__ __attribute__((aligned(16))) unsigned char lds_raw[];
    LAS unsigned char* lds = (LAS unsigned char*)lds_raw;
    cg::grid_group grid = cg::this_grid();
    const int tid = threadIdx.x, lane = tid & 63, wave = __builtin_amdgcn_readfirstlane(tid >> 6);
    const int G = gridDim.x, bx = blockIdx.x;
    const int vcu = (G % 8 == 0) ? (bx % 8) * (G / 8) + bx / 8 : bx;
    const int gw = vcu * NWAVES + wave, NGW = G * NWAVES;
    unsigned char* ws = a.ws;
    float* RS1 = (float*)(ws + WS_RS1); float* RS2 = (float*)(ws + WS_RS2); f32x2* ROPE = (f32x2*)(ws + WS_ROPE);
    bf16 *W1t = (bf16*)(ws + WS_W1), *Wna = (bf16*)(ws + WS_WNA), *Wdf = (bf16*)(ws + WS_WDF), *Wo = (bf16*)(ws + WS_WO), *Wgu = (bf16*)(ws + WS_WGU), *Wdn = (bf16*)(ws + WS_WDN), *Wpg = (bf16*)(ws + WS_WPG), *Wpp = (bf16*)(ws + WS_WPP);
    bf16 *QKG = (bf16*)(ws + WS_A), *HB = (bf16*)(ws + WS_A); float* T2 = (float*)(ws + WS_A);
    bf16 *XN = (bf16*)(ws + WS_B), *NAO = (bf16*)(ws + WS_B), *DFO = (bf16*)(ws + WS_B + 16 * MiB), *X1B = (bf16*)(ws + WS_B), *X2B = (bf16*)(ws + WS_B);
    bf16 *VT = (bf16*)(ws + WS_C), *MRG = (bf16*)(ws + WS_C), *PB = (bf16*)(ws + WS_PB);
    const int lo = a.ph_lo, hi_ph = a.ph_hi;
#ifndef PHASE_MASK
#define PHASE_MASK 0x1ff
#endif
#define IN(k) (((PHASE_MASK >> (k)) & 1) && lo <= (k) && (k) < hi_ph)
#define SEAM(k) do { if (IN(k) && IN((k) + 1)) grid.sync(); } while (0)

    if (IN(0)) {
        LAS float* scr = (LAS float*)(lds + wave * 16384);
        constexpr int I_IN = 32 * 320, I_NA = 16 * 64, I_O = 32 * 64, I_G = 32 * 176, I_DN = 88 * 64, I_PP = 4 * 64;
        constexpr int NITEMS = I_IN + 2 * I_NA + I_O + 2 * I_G + I_DN + I_O + I_PP;
        for (int it = gw; it < NITEMS; it += NGW) {
            int r = it;
            if (r < I_IN) { p0_transpose_item(a.w_in, D, 10240, W1t, 1, nullptr, scr, r, lane); continue; } r -= I_IN;
            if (r < I_NA) { p0_transpose_item(a.w_na_out, 1024, D, Wna, 0, nullptr, scr, r, lane); continue; } r -= I_NA;
            if (r < I_NA) { p0_transpose_item(a.w_df_out, 1024, D, Wdf, 0, nullptr, scr, r, lane); continue; } r -= I_NA;
            if (r < I_O) { p0_transpose_item(a.w_o, D, D, Wo, 0, nullptr, scr, r, lane); continue; } r -= I_O;
            if (r < I_G) { p0_transpose_item(a.w_gate, D, FF, Wgu, 2, a.g_ffn, scr, r, lane); continue; } r -= I_G;
            if (r < I_G) { p0_transpose_item(a.w_up, D, FF, Wgu, 3, a.g_ffn, scr, r, lane); continue; } r -= I_G;
            if (r < I_DN) { p0_transpose_item(a.w_down, FF, D, Wdn, 0, nullptr, scr, r, lane); continue; } r -= I_DN;
            if (r < I_O) { p0_transpose_item(a.w_ple_gate, D, D, Wpg, 0, a.g_ple, scr, r, lane); continue; } r -= I_O;
            p0_transpose_item(a.w_ple_proj, PLE, D, Wpp, 0, nullptr, scr, r, lane);
        }
        for (int m = gw; m < M; m += NGW) {
            const f32x4* xr = (const f32x4*)(a.x + (size_t)m * D) + lane; const f32x4* gr = (const f32x4*)a.g_mix + lane;
            f32x4 v[8]; float s = 0.f;
#pragma unroll
            for (int j = 0; j < 8; ++j) { v[j] = xr[64 * j]; s += (v[j].x * v[j].x + v[j].y * v[j].y) + (v[j].z * v[j].z + v[j].w * v[j].w); }
            const float rs = __builtin_amdgcn_rsqf(wave_sum(s) * (1.0f / D) + EPS);
            u32x2* o8 = (u32x2*)(XN + (size_t)m * D) + lane;
#pragma unroll
            for (int j = 0; j < 8; ++j) { const f32x4 g = gr[64 * j]; u32x2 w; w.x = cvt_pk_bf16(v[j].x * rs * g.x, v[j].y * rs * g.y); w.y = cvt_pk_bf16(v[j].z * rs * g.z, v[j].w * rs * g.w); o8[64 * j] = w; }
        }
        const int gt = vcu * NTHREADS + tid, NGT = G * NTHREADS;
        for (int i = gt; i < M * PLE / 8; i += NGT) { const f32x4 p0 = ((const f32x4*)a.p)[2 * i], p1 = ((const f32x4*)a.p)[2 * i + 1];
            u32x4 w; w.x = cvt_pk_bf16(p0.x, p0.y); w.y = cvt_pk_bf16(p0.z, p0.w); w.z = cvt_pk_bf16(p1.x, p1.y); w.w = cvt_pk_bf16(p1.z, p1.w); ((u32x4*)PB)[i] = w; }
        for (int i = gt; i < SEQ * 32; i += NGT) { const int pos = i >> 5, k = i & 31;
            const float inv = (float)(1.0 / pow(10000.0, (double)k / 32.0)); const float ang = (float)pos * inv;
            f32x2 cs; cs.x = (float)cos((double)ang); cs.y = (float)sin((double)ang); ROPE[i] = cs; }
        for (int i = gt; i < M; i += NGT) { RS1[i] = 0.f; RS2[i] = 0.f; }
    }
    SEAM(0);
    if (IN(1)) {
        { pg8::Gemm g{XN, W1t, M, NQKG, D}; pg8::StaticOrder S; S.init(M, NQKG, G, bx); pg8::EpiQKG E{QKG, NQKG};
          pg8::gemm_phase<pg8::EpiQKG, pg8::StaticOrder, true, true>(lds, g, S, E); }
        { pg8::Gemm g{W1t + (size_t)NQKG * D, XN, 2048, M, D}; pg8::StaticOrder S; S.init(2048, M, G, bx); pg8::EpiVT E{VT, M};
          pg8::gemm_phase<pg8::EpiVT, pg8::StaticOrder, true, true>(lds, g, S, E); }
    }
    SEAM(1);
    if (IN(2)) {
        for (int m = gw; m < M; m += NGW) qknorm_token(QKG + (size_t)m * NQKG, m & (SEQ - 1), a.g_na_q, a.g_na_k, a.g_df_q, a.g_df_k, ROPE, lane);
    }
    SEAM(2);
    if (IN(3)) {
        LAS float* red = (LAS float*)(lds + 131072);
        float mq = 0.f, mk = 0.f, mdq = 0.f, mdk = 0.f, mb = 0.f;
        if (tid < 128) { mq = fabsf(a.g_na_q[tid]); mk = fabsf(a.g_na_k[tid]); }
        if (tid < 64) { mdq = fabsf(a.g_df_q[tid]); mdk = fabsf(a.g_df_k[tid]); }
        for (int i = tid; i < NA_H * 15 * 31; i += NTHREADS) mb = fmaxf(mb, a.na_rpb[i]);
        mq = wave_max(mq); mk = wave_max(mk); mdq = wave_max(mdq); mdk = wave_max(mdk); mb = wave_max(mb);
        float d1 = 0.f, d2 = 0.f;
        if (wave == 0) { d1 = wave_sum(a.lam_q1[lane] * a.lam_k1[lane]); d2 = wave_sum(a.lam_q2[lane] * a.lam_k2[lane]); }
        if (lane == 0) { red[wave * 8 + 0] = mq; red[wave * 8 + 1] = mk; red[wave * 8 + 2] = mdq; red[wave * 8 + 3] = mdk; red[wave * 8 + 4] = mb; red[wave * 8 + 5] = d1; red[wave * 8 + 6] = d2; }
        __syncthreads();
        mq = 0.f; mk = 0.f; mdq = 0.f; mdk = 0.f; mb = 0.f;
#pragma unroll
        for (int w = 0; w < 8; ++w) { mq = fmaxf(mq, red[w * 8]); mk = fmaxf(mk, red[w * 8 + 1]); mdq = fmaxf(mdq, red[w * 8 + 2]); mdk = fmaxf(mdk, red[w * 8 + 3]); mb = fmaxf(mb, red[w * 8 + 4]); }
        const float lam = expf(red[5]) - expf(red[6]) + LAM_INIT;
        const float M2na = (11.313708498984761f * mq * mk + mb) * LOG2E + 0.125f;
        const float M2df = (8.0f * mdq * mdk) * LOG2E + 0.125f;
        __syncthreads();
#ifndef NO_DF
        for (int uidx = vcu; uidx < BATCH * DF_H * (SEQ / 256); uidx += G) {
            const int bh = uidx >> 4, qb = uidx & 15;
            df_unit(lds, QKG, VT, DFO, a.g_df_sub, lam, M2df, bh >> 3, bh & 7, qb);
        }
#endif
#ifndef NO_NA
        for (int uidx = vcu; uidx < BATCH * GROWS * 2; uidx += G) {
            const int b = uidx >> 7, r = (uidx >> 1) & 63, hg = uidx & 1;
            na_wave_unit(QKG, VT, a.na_rpb, NAO, M2na, b, hg * 4 + (wave >> 1), r, wave & 1);
        }
#endif
    }
    SEAM(3);
    if (IN(4)) {
        { pg8::Gemm g{NAO, Wna, M, D, 1024}; pg8::StaticOrder S; S.init(M, D, G, bx); pg8::EpiGateMul E{QKG + QC_GA, NQKG, a.out, D};
          pg8::gemm_phase<pg8::EpiGateMul, pg8::StaticOrder, true, true>(lds, g, S, E); }
        { pg8::Gemm g{DFO, Wdf, M, D, 1024}; pg8::StaticOrder S; S.init(M, D, G, bx); pg8::EpiGateMulAdd E{QKG + QC_GB, NQKG, a.out, D, MRG};
          pg8::gemm_phase<pg8::EpiGateMulAdd, pg8::StaticOrder, true, true>(lds, g, S, E); }
    }
    SEAM(4);
    if (IN(5)) {
        pg8::Gemm g{MRG, Wo, M, D, D}; pg8::StaticOrder S; S.init(M, D, G, bx); pg8::EpiResid E{a.x, a.out, X1B, RS1, D};
        pg8::gemm_phase<pg8::EpiResid, pg8::StaticOrder, true, true>(lds, g, S, E);
    }
    SEAM(5);
    if (IN(6)) {
        pg8::Gemm g{X1B, Wgu, M, 2 * FF, D}; pg8::StaticOrder S; S.init(M, 2 * FF, G, bx); pg8::EpiSwiGLU E{RS1, HB, FF, 1.0f / D, EPS};
        pg8::gemm_phase<pg8::EpiSwiGLU, pg8::StaticOrder, true, true>(lds, g, S, E);
    }
    SEAM(6);
    if (IN(7)) {
        pg8::Gemm g{HB, Wdn, M, D, FF}; pg8::StaticOrder S; S.init(M, D, G, bx); pg8::EpiResid E{a.out, a.out, X2B, RS2, D};
        pg8::gemm_phase<pg8::EpiResid, pg8::StaticOrder, true, true>(lds, g, S, E);
    }
    SEAM(7);
    if (IN(8)) {
#ifndef NO_P8A
        { pg8::Gemm g{PB, Wpp, M, D, PLE}; pg8::StaticOrder S; S.init(M, D, G, bx); pg8::EpiStoreF32 E{T2, D};
          pg8::gemm_phase<pg8::EpiStoreF32, pg8::StaticOrder, true, true>(lds, g, S, E); }
#endif
#ifndef NO_P8B
        { pg8::Gemm g{X2B, Wpg, M, D, D}; pg8::StaticOrder S; S.init(M, D, G, bx); pg8::EpiPle E{RS2, T2, a.out, D, 1.0f / D, EPS};
          pg8::gemm_phase<pg8::EpiPle, pg8::StaticOrder, true, true>(lds, g, S, E); }
#endif
    }
#undef IN
#undef SEAM
}

#ifndef MK_SPLIT
#define MK_SPLIT 0
#endif
extern "C" void kernel_launch(void* const* d_in, const int* in_sizes, int n_in, void* d_out, int out_size, void* d_ws, size_t ws_size, hipStream_t stream) {
    static int grid = 0;
    if (grid == 0) {
        if (n_in != 24 || in_sizes[0] != M * D || out_size != M * D || ws_size < WS_END) { fprintf(stderr, "kernel_launch: unexpected shapes (n_in %d, in0 %d, out %d, ws %zu); nothing launched\n", n_in, n_in > 0 ? in_sizes[0] : -1, out_size, ws_size); grid = -1; return; }
        int dev = 0, cus = 0, per_cu = 0;
        hipGetDevice(&dev); hipDeviceGetAttribute(&cus, hipDeviceAttributeMultiprocessorCount, dev);
        hipFuncSetAttribute((const void*)fwd_megakernel, hipFuncAttributeMaxDynamicSharedMemorySize, LDS_BYTES);
        hipOccupancyMaxActiveBlocksPerMultiprocessor(&per_cu, (const void*)fwd_megakernel, NTHREADS, LDS_BYTES);
        if (per_cu < 1) per_cu = 1;
        grid = cus * per_cu;
        (void)hipGetLastError();
    }
    if (grid < 0) return;
    Args a{};
    const float** ap = (const float**)&a;
    for (int i = 0; i < 24; ++i) ap[i] = (const float*)d_in[i];
    a.out = (float*)d_out; a.ws = (unsigned char*)d_ws;
#if MK_SPLIT
    for (int ph = 0; ph < NPHASE; ++ph) { a.ph_lo = ph; a.ph_hi = ph + 1; hipLaunchKernelGGL(fwd_megakernel, dim3(grid), dim3(NTHREADS), LDS_BYTES, stream, a); }
#else
    a.ph_lo = 0; a.ph_hi = NPHASE;
    void* args[] = {&a};
    hipError_t e = hipLaunchCooperativeKernel((const void*)fwd_megakernel, dim3(grid), dim3(NTHREADS), args, LDS_BYTES, stream);
    if (e != hipSuccess) fprintf(stderr, "cooperative launch failed: %s (grid %d)\n", hipGetErrorString(e), grid);
#endif
}
```

```cpp
#include <hip/hip_runtime.h>
#include <hip/hip_cooperative_groups.h>
#include <cstdio>
#include <cstdint>
namespace cg = cooperative_groups;
namespace pg8 {
#define PG8_LAS __attribute__((address_space(3)))
typedef unsigned short bf16_t;
typedef short bf16x8 __attribute__((ext_vector_type(8)));
typedef float f32x4 __attribute__((ext_vector_type(4)));
typedef unsigned u32x4 __attribute__((ext_vector_type(4)));
constexpr int BM = 256, BK = 64, HALF = 128, HTB = HALF * BK * 2  , STAGE_BYTES = 8 * HTB, NXCD = 8, WGM = 8;

__host__ __device__ __forceinline__ int lds_byte(int r, int c) { const int st = (r >> 4) * 2 + (c >> 5), rr = r & 15, cc = c & 31, ob = rr * 64 + cc * 2; return st * 1024 + (ob ^ (((ob >> 9) & 1) << 5)); }
__host__ __device__ __forceinline__ void stage_rc(int b, int& R, int& C) { const int st = b / 1024, sb = b % 1024, swz = sb ^ (((sb >> 9) & 1) << 5); R = (st >> 1) * 16 + swz / 64; C = (st & 1) * 32 + (swz % 64) / 2; }
__host__ __device__ __forceinline__ int perm32(int rho) { const int n = rho >> 4, i = rho & 15; return 8 * (i >> 2) + 4 * n + (i & 3); }

struct Unit { int pm, pn; int ko = 0; };
struct Gemm { const bf16_t* A; const bf16_t* Bt; int M, N, K; int nt = 0; };

struct StaticOrder {
    int nM, nN, nwg, G, c;
    __host__ __device__ void init(int M, int N, int G_, int c_) { nM = M / BM; nN = N / BM; nwg = nM * nN; G = G_; c = c_; }
    __host__ __device__ bool next(int i, Unit& u) const {
        const long L = (long)i * G + c; if (L >= nwg) return false;
        int wgid = (int)L; { const int q = nwg / NXCD, r = nwg % NXCD, xcd = wgid % NXCD, off = wgid / NXCD; wgid = (xcd < r ? xcd * (q + 1) : r * (q + 1) + (xcd - r) * q) + off; }
        const int nig = WGM * nN, gid = wgid / nig, fm = gid * WGM, gsz = (nM - fm) < WGM ? (nM - fm) : WGM;
        u.pm = fm + ((wgid % nig) % gsz); u.pn = (wgid % nig) / gsz; return true;
    }
    __device__ __forceinline__ void a_ready(const Unit&) const {}
    __device__ __forceinline__ void done(const Unit&) const {}
};


struct TailOrder {
    int first, stride, total;
    __host__ __device__ bool next(int i, Unit& u) const { if (first < 0) return false; const int j = first + i * stride; if (j >= total) return false; u.pm = j >> 3; u.pn = j & 7; return true; }
    __device__ __forceinline__ void a_ready(const Unit&) const {}
    __device__ __forceinline__ void done(const Unit&) const {}
};

struct PairOrder {
    StaticOrder S; int kob;
    __host__ __device__ bool next(int i, Unit& u) const { if (!S.next(i >> 1, u)) return false; u.ko = (i & 1) * kob; return true; }
    __device__ __forceinline__ void a_ready(const Unit&) const {}
    __device__ __forceinline__ void done(const Unit&) const {}
};
__device__ __forceinline__ unsigned cvt_pk_bf16(float lo, float hi) { unsigned r; asm volatile("v_cvt_pk_bf16_f32 %0, %1, %2" : "=v"(r) : "v"(lo), "v"(hi)); return r; }
__device__ __forceinline__ float bf_lo(unsigned w) { return __uint_as_float(w << 16); }
__device__ __forceinline__ float bf_hi(unsigned w) { return __uint_as_float(w & 0xffff0000u); }
__device__ __forceinline__ float sigmoidf_(float x) { return __builtin_amdgcn_rcpf(1.0f + __expf(-x)); }
typedef unsigned u32x2 __attribute__((ext_vector_type(2)));
#define EPI_FENCE() asm volatile("" ::: "memory")
#define EPI_ROWS(...) _Pragma("unroll") for (int ai = 0; ai < 2; ++ai) _Pragma("unroll") for (int m = 0; m < 4; ++m) { const int row = u.pm * BM + ai * HALF + wr * 64 + m * 16 + fr; __VA_ARGS__ }

struct EpiQKG {
    static constexpr bool PERM = true, AFTER_DRAIN = false, MIDK = false;
    bf16_t* O; int ldc;
    __device__ __forceinline__ void operator()(const f32x4 (&acc)[2][2][4][2], const Unit& u, int wr, int wc, int fr, int fq) const {
        const bool gate = u.pn >= 16; const int col0 = u.pn * BM + wc * 32 + 8 * fq;
        EPI_ROWS(
            bf16_t* rowp = O + (size_t)row * ldc + col0;
            _Pragma("unroll") for (int bj = 0; bj < 2; ++bj) { f32x4 v0 = acc[ai][bj][m][0], v1 = acc[ai][bj][m][1];
                if (gate) { _Pragma("unroll") for (int j = 0; j < 4; ++j) { v0[j] = sigmoidf_(v0[j]); v1[j] = sigmoidf_(v1[j]); } }
                u32x4 w; w.x = cvt_pk_bf16(v0[0], v0[1]); w.y = cvt_pk_bf16(v0[2], v0[3]); w.z = cvt_pk_bf16(v1[0], v1[1]); w.w = cvt_pk_bf16(v1[2], v1[3]);
                *(u32x4*)(rowp + bj * HALF) = w; }
            EPI_FENCE();
        )
    }
};
struct EpiVT {
    static constexpr bool PERM = true, AFTER_DRAIN = false, MIDK = false;
    bf16_t* O; int ldc;
    __device__ __forceinline__ void operator()(const f32x4 (&acc)[2][2][4][2], const Unit& u, int wr, int wc, int fr, int fq) const {
        const int cbase = u.pn * BM + wc * 32 + 16 * (fq >> 1) + 4 * (fq & 1);
        EPI_ROWS(
            const int hv = row >> 7, dd = row & 127;
            _Pragma("unroll") for (int bj = 0; bj < 2; ++bj) _Pragma("unroll") for (int n = 0; n < 2; ++n) { const f32x4 v = acc[ai][bj][m][n];
                const int col = cbase + bj * HALF + 8 * n, bb = col >> 12, kt = (col >> 6) & 63, pos = col & 63;
                u32x2 w; w.x = cvt_pk_bf16(v[0], v[1]); w.y = cvt_pk_bf16(v[2], v[3]);
                *(u32x2*)(O + ((((size_t)(bb * 16 + hv)) * 64 + kt) * 128 + dd) * 64 + pos) = w; }
            EPI_FENCE();
        )
    }
};
struct EpiMerge {
    static constexpr bool PERM = true, AFTER_DRAIN = false, MIDK = true;
    const bf16_t* GA; const bf16_t* GB; int ldg; bf16_t* O; int ldc; int midk;
    __device__ __forceinline__ void mid(f32x4 (&acc)[2][2][4][2], const Unit& u, int wr, int wc, int fr, int fq) const {
        const int col0 = u.pn * BM + wc * 32 + 8 * fq;
        EPI_ROWS(
            _Pragma("unroll") for (int bj = 0; bj < 2; ++bj) { const size_t off = (size_t)row * ldg + col0 + bj * HALF;
                const u32x4 a = *(const u32x4*)(GA + off), b = *(const u32x4*)(GB + off);
                float r[8];
                r[0] = bf_lo(a.x) * __builtin_amdgcn_rcpf(fmaxf(bf_lo(b.x), 1e-30f)); r[1] = bf_hi(a.x) * __builtin_amdgcn_rcpf(fmaxf(bf_hi(b.x), 1e-30f));
                r[2] = bf_lo(a.y) * __builtin_amdgcn_rcpf(fmaxf(bf_lo(b.y), 1e-30f)); r[3] = bf_hi(a.y) * __builtin_amdgcn_rcpf(fmaxf(bf_hi(b.y), 1e-30f));
                r[4] = bf_lo(a.z) * __builtin_amdgcn_rcpf(fmaxf(bf_lo(b.z), 1e-30f)); r[5] = bf_hi(a.z) * __builtin_amdgcn_rcpf(fmaxf(bf_hi(b.z), 1e-30f));
                r[6] = bf_lo(a.w) * __builtin_amdgcn_rcpf(fmaxf(bf_lo(b.w), 1e-30f)); r[7] = bf_hi(a.w) * __builtin_amdgcn_rcpf(fmaxf(bf_hi(b.w), 1e-30f));
                _Pragma("unroll") for (int j = 0; j < 4; ++j) { acc[ai][bj][m][0][j] *= r[j]; acc[ai][bj][m][1][j] *= r[4 + j]; } }
            EPI_FENCE();
        )
    }
    __device__ __forceinline__ void operator()(const f32x4 (&acc)[2][2][4][2], const Unit& u, int wr, int wc, int fr, int fq) const {
        const int col0 = u.pn * BM + wc * 32 + 8 * fq;
        EPI_ROWS(
            _Pragma("unroll") for (int bj = 0; bj < 2; ++bj) { const u32x4 b = *(const u32x4*)(GB + (size_t)row * ldg + col0 + bj * HALF);
                f32x4 v0 = acc[ai][bj][m][0], v1 = acc[ai][bj][m][1];
                v0[0] *= fmaxf(bf_lo(b.x), 1e-30f); v0[1] *= fmaxf(bf_hi(b.x), 1e-30f); v0[2] *= fmaxf(bf_lo(b.y), 1e-30f); v0[3] *= fmaxf(bf_hi(b.y), 1e-30f);
                v1[0] *= fmaxf(bf_lo(b.z), 1e-30f); v1[1] *= fmaxf(bf_hi(b.z), 1e-30f); v1[2] *= fmaxf(bf_lo(b.w), 1e-30f); v1[3] *= fmaxf(bf_hi(b.w), 1e-30f);
                u32x4 w; w.x = cvt_pk_bf16(v0[0], v0[1]); w.y = cvt_pk_bf16(v0[2], v0[3]); w.z = cvt_pk_bf16(v1[0], v1[1]); w.w = cvt_pk_bf16(v1[2], v1[3]);
                *(u32x4*)(O + (size_t)row * ldc + col0 + bj * HALF) = w; }
            EPI_FENCE();
        )
    }
};
template <bool BASE_BF16> struct EpiResid {
    static constexpr bool PERM = true, AFTER_DRAIN = false, MIDK = false;
    const void* base; bf16_t* ob; float* rowss; int ldc;
    __device__ __forceinline__ void operator()(const f32x4 (&acc)[2][2][4][2], const Unit& u, int wr, int wc, int fr, int fq) const {
        const int col0 = u.pn * BM + wc * 32 + 8 * fq;
        EPI_ROWS(
            float ss = 0.f;
            _Pragma("unroll") for (int bj = 0; bj < 2; ++bj) { const size_t off = (size_t)row * ldc + col0 + bj * HALF;
                f32x4 b0, b1;
                if (BASE_BF16) { const u32x4 bw = *(const u32x4*)((const bf16_t*)base + off); b0 = (f32x4){bf_lo(bw.x), bf_hi(bw.x), bf_lo(bw.y), bf_hi(bw.y)}; b1 = (f32x4){bf_lo(bw.z), bf_hi(bw.z), bf_lo(bw.w), bf_hi(bw.w)}; }
                else { b0 = __builtin_nontemporal_load((const f32x4*)((const float*)base + off)); b1 = __builtin_nontemporal_load((const f32x4*)((const float*)base + off + 4)); }
                const f32x4 v0 = acc[ai][bj][m][0] + b0, v1 = acc[ai][bj][m][1] + b1;
                ss += (v0[0] * v0[0] + v0[1] * v0[1]) + (v0[2] * v0[2] + v0[3] * v0[3]) + (v1[0] * v1[0] + v1[1] * v1[1]) + (v1[2] * v1[2] + v1[3] * v1[3]);
                u32x4 w; w.x = cvt_pk_bf16(v0[0], v0[1]); w.y = cvt_pk_bf16(v0[2], v0[3]); w.z = cvt_pk_bf16(v1[0], v1[1]); w.w = cvt_pk_bf16(v1[2], v1[3]);
                *(u32x4*)(ob + off) = w; }
            ss += __shfl_xor(ss, 16); ss += __shfl_xor(ss, 32);
            if (fq == 0) atomicAdd(rowss + row, ss);
            EPI_FENCE();
        )
    }
};
struct EpiSwiGLU {
    static constexpr bool PERM = true, AFTER_DRAIN = false, MIDK = false;
    const float* rowss; bf16_t* H; int ldh; float inv_d, eps;
    __device__ __forceinline__ void operator()(const f32x4 (&acc)[2][2][4][2], const Unit& u, int wr, int wc, int fr, int fq) const {
        const int col0 = u.pn * HALF + wc * 32 + 8 * fq;
        EPI_ROWS(
            const float rs = __builtin_amdgcn_rsqf(rowss[row] * inv_d + eps);
            float hv[8];
            _Pragma("unroll") for (int n = 0; n < 2; ++n) _Pragma("unroll") for (int j = 0; j < 4; ++j) { const float g = acc[ai][0][m][n][j] * rs, up = acc[ai][1][m][n][j] * rs; hv[n * 4 + j] = g * sigmoidf_(g) * up; }
            u32x4 w; w.x = cvt_pk_bf16(hv[0], hv[1]); w.y = cvt_pk_bf16(hv[2], hv[3]); w.z = cvt_pk_bf16(hv[4], hv[5]); w.w = cvt_pk_bf16(hv[6], hv[7]);
            *(u32x4*)(H + (size_t)row * ldh + col0) = w;
            EPI_FENCE();
        )
    }
};
struct EpiStoreBf16 {
    static constexpr bool PERM = true, AFTER_DRAIN = false, MIDK = false;
    bf16_t* T; int ldc;
    __device__ __forceinline__ void operator()(const f32x4 (&acc)[2][2][4][2], const Unit& u, int wr, int wc, int fr, int fq) const {
        const int col0 = u.pn * BM + wc * 32 + 8 * fq;
        EPI_ROWS(
            _Pragma("unroll") for (int bj = 0; bj < 2; ++bj) { const f32x4 v0 = acc[ai][bj][m][0], v1 = acc[ai][bj][m][1];
                u32x4 w; w.x = cvt_pk_bf16(v0[0], v0[1]); w.y = cvt_pk_bf16(v0[2], v0[3]); w.z = cvt_pk_bf16(v1[0], v1[1]); w.w = cvt_pk_bf16(v1[2], v1[3]);
                *(u32x4*)(T + (size_t)row * ldc + col0 + bj * HALF) = w; }
            EPI_FENCE();
        )
    }
};
struct EpiPle {
    static constexpr bool PERM = true, AFTER_DRAIN = false, MIDK = false;
    const float* rowss; const bf16_t* T; const bf16_t* X; float* out; int ldc; float inv_d, eps;
    __device__ __forceinline__ void operator()(const f32x4 (&acc)[2][2][4][2], const Unit& u, int wr, int wc, int fr, int fq) const {
        const int col0 = u.pn * BM + wc * 32 + 8 * fq;
        EPI_ROWS(
            const float rs = __builtin_amdgcn_rsqf(rowss[row] * inv_d + eps);
            _Pragma("unroll") for (int bj = 0; bj < 2; ++bj) { const size_t off = (size_t)row * ldc + col0 + bj * HALF;
                const u32x4 tw = *(const u32x4*)(T + off), xw = *(const u32x4*)(X + off);
                const float t[8] = {bf_lo(tw.x), bf_hi(tw.x), bf_lo(tw.y), bf_hi(tw.y), bf_lo(tw.z), bf_hi(tw.z), bf_lo(tw.w), bf_hi(tw.w)};
                const float x[8] = {bf_lo(xw.x), bf_hi(xw.x), bf_lo(xw.y), bf_hi(xw.y), bf_lo(xw.z), bf_hi(xw.z), bf_lo(xw.w), bf_hi(xw.w)};
                f32x4 o0, o1;
                _Pragma("unroll") for (int j = 0; j < 4; ++j) { o0[j] = x[j] + sigmoidf_(acc[ai][bj][m][0][j] * rs) * t[j]; o1[j] = x[4 + j] + sigmoidf_(acc[ai][bj][m][1][j] * rs) * t[4 + j]; }
                __builtin_nontemporal_store(o0, (f32x4*)(out + off)); __builtin_nontemporal_store(o1, (f32x4*)(out + off + 4)); }
            EPI_FENCE();
        )
    }
};
template <class Epi, class Sched, bool ALIGN_EPI = false, bool SP2 = false>
__device__ __forceinline__ void gemm_phase(PG8_LAS unsigned char* lds, const Gemm g, const Sched& S, const Epi& E) {
    int tid_ = threadIdx.x; asm volatile("" : "+v"(tid_));
    const int tid = tid_, wid = __builtin_amdgcn_readfirstlane(tid >> 6), lane = tid & 63, wr = wid >> 2, wc = wid & 3, fr = lane & 15, fq = lane >> 4;
    const int K = g.K, nt = g.nt ? g.nt : K / BK;
    unsigned voffA[2], voffB[2];
#pragma unroll
    for (int i = 0; i < 2; ++i) { int R, C; stage_rc(tid * 16 + i * 8192, R, C); const int Rb = Epi::PERM ? ((R & ~31) + perm32(R & 31)) : R;
        voffA[i] = (unsigned)(R * K + C) * 2u; voffB[i] = (unsigned)(Rb * K + C) * 2u; }
    const size_t kstep = (size_t)(BK * 2);
    const size_t hstep = (size_t)HALF * K * 2;
    const size_t tstep = 2 * hstep;
    const unsigned ldsw = (unsigned)wid * 1024u;
    const int aoff = lds_byte(wr * 64 + fr, fq * 8), boff = lds_byte(wc * 32 + fr, fq * 8);
#define PG8_SA(b, h) (((b) * 2 + (h)) * HTB)
#define PG8_SB(b, h) ((4 + (b) * 2 + (h)) * HTB)
#define PG8_STAGE(bufoff, gbase, voff) do { _Pragma("unroll") for (int _i = 0; _i < 2; ++_i) \
        __builtin_amdgcn_global_load_lds((const unsigned*)((const char*)(gbase) + (voff)[_i]), (PG8_LAS unsigned*)(lds + (bufoff) + ldsw + _i * 8192), 16, 0, 0); } while (0)
#define PG8_LDA(dst, b, h) do { _Pragma("unroll") for (int m = 0; m < 4; ++m) _Pragma("unroll") for (int k = 0; k < 2; ++k) dst[m][k] = *(const PG8_LAS bf16x8*)(lds + PG8_SA(b, h) + aoff + m * 2048 + k * 1024); } while (0)
#define PG8_LDB(dst, b, h) do { _Pragma("unroll") for (int n = 0; n < 2; ++n) _Pragma("unroll") for (int k = 0; k < 2; ++k) dst[n][k] = *(const PG8_LAS bf16x8*)(lds + PG8_SB(b, h) + boff + n * 2048 + k * 1024); } while (0)
#define PG8_MMA(ai, bj, At, Bt) do { __builtin_amdgcn_s_setprio(1); _Pragma("unroll") for (int m = 0; m < 4; ++m) _Pragma("unroll") for (int n = 0; n < 2; ++n) _Pragma("unroll") for (int k = 0; k < 2; ++k) \
        acc[ai][bj][m][n] = __builtin_amdgcn_mfma_f32_16x16x32_bf16(Bt[n][k], At[m][k], acc[ai][bj][m][n], 0, 0, 0); __builtin_amdgcn_s_setprio(0); } while (0)
#define PG8_WAIT_V(n) asm volatile("s_waitcnt vmcnt(" #n ")" ::: "memory")
#define PG8_WAIT_L(n) asm volatile("s_waitcnt lgkmcnt(" #n ")" ::: "memory")
#define PG8_BAR __builtin_amdgcn_s_barrier()
#define PG8_SCHED __builtin_amdgcn_sched_barrier(0)
    Unit cur, nxt; int ui = 0;
    if (!S.next(0, cur)) return;
    f32x4 acc[2][2][4][2];
#pragma unroll
    for (int a = 0; a < 2; ++a)
#pragma unroll
        for (int b = 0; b < 2; ++b)
#pragma unroll
            for (int m = 0; m < 4; ++m)
#pragma unroll
                for (int n = 0; n < 2; ++n) acc[a][b][m][n] = (f32x4){0.f, 0.f, 0.f, 0.f};
    bf16x8 At[4][2], B0[2][2], B1[2][2];
    const char* cA = (const char*)g.A + (size_t)cur.pm * tstep + cur.ko; const char* cB = (const char*)g.Bt + (size_t)cur.pn * tstep + cur.ko;
    S.a_ready(cur);
    if constexpr (SP2) {
        PG8_STAGE(PG8_SB(0, 0), cB, voffB); PG8_STAGE(PG8_SB(0, 1), cB + hstep, voffB); PG8_STAGE(PG8_SA(0, 0), cA, voffA); PG8_STAGE(PG8_SA(0, 1), cA + hstep, voffA);
        if (wr == 1) PG8_BAR;
        PG8_WAIT_V(2); PG8_BAR;
        PG8_STAGE(PG8_SB(1, 0), cB + kstep, voffB); PG8_STAGE(PG8_SA(1, 0), cA + kstep, voffA); PG8_STAGE(PG8_SB(1, 1), cB + hstep + kstep, voffB);
        PG8_WAIT_V(6); PG8_BAR;
    } else {
        PG8_STAGE(PG8_SB(0, 0), cB, voffB); PG8_STAGE(PG8_SA(0, 0), cA, voffA); PG8_STAGE(PG8_SB(0, 1), cB + hstep, voffB); PG8_STAGE(PG8_SA(0, 1), cA + hstep, voffA);
        if (wr == 1) PG8_BAR;
        PG8_WAIT_V(4); PG8_BAR;
        PG8_STAGE(PG8_SB(1, 0), cB + kstep, voffB); PG8_STAGE(PG8_SA(1, 0), cA + kstep, voffA); PG8_STAGE(PG8_SB(1, 1), cB + hstep + kstep, voffB);
        PG8_WAIT_V(6); PG8_BAR;
    }
    for (;;) {
        const bool has_next = S.next(ui + 1, nxt);
        const char* nA = has_next ? (const char*)g.A + (size_t)nxt.pm * tstep + nxt.ko : cA; const char* nB = has_next ? (const char*)g.Bt + (size_t)nxt.pn * tstep + nxt.ko : cB;
        for (int t = 0; t < nt; t += 2) {
            const bool last = (t == nt - 2);
            const char* a1 = cA + (size_t)(t + 1) * kstep;
            const char* a2 = last ? nA : cA + (size_t)(t + 2) * kstep; const char* b2 = last ? nB : cB + (size_t)(t + 2) * kstep;
            const char* a3 = a2 + kstep; const char* b3 = b2 + kstep;
            if (last && has_next) S.a_ready(nxt);
            if constexpr (SP2) {
            PG8_LDB(B0, 0, 0); PG8_LDB(B1, 0, 1); PG8_SCHED; PG8_LDA(At, 0, 0); PG8_STAGE(PG8_SA(1, 1), a1 + hstep, voffA);
            PG8_WAIT_V(8); PG8_WAIT_L(0); PG8_BAR; PG8_MMA(0, 0, At, B0); PG8_MMA(0, 1, At, B1); PG8_BAR; PG8_SCHED;
            PG8_LDA(At, 0, 1); PG8_STAGE(PG8_SB(0, 0), b2, voffB); PG8_STAGE(PG8_SB(0, 1), b2 + hstep, voffB); PG8_STAGE(PG8_SA(0, 0), a2, voffA);
            PG8_WAIT_V(8); PG8_WAIT_L(0); PG8_BAR; PG8_MMA(1, 0, At, B0); PG8_MMA(1, 1, At, B1); PG8_BAR; PG8_SCHED;
            PG8_LDB(B0, 1, 0); PG8_LDB(B1, 1, 1); PG8_SCHED; PG8_LDA(At, 1, 0); PG8_STAGE(PG8_SA(0, 1), a2 + hstep, voffA);
            PG8_WAIT_V(8); PG8_WAIT_L(0); PG8_BAR; PG8_MMA(0, 0, At, B0); PG8_MMA(0, 1, At, B1); PG8_BAR; PG8_SCHED;
            PG8_LDA(At, 1, 1); PG8_STAGE(PG8_SB(1, 0), b3, voffB); PG8_STAGE(PG8_SB(1, 1), b3 + hstep, voffB); PG8_STAGE(PG8_SA(1, 0), a3, voffA);
            PG8_WAIT_V(8); PG8_WAIT_L(0); PG8_BAR; PG8_MMA(1, 0, At, B0); PG8_MMA(1, 1, At, B1); PG8_BAR; PG8_SCHED;
            } else {
            PG8_LDB(B0, 0, 0); PG8_SCHED; PG8_LDA(At, 0, 0); PG8_STAGE(PG8_SA(1, 1), a1 + hstep, voffA);
            PG8_WAIT_L(8); PG8_BAR; PG8_WAIT_L(0); PG8_MMA(0, 0, At, B0); PG8_BAR; PG8_SCHED;
            PG8_LDB(B1, 0, 1); PG8_STAGE(PG8_SB(0, 0), b2, voffB);
            PG8_BAR; PG8_WAIT_L(0); PG8_MMA(0, 1, At, B1); PG8_BAR;
            PG8_LDA(At, 0, 1); PG8_STAGE(PG8_SA(0, 0), a2, voffA);
            PG8_BAR; PG8_WAIT_L(0); PG8_MMA(1, 0, At, B0); PG8_BAR; PG8_SCHED;
            PG8_STAGE(PG8_SB(0, 1), b2 + hstep, voffB);
            PG8_WAIT_V(6); PG8_BAR; PG8_MMA(1, 1, At, B1); PG8_BAR;
            PG8_LDB(B0, 1, 0); PG8_SCHED; PG8_LDA(At, 1, 0); PG8_STAGE(PG8_SA(0, 1), a2 + hstep, voffA);
            PG8_WAIT_L(8); PG8_BAR; PG8_WAIT_L(0); PG8_MMA(0, 0, At, B0); PG8_BAR; PG8_SCHED;
            PG8_LDB(B1, 1, 1); PG8_STAGE(PG8_SB(1, 0), b3, voffB);
            PG8_BAR; PG8_WAIT_L(0); PG8_MMA(0, 1, At, B1); PG8_BAR;
            PG8_LDA(At, 1, 1); PG8_STAGE(PG8_SA(1, 0), a3, voffA);
            PG8_BAR; PG8_WAIT_L(0); PG8_MMA(1, 0, At, B0); PG8_BAR; PG8_SCHED;
            PG8_STAGE(PG8_SB(1, 1), b3 + hstep, voffB);
            PG8_WAIT_V(6); PG8_BAR; PG8_MMA(1, 1, At, B1); PG8_BAR;
            }
        }
        if constexpr (ALIGN_EPI) { if (wr == 0) PG8_BAR; }
        bool keep_acc = false;
        if constexpr (Epi::MIDK) { if (cur.ko == 0) { E.mid(acc, cur, wr, wc, fr, fq); keep_acc = true; } else E(acc, cur, wr, wc, fr, fq); }
        else if constexpr (!Epi::AFTER_DRAIN) { E(acc, cur, wr, wc, fr, fq); S.done(cur); }
        if (!has_next) break;
        if (!keep_acc) {
#pragma unroll
        for (int a = 0; a < 2; ++a)
#pragma unroll
            for (int b = 0; b < 2; ++b)
#pragma unroll
                for (int m = 0; m < 4; ++m)
#pragma unroll
                    for (int n = 0; n < 2; ++n) acc[a][b][m][n] = (f32x4){0.f, 0.f, 0.f, 0.f};
        }
        cur = nxt; cA = nA; cB = nB; ++ui;
        if constexpr (ALIGN_EPI) { if (wr == 1) PG8_BAR; }
    }
    PG8_WAIT_V(0);
    if constexpr (!ALIGN_EPI) { if (wr == 0) PG8_BAR; }
    PG8_BAR;
    if constexpr (Epi::AFTER_DRAIN) { E.fused(acc, cur, wr, wc, fr, fq, lds, wid, lane); S.done(cur); }
#undef PG8_SA
#undef PG8_SB
#undef PG8_STAGE
#undef PG8_LDA
#undef PG8_LDB
#undef PG8_MMA
#undef PG8_WAIT_V
#undef PG8_WAIT_L
#undef PG8_BAR
#undef PG8_SCHED
}
}
constexpr int D = 2048, BATCH = 2, SEQ = 4096, M = BATCH * SEQ, GW = 64, GROWS = SEQ / GW, FF = 5632, PLE = 256;
constexpr int NA_H = 8, NA_DH = 128, DF_H = 8, DF_DQ = 64, DF_DV = 128;
constexpr int NQKG = 8192;
constexpr int QC_NAQ = 0, QC_NAK = 1024, QC_DFQ = 2048, QC_DFK = 3072, QC_GA = 4096, QC_GB = 6144;
constexpr float EPS = 1e-6f, LOG2E = 1.4426950408889634f;
constexpr float LAM_INIT = 0.2f;
constexpr int NWAVES = 8, NTHREADS = 512;
constexpr size_t MiB = 1u << 20;
constexpr size_t WS_RS1 = 64 * 1024, WS_RS2 = 128 * 1024, WS_ROPE = 1 * MiB;
constexpr size_t WS_W1 = 2 * MiB, WS_WNA = 42 * MiB, WS_WDF = 46 * MiB, WS_WO = 50 * MiB, WS_WGU = 58 * MiB, WS_WDN = 102 * MiB, WS_WPG = 124 * MiB, WS_WPP = 132 * MiB;
constexpr size_t WS_A = 133 * MiB;
constexpr size_t WS_B = 261 * MiB;
constexpr size_t WS_C = 293 * MiB;
constexpr size_t WS_PB = 325 * MiB;
constexpr size_t WS_END = 329 * MiB;
constexpr int LDS_BYTES = 147456;
#define LAS __attribute__((address_space(3)))
typedef unsigned short bf16;
typedef unsigned u32x4 __attribute__((ext_vector_type(4)));
typedef unsigned u32x2 __attribute__((ext_vector_type(2)));
typedef float f32x4 __attribute__((ext_vector_type(4)));
typedef float f32x2 __attribute__((ext_vector_type(2)));
typedef float f32x16 __attribute__((ext_vector_type(16)));
typedef short bf16x8 __attribute__((ext_vector_type(8)));
using pg8::cvt_pk_bf16; using pg8::bf_lo; using pg8::bf_hi;

__device__ __forceinline__ float wave_sum(float v) {
#pragma unroll
    for (int o = 1; o < 64; o <<= 1) v += __shfl_xor(v, o);
    return v;
}
__device__ __forceinline__ float wave_max(float v) {
#pragma unroll
    for (int o = 1; o < 64; o <<= 1) v = fmaxf(v, __shfl_xor(v, o));
    return v;
}
__device__ __forceinline__ int crow(int r, int hi) { return (r & 3) + 8 * (r >> 2) + 4 * hi; }

__device__ __forceinline__ int rowmap(int mode, int n0) {
    if (mode == 0) return n0;
    if (mode == 1) {
        if (n0 < 2048) return n0;
        if (n0 < 3072) return 8192 + (n0 - 2048);
        if (n0 < 4096) return 2048 + (n0 - 3072);
        if (n0 < 5120) return 3072 + (n0 - 4096);
        if (n0 < 6144) return 9216 + (n0 - 5120);
        return 4096 + (n0 - 6144);
    }
    return 256 * (n0 >> 7) + (n0 & 127) + (mode == 3 ? 128 : 0);
}
struct P0Item { const float* W; bf16* WT; const float* gk; int K, N, mode, item, Kd, kofs; };
__device__ __forceinline__ void p0_item_load(const P0Item& d, float (&v)[32], int lane) {
    const int nblk = d.N / 32, kb = d.item / nblk, nb = d.item % nblk, k0 = 64 * kb, n0 = 32 * nb;
    const float* src = d.W + (size_t)(k0 + (lane >> 5)) * d.N + n0 + (lane & 31);
#pragma unroll
    for (int i = 0; i < 32; ++i) v[i] = __builtin_nontemporal_load(src + (size_t)(2 * i) * d.N);
}
__device__ __forceinline__ void p0_item_store(const P0Item& d, const float (&v)[32], LAS float* scr, int lane) {
    const int nblk = d.N / 32, kb = d.item / nblk, nb = d.item % nblk, k0 = 64 * kb, n0 = 32 * nb;
    const int r0 = rowmap(d.mode, n0);
    if (d.gk) {
#pragma unroll
        for (int i = 0; i < 32; ++i) { const int kk = 2 * i + (lane >> 5); scr[kk * 33 + (lane & 31)] = v[i] * d.gk[k0 + kk]; }
    } else {
#pragma unroll
        for (int i = 0; i < 32; ++i) { const int kk = 2 * i + (lane >> 5); scr[kk * 33 + (lane & 31)] = v[i]; }
    }
    asm volatile("s_waitcnt lgkmcnt(0)" ::: "memory");
    const int c = lane & 7;
#pragma unroll
    for (int j = 0; j < 4; ++j) { const int n = (lane >> 3) + 8 * j; const LAS float* s = scr + (8 * c) * 33 + n;
        u32x4 o; o.x = cvt_pk_bf16(s[0 * 33], s[1 * 33]); o.y = cvt_pk_bf16(s[2 * 33], s[3 * 33]); o.z = cvt_pk_bf16(s[4 * 33], s[5 * 33]); o.w = cvt_pk_bf16(s[6 * 33], s[7 * 33]);
        *(u32x4*)(d.WT + (size_t)(r0 + n) * d.Kd + d.kofs + k0 + 8 * c) = o; }
    asm volatile("s_waitcnt lgkmcnt(0)" ::: "memory");
}
#define RLX_AGENT __ATOMIC_RELAXED, __HIP_MEMORY_SCOPE_AGENT
#define XB_TMO      128
#define XB_XCNT(j)  (256  + 64 * (j))
#define XB_XSUB(j)  (1280 + 64 * (j))
#define XB_XGEN(j)  (2304 + 64 * (j))
#define XB_TOP      3328
#define XB_TOPGEN   3392
#define XCD_BAR_WORDS 3456
#define XB_SPIN_CAP (1u << 18)

__device__ __forceinline__ unsigned xb_ld(unsigned* p)              { return __hip_atomic_load(p, __ATOMIC_RELAXED, __HIP_MEMORY_SCOPE_AGENT); }
__device__ __forceinline__ unsigned xb_add(unsigned* p, unsigned v) { return __hip_atomic_fetch_add(p, v, __ATOMIC_RELAXED, __HIP_MEMORY_SCOPE_AGENT); }
__device__ __forceinline__ unsigned xb_xcc_id() { return (unsigned)__builtin_amdgcn_s_getreg((3 << 11) | 20) & 0xFu; }
#define XB_SPIN(cond, bar) do { unsigned _sp = 0; while (cond) { __builtin_amdgcn_s_sleep(1); \
    if ((++_sp & 255u) == 0u) { if (xb_ld(&(bar)[XB_TMO])) break; if (_sp > XB_SPIN_CAP) { atomicAdd(&(bar)[XB_TMO], 1u); break; } } } } while (0)

struct XcdBarrier {
    unsigned* bar; unsigned x;
    volatile LAS unsigned* st;
};

__device__ __forceinline__ XcdBarrier xcd_barrier_post(unsigned* bar, volatile LAS unsigned* st) {
    XcdBarrier b; b.bar = bar; b.x = xb_xcc_id(); b.st = st;
    if (threadIdx.x == 0) (void)xb_add(&bar[XB_XCNT(b.x)], 1u);
    return b;
}
__device__ __forceinline__ void xcd_barrier_complete(unsigned* bar, unsigned x, unsigned& nloc, unsigned& nx) {
    const unsigned G = gridDim.x * gridDim.y * gridDim.z;
    unsigned sum, cnt, mine, sp = 0u;
    for (;;) {
        sum = 0u; cnt = 0u; mine = 0u;
#pragma unroll
        for (unsigned j = 0; j < 16; ++j) { const unsigned c = xb_ld(&bar[XB_XCNT(j)]); sum += c; cnt += (c > 0u) ? 1u : 0u; mine = (j == x) ? c : mine; }
        if (sum == G) break;
        __builtin_amdgcn_s_sleep(1);
        if ((++sp & 255u) == 0u) { if (xb_ld(&bar[XB_TMO])) break; if (sp > XB_SPIN_CAP) { atomicAdd(&bar[XB_TMO], 1u); break; } }
    }
    nloc = mine > 0u ? mine : 1u; nx = cnt > 0u ? cnt : 1u;
}

__device__ __forceinline__ void xcd_barrier(const XcdBarrier& b) {
    asm volatile("s_waitcnt vmcnt(0)" ::: "memory");
    __syncthreads();
    if (threadIdx.x == 0) {
        unsigned* bar = b.bar;
        __builtin_amdgcn_s_waitcnt(0);
        unsigned nloc = b.st[0], nx = b.st[1];
        if (nloc == 0u) { xcd_barrier_complete(bar, b.x, nloc, nx); b.st[0] = nloc; b.st[1] = nx; }
        const unsigned old = xb_add(&bar[XB_XSUB(b.x)], 1u);
        const unsigned gen = old / nloc;
        if (old + 1u == (gen + 1u) * nloc) {
            __builtin_amdgcn_fence(__ATOMIC_RELEASE, "agent");
            asm volatile("s_waitcnt vmcnt(0)" ::: "memory");
            const unsigned og = xb_add(&bar[XB_TOP], 1u);
            const unsigned tg = og / nx;
            if (og + 1u == (tg + 1u) * nx) xb_add(&bar[XB_TOPGEN], 1u);
            else XB_SPIN(xb_ld(&bar[XB_TOPGEN]) == tg, bar);
            __builtin_amdgcn_fence(__ATOMIC_ACQUIRE, "agent");
            xb_add(&bar[XB_XGEN(b.x)], 1u);
            asm volatile("s_waitcnt vmcnt(0)" ::: "memory");
        } else {
            XB_SPIN(xb_ld(&bar[XB_XGEN(b.x)]) == gen, bar);
            __builtin_amdgcn_fence(__ATOMIC_ACQUIRE, "agent");
            asm volatile("s_waitcnt vmcnt(0)" ::: "memory");
        }
    }
    __syncthreads();
}
struct Args {
    const float *x, *p, *g_mix, *w_in, *g_na_q, *g_na_k, *na_rpb, *g_df_q, *g_df_k, *lam_q1, *lam_k1, *lam_q2, *lam_k2, *g_df_sub,
                *w_na_out, *w_df_out, *w_o, *g_ffn, *w_gate, *w_up, *w_down, *g_ple, *w_ple_gate, *w_ple_proj;
    float* out; unsigned char* ws; int ph_lo, ph_hi, rep3, pad;
};

__device__ __forceinline__ void na_wave_unit(const bf16* QKG, const bf16* VT, const float* rpb, bf16* NAO, float M2, int b, int h, int r, int half) {
    int tid_ = threadIdx.x; asm volatile("" : "+v"(tid_)); const int lane = tid_ & 63;
    const int q = lane & 31, hi = lane >> 5, c = 32 * half + q;
    const size_t tokq = (size_t)b * SEQ + r * GW + c;
    bf16x8 qf[8];
#pragma unroll
    for (int d0 = 0; d0 < 8; ++d0) qf[d0] = *(const bf16x8*)(QKG + tokq * NQKG + QC_NAQ + h * NA_DH + 16 * d0 + 8 * hi);
    int rs = r - 4; rs = rs < 0 ? 0 : (rs > GROWS - 8 ? GROWS - 8 : rs);
    int cs = c - 8; cs = cs < 0 ? 0 : (cs > GW - 16 ? GW - 16 : cs);
    f32x16 o[4];
#pragma unroll
    for (int i = 0; i < 4; ++i) o[i] = (f32x16){};
    float l = 0.f;
    for (int kr = 0; kr < 8; ++kr) {
        const int krow = rs + kr, dr = krow - r + 7;
        const float* brow = rpb + (h * 15 + dr) * 31;
#pragma unroll
        for (int kb = 0; kb < 2; ++kb) {
            f32x16 s = (f32x16){};
            const bf16* kp = QKG + ((size_t)b * SEQ + krow * GW + 32 * kb + q) * NQKG + QC_NAK + h * NA_DH + 8 * hi;
#pragma unroll
            for (int d0 = 0; d0 < 8; ++d0) { const bf16x8 kf = *(const bf16x8*)(kp + 16 * d0); s = __builtin_amdgcn_mfma_f32_32x32x16_bf16(kf, qf[d0], s, 0, 0, 0); }
            float pv[16];
#pragma unroll
            for (int i = 0; i < 16; ++i) { const int kc = 32 * kb + crow(i, hi); const bool in = (kc >= cs) && (kc < cs + 16); const int dc = in ? (kc - c + 15) : 0;
                const float bias = brow[dc] * LOG2E - M2; const float e = __builtin_amdgcn_exp2f(s[i] + bias); pv[i] = in ? e : 0.f; l += pv[i]; }
            u32x4 w0, w1;
            w0.x = cvt_pk_bf16(pv[0], pv[1]); w0.y = cvt_pk_bf16(pv[2], pv[3]); w0.z = cvt_pk_bf16(pv[4], pv[5]); w0.w = cvt_pk_bf16(pv[6], pv[7]);
            w1.x = cvt_pk_bf16(pv[8], pv[9]); w1.y = cvt_pk_bf16(pv[10], pv[11]); w1.z = cvt_pk_bf16(pv[12], pv[13]); w1.w = cvt_pk_bf16(pv[14], pv[15]);
            const bf16x8 p0 = __builtin_bit_cast(bf16x8, w0), p1 = __builtin_bit_cast(bf16x8, w1);
            const bf16* vp = VT + (size_t)(h * NA_DH + q) * M + (size_t)b * SEQ + krow * GW + 32 * kb + 8 * hi;
#pragma unroll
            for (int db = 0; db < 4; ++db) {
                const bf16x8 v0 = *(const bf16x8*)(vp + (size_t)(32 * db) * M), v1 = *(const bf16x8*)(vp + (size_t)(32 * db) * M + 16);
                o[db] = __builtin_amdgcn_mfma_f32_32x32x16_bf16(v0, p0, o[db], 0, 0, 0);
                o[db] = __builtin_amdgcn_mfma_f32_32x32x16_bf16(v1, p1, o[db], 0, 0, 0);
            }
        }
    }
    l += __shfl_xor(l, 32);
    const float rl = 1.0f / l;
    bf16* op = NAO + tokq * 2048 + h * NA_DH + 4 * hi;
#pragma unroll
    for (int db = 0; db < 4; ++db)
#pragma unroll
        for (int g = 0; g < 4; ++g) { u32x2 w; w.x = cvt_pk_bf16(o[db][4 * g] * rl, o[db][4 * g + 1] * rl); w.y = cvt_pk_bf16(o[db][4 * g + 2] * rl, o[db][4 * g + 3] * rl);
            *(u32x2*)(op + 32 * db + 8 * g) = w; }
}

__device__ __forceinline__ void df_unit(LAS unsigned char* lds, const bf16* QKG, const bf16* KC, const bf16* VT, bf16* DFO, const float* g_sub, float lam, float M2, int b, int h, int qb, unsigned long long* df_wait = nullptr) {
    int tid_ = threadIdx.x; asm volatile("" : "+v"(tid_));
    const int tid = tid_, lane = tid & 63, w = __builtin_amdgcn_readfirstlane(tid >> 6), q = lane & 31, hi = lane >> 5;
    const int mm = w & 1, qg = w >> 1;
    const int q0 = qb * 128 + qg * 32;
    bf16x8 qf[4];
#pragma unroll
    for (int d0 = 0; d0 < 4; ++d0) qf[d0] = *(const bf16x8*)(QKG + ((size_t)b * SEQ + q0 + q) * NQKG + QC_DFQ + h * 128 + mm * 64 + 16 * d0 + 8 * hi);
    const unsigned char* kbase = (const unsigned char*)(KC + ((size_t)(b * 8 + h) * SEQ) * 128);
    const unsigned char* vbase = (const unsigned char*)(VT + ((size_t)(b * 16 + 8 + h) * 64) * 128 * 64);
    unsigned koff[2], voff[2];
#pragma unroll
    for (int i = 0; i < 2; ++i) {
        const int piece = w * 2 + i;
        { const int row = piece * 4 + (lane >> 4), ph = lane & 15, ch = ph ^ (row & 15); koff[i] = (unsigned)(row * 128 + ch * 8) * 2u; }
        { const int row = piece * 8 + (lane >> 3), ph = lane & 7, ch = ph ^ ((row >> 1) & 7); voff[i] = (unsigned)(row * 64 + ch * 8) * 2u; }
    }
#define DF_DMA(kt, stg) do { const unsigned char* kb_ = kbase + (size_t)(kt) * 16384; const unsigned char* vb_ = vbase + (size_t)(kt) * 16384; _Pragma("unroll") for (int _i = 0; _i < 2; ++_i) { \
        __builtin_amdgcn_global_load_lds((const unsigned*)(kb_ + koff[_i]), (LAS unsigned*)(lds + (stg) * 32768 + (w * 2 + _i) * 1024), 16, 0, 0); \
        __builtin_amdgcn_global_load_lds((const unsigned*)(vb_ + voff[_i]), (LAS unsigned*)(lds + (stg) * 32768 + 16384 + (w * 2 + _i) * 1024), 16, 0, 0); } } while (0)
    int kofs[4], vofs[4];
#pragma unroll
    for (int d0 = 0; d0 < 4; ++d0) kofs[d0] = q * 256 + (((mm * 8 + 2 * d0 + hi) ^ (q & 15)) * 16);
#pragma unroll
    for (int g = 0; g < 4; ++g) vofs[g] = 16384 + q * 128 + (((2 * g + hi) ^ ((q >> 1) & 7)) * 16);
    f32x16 o[4];
#pragma unroll
    for (int i = 0; i < 4; ++i) o[i] = (f32x16){};
    float l = 0.f;
    const float shift = (M2 > 60.0f) ? M2 : 0.0f;
    constexpr int NT = SEQ / 64;
    typedef float f32x2_t __attribute__((ext_vector_type(2))); typedef __bf16 bf16x2_t __attribute__((ext_vector_type(2)));
#define CVTPK(lo, hi) __builtin_bit_cast(unsigned, __builtin_convertvector((f32x2_t){(lo), (hi)}, bf16x2_t))
#define DF_S(dst, St_, kb_) do { bf16x8 kf_[4]; _Pragma("unroll") for (int d0 = 0; d0 < 4; ++d0) kf_[d0] = *(const LAS bf16x8*)((St_) + kofs[d0] + (kb_) * 8192); \
        dst = (f32x16){}; _Pragma("unroll") for (int d0 = 0; d0 < 4; ++d0) dst = __builtin_amdgcn_mfma_f32_32x32x16_bf16(kf_[d0], qf[d0], dst, 0, 0, 0); } while (0)
    DF_DMA(0, 0); DF_DMA(1, 1); DF_DMA(2, 2);
    asm volatile("s_waitcnt vmcnt(4)" ::: "memory");
    __builtin_amdgcn_s_barrier();
    asm volatile("" ::: "memory");
    f32x16 sc[2], sn[2];
    DF_S(sc[0], lds, 0); DF_S(sc[1], lds, 1);
    for (int kt = 0; kt < NT; ++kt) {
        if (kt + 3 < NT) DF_DMA(kt + 3, (kt + 3) & 3);
        const LAS unsigned char* St = lds + (kt & 3) * 32768;
        const LAS unsigned char* Sn = lds + ((kt + 1) & 3) * 32768;
        if (kt + 1 < NT) { DF_S(sn[0], Sn, 0); DF_S(sn[1], Sn, 1); }
#pragma unroll
        for (int kb = 0; kb < 2; ++kb) {
            bf16x8 vf[2][4];
#pragma unroll
            for (int jj = 0; jj < 2; ++jj)
#pragma unroll
                for (int db = 0; db < 4; ++db) vf[jj][db] = *(const LAS bf16x8*)(St + vofs[2 * kb + jj] + db * 4096);
            f32x16 s = sc[kb];
            if (shift != 0.f) {
#pragma unroll
                for (int i = 0; i < 16; ++i) s[i] -= shift;
            }
            float ls = 0.f;
#pragma unroll
            for (int i = 0; i < 16; ++i) { s[i] = __builtin_amdgcn_exp2f(s[i]); ls += s[i]; }
            l += ls;
            u32x4 w0, w1;
            w0.x = CVTPK(s[0], s[1]); w0.y = CVTPK(s[2], s[3]); w0.z = CVTPK(s[4], s[5]); w0.w = CVTPK(s[6], s[7]);
            w1.x = CVTPK(s[8], s[9]); w1.y = CVTPK(s[10], s[11]); w1.z = CVTPK(s[12], s[13]); w1.w = CVTPK(s[14], s[15]);
            const bf16x8 p0 = __builtin_bit_cast(bf16x8, w0), p1 = __builtin_bit_cast(bf16x8, w1);
#pragma unroll
            for (int db = 0; db < 4; ++db) o[db] = __builtin_amdgcn_mfma_f32_32x32x16_bf16(vf[0][db], p0, o[db], 0, 0, 0);
#pragma unroll
            for (int db = 0; db < 4; ++db) o[db] = __builtin_amdgcn_mfma_f32_32x32x16_bf16(vf[1][db], p1, o[db], 0, 0, 0);
        }
        sc[0] = sn[0]; sc[1] = sn[1];
#ifdef PROBE_DFWAIT
        const unsigned long long tw0_ = __builtin_amdgcn_s_memrealtime();
#endif
        if (kt + 3 < NT) asm volatile("s_waitcnt vmcnt(4) lgkmcnt(0)" ::: "memory"); else asm volatile("s_waitcnt vmcnt(0) lgkmcnt(0)" ::: "memory");
#if defined(PROBE_DFWAIT) && PROBE_DFWAIT == 2
        const unsigned long long tw1_ = __builtin_amdgcn_s_memrealtime(); if (df_wait) *df_wait += tw1_ - tw0_;
#endif
        __builtin_amdgcn_s_barrier();
        asm volatile("" ::: "memory");
#if defined(PROBE_DFWAIT) && PROBE_DFWAIT == 1
        const unsigned long long tw1_ = __builtin_amdgcn_s_memrealtime(); if (df_wait) *df_wait += tw1_ - tw0_;
#endif
    }
#undef DF_S
#undef CVTPK
#undef DF_DMA
    LAS float* xch = (LAS float*)lds;
    { float lt = l; lt += __shfl_xor(lt, 32);
      const float sc = (mm == 1 ? lam : 1.0f) / lt;
#pragma unroll
      for (int db = 0; db < 4; ++db)
#pragma unroll
          for (int i = 0; i < 16; ++i) o[db][i] *= sc; }
    if (mm == 1) {
#pragma unroll
        for (int db = 0; db < 4; ++db)
#pragma unroll
            for (int i = 0; i < 16; ++i) xch[(qg * 64 + db * 16 + i) * 64 + lane] = o[db][i];
    }
    __syncthreads();
    if (mm == 0) {
        float ss = 0.f;
#pragma unroll
        for (int db = 0; db < 4; ++db)
#pragma unroll
            for (int i = 0; i < 16; ++i) { const float v = o[db][i] - xch[(qg * 64 + db * 16 + i) * 64 + lane]; o[db][i] = v; ss += v * v; }
        ss += __shfl_xor(ss, 32);
        const float rn = __builtin_amdgcn_rsqf(ss * (1.0f / 128.0f) + EPS) * (1.0f - LAM_INIT);
        bf16* op = DFO + ((size_t)b * SEQ + q0 + q) * 2048 + h * 128 + 4 * hi;
#pragma unroll
        for (int db = 0; db < 4; ++db)
#pragma unroll
            for (int g = 0; g < 4; ++g) { const f32x4 gs = *(const f32x4*)(g_sub + 32 * db + 8 * g + 4 * hi);
                u32x2 wv; wv.x = cvt_pk_bf16(o[db][4 * g] * rn * gs[0], o[db][4 * g + 1] * rn * gs[1]); wv.y = cvt_pk_bf16(o[db][4 * g + 2] * rn * gs[2], o[db][4 * g + 3] * rn * gs[3]);
                *(u32x2*)(op + 32 * db + 8 * g) = wv; }
    }
    __syncthreads();
}

__device__ __forceinline__ void na_unit(LAS unsigned char* lds, const bf16* QKG, const bf16* KC, const bf16* VT, const float* rpb, bf16* NAO, float M2, int b, int h, int r0) {
    int tid_ = threadIdx.x; asm volatile("" : "+v"(tid_));
    const int tid = tid_, lane = tid & 63, w = __builtin_amdgcn_readfirstlane(tid >> 6), q = lane & 31, hi = lane >> 5;
    const int rq = r0 + (w >> 1), half = w & 1, c = 32 * half + q;
    const size_t tokq = (size_t)b * SEQ + rq * GW + c;
    bf16x8 qf[8];
#pragma unroll
    for (int d0 = 0; d0 < 8; ++d0) qf[d0] = *(const bf16x8*)(QKG + tokq * NQKG + QC_NAQ + h * NA_DH + 16 * d0 + 8 * hi);
    int rs = rq - 4; rs = rs < 0 ? 0 : (rs > GROWS - 8 ? GROWS - 8 : rs);
    int cs = c - 8; cs = cs < 0 ? 0 : (cs > GW - 16 ? GW - 16 : cs);
    int klo = r0 - 4; klo = klo < 0 ? 0 : (klo > GROWS - 8 ? GROWS - 8 : klo);
    int khi = r0 + 3 - 4; khi = (khi < 0 ? 0 : (khi > GROWS - 8 ? GROWS - 8 : khi)) + 7;
    const int nst = khi - klo + 1;
    const unsigned char* kbase = (const unsigned char*)(KC + ((size_t)(b * 8 + h) * SEQ + klo * GW) * 128);
    const unsigned char* vbase = (const unsigned char*)(VT + ((size_t)(b * 16 + h) * 64 + klo) * 128 * 64);
    unsigned koff[2], voff[2];
#pragma unroll
    for (int i = 0; i < 2; ++i) {
        const int piece = w * 2 + i;
        { const int row = piece * 4 + (lane >> 4), ph = lane & 15, ch = ph ^ (row & 15); koff[i] = (unsigned)(row * 128 + ch * 8) * 2u; }
        { const int row = piece * 8 + (lane >> 3), ph = lane & 7, ch = ph ^ ((row >> 1) & 7); voff[i] = (unsigned)(row * 64 + ch * 8) * 2u; }
    }
#define NA_DMA(t, stg) do { const unsigned char* kb_ = kbase + (size_t)(t) * 16384; const unsigned char* vb_ = vbase + (size_t)(t) * 16384; _Pragma("unroll") for (int _i = 0; _i < 2; ++_i) { \
        __builtin_amdgcn_global_load_lds((const unsigned*)(kb_ + koff[_i]), (LAS unsigned*)(lds + (stg) * 32768 + (w * 2 + _i) * 1024), 16, 0, 0); \
        __builtin_amdgcn_global_load_lds((const unsigned*)(vb_ + voff[_i]), (LAS unsigned*)(lds + (stg) * 32768 + 16384 + (w * 2 + _i) * 1024), 16, 0, 0); } } while (0)
    int kofs[8], vofs[4];
#pragma unroll
    for (int d0 = 0; d0 < 8; ++d0) kofs[d0] = q * 256 + (((2 * d0 + hi) ^ (q & 15)) * 16);
#pragma unroll
    for (int g = 0; g < 4; ++g) vofs[g] = 16384 + q * 128 + (((2 * g + hi) ^ ((q >> 1) & 7)) * 16);
    f32x16 o[4];
#pragma unroll
    for (int i = 0; i < 4; ++i) o[i] = (f32x16){};
    float l = 0.f;
    LAS float* btab = (LAS float*)(lds + 131072 + 1024);
    for (int i = tid; i < 15 * 31; i += NTHREADS) btab[i] = rpb[h * 15 * 31 + i] * LOG2E - M2;
    asm volatile("s_waitcnt vmcnt(0) lgkmcnt(0)" ::: "memory");
    __builtin_amdgcn_s_barrier();
    asm volatile("" ::: "memory");
    NA_DMA(0, 0); NA_DMA(1, 1);
    asm volatile("s_waitcnt vmcnt(4)" ::: "memory");
    __builtin_amdgcn_s_barrier();
    asm volatile("" ::: "memory");
    for (int t = 0; t < nst; ++t) {
        if (t + 2 < nst) NA_DMA(t + 2, (t + 2) & 3);
        const int krow = klo + t;
        if (krow >= rs && krow < rs + 8) {
            const LAS unsigned char* St = lds + (t & 3) * 32768;
            const LAS float* brow = btab + (krow - rq + 7) * 31;
#pragma unroll 1
            for (int kb = 0; kb < 2; ++kb) {
                f32x16 s = (f32x16){};
#pragma unroll
                for (int d0 = 0; d0 < 8; ++d0) { const bf16x8 kf = *(const LAS bf16x8*)(St + kofs[d0] + kb * 8192); s = __builtin_amdgcn_mfma_f32_32x32x16_bf16(kf, qf[d0], s, 0, 0, 0); }
                bf16x8 vf[2][4];
#pragma unroll
                for (int jj = 0; jj < 2; ++jj)
#pragma unroll
                    for (int db = 0; db < 4; ++db) vf[jj][db] = *(const LAS bf16x8*)(St + (kb ? vofs[2 + jj] : vofs[jj]) + db * 4096);
                float pv[16];
                const LAS float* bp = brow + (4 * hi - c + 15 + 32 * kb);
                const int wa = 4 * hi - cs + 32 * kb;
#pragma unroll
                for (int i = 0; i < 16; ++i) { const int e0 = (i & 3) + 8 * (i >> 2); const float bias = bp[e0]; const float e = __builtin_amdgcn_exp2f(s[i] + bias);
                    pv[i] = ((unsigned)(wa + e0) < 16u) ? e : 0.f; l += pv[i]; }
                u32x4 w0, w1;
                w0.x = cvt_pk_bf16(pv[0], pv[1]); w0.y = cvt_pk_bf16(pv[2], pv[3]); w0.z = cvt_pk_bf16(pv[4], pv[5]); w0.w = cvt_pk_bf16(pv[6], pv[7]);
                w1.x = cvt_pk_bf16(pv[8], pv[9]); w1.y = cvt_pk_bf16(pv[10], pv[11]); w1.z = cvt_pk_bf16(pv[12], pv[13]); w1.w = cvt_pk_bf16(pv[14], pv[15]);
                const bf16x8 p0 = __builtin_bit_cast(bf16x8, w0), p1 = __builtin_bit_cast(bf16x8, w1);
#pragma unroll
                for (int db = 0; db < 4; ++db) o[db] = __builtin_amdgcn_mfma_f32_32x32x16_bf16(vf[0][db], p0, o[db], 0, 0, 0);
#pragma unroll
                for (int db = 0; db < 4; ++db) o[db] = __builtin_amdgcn_mfma_f32_32x32x16_bf16(vf[1][db], p1, o[db], 0, 0, 0);
            }
        }
        if (t + 2 < nst) asm volatile("s_waitcnt vmcnt(4) lgkmcnt(0)" ::: "memory"); else asm volatile("s_waitcnt vmcnt(0) lgkmcnt(0)" ::: "memory");
        __builtin_amdgcn_s_barrier();
        asm volatile("" ::: "memory");
    }
#undef NA_DMA
    l += __shfl_xor(l, 32);
    const float rl = 1.0f / l;
    bf16* op = NAO + tokq * 2048 + h * NA_DH + 4 * hi;
#pragma unroll
    for (int db = 0; db < 4; ++db)
#pragma unroll
        for (int g = 0; g < 4; ++g) { u32x2 wv; wv.x = cvt_pk_bf16(o[db][4 * g] * rl, o[db][4 * g + 1] * rl); wv.y = cvt_pk_bf16(o[db][4 * g + 2] * rl, o[db][4 * g + 3] * rl);
            *(u32x2*)(op + 32 * db + 8 * g) = wv; }
}
template <int TB>
__device__ __forceinline__ void qknorm_batch(bf16* QKG, bf16* KCna, bf16* KCdf, int m0, int mstride, const float* gnq, const float* gnk, const float* gdq, const float* gdk, const f32x2* rope, int lane) {
    const float QS_NA = 0.08838834764831845f * LOG2E, QS_DF = 0.125f * LOG2E;
    u32x4 na[TB][4], da[TB][2], db[TB][2];
#pragma unroll
    for (int t = 0; t < TB; ++t) { int mt = m0 + t * mstride; if (mt >= M) mt = M - 1; bf16* row = QKG + (size_t)mt * NQKG;
#pragma unroll
        for (int j = 0; j < 4; ++j) na[t][j] = *(const u32x4*)(row + 512 * j + 8 * lane);
#pragma unroll
        for (int j = 0; j < 2; ++j) { const bf16* p1 = row + 2048 + 1024 * j + 64 * (lane >> 2) + 8 * (lane & 3); da[t][j] = *(const u32x4*)p1; db[t][j] = *(const u32x4*)(p1 + 32); } }
#pragma unroll
    for (int t = 0; t < TB; ++t) { const int mt = m0 + t * mstride; if (mt >= M) break; bf16* row = QKG + (size_t)mt * NQKG; const int pos = mt & (SEQ - 1);
#pragma unroll
        for (int j = 0; j < 4; ++j) {
            const u32x4 w = na[t][j];
            float v[8] = {bf_lo(w.x), bf_hi(w.x), bf_lo(w.y), bf_hi(w.y), bf_lo(w.z), bf_hi(w.z), bf_lo(w.w), bf_hi(w.w)};
            float ss = 0.f;
#pragma unroll
            for (int i = 0; i < 8; ++i) ss += v[i] * v[i];
            ss += __shfl_xor(ss, 1); ss += __shfl_xor(ss, 2); ss += __shfl_xor(ss, 4); ss += __shfl_xor(ss, 8);
            const float rs = __builtin_amdgcn_rsqf(ss * (1.0f / 128.0f) + EPS) * (j < 2 ? QS_NA : 1.0f);
            const float* g = (j < 2 ? gnq : gnk) + 8 * (lane & 15);
#pragma unroll
            for (int i = 0; i < 8; ++i) v[i] = v[i] * rs * g[i];
            u32x4 o; o.x = cvt_pk_bf16(v[0], v[1]); o.y = cvt_pk_bf16(v[2], v[3]); o.z = cvt_pk_bf16(v[4], v[5]); o.w = cvt_pk_bf16(v[6], v[7]);
            if (j < 2) *(u32x4*)(row + 512 * j + 8 * lane) = o;
            else { const int x = 512 * (j - 2) + 8 * lane;
                   *(u32x4*)(KCna + ((size_t)((mt >> 12) * 8 + (x >> 7)) * SEQ + pos) * 128 + (x & 127)) = o; }
        }
#pragma unroll
        for (int j = 0; j < 2; ++j) {
            bf16* p1 = row + 2048 + 1024 * j + 64 * (lane >> 2) + 8 * (lane & 3); bf16* p2 = p1 + 32;
            const u32x4 wa = da[t][j], wb = db[t][j];
            float a[8] = {bf_lo(wa.x), bf_hi(wa.x), bf_lo(wa.y), bf_hi(wa.y), bf_lo(wa.z), bf_hi(wa.z), bf_lo(wa.w), bf_hi(wa.w)};
            float c[8] = {bf_lo(wb.x), bf_hi(wb.x), bf_lo(wb.y), bf_hi(wb.y), bf_lo(wb.z), bf_hi(wb.z), bf_lo(wb.w), bf_hi(wb.w)};
            float ss = 0.f;
#pragma unroll
            for (int i = 0; i < 8; ++i) ss += a[i] * a[i] + c[i] * c[i];
            ss += __shfl_xor(ss, 1); ss += __shfl_xor(ss, 2);
            const float rs = __builtin_amdgcn_rsqf(ss * (1.0f / 64.0f) + EPS);
            const float* g = (j == 0 ? gdq : gdk) + 8 * (lane & 3);
            const f32x2* rp = rope + pos * 32 + 8 * (lane & 3);
            const float qs = (j == 0 ? QS_DF : 1.0f);
            float o1[8], o2[8];
#pragma unroll
            for (int i = 0; i < 8; ++i) { const float x1 = a[i] * rs * g[i], x2 = c[i] * rs * g[32 + i]; const f32x2 cs = rp[i]; o1[i] = (x1 * cs.x - x2 * cs.y) * qs; o2[i] = (x1 * cs.y + x2 * cs.x) * qs; }
            u32x4 oa, ob; oa.x = cvt_pk_bf16(o1[0], o1[1]); oa.y = cvt_pk_bf16(o1[2], o1[3]); oa.z = cvt_pk_bf16(o1[4], o1[5]); oa.w = cvt_pk_bf16(o1[6], o1[7]);
            ob.x = cvt_pk_bf16(o2[0], o2[1]); ob.y = cvt_pk_bf16(o2[2], o2[3]); ob.z = cvt_pk_bf16(o2[4], o2[5]); ob.w = cvt_pk_bf16(o2[6], o2[7]);
            if (j == 0) { *(u32x4*)p1 = oa; *(u32x4*)p2 = ob; }
            else { const int x = 64 * (lane >> 2) + 8 * (lane & 3); bf16* kp = KCdf + ((size_t)((mt >> 12) * 8 + (x >> 7)) * SEQ + pos) * 128 + (x & 127);
                   *(u32x4*)kp = oa; *(u32x4*)(kp + 32) = ob; }
        }
    }
}

__device__ __forceinline__ void grid_barrier(unsigned* cnt, unsigned target) {
    asm volatile("s_waitcnt vmcnt(0) lgkmcnt(0)" ::: "memory");
    __syncthreads();
    if (threadIdx.x == 0) {
        __builtin_amdgcn_fence(__ATOMIC_RELEASE, "agent");
        asm volatile("s_waitcnt vmcnt(0)" ::: "memory");
        __hip_atomic_fetch_add(cnt, 1u, __ATOMIC_RELAXED, __HIP_MEMORY_SCOPE_AGENT);
        while (__hip_atomic_load(cnt, __ATOMIC_RELAXED, __HIP_MEMORY_SCOPE_AGENT) < target) __builtin_amdgcn_s_sleep(2);
        __builtin_amdgcn_fence(__ATOMIC_ACQUIRE, "agent");
        asm volatile("s_waitcnt vmcnt(0)" ::: "memory");
    }
    __syncthreads();
}
constexpr int NPHASE = 9;
__global__ void __launch_bounds__(NTHREADS, 2) fwd_megakernel(Args a) {
    extern __shared__ __attribute__((aligned(16))) unsigned char lds_raw[];
    LAS unsigned char* lds = (LAS unsigned char*)lds_raw;
    cg::grid_group grid = cg::this_grid();
    const int G = gridDim.x, bx = blockIdx.x;
    const int vcu = (G % 8 == 0) ? (bx % 8) * (G / 8) + bx / 8 : bx;
    const int NGW = G * NWAVES;
typedef __attribute__((opencl_constant)) const Args* CArgsP;
#define FRESH_ARGS() auto kp_ = __builtin_amdgcn_kernarg_segment_ptr(); asm volatile("" : "+s"(kp_)); const CArgsP ap = (CArgsP)kp_
#define FRESH_TID() int tid_ = threadIdx.x; asm volatile("" : "+v"(tid_)); const int tid = tid_, lane = tid & 63, wave = __builtin_amdgcn_readfirstlane(tid >> 6), gw = vcu * NWAVES + wave; (void)lane; (void)gw
    unsigned char* ws = a.ws;
    float* RS1 = (float*)(ws + WS_RS1); float* RS2 = (float*)(ws + WS_RS2); f32x2* ROPE = (f32x2*)(ws + WS_ROPE);
    bf16 *W1t = (bf16*)(ws + WS_W1), *Wna = (bf16*)(ws + WS_WNA), *Wdf = (bf16*)(ws + WS_WDF), *Wo = (bf16*)(ws + WS_WO), *Wgu = (bf16*)(ws + WS_WGU), *Wdn = (bf16*)(ws + WS_WDN), *Wpg = (bf16*)(ws + WS_WPG), *Wpp = (bf16*)(ws + WS_WPP);
    bf16 *QKG = (bf16*)(ws + WS_A), *HB = (bf16*)(ws + WS_A);
    bf16 *XN = (bf16*)(ws + WS_B), *AO = (bf16*)(ws + WS_B), *X1B = (bf16*)(ws + WS_B), *X2B = (bf16*)(ws + WS_B);
    bf16 *VT = (bf16*)(ws + WS_C), *MRG = (bf16*)(ws + WS_C), *T2B = (bf16*)(ws + WS_C), *PB = (bf16*)(ws + WS_PB);
    bf16* KCna = (bf16*)a.out; bf16* KCdf = KCna + (size_t)M * 1024;
    const int lo = a.ph_lo, hi_ph = a.ph_hi;
    if (lo < 0) grid.sync();
    { volatile LAS unsigned* st0 = (volatile LAS unsigned*)(lds + 131072 + 768); if (threadIdx.x < 2) st0[threadIdx.x] = 0u; __syncthreads(); }
    XcdBarrier xbar = xcd_barrier_post((unsigned*)(ws + 8192), (volatile LAS unsigned*)(lds + 131072 + 768));
#ifndef PHASE_MASK
#define PHASE_MASK 0x1ff
#endif
#define IN(k) (((PHASE_MASK >> (k)) & 1) && lo <= (k) && (k) < hi_ph)
#ifdef PROBE_TS
#define STAMP(k) do { if (bx == 0 && threadIdx.x == 0) ((volatile unsigned long long*)(ws + 2048))[k] = __builtin_amdgcn_s_memrealtime(); } while (0)
#else
#define STAMP(k) do {} while (0)
#endif
#define GBAR(idx) xcd_barrier(xbar)
#define SEAM(k) do { if (IN(k) && IN((k) + 1)) GBAR(k); STAMP((k) + 1); } while (0)
#ifndef PROBE_DUP
#define PROBE_DUP 0
#endif
#define NREP(k) (((PROBE_DUP >> (k)) & 1) ? 2 : 1)

    STAMP(0);
    for (int rep_ = 0; rep_ < NREP(0); ++rep_) {
    if (IN(0)) {
        FRESH_ARGS();
        FRESH_TID();
        LAS float* scr = (LAS float*)(lds + wave * 16384);
        constexpr int I_IN = 32 * 320, I_NA = 16 * 64, I_O = 32 * 64, I_G = 32 * 176, I_DN = 88 * 64, I_PP = 4 * 64;
        constexpr int NITEMS = I_IN + 2 * I_NA + I_O + 2 * I_G + I_DN + I_O + I_PP;
#define P0_DECODE(it_, d_) do { int r = (it_); \
            if (r < I_IN) { d_ = P0Item{ap->w_in, W1t, nullptr, D, 10240, 1, r, D, 0}; break; } r -= I_IN; \
            if (r < I_NA) { d_ = P0Item{ap->w_na_out, Wna, nullptr, 1024, D, 0, r, 2048, 0}; break; } r -= I_NA; \
            if (r < I_NA) { d_ = P0Item{ap->w_df_out, Wna, nullptr, 1024, D, 0, r, 2048, 1024}; break; } r -= I_NA; \
            if (r < I_O) { d_ = P0Item{ap->w_o, Wo, nullptr, D, D, 0, r, D, 0}; break; } r -= I_O; \
            if (r < I_G) { d_ = P0Item{ap->w_gate, Wgu, ap->g_ffn, D, FF, 2, r, D, 0}; break; } r -= I_G; \
            if (r < I_G) { d_ = P0Item{ap->w_up, Wgu, ap->g_ffn, D, FF, 3, r, D, 0}; break; } r -= I_G; \
            if (r < I_DN) { d_ = P0Item{ap->w_down, Wdn, nullptr, FF, D, 0, r, FF, 0}; break; } r -= I_DN; \
            if (r < I_O) { d_ = P0Item{ap->w_ple_gate, Wpg, ap->g_ple, D, D, 0, r, D, 0}; break; } r -= I_O; \
            d_ = P0Item{ap->w_ple_proj, Wpp, nullptr, PLE, D, 0, r, PLE, 0}; } while (0)
        {
            float cur[32], nxt[32]; P0Item dc, dn;
            int it = gw;
            if (it < NITEMS) { P0_DECODE(it, dc); p0_item_load(dc, cur, lane); }
            for (; it < NITEMS; it += NGW) {
                const int nit = it + NGW; const bool more = nit < NITEMS;
                if (more) { P0_DECODE(nit, dn); p0_item_load(dn, nxt, lane); }
                p0_item_store(dc, cur, scr, lane);
                if (more) { dc = dn;
#pragma unroll
                    for (int i = 0; i < 32; ++i) cur[i] = nxt[i]; }
            }
        }
#undef P0_DECODE
        for (int m = gw; m < M; m += NGW) {
            const f32x4* xr = (const f32x4*)(ap->x + (size_t)m * D) + lane; const f32x4* gr = (const f32x4*)ap->g_mix + lane;
            f32x4 v[8]; float s = 0.f;
#pragma unroll
            for (int j = 0; j < 8; ++j) { v[j] = __builtin_nontemporal_load(xr + 64 * j); s += (v[j].x * v[j].x + v[j].y * v[j].y) + (v[j].z * v[j].z + v[j].w * v[j].w); }
            const float rs = __builtin_amdgcn_rsqf(wave_sum(s) * (1.0f / D) + EPS);
            u32x2* o8 = (u32x2*)(XN + (size_t)m * D) + lane;
#pragma unroll
            for (int j = 0; j < 8; ++j) { const f32x4 g = gr[64 * j]; u32x2 w; w.x = cvt_pk_bf16(v[j].x * rs * g.x, v[j].y * rs * g.y); w.y = cvt_pk_bf16(v[j].z * rs * g.z, v[j].w * rs * g.w); o8[64 * j] = w; }
        }
        const int gt = vcu * NTHREADS + tid, NGT = G * NTHREADS;
        for (int i = gt; i < M * PLE / 8; i += NGT) { const f32x4 p0 = __builtin_nontemporal_load((const f32x4*)ap->p + 2 * i), p1 = __builtin_nontemporal_load((const f32x4*)ap->p + 2 * i + 1);
            u32x4 w; w.x = cvt_pk_bf16(p0.x, p0.y); w.y = cvt_pk_bf16(p0.z, p0.w); w.z = cvt_pk_bf16(p1.x, p1.y); w.w = cvt_pk_bf16(p1.z, p1.w); ((u32x4*)PB)[i] = w; }
        for (int i = gt; i < SEQ * 32; i += NGT) { const int pos = i >> 5, k = i & 31;
            const float inv = (float)(1.0 / pow(10000.0, (double)k / 32.0)); const float ang = (float)pos * inv;
            f32x2 cs; cs.x = (float)cos((double)ang); cs.y = (float)sin((double)ang); ROPE[i] = cs; }
        for (int i = gt; i < M; i += NGT) { RS1[i] = 0.f; RS2[i] = 0.f; }
    }
    }
    SEAM(0);
    for (int rep_ = 0; rep_ < NREP(1); ++rep_) {
    if (IN(1)) {
        FRESH_ARGS();
        { pg8::Gemm g{XN, W1t, M, NQKG, D}; pg8::StaticOrder S; S.init(M, NQKG, G, bx); pg8::EpiQKG E{QKG, NQKG};
          pg8::gemm_phase<pg8::EpiQKG, pg8::StaticOrder, true, true>(lds, g, S, E); }
        { pg8::Gemm g{W1t + (size_t)NQKG * D, XN, 2048, M, D}; pg8::StaticOrder S; S.init(2048, M, G, bx); pg8::EpiVT E{VT, M};
          pg8::gemm_phase<pg8::EpiVT, pg8::StaticOrder, true, true>(lds, g, S, E); }
    }
    }
    SEAM(1);
    if (IN(2)) {
        FRESH_ARGS();
        FRESH_TID();
        for (int m0 = gw; m0 < M; m0 += 4 * NGW) qknorm_batch<4>(QKG, KCna, KCdf, m0, NGW, ap->g_na_q, ap->g_na_k, ap->g_df_q, ap->g_df_k, ROPE, lane);
    }
    SEAM(2);
    for (int rep_ = 0; rep_ < NREP(3); ++rep_) {
    if (IN(3)) {
        FRESH_ARGS();
        FRESH_TID();
        LAS float* red = (LAS float*)(lds + 131072);
        float mq = 0.f, mk = 0.f, mdq = 0.f, mdk = 0.f, mb = 0.f;
        if (tid < 128) { mq = fabsf(ap->g_na_q[tid]); mk = fabsf(ap->g_na_k[tid]); }
        if (tid < 64) { mdq = fabsf(ap->g_df_q[tid]); mdk = fabsf(ap->g_df_k[tid]); }
        for (int i = tid; i < NA_H * 15 * 31; i += NTHREADS) mb = fmaxf(mb, ap->na_rpb[i]);
        mq = wave_max(mq); mk = wave_max(mk); mdq = wave_max(mdq); mdk = wave_max(mdk); mb = wave_max(mb);
        float d1 = 0.f, d2 = 0.f;
        if (wave == 0) { d1 = wave_sum(ap->lam_q1[lane] * ap->lam_k1[lane]); d2 = wave_sum(ap->lam_q2[lane] * ap->lam_k2[lane]); }
        if (lane == 0) { red[wave * 8 + 0] = mq; red[wave * 8 + 1] = mk; red[wave * 8 + 2] = mdq; red[wave * 8 + 3] = mdk; red[wave * 8 + 4] = mb; red[wave * 8 + 5] = d1; red[wave * 8 + 6] = d2; }
        __syncthreads();
        mq = 0.f; mk = 0.f; mdq = 0.f; mdk = 0.f; mb = 0.f;
#pragma unroll
        for (int w = 0; w < 8; ++w) { mq = fmaxf(mq, red[w * 8]); mk = fmaxf(mk, red[w * 8 + 1]); mdq = fmaxf(mdq, red[w * 8 + 2]); mdk = fmaxf(mdk, red[w * 8 + 3]); mb = fmaxf(mb, red[w * 8 + 4]); }
        const float lam = expf(red[5]) - expf(red[6]) + LAM_INIT;
        const float M2na = (11.313708498984761f * mq * mk + mb) * LOG2E + 0.125f;
        const float M2df = (8.0f * mdq * mdk) * LOG2E + 0.125f;
        __syncthreads();
#ifndef NO_DF
        for (int uu = 2 * vcu; uu < BATCH * DF_H * (SEQ / 128); uu += 2 * G)
            for (int i2 = 0; i2 < 2; ++i2) { const int uidx = uu + i2, bh = uidx >> 5, qb = uidx & 31;
#ifdef PROBE_DFWAIT
                unsigned long long dfw_ = 0;
                df_unit(lds, QKG, KCdf, VT, AO + 1024, ap->g_df_sub, lam, M2df, bh >> 3, bh & 7, qb, &dfw_);
                if (bx == 0 && threadIdx.x == 0) { volatile unsigned long long* TS = (volatile unsigned long long*)(ws + 2048); TS[11] = (i2 ? TS[11] : 0ull) + dfw_; TS[12] = 0ull; }
#else
                df_unit(lds, QKG, KCdf, VT, AO + 1024, ap->g_df_sub, lam, M2df, bh >> 3, bh & 7, qb);
#endif
            }
#endif
        STAMP(10);
#ifdef PROBE_TS
        if (threadIdx.x == 0) { atomicMax((unsigned long long*)(ws + 2048) + 14, (unsigned long long)__builtin_amdgcn_s_memrealtime()); atomicMin((unsigned long long*)(ws + 2048) + 16, (unsigned long long)__builtin_amdgcn_s_memrealtime()); }
#endif
#ifndef NO_NA
        for (int uidx = vcu; uidx < BATCH * NA_H * (GROWS / 4); uidx += G) {
            const int bh = uidx >> 4, rg = uidx & 15;
            na_unit(lds, QKG, KCna, VT, ap->na_rpb, AO, M2na, bh >> 3, bh & 7, rg * 4);
        }
        STAMP(13);
#ifdef PROBE_TS
        if (threadIdx.x == 0) atomicMax((unsigned long long*)(ws + 2048) + 15, (unsigned long long)__builtin_amdgcn_s_memrealtime());
#endif
#endif
    }
    }
    SEAM(3);
    for (int rep_ = 0; rep_ < NREP(4); ++rep_) {
    if (IN(4)) {
        FRESH_ARGS();
        { pg8::Gemm g{AO, Wna, M, D, 2048, 16}; pg8::PairOrder S; S.S.init(M, D, G, bx); S.kob = 1024 * 2; pg8::EpiMerge E{QKG + QC_GA, QKG + QC_GB, NQKG, MRG, D, 16};
          pg8::gemm_phase<pg8::EpiMerge, pg8::PairOrder, true, true>(lds, g, S, E); }
    }
    }
    SEAM(4);
    if (IN(5)) {
        FRESH_ARGS();
        pg8::Gemm g{MRG, Wo, M, D, D}; pg8::StaticOrder S; S.init(M, D, G, bx); pg8::EpiResid<false> E{ap->x, X1B, RS1, D};
        pg8::gemm_phase<pg8::EpiResid<false>, pg8::StaticOrder, true, true>(lds, g, S, E);
    }
    SEAM(5);
    for (int rep_ = 0; rep_ < NREP(6); ++rep_) {
    if (IN(6)) {
        FRESH_ARGS();
        pg8::Gemm g{X1B, Wgu, M, 2 * FF, D}; pg8::StaticOrder S; S.init(M, 2 * FF, G, bx); pg8::EpiSwiGLU E{RS1, HB, FF, 1.0f / D, EPS};
        pg8::gemm_phase<pg8::EpiSwiGLU, pg8::StaticOrder, true, true>(lds, g, S, E);
        { constexpr int NU6 = (M / 256) * (2 * FF / 256), NU8 = (M / 256) * (D / 256);
          const int rem = NU6 % G, nshort = rem ? G - rem : G;
          pg8::TailOrder T; T.first = (rem == 0) ? bx : (bx >= rem ? bx - rem : -1); T.stride = nshort; T.total = NU8;
          int kple = PLE; asm volatile("" : "+s"(kple));
          pg8::Gemm g2{PB, Wpp, M, D, kple}; pg8::EpiStoreBf16 E2{T2B, D};
          pg8::gemm_phase<pg8::EpiStoreBf16, pg8::TailOrder, true, true>(lds, g2, T, E2); }
    }
    }
    SEAM(6);
    if (IN(7)) {
        FRESH_ARGS();
        pg8::Gemm g{HB, Wdn, M, D, FF}; pg8::StaticOrder S; S.init(M, D, G, bx); pg8::EpiResid<true> E{X1B, X2B, RS2, D};
        pg8::gemm_phase<pg8::EpiResid<true>, pg8::StaticOrder, true, true>(lds, g, S, E);
    }
    SEAM(7);
    if (IN(8)) {
        FRESH_ARGS();
#ifndef NO_P8B
        { pg8::Gemm g{X2B, Wpg, M, D, D}; pg8::StaticOrder S; S.init(M, D, G, bx); pg8::EpiPle E{RS2, T2B, X2B, ap->out, D, 1.0f / D, EPS};
          pg8::gemm_phase<pg8::EpiPle, pg8::StaticOrder, true, true>(lds, g, S, E); }
#endif
    }
#ifdef PROBE_TS
    STAMP(9);
    GBAR(8);
    { const unsigned long long* TS = (const unsigned long long*)(ws + 2048);
      const unsigned long long ta = __hip_atomic_load(TS + PROBE_A, __ATOMIC_RELAXED, __HIP_MEMORY_SCOPE_AGENT), tb = __hip_atomic_load(TS + PROBE_B, __ATOMIC_RELAXED, __HIP_MEMORY_SCOPE_AGENT);
      const int K = PROBE_CONST ? PROBE_CONST : (int)((tb - ta) / 8);
      FRESH_ARGS();
      for (int i = vcu * NTHREADS + (int)threadIdx.x; i < K && i < 42000; i += G * NTHREADS) ap->out[(size_t)i * 397] += 0.125f; }
#endif
#undef IN
#undef SEAM
}

#ifndef MK_SPLIT
#define MK_SPLIT 0
#endif
extern "C" void kernel_launch(void* const* d_in, const int* in_sizes, int n_in, void* d_out, int out_size, void* d_ws, size_t ws_size, hipStream_t stream) {
    static int grid = 0;
    if (grid == 0) {
        if (n_in != 24 || in_sizes[0] != M * D || out_size != M * D || ws_size < WS_END) { fprintf(stderr, "kernel_launch: unexpected shapes (n_in %d, in0 %d, out %d, ws %zu); nothing launched\n", n_in, n_in > 0 ? in_sizes[0] : -1, out_size, ws_size); grid = -1; return; }
        int dev = 0, cus = 0, per_cu = 0;
        hipGetDevice(&dev); hipDeviceGetAttribute(&cus, hipDeviceAttributeMultiprocessorCount, dev);
        hipFuncSetAttribute((const void*)fwd_megakernel, hipFuncAttributeMaxDynamicSharedMemorySize, LDS_BYTES);
        hipOccupancyMaxActiveBlocksPerMultiprocessor(&per_cu, (const void*)fwd_megakernel, NTHREADS, LDS_BYTES);
        if (per_cu < 1) per_cu = 1;
        grid = cus * per_cu;
        (void)hipGetLastError();
    }
    if (grid < 0) return;
    Args a{};
    const float** ap = (const float**)&a;
    for (int i = 0; i < 24; ++i) ap[i] = (const float*)d_in[i];
    a.out = (float*)d_out; a.ws = (unsigned char*)d_ws; a.rep3 = NREP(3); a.pad = 0;
#if MK_SPLIT
    for (int ph = 0; ph < NPHASE; ++ph) { a.ph_lo = ph; a.ph_hi = ph + 1; hipLaunchKernelGGL(fwd_megakernel, dim3(grid), dim3(NTHREADS), LDS_BYTES, stream, a); }
#else
    a.ph_lo = 0; a.ph_hi = NPHASE;
    (void)hipMemsetAsync((unsigned char*)d_ws + 4096, 0, 20480, stream);
#ifdef PROBE_TS
    (void)hipMemsetAsync((unsigned char*)d_ws + 2048 + 14 * 8, 0, 16, stream); (void)hipMemsetAsync((unsigned char*)d_ws + 2048 + 16 * 8, 0x7f, 8, stream);
#endif
    void* args[] = {&a};
    hipError_t e = hipLaunchCooperativeKernel((const void*)fwd_megakernel, dim3(grid), dim3(NTHREADS), args, LDS_BYTES, stream);
    if (e != hipSuccess) fprintf(stderr, "cooperative launch failed: %s (grid %d)\n", hipGetErrorString(e), grid);
#endif
}
```

```cpp
#include <hip/hip_runtime.h>
#include <hip/hip_cooperative_groups.h>
#include <cstdio>
#include <cstdint>
namespace cg = cooperative_groups;
namespace pg8 {
#define PG8_LAS __attribute__((address_space(3)))
typedef unsigned short bf16_t;
typedef short bf16x8 __attribute__((ext_vector_type(8)));
typedef float f32x4 __attribute__((ext_vector_type(4)));
typedef unsigned u32x4 __attribute__((ext_vector_type(4)));
constexpr int BM = 256, BK = 64, HALF = 128, HTB = HALF * BK * 2  , STAGE_BYTES = 8 * HTB, NXCD = 8, WGM = 8;

__host__ __device__ __forceinline__ int lds_byte(int r, int c) { const int st = (r >> 4) * 2 + (c >> 5), rr = r & 15, cc = c & 31, ob = rr * 64 + cc * 2; return st * 1024 + (ob ^ (((ob >> 9) & 1) << 5)); }
__host__ __device__ __forceinline__ void stage_rc(int b, int& R, int& C) { const int st = b / 1024, sb = b % 1024, swz = sb ^ (((sb >> 9) & 1) << 5); R = (st >> 1) * 16 + swz / 64; C = (st & 1) * 32 + (swz % 64) / 2; }
__host__ __device__ __forceinline__ int perm32(int rho) { const int n = rho >> 4, i = rho & 15; return 8 * (i >> 2) + 4 * n + (i & 3); }

struct Unit { int pm, pn; int ko = 0; };
struct Gemm { const bf16_t* A; const bf16_t* Bt; int M, N, K; int nt = 0; };

struct StaticOrder {
    int nM, nN, nwg, G, c;
    __host__ __device__ void init(int M, int N, int G_, int c_) { nM = M / BM; nN = N / BM; nwg = nM * nN; G = G_; c = c_; }
    __host__ __device__ bool next(int i, Unit& u) const {
        const long L = (long)i * G + c; if (L >= nwg) return false;
        int wgid = (int)L; { const int q = nwg / NXCD, r = nwg % NXCD, xcd = wgid % NXCD, off = wgid / NXCD; wgid = (xcd < r ? xcd * (q + 1) : r * (q + 1) + (xcd - r) * q) + off; }
        const int nig = WGM * nN, gid = wgid / nig, fm = gid * WGM, gsz = (nM - fm) < WGM ? (nM - fm) : WGM;
        u.pm = fm + ((wgid % nig) % gsz); u.pn = (wgid % nig) / gsz; return true;
    }
    __device__ __forceinline__ void a_ready(const Unit&) const {}
    __device__ __forceinline__ void done(const Unit&) const {}
};


struct TailOrder {
    int first, stride, total;
    __host__ __device__ bool next(int i, Unit& u) const { if (first < 0) return false; const int j = first + i * stride; if (j >= total) return false; u.pm = j >> 3; u.pn = j & 7; return true; }
    __device__ __forceinline__ void a_ready(const Unit&) const {}
    __device__ __forceinline__ void done(const Unit&) const {}
};

struct PairOrder {
    StaticOrder S; int kob;
    __host__ __device__ bool next(int i, Unit& u) const { if (!S.next(i >> 1, u)) return false; u.ko = (i & 1) * kob; return true; }
    __device__ __forceinline__ void a_ready(const Unit&) const {}
    __device__ __forceinline__ void done(const Unit&) const {}
};
__device__ __forceinline__ unsigned cvt_pk_bf16(float lo, float hi) { unsigned r; asm volatile("v_cvt_pk_bf16_f32 %0, %1, %2" : "=v"(r) : "v"(lo), "v"(hi)); return r; }
__device__ __forceinline__ float bf_lo(unsigned w) { return __uint_as_float(w << 16); }
__device__ __forceinline__ float bf_hi(unsigned w) { return __uint_as_float(w & 0xffff0000u); }
__device__ __forceinline__ float sigmoidf_(float x) { return __builtin_amdgcn_rcpf(1.0f + __expf(-x)); }
typedef unsigned u32x2 __attribute__((ext_vector_type(2)));
#define EPI_FENCE() asm volatile("" ::: "memory")
#define EPI_ROWS(...) _Pragma("unroll") for (int ai = 0; ai < 2; ++ai) _Pragma("unroll") for (int m = 0; m < 4; ++m) { const int row = u.pm * BM + ai * HALF + wr * 64 + m * 16 + fr; __VA_ARGS__ }

struct EpiQKG {
    static constexpr bool PERM = true, AFTER_DRAIN = false, MIDK = false;
    bf16_t* O; int ldc;
    __device__ __forceinline__ void operator()(const f32x4 (&acc)[2][2][4][2], const Unit& u, int wr, int wc, int fr, int fq) const {
        const bool gate = u.pn >= 16; const int col0 = u.pn * BM + wc * 32 + 8 * fq;
        EPI_ROWS(
            bf16_t* rowp = O + (size_t)row * ldc + col0;
            _Pragma("unroll") for (int bj = 0; bj < 2; ++bj) { f32x4 v0 = acc[ai][bj][m][0], v1 = acc[ai][bj][m][1];
                if (gate) { _Pragma("unroll") for (int j = 0; j < 4; ++j) { v0[j] = sigmoidf_(v0[j]); v1[j] = sigmoidf_(v1[j]); } }
                u32x4 w; w.x = cvt_pk_bf16(v0[0], v0[1]); w.y = cvt_pk_bf16(v0[2], v0[3]); w.z = cvt_pk_bf16(v1[0], v1[1]); w.w = cvt_pk_bf16(v1[2], v1[3]);
                *(u32x4*)(rowp + bj * HALF) = w; }
            EPI_FENCE();
        )
    }
};
struct EpiVT {
    static constexpr bool PERM = true, AFTER_DRAIN = false, MIDK = false;
    bf16_t* O; int ldc;
    __device__ __forceinline__ void operator()(const f32x4 (&acc)[2][2][4][2], const Unit& u, int wr, int wc, int fr, int fq) const {
        const int cbase = u.pn * BM + wc * 32 + 16 * (fq >> 1) + 4 * (fq & 1);
        EPI_ROWS(
            const int hv = row >> 7, dd = row & 127;
            _Pragma("unroll") for (int bj = 0; bj < 2; ++bj) _Pragma("unroll") for (int n = 0; n < 2; ++n) { const f32x4 v = acc[ai][bj][m][n];
                const int col = cbase + bj * HALF + 8 * n, bb = col >> 12, kt = (col >> 6) & 63, pos = col & 63;
                u32x2 w; w.x = cvt_pk_bf16(v[0], v[1]); w.y = cvt_pk_bf16(v[2], v[3]);
                *(u32x2*)(O + ((((size_t)(bb * 16 + hv)) * 64 + kt) * 128 + dd) * 64 + pos) = w; }
            EPI_FENCE();
        )
    }
};
struct EpiMerge {
    static constexpr bool PERM = true, AFTER_DRAIN = false, MIDK = true;
    const bf16_t* GA; const bf16_t* GB; int ldg; bf16_t* O; int ldc; int midk;
    __device__ __forceinline__ void mid(f32x4 (&acc)[2][2][4][2], const Unit& u, int wr, int wc, int fr, int fq) const {
        const int col0 = u.pn * BM + wc * 32 + 8 * fq;
        EPI_ROWS(
            _Pragma("unroll") for (int bj = 0; bj < 2; ++bj) { const size_t off = (size_t)row * ldg + col0 + bj * HALF;
                const u32x4 a = *(const u32x4*)(GA + off), b = *(const u32x4*)(GB + off);
                float r[8];
                r[0] = bf_lo(a.x) * __builtin_amdgcn_rcpf(fmaxf(bf_lo(b.x), 1e-30f)); r[1] = bf_hi(a.x) * __builtin_amdgcn_rcpf(fmaxf(bf_hi(b.x), 1e-30f));
                r[2] = bf_lo(a.y) * __builtin_amdgcn_rcpf(fmaxf(bf_lo(b.y), 1e-30f)); r[3] = bf_hi(a.y) * __builtin_amdgcn_rcpf(fmaxf(bf_hi(b.y), 1e-30f));
                r[4] = bf_lo(a.z) * __builtin_amdgcn_rcpf(fmaxf(bf_lo(b.z), 1e-30f)); r[5] = bf_hi(a.z) * __builtin_amdgcn_rcpf(fmaxf(bf_hi(b.z), 1e-30f));
                r[6] = bf_lo(a.w) * __builtin_amdgcn_rcpf(fmaxf(bf_lo(b.w), 1e-30f)); r[7] = bf_hi(a.w) * __builtin_amdgcn_rcpf(fmaxf(bf_hi(b.w), 1e-30f));
                _Pragma("unroll") for (int j = 0; j < 4; ++j) { acc[ai][bj][m][0][j] *= r[j]; acc[ai][bj][m][1][j] *= r[4 + j]; } }
            EPI_FENCE();
        )
    }
    __device__ __forceinline__ void operator()(const f32x4 (&acc)[2][2][4][2], const Unit& u, int wr, int wc, int fr, int fq) const {
        const int col0 = u.pn * BM + wc * 32 + 8 * fq;
        EPI_ROWS(
            _Pragma("unroll") for (int bj = 0; bj < 2; ++bj) { const u32x4 b = *(const u32x4*)(GB + (size_t)row * ldg + col0 + bj * HALF);
                f32x4 v0 = acc[ai][bj][m][0], v1 = acc[ai][bj][m][1];
                v0[0] *= fmaxf(bf_lo(b.x), 1e-30f); v0[1] *= fmaxf(bf_hi(b.x), 1e-30f); v0[2] *= fmaxf(bf_lo(b.y), 1e-30f); v0[3] *= fmaxf(bf_hi(b.y), 1e-30f);
                v1[0] *= fmaxf(bf_lo(b.z), 1e-30f); v1[1] *= fmaxf(bf_hi(b.z), 1e-30f); v1[2] *= fmaxf(bf_lo(b.w), 1e-30f); v1[3] *= fmaxf(bf_hi(b.w), 1e-30f);
                u32x4 w; w.x = cvt_pk_bf16(v0[0], v0[1]); w.y = cvt_pk_bf16(v0[2], v0[3]); w.z = cvt_pk_bf16(v1[0], v1[1]); w.w = cvt_pk_bf16(v1[2], v1[3]);
                *(u32x4*)(O + (size_t)row * ldc + col0 + bj * HALF) = w; }
            EPI_FENCE();
        )
    }
};
template <bool BASE_BF16> struct EpiResid {
    static constexpr bool PERM = true, AFTER_DRAIN = false, MIDK = false;
    const void* base; bf16_t* ob; float* rowss; int ldc;
    __device__ __forceinline__ void operator()(const f32x4 (&acc)[2][2][4][2], const Unit& u, int wr, int wc, int fr, int fq) const {
        const int col0 = u.pn * BM + wc * 32 + 8 * fq;
        EPI_ROWS(
            float ss = 0.f;
            _Pragma("unroll") for (int bj = 0; bj < 2; ++bj) { const size_t off = (size_t)row * ldc + col0 + bj * HALF;
                f32x4 b0, b1;
                if (BASE_BF16) { const u32x4 bw = *(const u32x4*)((const bf16_t*)base + off); b0 = (f32x4){bf_lo(bw.x), bf_hi(bw.x), bf_lo(bw.y), bf_hi(bw.y)}; b1 = (f32x4){bf_lo(bw.z), bf_hi(bw.z), bf_lo(bw.w), bf_hi(bw.w)}; }
                else { b0 = __builtin_nontemporal_load((const f32x4*)((const float*)base + off)); b1 = __builtin_nontemporal_load((const f32x4*)((const float*)base + off + 4)); }
                const f32x4 v0 = acc[ai][bj][m][0] + b0, v1 = acc[ai][bj][m][1] + b1;
                ss += (v0[0] * v0[0] + v0[1] * v0[1]) + (v0[2] * v0[2] + v0[3] * v0[3]) + (v1[0] * v1[0] + v1[1] * v1[1]) + (v1[2] * v1[2] + v1[3] * v1[3]);
                u32x4 w; w.x = cvt_pk_bf16(v0[0], v0[1]); w.y = cvt_pk_bf16(v0[2], v0[3]); w.z = cvt_pk_bf16(v1[0], v1[1]); w.w = cvt_pk_bf16(v1[2], v1[3]);
                *(u32x4*)(ob + off) = w; }
            ss += __shfl_xor(ss, 16); ss += __shfl_xor(ss, 32);
            if (fq == 0) atomicAdd(rowss + row, ss);
            EPI_FENCE();
        )
    }
};
struct EpiSwiGLU {
    static constexpr bool PERM = true, AFTER_DRAIN = false, MIDK = false;
    const float* rowss; bf16_t* H; int ldh; float inv_d, eps;
    __device__ __forceinline__ void operator()(const f32x4 (&acc)[2][2][4][2], const Unit& u, int wr, int wc, int fr, int fq) const {
        const int col0 = u.pn * HALF + wc * 32 + 8 * fq;
        EPI_ROWS(
            const float rs = __builtin_amdgcn_rsqf(rowss[row] * inv_d + eps);
            float hv[8];
            _Pragma("unroll") for (int n = 0; n < 2; ++n) _Pragma("unroll") for (int j = 0; j < 4; ++j) { const float g = acc[ai][0][m][n][j] * rs, up = acc[ai][1][m][n][j] * rs; hv[n * 4 + j] = g * sigmoidf_(g) * up; }
            u32x4 w; w.x = cvt_pk_bf16(hv[0], hv[1]); w.y = cvt_pk_bf16(hv[2], hv[3]); w.z = cvt_pk_bf16(hv[4], hv[5]); w.w = cvt_pk_bf16(hv[6], hv[7]);
            *(u32x4*)(H + (size_t)row * ldh + col0) = w;
            EPI_FENCE();
        )
    }
};
struct EpiStoreBf16 {
    static constexpr bool PERM = true, AFTER_DRAIN = false, MIDK = false;
    bf16_t* T; int ldc;
    __device__ __forceinline__ void operator()(const f32x4 (&acc)[2][2][4][2], const Unit& u, int wr, int wc, int fr, int fq) const {
        const int col0 = u.pn * BM + wc * 32 + 8 * fq;
        EPI_ROWS(
            _Pragma("unroll") for (int bj = 0; bj < 2; ++bj) { const f32x4 v0 = acc[ai][bj][m][0], v1 = acc[ai][bj][m][1];
                u32x4 w; w.x = cvt_pk_bf16(v0[0], v0[1]); w.y = cvt_pk_bf16(v0[2], v0[3]); w.z = cvt_pk_bf16(v1[0], v1[1]); w.w = cvt_pk_bf16(v1[2], v1[3]);
                *(u32x4*)(T + (size_t)row * ldc + col0 + bj * HALF) = w; }
            EPI_FENCE();
        )
    }
};
struct EpiPle {
    static constexpr bool PERM = true, AFTER_DRAIN = false, MIDK = false;
    const float* rowss; const bf16_t* T; const bf16_t* X; float* out; int ldc; float inv_d, eps;
    __device__ __forceinline__ void operator()(const f32x4 (&acc)[2][2][4][2], const Unit& u, int wr, int wc, int fr, int fq) const {
        const int col0 = u.pn * BM + wc * 32 + 8 * fq;
        EPI_ROWS(
            const float rs = __builtin_amdgcn_rsqf(rowss[row] * inv_d + eps);
            _Pragma("unroll") for (int bj = 0; bj < 2; ++bj) { const size_t off = (size_t)row * ldc + col0 + bj * HALF;
                const u32x4 tw = *(const u32x4*)(T + off), xw = *(const u32x4*)(X + off);
                const float t[8] = {bf_lo(tw.x), bf_hi(tw.x), bf_lo(tw.y), bf_hi(tw.y), bf_lo(tw.z), bf_hi(tw.z), bf_lo(tw.w), bf_hi(tw.w)};
                const float x[8] = {bf_lo(xw.x), bf_hi(xw.x), bf_lo(xw.y), bf_hi(xw.y), bf_lo(xw.z), bf_hi(xw.z), bf_lo(xw.w), bf_hi(xw.w)};
                f32x4 o0, o1;
                _Pragma("unroll") for (int j = 0; j < 4; ++j) { o0[j] = x[j] + sigmoidf_(acc[ai][bj][m][0][j] * rs) * t[j]; o1[j] = x[4 + j] + sigmoidf_(acc[ai][bj][m][1][j] * rs) * t[4 + j]; }
                __builtin_nontemporal_store(o0, (f32x4*)(out + off)); __builtin_nontemporal_store(o1, (f32x4*)(out + off + 4)); }
            EPI_FENCE();
        )
    }
};
template <class Epi, class Sched, bool ALIGN_EPI = false, bool SP2 = false>
__device__ __forceinline__ void gemm_phase(PG8_LAS unsigned char* lds, const Gemm g, const Sched& S, const Epi& E) {
    int tid_ = threadIdx.x; asm volatile("" : "+v"(tid_));
    const int tid = tid_, wid = __builtin_amdgcn_readfirstlane(tid >> 6), lane = tid & 63, wr = wid >> 2, wc = wid & 3, fr = lane & 15, fq = lane >> 4;
    const int K = g.K, nt = g.nt ? g.nt : K / BK;
    unsigned voffA[2], voffB[2];
#pragma unroll
    for (int i = 0; i < 2; ++i) { int R, C; stage_rc(tid * 16 + i * 8192, R, C); const int Rb = Epi::PERM ? ((R & ~31) + perm32(R & 31)) : R;
        voffA[i] = (unsigned)(R * K + C) * 2u; voffB[i] = (unsigned)(Rb * K + C) * 2u; }
    const size_t kstep = (size_t)(BK * 2);
    const size_t hstep = (size_t)HALF * K * 2;
    const size_t tstep = 2 * hstep;
    const unsigned ldsw = (unsigned)wid * 1024u;
    const int aoff = lds_byte(wr * 64 + fr, fq * 8), boff = lds_byte(wc * 32 + fr, fq * 8);
#define PG8_SA(b, h) (((b) * 2 + (h)) * HTB)
#define PG8_SB(b, h) ((4 + (b) * 2 + (h)) * HTB)
#define PG8_STAGE(bufoff, gbase, voff) do { _Pragma("unroll") for (int _i = 0; _i < 2; ++_i) \
        __builtin_amdgcn_global_load_lds((const unsigned*)((const char*)(gbase) + (voff)[_i]), (PG8_LAS unsigned*)(lds + (bufoff) + ldsw + _i * 8192), 16, 0, 0); } while (0)
#define PG8_LDA(dst, b, h) do { _Pragma("unroll") for (int m = 0; m < 4; ++m) _Pragma("unroll") for (int k = 0; k < 2; ++k) dst[m][k] = *(const PG8_LAS bf16x8*)(lds + PG8_SA(b, h) + aoff + m * 2048 + k * 1024); } while (0)
#define PG8_LDB(dst, b, h) do { _Pragma("unroll") for (int n = 0; n < 2; ++n) _Pragma("unroll") for (int k = 0; k < 2; ++k) dst[n][k] = *(const PG8_LAS bf16x8*)(lds + PG8_SB(b, h) + boff + n * 2048 + k * 1024); } while (0)
#define PG8_MMA(ai, bj, At, Bt) do { __builtin_amdgcn_s_setprio(1); _Pragma("unroll") for (int m = 0; m < 4; ++m) _Pragma("unroll") for (int n = 0; n < 2; ++n) _Pragma("unroll") for (int k = 0; k < 2; ++k) \
        acc[ai][bj][m][n] = __builtin_amdgcn_mfma_f32_16x16x32_bf16(Bt[n][k], At[m][k], acc[ai][bj][m][n], 0, 0, 0); __builtin_amdgcn_s_setprio(0); } while (0)
#define PG8_WAIT_V(n) asm volatile("s_waitcnt vmcnt(" #n ")" ::: "memory")
#define PG8_WAIT_L(n) asm volatile("s_waitcnt lgkmcnt(" #n ")" ::: "memory")
#define PG8_BAR __builtin_amdgcn_s_barrier()
#define PG8_SCHED __builtin_amdgcn_sched_barrier(0)
    Unit cur, nxt; int ui = 0;
    if (!S.next(0, cur)) return;
    f32x4 acc[2][2][4][2];
#pragma unroll
    for (int a = 0; a < 2; ++a)
#pragma unroll
        for (int b = 0; b < 2; ++b)
#pragma unroll
            for (int m = 0; m < 4; ++m)
#pragma unroll
                for (int n = 0; n < 2; ++n) acc[a][b][m][n] = (f32x4){0.f, 0.f, 0.f, 0.f};
    bf16x8 At[4][2], B0[2][2], B1[2][2];
    const char* cA = (const char*)g.A + (size_t)cur.pm * tstep + cur.ko; const char* cB = (const char*)g.Bt + (size_t)cur.pn * tstep + cur.ko;
    S.a_ready(cur);
    if constexpr (SP2) {
        PG8_STAGE(PG8_SB(0, 0), cB, voffB); PG8_STAGE(PG8_SB(0, 1), cB + hstep, voffB); PG8_STAGE(PG8_SA(0, 0), cA, voffA); PG8_STAGE(PG8_SA(0, 1), cA + hstep, voffA);
        if (wr == 1) PG8_BAR;
        PG8_WAIT_V(2); PG8_BAR;
        PG8_STAGE(PG8_SB(1, 0), cB + kstep, voffB); PG8_STAGE(PG8_SA(1, 0), cA + kstep, voffA); PG8_STAGE(PG8_SB(1, 1), cB + hstep + kstep, voffB);
        PG8_WAIT_V(6); PG8_BAR;
    } else {
        PG8_STAGE(PG8_SB(0, 0), cB, voffB); PG8_STAGE(PG8_SA(0, 0), cA, voffA); PG8_STAGE(PG8_SB(0, 1), cB + hstep, voffB); PG8_STAGE(PG8_SA(0, 1), cA + hstep, voffA);
        if (wr == 1) PG8_BAR;
        PG8_WAIT_V(4); PG8_BAR;
        PG8_STAGE(PG8_SB(1, 0), cB + kstep, voffB); PG8_STAGE(PG8_SA(1, 0), cA + kstep, voffA); PG8_STAGE(PG8_SB(1, 1), cB + hstep + kstep, voffB);
        PG8_WAIT_V(6); PG8_BAR;
    }
    for (;;) {
        const bool has_next = S.next(ui + 1, nxt);
        const char* nA = has_next ? (const char*)g.A + (size_t)nxt.pm * tstep + nxt.ko : cA; const char* nB = has_next ? (const char*)g.Bt + (size_t)nxt.pn * tstep + nxt.ko : cB;
        for (int t = 0; t < nt; t += 2) {
            const bool last = (t == nt - 2);
            const char* a1 = cA + (size_t)(t + 1) * kstep;
            const char* a2 = last ? nA : cA + (size_t)(t + 2) * kstep; const char* b2 = last ? nB : cB + (size_t)(t + 2) * kstep;
            const char* a3 = a2 + kstep; const char* b3 = b2 + kstep;
            if (last && has_next) S.a_ready(nxt);
            if constexpr (SP2) {
            PG8_LDB(B0, 0, 0); PG8_LDB(B1, 0, 1); PG8_SCHED; PG8_LDA(At, 0, 0); PG8_STAGE(PG8_SA(1, 1), a1 + hstep, voffA);
            PG8_WAIT_V(8); PG8_WAIT_L(0); PG8_BAR; PG8_MMA(0, 0, At, B0); PG8_MMA(0, 1, At, B1); PG8_BAR; PG8_SCHED;
            PG8_LDA(At, 0, 1); PG8_STAGE(PG8_SB(0, 0), b2, voffB); PG8_STAGE(PG8_SB(0, 1), b2 + hstep, voffB); PG8_STAGE(PG8_SA(0, 0), a2, voffA);
            PG8_WAIT_V(8); PG8_WAIT_L(0); PG8_BAR; PG8_MMA(1, 0, At, B0); PG8_MMA(1, 1, At, B1); PG8_BAR; PG8_SCHED;
            PG8_LDB(B0, 1, 0); PG8_LDB(B1, 1, 1); PG8_SCHED; PG8_LDA(At, 1, 0); PG8_STAGE(PG8_SA(0, 1), a2 + hstep, voffA);
            PG8_WAIT_V(8); PG8_WAIT_L(0); PG8_BAR; PG8_MMA(0, 0, At, B0); PG8_MMA(0, 1, At, B1); PG8_BAR; PG8_SCHED;
            PG8_LDA(At, 1, 1); PG8_STAGE(PG8_SB(1, 0), b3, voffB); PG8_STAGE(PG8_SB(1, 1), b3 + hstep, voffB); PG8_STAGE(PG8_SA(1, 0), a3, voffA);
            PG8_WAIT_V(8); PG8_WAIT_L(0); PG8_BAR; PG8_MMA(1, 0, At, B0); PG8_MMA(1, 1, At, B1); PG8_BAR; PG8_SCHED;
            } else {
            PG8_LDB(B0, 0, 0); PG8_SCHED; PG8_LDA(At, 0, 0); PG8_STAGE(PG8_SA(1, 1), a1 + hstep, voffA);
            PG8_WAIT_L(8); PG8_BAR; PG8_WAIT_L(0); PG8_MMA(0, 0, At, B0); PG8_BAR; PG8_SCHED;
            PG8_LDB(B1, 0, 1); PG8_STAGE(PG8_SB(0, 0), b2, voffB);
            PG8_BAR; PG8_WAIT_L(0); PG8_MMA(0, 1, At, B1); PG8_BAR;
            PG8_LDA(At, 0, 1); PG8_STAGE(PG8_SA(0, 0), a2, voffA);
            PG8_BAR; PG8_WAIT_L(0); PG8_MMA(1, 0, At, B0); PG8_BAR; PG8_SCHED;
            PG8_STAGE(PG8_SB(0, 1), b2 + hstep, voffB);
            PG8_WAIT_V(6); PG8_BAR; PG8_MMA(1, 1, At, B1); PG8_BAR;
            PG8_LDB(B0, 1, 0); PG8_SCHED; PG8_LDA(At, 1, 0); PG8_STAGE(PG8_SA(0, 1), a2 + hstep, voffA);
            PG8_WAIT_L(8); PG8_BAR; PG8_WAIT_L(0); PG8_MMA(0, 0, At, B0); PG8_BAR; PG8_SCHED;
            PG8_LDB(B1, 1, 1); PG8_STAGE(PG8_SB(1, 0), b3, voffB);
            PG8_BAR; PG8_WAIT_L(0); PG8_MMA(0, 1, At, B1); PG8_BAR;
            PG8_LDA(At, 1, 1); PG8_STAGE(PG8_SA(1, 0), a3, voffA);
            PG8_BAR; PG8_WAIT_L(0); PG8_MMA(1, 0, At, B0); PG8_BAR; PG8_SCHED;
            PG8_STAGE(PG8_SB(1, 1), b3 + hstep, voffB);
            PG8_WAIT_V(6); PG8_BAR; PG8_MMA(1, 1, At, B1); PG8_BAR;
            }
        }
        if constexpr (ALIGN_EPI) { if (wr == 0) PG8_BAR; }
        bool keep_acc = false;
        if constexpr (Epi::MIDK) { if (cur.ko == 0) { E.mid(acc, cur, wr, wc, fr, fq); keep_acc = true; } else E(acc, cur, wr, wc, fr, fq); }
        else if constexpr (!Epi::AFTER_DRAIN) { E(acc, cur, wr, wc, fr, fq); S.done(cur); }
        if (!has_next) break;
        if (!keep_acc) {
#pragma unroll
        for (int a = 0; a < 2; ++a)
#pragma unroll
            for (int b = 0; b < 2; ++b)
#pragma unroll
                for (int m = 0; m < 4; ++m)
#pragma unroll
                    for (int n = 0; n < 2; ++n) acc[a][b][m][n] = (f32x4){0.f, 0.f, 0.f, 0.f};
        }
        cur = nxt; cA = nA; cB = nB; ++ui;
        if constexpr (ALIGN_EPI) { if (wr == 1) PG8_BAR; }
    }
    PG8_WAIT_V(0);
    if constexpr (!ALIGN_EPI) { if (wr == 0) PG8_BAR; }
    PG8_BAR;
    if constexpr (Epi::AFTER_DRAIN) { E.fused(acc, cur, wr, wc, fr, fq, lds, wid, lane); S.done(cur); }
#undef PG8_SA
#undef PG8_SB
#undef PG8_STAGE
#undef PG8_LDA
#undef PG8_LDB
#undef PG8_MMA
#undef PG8_WAIT_V
#undef PG8_WAIT_L
#undef PG8_BAR
#undef PG8_SCHED
}
}
constexpr int D = 2048, BATCH = 2, SEQ = 4096, M = BATCH * SEQ, GW = 64, GROWS = SEQ / GW, FF = 5632, PLE = 256;
constexpr int NA_H = 8, NA_DH = 128, DF_H = 8, DF_DQ = 64, DF_DV = 128;
constexpr int NQKG = 8192;
constexpr int QC_NAQ = 0, QC_NAK = 1024, QC_DFQ = 2048, QC_DFK = 3072, QC_GA = 4096, QC_GB = 6144;
constexpr float EPS = 1e-6f, LOG2E = 1.4426950408889634f;
constexpr float LAM_INIT = 0.2f;
constexpr int NWAVES = 8, NTHREADS = 512;
constexpr size_t MiB = 1u << 20;
constexpr size_t WS_RS1 = 64 * 1024, WS_RS2 = 128 * 1024, WS_ROPE = 1 * MiB;
constexpr size_t WS_W1 = 2 * MiB, WS_WNA = 42 * MiB, WS_WDF = 46 * MiB, WS_WO = 50 * MiB, WS_WGU = 58 * MiB, WS_WDN = 102 * MiB, WS_WPG = 124 * MiB, WS_WPP = 132 * MiB;
constexpr size_t WS_A = 133 * MiB;
constexpr size_t WS_B = 261 * MiB;
constexpr size_t WS_C = 293 * MiB;
constexpr size_t WS_PB = 325 * MiB;
constexpr size_t WS_END = 329 * MiB;
constexpr int LDS_BYTES = 147456;
#define LAS __attribute__((address_space(3)))
typedef unsigned short bf16;
typedef unsigned u32x4 __attribute__((ext_vector_type(4)));
typedef unsigned u32x2 __attribute__((ext_vector_type(2)));
typedef float f32x4 __attribute__((ext_vector_type(4)));
typedef float f32x2 __attribute__((ext_vector_type(2)));
typedef float f32x16 __attribute__((ext_vector_type(16)));
typedef short bf16x8 __attribute__((ext_vector_type(8)));
using pg8::cvt_pk_bf16; using pg8::bf_lo; using pg8::bf_hi;

__device__ __forceinline__ float wave_sum(float v) {
#pragma unroll
    for (int o = 1; o < 64; o <<= 1) v += __shfl_xor(v, o);
    return v;
}
__device__ __forceinline__ float wave_max(float v) {
#pragma unroll
    for (int o = 1; o < 64; o <<= 1) v = fmaxf(v, __shfl_xor(v, o));
    return v;
}
__device__ __forceinline__ int crow(int r, int hi) { return (r & 3) + 8 * (r >> 2) + 4 * hi; }

__device__ __forceinline__ int rowmap(int mode, int n0) {
    if (mode == 0) return n0;
    if (mode == 1) {
        if (n0 < 2048) return n0;
        if (n0 < 3072) return 8192 + (n0 - 2048);
        if (n0 < 4096) return 2048 + (n0 - 3072);
        if (n0 < 5120) return 3072 + (n0 - 4096);
        if (n0 < 6144) return 9216 + (n0 - 5120);
        return 4096 + (n0 - 6144);
    }
    return 256 * (n0 >> 7) + (n0 & 127) + (mode == 3 ? 128 : 0);
}
struct P0Item { const float* W; bf16* WT; const float* gk; int K, N, mode, item, Kd, kofs; };
__device__ __forceinline__ void p0_item_load(const P0Item& d, float (&v)[32], int lane) {
    const int nblk = d.N / 32, kb = d.item / nblk, nb = d.item % nblk, k0 = 64 * kb, n0 = 32 * nb;
    const float* src = d.W + (size_t)(k0 + (lane >> 5)) * d.N + n0 + (lane & 31);
#pragma unroll
    for (int i = 0; i < 32; ++i) v[i] = __builtin_nontemporal_load(src + (size_t)(2 * i) * d.N);
}
__device__ __forceinline__ void p0_item_store(const P0Item& d, const float (&v)[32], LAS float* scr, int lane) {
    const int nblk = d.N / 32, kb = d.item / nblk, nb = d.item % nblk, k0 = 64 * kb, n0 = 32 * nb;
    const int r0 = rowmap(d.mode, n0);
    if (d.gk) {
#pragma unroll
        for (int i = 0; i < 32; ++i) { const int kk = 2 * i + (lane >> 5); scr[kk * 33 + (lane & 31)] = v[i] * d.gk[k0 + kk]; }
    } else {
#pragma unroll
        for (int i = 0; i < 32; ++i) { const int kk = 2 * i + (lane >> 5); scr[kk * 33 + (lane & 31)] = v[i]; }
    }
    asm volatile("s_waitcnt lgkmcnt(0)" ::: "memory");
    const int c = lane & 7;
#pragma unroll
    for (int j = 0; j < 4; ++j) { const int n = (lane >> 3) + 8 * j; const LAS float* s = scr + (8 * c) * 33 + n;
        u32x4 o; o.x = cvt_pk_bf16(s[0 * 33], s[1 * 33]); o.y = cvt_pk_bf16(s[2 * 33], s[3 * 33]); o.z = cvt_pk_bf16(s[4 * 33], s[5 * 33]); o.w = cvt_pk_bf16(s[6 * 33], s[7 * 33]);
        *(u32x4*)(d.WT + (size_t)(r0 + n) * d.Kd + d.kofs + k0 + 8 * c) = o; }
    asm volatile("s_waitcnt lgkmcnt(0)" ::: "memory");
}
#define RLX_AGENT __ATOMIC_RELAXED, __HIP_MEMORY_SCOPE_AGENT
#define XB_TMO      128
#define XB_XCNT(j)  (256  + 64 * (j))
#define XB_XSUB(j)  (1280 + 64 * (j))
#define XB_XGEN(j)  (2304 + 64 * (j))
#define XB_TOP      3328
#define XB_TOPGEN   3392
#define XCD_BAR_WORDS 3456
#define XB_SPIN_CAP (1u << 18)

__device__ __forceinline__ unsigned xb_ld(unsigned* p)              { return __hip_atomic_load(p, __ATOMIC_RELAXED, __HIP_MEMORY_SCOPE_AGENT); }
__device__ __forceinline__ unsigned xb_add(unsigned* p, unsigned v) { return __hip_atomic_fetch_add(p, v, __ATOMIC_RELAXED, __HIP_MEMORY_SCOPE_AGENT); }
__device__ __forceinline__ unsigned xb_xcc_id() { return (unsigned)__builtin_amdgcn_s_getreg((3 << 11) | 20) & 0xFu; }
#define XB_SPIN(cond, bar) do { unsigned _sp = 0; while (cond) { __builtin_amdgcn_s_sleep(1); \
    if ((++_sp & 255u) == 0u) { if (xb_ld(&(bar)[XB_TMO])) break; if (_sp > XB_SPIN_CAP) { atomicAdd(&(bar)[XB_TMO], 1u); break; } } } } while (0)

struct XcdBarrier {
    unsigned* bar; unsigned x;
    volatile LAS unsigned* st;
};

__device__ __forceinline__ XcdBarrier xcd_barrier_post(unsigned* bar, volatile LAS unsigned* st) {
    XcdBarrier b; b.bar = bar; b.x = xb_xcc_id(); b.st = st;
    if (threadIdx.x == 0) (void)xb_add(&bar[XB_XCNT(b.x)], 1u);
    return b;
}
__device__ __forceinline__ void xcd_barrier_complete(unsigned* bar, unsigned x, unsigned& nloc, unsigned& nx) {
    const unsigned G = gridDim.x * gridDim.y * gridDim.z;
    unsigned sum, cnt, mine, sp = 0u;
    for (;;) {
        sum = 0u; cnt = 0u; mine = 0u;
#pragma unroll
        for (unsigned j = 0; j < 16; ++j) { const unsigned c = xb_ld(&bar[XB_XCNT(j)]); sum += c; cnt += (c > 0u) ? 1u : 0u; mine = (j == x) ? c : mine; }
        if (sum == G) break;
        __builtin_amdgcn_s_sleep(1);
        if ((++sp & 255u) == 0u) { if (xb_ld(&bar[XB_TMO])) break; if (sp > XB_SPIN_CAP) { atomicAdd(&bar[XB_TMO], 1u); break; } }
    }
    nloc = mine > 0u ? mine : 1u; nx = cnt > 0u ? cnt : 1u;
}

__device__ __forceinline__ void xcd_barrier(const XcdBarrier& b) {
    asm volatile("s_waitcnt vmcnt(0)" ::: "memory");
    __syncthreads();
    if (threadIdx.x == 0) {
        unsigned* bar = b.bar;
        __builtin_amdgcn_s_waitcnt(0);
        unsigned nloc = b.st[0], nx = b.st[1];
        if (nloc == 0u) { xcd_barrier_complete(bar, b.x, nloc, nx); b.st[0] = nloc; b.st[1] = nx; }
        const unsigned old = xb_add(&bar[XB_XSUB(b.x)], 1u);
        const unsigned gen = old / nloc;
        if (old + 1u == (gen + 1u) * nloc) {
            __builtin_amdgcn_fence(__ATOMIC_RELEASE, "agent");
            asm volatile("s_waitcnt vmcnt(0)" ::: "memory");
            const unsigned og = xb_add(&bar[XB_TOP], 1u);
            const unsigned tg = og / nx;
            if (og + 1u == (tg + 1u) * nx) xb_add(&bar[XB_TOPGEN], 1u);
            else XB_SPIN(xb_ld(&bar[XB_TOPGEN]) == tg, bar);
            __builtin_amdgcn_fence(__ATOMIC_ACQUIRE, "agent");
            xb_add(&bar[XB_XGEN(b.x)], 1u);
            asm volatile("s_waitcnt vmcnt(0)" ::: "memory");
        } else {
            XB_SPIN(xb_ld(&bar[XB_XGEN(b.x)]) == gen, bar);
            __builtin_amdgcn_fence(__ATOMIC_ACQUIRE, "agent");
            asm volatile("s_waitcnt vmcnt(0)" ::: "memory");
        }
    }
    __syncthreads();
}
struct Args {
    const float *x, *p, *g_mix, *w_in, *g_na_q, *g_na_k, *na_rpb, *g_df_q, *g_df_k, *lam_q1, *lam_k1, *lam_q2, *lam_k2, *g_df_sub,
                *w_na_out, *w_df_out, *w_o, *g_ffn, *w_gate, *w_up, *w_down, *g_ple, *w_ple_gate, *w_ple_proj;
    float* out; unsigned char* ws; int ph_lo, ph_hi, rep3, pad;
};

__device__ __forceinline__ void na_wave_unit(const bf16* QKG, const bf16* VT, const float* rpb, bf16* NAO, float M2, int b, int h, int r, int half) {
    int tid_ = threadIdx.x; asm volatile("" : "+v"(tid_)); const int lane = tid_ & 63;
    const int q = lane & 31, hi = lane >> 5, c = 32 * half + q;
    const size_t tokq = (size_t)b * SEQ + r * GW + c;
    bf16x8 qf[8];
#pragma unroll
    for (int d0 = 0; d0 < 8; ++d0) qf[d0] = *(const bf16x8*)(QKG + tokq * NQKG + QC_NAQ + h * NA_DH + 16 * d0 + 8 * hi);
    int rs = r - 4; rs = rs < 0 ? 0 : (rs > GROWS - 8 ? GROWS - 8 : rs);
    int cs = c - 8; cs = cs < 0 ? 0 : (cs > GW - 16 ? GW - 16 : cs);
    f32x16 o[4];
#pragma unroll
    for (int i = 0; i < 4; ++i) o[i] = (f32x16){};
    float l = 0.f;
    for (int kr = 0; kr < 8; ++kr) {
        const int krow = rs + kr, dr = krow - r + 7;
        const float* brow = rpb + (h * 15 + dr) * 31;
#pragma unroll
        for (int kb = 0; kb < 2; ++kb) {
            f32x16 s = (f32x16){};
            const bf16* kp = QKG + ((size_t)b * SEQ + krow * GW + 32 * kb + q) * NQKG + QC_NAK + h * NA_DH + 8 * hi;
#pragma unroll
            for (int d0 = 0; d0 < 8; ++d0) { const bf16x8 kf = *(const bf16x8*)(kp + 16 * d0); s = __builtin_amdgcn_mfma_f32_32x32x16_bf16(kf, qf[d0], s, 0, 0, 0); }
            float pv[16];
#pragma unroll
            for (int i = 0; i < 16; ++i) { const int kc = 32 * kb + crow(i, hi); const bool in = (kc >= cs) && (kc < cs + 16); const int dc = in ? (kc - c + 15) : 0;
                const float bias = brow[dc] * LOG2E - M2; const float e = __builtin_amdgcn_exp2f(s[i] + bias); pv[i] = in ? e : 0.f; l += pv[i]; }
            u32x4 w0, w1;
            w0.x = cvt_pk_bf16(pv[0], pv[1]); w0.y = cvt_pk_bf16(pv[2], pv[3]); w0.z = cvt_pk_bf16(pv[4], pv[5]); w0.w = cvt_pk_bf16(pv[6], pv[7]);
            w1.x = cvt_pk_bf16(pv[8], pv[9]); w1.y = cvt_pk_bf16(pv[10], pv[11]); w1.z = cvt_pk_bf16(pv[12], pv[13]); w1.w = cvt_pk_bf16(pv[14], pv[15]);
            const bf16x8 p0 = __builtin_bit_cast(bf16x8, w0), p1 = __builtin_bit_cast(bf16x8, w1);
            const bf16* vp = VT + (size_t)(h * NA_DH + q) * M + (size_t)b * SEQ + krow * GW + 32 * kb + 8 * hi;
#pragma unroll
            for (int db = 0; db < 4; ++db) {
                const bf16x8 v0 = *(const bf16x8*)(vp + (size_t)(32 * db) * M), v1 = *(const bf16x8*)(vp + (size_t)(32 * db) * M + 16);
                o[db] = __builtin_amdgcn_mfma_f32_32x32x16_bf16(v0, p0, o[db], 0, 0, 0);
                o[db] = __builtin_amdgcn_mfma_f32_32x32x16_bf16(v1, p1, o[db], 0, 0, 0);
            }
        }
    }
    l += __shfl_xor(l, 32);
    const float rl = 1.0f / l;
    bf16* op = NAO + tokq * 2048 + h * NA_DH + 4 * hi;
#pragma unroll
    for (int db = 0; db < 4; ++db)
#pragma unroll
        for (int g = 0; g < 4; ++g) { u32x2 w; w.x = cvt_pk_bf16(o[db][4 * g] * rl, o[db][4 * g + 1] * rl); w.y = cvt_pk_bf16(o[db][4 * g + 2] * rl, o[db][4 * g + 3] * rl);
            *(u32x2*)(op + 32 * db + 8 * g) = w; }
}

__device__ __forceinline__ void df_unit(LAS unsigned char* lds, const bf16* QKG, const bf16* KC, const bf16* VT, bf16* DFO, const float* g_sub, float lam, float M2, int b, int h, int qb, unsigned long long* df_wait = nullptr) {
    int tid_ = threadIdx.x; asm volatile("" : "+v"(tid_));
    const int tid = tid_, lane = tid & 63, w = __builtin_amdgcn_readfirstlane(tid >> 6), q = lane & 31, hi = lane >> 5;
    const int mm = w & 1, qg = w >> 1;
    const int q0 = qb * 128 + qg * 32;
    bf16x8 qf[4];
#pragma unroll
    for (int d0 = 0; d0 < 4; ++d0) qf[d0] = *(const bf16x8*)(QKG + ((size_t)b * SEQ + q0 + q) * NQKG + QC_DFQ + h * 128 + mm * 64 + 16 * d0 + 8 * hi);
    const unsigned char* kbase = (const unsigned char*)(KC + ((size_t)(b * 8 + h) * SEQ) * 128);
    const unsigned char* vbase = (const unsigned char*)(VT + ((size_t)(b * 16 + 8 + h) * 64) * 128 * 64);
    unsigned koff[2], voff[2];
#pragma unroll
    for (int i = 0; i < 2; ++i) {
        const int piece = w * 2 + i;
        { const int row = piece * 4 + (lane >> 4), ph = lane & 15, ch = ph ^ (row & 15); koff[i] = (unsigned)(row * 128 + ch * 8) * 2u; }
        { const int row = piece * 8 + (lane >> 3), ph = lane & 7, ch = ph ^ ((row >> 1) & 7); voff[i] = (unsigned)(row * 64 + ch * 8) * 2u; }
    }
#define DF_DMA(kt, stg) do { const unsigned char* kb_ = kbase + (size_t)(kt) * 16384; const unsigned char* vb_ = vbase + (size_t)(kt) * 16384; _Pragma("unroll") for (int _i = 0; _i < 2; ++_i) { \
        __builtin_amdgcn_global_load_lds((const unsigned*)(kb_ + koff[_i]), (LAS unsigned*)(lds + (stg) * 32768 + (w * 2 + _i) * 1024), 16, 0, 0); \
        __builtin_amdgcn_global_load_lds((const unsigned*)(vb_ + voff[_i]), (LAS unsigned*)(lds + (stg) * 32768 + 16384 + (w * 2 + _i) * 1024), 16, 0, 0); } } while (0)
    int kofs[4], vofs[4];
#pragma unroll
    for (int d0 = 0; d0 < 4; ++d0) kofs[d0] = q * 256 + (((mm * 8 + 2 * d0 + hi) ^ (q & 15)) * 16);
#pragma unroll
    for (int g = 0; g < 4; ++g) vofs[g] = 16384 + q * 128 + (((2 * g + hi) ^ ((q >> 1) & 7)) * 16);
    f32x16 o[4];
#pragma unroll
    for (int i = 0; i < 4; ++i) o[i] = (f32x16){};
    float l = 0.f;
    const float shift = (M2 > 60.0f) ? M2 : 0.0f;
    constexpr int NT = SEQ / 64;
    typedef float f32x2_t __attribute__((ext_vector_type(2))); typedef __bf16 bf16x2_t __attribute__((ext_vector_type(2)));
#define CVTPK(lo, hi) __builtin_bit_cast(unsigned, __builtin_convertvector((f32x2_t){(lo), (hi)}, bf16x2_t))
#define DF_S(dst, St_, kb_) do { bf16x8 kf_[4]; _Pragma("unroll") for (int d0 = 0; d0 < 4; ++d0) kf_[d0] = *(const LAS bf16x8*)((St_) + kofs[d0] + (kb_) * 8192); \
        dst = (f32x16){}; _Pragma("unroll") for (int d0 = 0; d0 < 4; ++d0) dst = __builtin_amdgcn_mfma_f32_32x32x16_bf16(kf_[d0], qf[d0], dst, 0, 0, 0); } while (0)
    DF_DMA(0, 0); DF_DMA(1, 1); DF_DMA(2, 2);
    asm volatile("s_waitcnt vmcnt(4)" ::: "memory");
    __builtin_amdgcn_s_barrier();
    asm volatile("" ::: "memory");
    f32x16 sc[2], sn[2];
    DF_S(sc[0], lds, 0); DF_S(sc[1], lds, 1);
    for (int kt = 0; kt < NT; ++kt) {
        if (kt + 3 < NT) DF_DMA(kt + 3, (kt + 3) & 3);
        const LAS unsigned char* St = lds + (kt & 3) * 32768;
        const LAS unsigned char* Sn = lds + ((kt + 1) & 3) * 32768;
        if (kt + 1 < NT) { DF_S(sn[0], Sn, 0); DF_S(sn[1], Sn, 1); }
#pragma unroll
        for (int kb = 0; kb < 2; ++kb) {
            bf16x8 vf[2][4];
#pragma unroll
            for (int jj = 0; jj < 2; ++jj)
#pragma unroll
                for (int db = 0; db < 4; ++db) vf[jj][db] = *(const LAS bf16x8*)(St + vofs[2 * kb + jj] + db * 4096);
            f32x16 s = sc[kb];
            if (shift != 0.f) {
#pragma unroll
                for (int i = 0; i < 16; ++i) s[i] -= shift;
            }
            float ls = 0.f;
#pragma unroll
            for (int i = 0; i < 16; ++i) { s[i] = __builtin_amdgcn_exp2f(s[i]); ls += s[i]; }
            l += ls;
            u32x4 w0, w1;
            w0.x = CVTPK(s[0], s[1]); w0.y = CVTPK(s[2], s[3]); w0.z = CVTPK(s[4], s[5]); w0.w = CVTPK(s[6], s[7]);
            w1.x = CVTPK(s[8], s[9]); w1.y = CVTPK(s[10], s[11]); w1.z = CVTPK(s[12], s[13]); w1.w = CVTPK(s[14], s[15]);
            const bf16x8 p0 = __builtin_bit_cast(bf16x8, w0), p1 = __builtin_bit_cast(bf16x8, w1);
#pragma unroll
            for (int db = 0; db < 4; ++db) o[db] = __builtin_amdgcn_mfma_f32_32x32x16_bf16(vf[0][db], p0, o[db], 0, 0, 0);
#pragma unroll
            for (int db = 0; db < 4; ++db) o[db] = __builtin_amdgcn_mfma_f32_32x32x16_bf16(vf[1][db], p1, o[db], 0, 0, 0);
        }
        sc[0] = sn[0]; sc[1] = sn[1];
#ifdef PROBE_DFWAIT
        const unsigned long long tw0_ = __builtin_amdgcn_s_memrealtime();
#endif
        if (kt + 3 < NT) asm volatile("s_waitcnt vmcnt(4) lgkmcnt(0)" ::: "memory"); else asm volatile("s_waitcnt vmcnt(0) lgkmcnt(0)" ::: "memory");
#if defined(PROBE_DFWAIT) && PROBE_DFWAIT == 2
        const unsigned long long tw1_ = __builtin_amdgcn_s_memrealtime(); if (df_wait) *df_wait += tw1_ - tw0_;
#endif
        __builtin_amdgcn_s_barrier();
        asm volatile("" ::: "memory");
#if defined(PROBE_DFWAIT) && PROBE_DFWAIT == 1
        const unsigned long long tw1_ = __builtin_amdgcn_s_memrealtime(); if (df_wait) *df_wait += tw1_ - tw0_;
#endif
    }
#undef DF_S
#undef CVTPK
#undef DF_DMA
    LAS float* xch = (LAS float*)lds;
    { float lt = l; lt += __shfl_xor(lt, 32);
      const float sc = (mm == 1 ? lam : 1.0f) / lt;
#pragma unroll
      for (int db = 0; db < 4; ++db)
#pragma unroll
          for (int i = 0; i < 16; ++i) o[db][i] *= sc; }
    if (mm == 1) {
#pragma unroll
        for (int db = 0; db < 4; ++db)
#pragma unroll
            for (int i = 0; i < 16; ++i) xch[(qg * 64 + db * 16 + i) * 64 + lane] = o[db][i];
    }
    __syncthreads();
    if (mm == 0) {
        float ss = 0.f;
#pragma unroll
        for (int db = 0; db < 4; ++db)
#pragma unroll
            for (int i = 0; i < 16; ++i) { const float v = o[db][i] - xch[(qg * 64 + db * 16 + i) * 64 + lane]; o[db][i] = v; ss += v * v; }
        ss += __shfl_xor(ss, 32);
        const float rn = __builtin_amdgcn_rsqf(ss * (1.0f / 128.0f) + EPS) * (1.0f - LAM_INIT);
        bf16* op = DFO + ((size_t)b * SEQ + q0 + q) * 2048 + h * 128 + 4 * hi;
#pragma unroll
        for (int db = 0; db < 4; ++db)
#pragma unroll
            for (int g = 0; g < 4; ++g) { const f32x4 gs = *(const f32x4*)(g_sub + 32 * db + 8 * g + 4 * hi);
                u32x2 wv; wv.x = cvt_pk_bf16(o[db][4 * g] * rn * gs[0], o[db][4 * g + 1] * rn * gs[1]); wv.y = cvt_pk_bf16(o[db][4 * g + 2] * rn * gs[2], o[db][4 * g + 3] * rn * gs[3]);
                *(u32x2*)(op + 32 * db + 8 * g) = wv; }
    }
    __syncthreads();
}

__device__ __forceinline__ void na_unit(LAS unsigned char* lds, const bf16* QKG, const bf16* KC, const bf16* VT, const float* rpb, bf16* NAO, float M2, int b, int h, int r0) {
    int tid_ = threadIdx.x; asm volatile("" : "+v"(tid_));
    const int tid = tid_, lane = tid & 63, w = __builtin_amdgcn_readfirstlane(tid >> 6), q = lane & 31, hi = lane >> 5;
    const int rq = r0 + (w >> 1), half = w & 1, c = 32 * half + q;
    const size_t tokq = (size_t)b * SEQ + rq * GW + c;
    bf16x8 qf[8];
#pragma unroll
    for (int d0 = 0; d0 < 8; ++d0) qf[d0] = *(const bf16x8*)(QKG + tokq * NQKG + QC_NAQ + h * NA_DH + 16 * d0 + 8 * hi);
    int rs = rq - 4; rs = rs < 0 ? 0 : (rs > GROWS - 8 ? GROWS - 8 : rs);
    int cs = c - 8; cs = cs < 0 ? 0 : (cs > GW - 16 ? GW - 16 : cs);
    int klo = r0 - 4; klo = klo < 0 ? 0 : (klo > GROWS - 8 ? GROWS - 8 : klo);
    int khi = r0 + 3 - 4; khi = (khi < 0 ? 0 : (khi > GROWS - 8 ? GROWS - 8 : khi)) + 7;
    const int nst = khi - klo + 1;
    const unsigned char* kbase = (const unsigned char*)(KC + ((size_t)(b * 8 + h) * SEQ + klo * GW) * 128);
    const unsigned char* vbase = (const unsigned char*)(VT + ((size_t)(b * 16 + h) * 64 + klo) * 128 * 64);
    unsigned koff[2], voff[2];
#pragma unroll
    for (int i = 0; i < 2; ++i) {
        const int piece = w * 2 + i;
        { const int row = piece * 4 + (lane >> 4), ph = lane & 15, ch = ph ^ (row & 15); koff[i] = (unsigned)(row * 128 + ch * 8) * 2u; }
        { const int row = piece * 8 + (lane >> 3), ph = lane & 7, ch = ph ^ ((row >> 1) & 7); voff[i] = (unsigned)(row * 64 + ch * 8) * 2u; }
    }
#define NA_DMA(t, stg) do { const unsigned char* kb_ = kbase + (size_t)(t) * 16384; const unsigned char* vb_ = vbase + (size_t)(t) * 16384; _Pragma("unroll") for (int _i = 0; _i < 2; ++_i) { \
        __builtin_amdgcn_global_load_lds((const unsigned*)(kb_ + koff[_i]), (LAS unsigned*)(lds + (stg) * 32768 + (w * 2 + _i) * 1024), 16, 0, 0); \
        __builtin_amdgcn_global_load_lds((const unsigned*)(vb_ + voff[_i]), (LAS unsigned*)(lds + (stg) * 32768 + 16384 + (w * 2 + _i) * 1024), 16, 0, 0); } } while (0)
    int kofs[8], vofs[4];
#pragma unroll
    for (int d0 = 0; d0 < 8; ++d0) kofs[d0] = q * 256 + (((2 * d0 + hi) ^ (q & 15)) * 16);
#pragma unroll
    for (int g = 0; g < 4; ++g) vofs[g] = 16384 + q * 128 + (((2 * g + hi) ^ ((q >> 1) & 7)) * 16);
    f32x16 o[4];
#pragma unroll
    for (int i = 0; i < 4; ++i) o[i] = (f32x16){};
    float l = 0.f;
    LAS float* btab = (LAS float*)(lds + 131072 + 1024);
    for (int i = tid; i < 15 * 31; i += NTHREADS) btab[i] = rpb[h * 15 * 31 + i] * LOG2E - M2;
    asm volatile("s_waitcnt vmcnt(0) lgkmcnt(0)" ::: "memory");
    __builtin_amdgcn_s_barrier();
    asm volatile("" ::: "memory");
    NA_DMA(0, 0); NA_DMA(1, 1);
    asm volatile("s_waitcnt vmcnt(4)" ::: "memory");
    __builtin_amdgcn_s_barrier();
    asm volatile("" ::: "memory");
    for (int t = 0; t < nst; ++t) {
        if (t + 2 < nst) NA_DMA(t + 2, (t + 2) & 3);
        const int krow = klo + t;
        if (krow >= rs && krow < rs + 8) {
            const LAS unsigned char* St = lds + (t & 3) * 32768;
            const LAS float* brow = btab + (krow - rq + 7) * 31;
#pragma unroll 1
            for (int kb = 0; kb < 2; ++kb) {
                f32x16 s = (f32x16){};
#pragma unroll
                for (int d0 = 0; d0 < 8; ++d0) { const bf16x8 kf = *(const LAS bf16x8*)(St + kofs[d0] + kb * 8192); s = __builtin_amdgcn_mfma_f32_32x32x16_bf16(kf, qf[d0], s, 0, 0, 0); }
                bf16x8 vf[2][4];
#pragma unroll
                for (int jj = 0; jj < 2; ++jj)
#pragma unroll
                    for (int db = 0; db < 4; ++db) vf[jj][db] = *(const LAS bf16x8*)(St + (kb ? vofs[2 + jj] : vofs[jj]) + db * 4096);
                float pv[16];
                const LAS float* bp = brow + (4 * hi - c + 15 + 32 * kb);
                const int wa = 4 * hi - cs + 32 * kb;
#pragma unroll
                for (int i = 0; i < 16; ++i) { const int e0 = (i & 3) + 8 * (i >> 2); const float bias = bp[e0]; const float e = __builtin_amdgcn_exp2f(s[i] + bias);
                    pv[i] = ((unsigned)(wa + e0) < 16u) ? e : 0.f; l += pv[i]; }
                u32x4 w0, w1;
                w0.x = cvt_pk_bf16(pv[0], pv[1]); w0.y = cvt_pk_bf16(pv[2], pv[3]); w0.z = cvt_pk_bf16(pv[4], pv[5]); w0.w = cvt_pk_bf16(pv[6], pv[7]);
                w1.x = cvt_pk_bf16(pv[8], pv[9]); w1.y = cvt_pk_bf16(pv[10], pv[11]); w1.z = cvt_pk_bf16(pv[12], pv[13]); w1.w = cvt_pk_bf16(pv[14], pv[15]);
                const bf16x8 p0 = __builtin_bit_cast(bf16x8, w0), p1 = __builtin_bit_cast(bf16x8, w1);
#pragma unroll
                for (int db = 0; db < 4; ++db) o[db] = __builtin_amdgcn_mfma_f32_32x32x16_bf16(vf[0][db], p0, o[db], 0, 0, 0);
#pragma unroll
                for (int db = 0; db < 4; ++db) o[db] = __builtin_amdgcn_mfma_f32_32x32x16_bf16(vf[1][db], p1, o[db], 0, 0, 0);
            }
        }
        if (t + 2 < nst) asm volatile("s_waitcnt vmcnt(4) lgkmcnt(0)" ::: "memory"); else asm volatile("s_waitcnt vmcnt(0) lgkmcnt(0)" ::: "memory");
        __builtin_amdgcn_s_barrier();
        asm volatile("" ::: "memory");
    }
#undef NA_DMA
    l += __shfl_xor(l, 32);
    const float rl = 1.0f / l;
    bf16* op = NAO + tokq * 2048 + h * NA_DH + 4 * hi;
#pragma unroll
    for (int db = 0; db < 4; ++db)
#pragma unroll
        for (int g = 0; g < 4; ++g) { u32x2 wv; wv.x = cvt_pk_bf16(o[db][4 * g] * rl, o[db][4 * g + 1] * rl); wv.y = cvt_pk_bf16(o[db][4 * g + 2] * rl, o[db][4 * g + 3] * rl);
            *(u32x2*)(op + 32 * db + 8 * g) = wv; }
}
template <int TB>
__device__ __forceinline__ void qknorm_batch(bf16* QKG, bf16* KCna, bf16* KCdf, int m0, int mstride, const float* gnq, const float* gnk, const float* gdq, const float* gdk, const f32x2* rope, int lane) {
    const float QS_NA = 0.08838834764831845f * LOG2E, QS_DF = 0.125f * LOG2E;
    u32x4 na[TB][4], da[TB][2], db[TB][2];
#pragma unroll
    for (int t = 0; t < TB; ++t) { int mt = m0 + t * mstride; if (mt >= M) mt = M - 1; bf16* row = QKG + (size_t)mt * NQKG;
#pragma unroll
        for (int j = 0; j < 4; ++j) na[t][j] = *(const u32x4*)(row + 512 * j + 8 * lane);
#pragma unroll
        for (int j = 0; j < 2; ++j) { const bf16* p1 = row + 2048 + 1024 * j + 64 * (lane >> 2) + 8 * (lane & 3); da[t][j] = *(const u32x4*)p1; db[t][j] = *(const u32x4*)(p1 + 32); } }
#pragma unroll
    for (int t = 0; t < TB; ++t) { const int mt = m0 + t * mstride; if (mt >= M) break; bf16* row = QKG + (size_t)mt * NQKG; const int pos = mt & (SEQ - 1);
#pragma unroll
        for (int j = 0; j < 4; ++j) {
            const u32x4 w = na[t][j];
            float v[8] = {bf_lo(w.x), bf_hi(w.x), bf_lo(w.y), bf_hi(w.y), bf_lo(w.z), bf_hi(w.z), bf_lo(w.w), bf_hi(w.w)};
            float ss = 0.f;
#pragma unroll
            for (int i = 0; i < 8; ++i) ss += v[i] * v[i];
            ss += __shfl_xor(ss, 1); ss += __shfl_xor(ss, 2); ss += __shfl_xor(ss, 4); ss += __shfl_xor(ss, 8);
            const float rs = __builtin_amdgcn_rsqf(ss * (1.0f / 128.0f) + EPS) * (j < 2 ? QS_NA : 1.0f);
            const float* g = (j < 2 ? gnq : gnk) + 8 * (lane & 15);
#pragma unroll
            for (int i = 0; i < 8; ++i) v[i] = v[i] * rs * g[i];
            u32x4 o; o.x = cvt_pk_bf16(v[0], v[1]); o.y = cvt_pk_bf16(v[2], v[3]); o.z = cvt_pk_bf16(v[4], v[5]); o.w = cvt_pk_bf16(v[6], v[7]);
            if (j < 2) *(u32x4*)(row + 512 * j + 8 * lane) = o;
            else { const int x = 512 * (j - 2) + 8 * lane;
                   *(u32x4*)(KCna + ((size_t)((mt >> 12) * 8 + (x >> 7)) * SEQ + pos) * 128 + (x & 127)) = o; }
        }
#pragma unroll
        for (int j = 0; j < 2; ++j) {
            bf16* p1 = row + 2048 + 1024 * j + 64 * (lane >> 2) + 8 * (lane & 3); bf16* p2 = p1 + 32;
            const u32x4 wa = da[t][j], wb = db[t][j];
            float a[8] = {bf_lo(wa.x), bf_hi(wa.x), bf_lo(wa.y), bf_hi(wa.y), bf_lo(wa.z), bf_hi(wa.z), bf_lo(wa.w), bf_hi(wa.w)};
            float c[8] = {bf_lo(wb.x), bf_hi(wb.x), bf_lo(wb.y), bf_hi(wb.y), bf_lo(wb.z), bf_hi(wb.z), bf_lo(wb.w), bf_hi(wb.w)};
            float ss = 0.f;
#pragma unroll
            for (int i = 0; i < 8; ++i) ss += a[i] * a[i] + c[i] * c[i];
            ss += __shfl_xor(ss, 1); ss += __shfl_xor(ss, 2);
            const float rs = __builtin_amdgcn_rsqf(ss * (1.0f / 64.0f) + EPS);
            const float* g = (j == 0 ? gdq : gdk) + 8 * (lane & 3);
            const f32x2* rp = rope + pos * 32 + 8 * (lane & 3);
            const float qs = (j == 0 ? QS_DF : 1.0f);
            float o1[8], o2[8];
#pragma unroll
            for (int i = 0; i < 8; ++i) { const float x1 = a[i] * rs * g[i], x2 = c[i] * rs * g[32 + i]; const f32x2 cs = rp[i]; o1[i] = (x1 * cs.x - x2 * cs.y) * qs; o2[i] = (x1 * cs.y + x2 * cs.x) * qs; }
            u32x4 oa, ob; oa.x = cvt_pk_bf16(o1[0], o1[1]); oa.y = cvt_pk_bf16(o1[2], o1[3]); oa.z = cvt_pk_bf16(o1[4], o1[5]); oa.w = cvt_pk_bf16(o1[6], o1[7]);
            ob.x = cvt_pk_bf16(o2[0], o2[1]); ob.y = cvt_pk_bf16(o2[2], o2[3]); ob.z = cvt_pk_bf16(o2[4], o2[5]); ob.w = cvt_pk_bf16(o2[6], o2[7]);
            if (j == 0) { *(u32x4*)p1 = oa; *(u32x4*)p2 = ob; }
            else { const int x = 64 * (lane >> 2) + 8 * (lane & 3); bf16* kp = KCdf + ((size_t)((mt >> 12) * 8 + (x >> 7)) * SEQ + pos) * 128 + (x & 127);
                   *(u32x4*)kp = oa; *(u32x4*)(kp + 32) = ob; }
        }
    }
}

__device__ __forceinline__ void grid_barrier(unsigned* cnt, unsigned target) {
    asm volatile("s_waitcnt vmcnt(0) lgkmcnt(0)" ::: "memory");
    __syncthreads();
    if (threadIdx.x == 0) {
        __builtin_amdgcn_fence(__ATOMIC_RELEASE, "agent");
        asm volatile("s_waitcnt vmcnt(0)" ::: "memory");
        __hip_atomic_fetch_add(cnt, 1u, __ATOMIC_RELAXED, __HIP_MEMORY_SCOPE_AGENT);
        while (__hip_atomic_load(cnt, __ATOMIC_RELAXED, __HIP_MEMORY_SCOPE_AGENT) < target) __builtin_amdgcn_s_sleep(2);
        __builtin_amdgcn_fence(__ATOMIC_ACQUIRE, "agent");
        asm volatile("s_waitcnt vmcnt(0)" ::: "memory");
    }
    __syncthreads();
}
constexpr int I_IN = 32 * 320, I_NA = 16 * 64, I_O = 32 * 64, I_G = 32 * 176, I_DN = 88 * 64, I_PP = 4 * 64;
constexpr int N_EARLY = I_IN + 2 * I_NA + I_O + 2 * I_G + I_PP, NITEMS = N_EARLY + I_DN + I_O;
#define P0_DECODE(it_, d_) do { int r = (it_); \
            if (r < I_IN) { d_ = P0Item{ap->w_in, W1t, nullptr, D, 10240, 1, r, D, 0}; break; } r -= I_IN; \
            if (r < I_NA) { d_ = P0Item{ap->w_na_out, Wna, nullptr, 1024, D, 0, r, 2048, 0}; break; } r -= I_NA; \
            if (r < I_NA) { d_ = P0Item{ap->w_df_out, Wna, nullptr, 1024, D, 0, r, 2048, 1024}; break; } r -= I_NA; \
            if (r < I_O) { d_ = P0Item{ap->w_o, Wo, nullptr, D, D, 0, r, D, 0}; break; } r -= I_O; \
            if (r < I_G) { d_ = P0Item{ap->w_gate, Wgu, ap->g_ffn, D, FF, 2, r, D, 0}; break; } r -= I_G; \
            if (r < I_G) { d_ = P0Item{ap->w_up, Wgu, ap->g_ffn, D, FF, 3, r, D, 0}; break; } r -= I_G; \
            if (r < I_PP) { d_ = P0Item{ap->w_ple_proj, Wpp, nullptr, PLE, D, 0, r, PLE, 0}; break; } r -= I_PP; \
            if (r < I_DN) { d_ = P0Item{ap->w_down, Wdn, nullptr, FF, D, 0, r, FF, 0}; break; } r -= I_DN; \
            d_ = P0Item{ap->w_ple_gate, Wpg, ap->g_ple, D, D, 0, r, D, 0}; } while (0)
constexpr int NPHASE = 9;
__global__ void __launch_bounds__(NTHREADS, 2) fwd_megakernel(Args a) {
    extern __shared__ __attribute__((aligned(16))) unsigned char lds_raw[];
    LAS unsigned char* lds = (LAS unsigned char*)lds_raw;
    cg::grid_group grid = cg::this_grid();
    const int G = gridDim.x, bx = blockIdx.x;
    const int vcu = (G % 8 == 0) ? (bx % 8) * (G / 8) + bx / 8 : bx;
    const int NGW = G * NWAVES;
typedef __attribute__((opencl_constant)) const Args* CArgsP;
#define FRESH_ARGS() auto kp_ = __builtin_amdgcn_kernarg_segment_ptr(); asm volatile("" : "+s"(kp_)); const CArgsP ap = (CArgsP)kp_
#define FRESH_TID() int tid_ = threadIdx.x; asm volatile("" : "+v"(tid_)); const int tid = tid_, lane = tid & 63, wave = __builtin_amdgcn_readfirstlane(tid >> 6), gw = vcu * NWAVES + wave; (void)lane; (void)gw
    unsigned char* ws = a.ws;
    float* RS1 = (float*)(ws + WS_RS1); float* RS2 = (float*)(ws + WS_RS2); f32x2* ROPE = (f32x2*)(ws + WS_ROPE);
    bf16 *W1t = (bf16*)(ws + WS_W1), *Wna = (bf16*)(ws + WS_WNA), *Wdf = (bf16*)(ws + WS_WDF), *Wo = (bf16*)(ws + WS_WO), *Wgu = (bf16*)(ws + WS_WGU), *Wdn = (bf16*)(ws + WS_WDN), *Wpg = (bf16*)(ws + WS_WPG), *Wpp = (bf16*)(ws + WS_WPP);
    bf16 *QKG = (bf16*)(ws + WS_A), *HB = (bf16*)(ws + WS_A);
    bf16 *XN = (bf16*)(ws + WS_B), *AO = (bf16*)(ws + WS_B), *X1B = (bf16*)(ws + WS_B), *X2B = (bf16*)(ws + WS_B);
    bf16 *VT = (bf16*)(ws + WS_C), *MRG = (bf16*)(ws + WS_C), *T2B = (bf16*)(ws + WS_C), *PB = (bf16*)(ws + WS_PB);
    bf16* KCna = (bf16*)a.out; bf16* KCdf = KCna + (size_t)M * 1024;
    const int lo = a.ph_lo, hi_ph = a.ph_hi;
    if (lo < 0) grid.sync();
    { volatile LAS unsigned* st0 = (volatile LAS unsigned*)(lds + 131072 + 768); if (threadIdx.x < 2) st0[threadIdx.x] = 0u; __syncthreads(); }
    XcdBarrier xbar = xcd_barrier_post((unsigned*)(ws + 8192), (volatile LAS unsigned*)(lds + 131072 + 768));
#ifndef PHASE_MASK
#define PHASE_MASK 0x1ff
#endif
#define IN(k) (((PHASE_MASK >> (k)) & 1) && lo <= (k) && (k) < hi_ph)
#ifdef PROBE_TS
#define STAMP(k) do { if (bx == 0 && threadIdx.x == 0) ((volatile unsigned long long*)(ws + 2048))[k] = __builtin_amdgcn_s_memrealtime(); } while (0)
#else
#define STAMP(k) do {} while (0)
#endif
#define GBAR(idx) xcd_barrier(xbar)
#define SEAM(k) do { if (IN(k) && IN((k) + 1)) GBAR(k); STAMP((k) + 1); } while (0)
#ifndef PROBE_DUP
#define PROBE_DUP 0
#endif
#define NREP(k) (((PROBE_DUP >> (k)) & 1) ? 2 : 1)

    STAMP(0);
    for (int rep_ = 0; rep_ < NREP(0); ++rep_) {
    if (IN(0)) {
        FRESH_ARGS();
        FRESH_TID();
        LAS float* scr = (LAS float*)(lds + wave * 16384);
        {
            float cur[32], nxt[32]; P0Item dc, dn;
            int it = gw;
            if (it < N_EARLY) { P0_DECODE(it, dc); p0_item_load(dc, cur, lane); }
            for (; it < N_EARLY; it += NGW) {
                const int nit = it + NGW; const bool more = nit < N_EARLY;
                if (more) { P0_DECODE(nit, dn); p0_item_load(dn, nxt, lane); }
                p0_item_store(dc, cur, scr, lane);
                if (more) { dc = dn;
#pragma unroll
                    for (int i = 0; i < 32; ++i) cur[i] = nxt[i]; }
            }
        }
        for (int m = gw; m < M; m += NGW) {
            const f32x4* xr = (const f32x4*)(ap->x + (size_t)m * D) + lane; const f32x4* gr = (const f32x4*)ap->g_mix + lane;
            f32x4 v[8]; float s = 0.f;
#pragma unroll
            for (int j = 0; j < 8; ++j) { v[j] = __builtin_nontemporal_load(xr + 64 * j); s += (v[j].x * v[j].x + v[j].y * v[j].y) + (v[j].z * v[j].z + v[j].w * v[j].w); }
            const float rs = __builtin_amdgcn_rsqf(wave_sum(s) * (1.0f / D) + EPS);
            u32x2* o8 = (u32x2*)(XN + (size_t)m * D) + lane;
#pragma unroll
            for (int j = 0; j < 8; ++j) { const f32x4 g = gr[64 * j]; u32x2 w; w.x = cvt_pk_bf16(v[j].x * rs * g.x, v[j].y * rs * g.y); w.y = cvt_pk_bf16(v[j].z * rs * g.z, v[j].w * rs * g.w); o8[64 * j] = w; }
        }
        const int gt = vcu * NTHREADS + tid, NGT = G * NTHREADS;
        for (int i = gt; i < M * PLE / 8; i += NGT) { const f32x4 p0 = __builtin_nontemporal_load((const f32x4*)ap->p + 2 * i), p1 = __builtin_nontemporal_load((const f32x4*)ap->p + 2 * i + 1);
            u32x4 w; w.x = cvt_pk_bf16(p0.x, p0.y); w.y = cvt_pk_bf16(p0.z, p0.w); w.z = cvt_pk_bf16(p1.x, p1.y); w.w = cvt_pk_bf16(p1.z, p1.w); ((u32x4*)PB)[i] = w; }
        for (int i = gt; i < SEQ * 32; i += NGT) { const int pos = i >> 5, k = i & 31;
            const float inv = (float)(1.0 / pow(10000.0, (double)k / 32.0)); const float ang = (float)pos * inv;
            f32x2 cs; cs.x = (float)cos((double)ang); cs.y = (float)sin((double)ang); ROPE[i] = cs; }
        for (int i = gt; i < M; i += NGT) { RS1[i] = 0.f; RS2[i] = 0.f; }
    }
    }
    SEAM(0);
    for (int rep_ = 0; rep_ < NREP(1); ++rep_) {
    if (IN(1)) {
        FRESH_ARGS();
        { pg8::Gemm g{XN, W1t, M, NQKG, D}; pg8::StaticOrder S; S.init(M, NQKG, G, bx); pg8::EpiQKG E{QKG, NQKG};
          pg8::gemm_phase<pg8::EpiQKG, pg8::StaticOrder, true, true>(lds, g, S, E); }
        { pg8::Gemm g{W1t + (size_t)NQKG * D, XN, 2048, M, D}; pg8::StaticOrder S; S.init(2048, M, G, bx); pg8::EpiVT E{VT, M};
          pg8::gemm_phase<pg8::EpiVT, pg8::StaticOrder, true, true>(lds, g, S, E); }
    }
    }
    SEAM(1);
    if (IN(2)) {
        FRESH_ARGS();
        FRESH_TID();
        for (int m0 = gw; m0 < M; m0 += 4 * NGW) qknorm_batch<4>(QKG, KCna, KCdf, m0, NGW, ap->g_na_q, ap->g_na_k, ap->g_df_q, ap->g_df_k, ROPE, lane);
    }
    SEAM(2);
    for (int rep_ = 0; rep_ < NREP(3); ++rep_) {
    if (IN(3)) {
        FRESH_ARGS();
        FRESH_TID();
        LAS float* red = (LAS float*)(lds + 131072);
        float mq = 0.f, mk = 0.f, mdq = 0.f, mdk = 0.f, mb = 0.f;
        if (tid < 128) { mq = fabsf(ap->g_na_q[tid]); mk = fabsf(ap->g_na_k[tid]); }
        if (tid < 64) { mdq = fabsf(ap->g_df_q[tid]); mdk = fabsf(ap->g_df_k[tid]); }
        for (int i = tid; i < NA_H * 15 * 31; i += NTHREADS) mb = fmaxf(mb, ap->na_rpb[i]);
        mq = wave_max(mq); mk = wave_max(mk); mdq = wave_max(mdq); mdk = wave_max(mdk); mb = wave_max(mb);
        float d1 = 0.f, d2 = 0.f;
        if (wave == 0) { d1 = wave_sum(ap->lam_q1[lane] * ap->lam_k1[lane]); d2 = wave_sum(ap->lam_q2[lane] * ap->lam_k2[lane]); }
        if (lane == 0) { red[wave * 8 + 0] = mq; red[wave * 8 + 1] = mk; red[wave * 8 + 2] = mdq; red[wave * 8 + 3] = mdk; red[wave * 8 + 4] = mb; red[wave * 8 + 5] = d1; red[wave * 8 + 6] = d2; }
        __syncthreads();
        mq = 0.f; mk = 0.f; mdq = 0.f; mdk = 0.f; mb = 0.f;
#pragma unroll
        for (int w = 0; w < 8; ++w) { mq = fmaxf(mq, red[w * 8]); mk = fmaxf(mk, red[w * 8 + 1]); mdq = fmaxf(mdq, red[w * 8 + 2]); mdk = fmaxf(mdk, red[w * 8 + 3]); mb = fmaxf(mb, red[w * 8 + 4]); }
        const float lam = expf(red[5]) - expf(red[6]) + LAM_INIT;
        const float M2na = (11.313708498984761f * mq * mk + mb) * LOG2E + 0.125f;
        const float M2df = (8.0f * mdq * mdk) * LOG2E + 0.125f;
        __syncthreads();
#ifndef NO_DF
        for (int uu = 2 * vcu; uu < BATCH * DF_H * (SEQ / 128); uu += 2 * G)
            for (int i2 = 0; i2 < 2; ++i2) { const int uidx = uu + i2, bh = uidx >> 5, qb = uidx & 31;
#ifdef PROBE_DFWAIT
                unsigned long long dfw_ = 0;
                df_unit(lds, QKG, KCdf, VT, AO + 1024, ap->g_df_sub, lam, M2df, bh >> 3, bh & 7, qb, &dfw_);
                if (bx == 0 && threadIdx.x == 0) { volatile unsigned long long* TS = (volatile unsigned long long*)(ws + 2048); TS[11] = (i2 ? TS[11] : 0ull) + dfw_; TS[12] = 0ull; }
#else
                df_unit(lds, QKG, KCdf, VT, AO + 1024, ap->g_df_sub, lam, M2df, bh >> 3, bh & 7, qb);
#endif
            }
#endif
        STAMP(10);
#ifdef PROBE_TS
        if (threadIdx.x == 0) { atomicMax((unsigned long long*)(ws + 2048) + 14, (unsigned long long)__builtin_amdgcn_s_memrealtime()); atomicMin((unsigned long long*)(ws + 2048) + 16, (unsigned long long)__builtin_amdgcn_s_memrealtime()); }
#endif
#ifndef NO_NA
        for (int uidx = vcu; uidx < BATCH * NA_H * (GROWS / 4); uidx += G) {
            const int bh = uidx >> 4, rg = uidx & 15;
            na_unit(lds, QKG, KCna, VT, ap->na_rpb, AO, M2na, bh >> 3, bh & 7, rg * 4);
        }
        STAMP(13);
#ifdef PROBE_TS
        if (threadIdx.x == 0) atomicMax((unsigned long long*)(ws + 2048) + 15, (unsigned long long)__builtin_amdgcn_s_memrealtime());
#endif
#endif
    }
    }
    SEAM(3);
    for (int rep_ = 0; rep_ < NREP(4); ++rep_) {
    if (IN(4)) {
        FRESH_ARGS();
        { pg8::Gemm g{AO, Wna, M, D, 2048, 16}; pg8::PairOrder S; S.S.init(M, D, G, bx); S.kob = 1024 * 2; pg8::EpiMerge E{QKG + QC_GA, QKG + QC_GB, NQKG, MRG, D, 16};
          pg8::gemm_phase<pg8::EpiMerge, pg8::PairOrder, true, true>(lds, g, S, E); }
    }
    }
    SEAM(4);
    if (IN(5)) {
        FRESH_ARGS();
        pg8::Gemm g{MRG, Wo, M, D, D}; pg8::StaticOrder S; S.init(M, D, G, bx); pg8::EpiResid<false> E{ap->x, X1B, RS1, D};
        pg8::gemm_phase<pg8::EpiResid<false>, pg8::StaticOrder, true, true>(lds, g, S, E);
    }
    SEAM(5);
    for (int rep_ = 0; rep_ < NREP(6); ++rep_) {
    if (IN(6)) {
        FRESH_ARGS();
        pg8::Gemm g{X1B, Wgu, M, 2 * FF, D}; pg8::StaticOrder S; S.init(M, 2 * FF, G, bx); pg8::EpiSwiGLU E{RS1, HB, FF, 1.0f / D, EPS};
        pg8::gemm_phase<pg8::EpiSwiGLU, pg8::StaticOrder, true, true>(lds, g, S, E);
        { constexpr int NU6 = (M / 256) * (2 * FF / 256), NU8 = (M / 256) * (D / 256);
          const int rem = NU6 % G, nshort = rem ? G - rem : G;
          pg8::TailOrder T; T.first = (rem == 0) ? bx : (bx >= rem ? bx - rem : -1); T.stride = nshort; T.total = NU8;
          int kple = PLE; asm volatile("" : "+s"(kple));
          pg8::Gemm g2{PB, Wpp, M, D, kple}; pg8::EpiStoreBf16 E2{T2B, D};
          pg8::gemm_phase<pg8::EpiStoreBf16, pg8::TailOrder, true, true>(lds, g2, T, E2);
          if (T.first >= 0) { FRESH_TID();
              LAS float* scr = (LAS float*)(lds + wave * 16384);
              const int sw = ((rem == 0) ? bx : bx - rem) * NWAVES + wave, nsw = nshort * NWAVES;
              float cur[32], nxt[32]; P0Item dc, dn;
              int it = N_EARLY + sw;
              if (it < NITEMS) { P0_DECODE(it, dc); p0_item_load(dc, cur, lane); }
              for (; it < NITEMS; it += nsw) {
                  const int nit = it + nsw; const bool more = nit < NITEMS;
                  if (more) { P0_DECODE(nit, dn); p0_item_load(dn, nxt, lane); }
                  p0_item_store(dc, cur, scr, lane);
                  if (more) { dc = dn;
#pragma unroll
                      for (int i = 0; i < 32; ++i) cur[i] = nxt[i]; }
              } } }
    }
    }
    SEAM(6);
    if (IN(7)) {
        FRESH_ARGS();
        pg8::Gemm g{HB, Wdn, M, D, FF}; pg8::StaticOrder S; S.init(M, D, G, bx); pg8::EpiResid<true> E{X1B, X2B, RS2, D};
        pg8::gemm_phase<pg8::EpiResid<true>, pg8::StaticOrder, true, true>(lds, g, S, E);
    }
    SEAM(7);
    if (IN(8)) {
        FRESH_ARGS();
#ifndef NO_P8B
        { pg8::Gemm g{X2B, Wpg, M, D, D}; pg8::StaticOrder S; S.init(M, D, G, bx); pg8::EpiPle E{RS2, T2B, X2B, ap->out, D, 1.0f / D, EPS};
          pg8::gemm_phase<pg8::EpiPle, pg8::StaticOrder, true, true>(lds, g, S, E); }
#endif
    }
#ifdef PROBE_TS
    STAMP(9);
    GBAR(8);
    { const unsigned long long* TS = (const unsigned long long*)(ws + 2048);
      const unsigned long long ta = __hip_atomic_load(TS + PROBE_A, __ATOMIC_RELAXED, __HIP_MEMORY_SCOPE_AGENT), tb = __hip_atomic_load(TS + PROBE_B, __ATOMIC_RELAXED, __HIP_MEMORY_SCOPE_AGENT);
      const int K = PROBE_CONST ? PROBE_CONST : (int)((tb - ta) / 8);
      FRESH_ARGS();
      for (int i = vcu * NTHREADS + (int)threadIdx.x; i < K && i < 42000; i += G * NTHREADS) ap->out[(size_t)i * 397] += 0.125f; }
#endif
#undef IN
#undef SEAM
}

#ifndef MK_SPLIT
#define MK_SPLIT 0
#endif
extern "C" void kernel_launch(void* const* d_in, const int* in_sizes, int n_in, void* d_out, int out_size, void* d_ws, size_t ws_size, hipStream_t stream) {
    static int grid = 0;
    if (grid == 0) {
        if (n_in != 24 || in_sizes[0] != M * D || out_size != M * D || ws_size < WS_END) { fprintf(stderr, "kernel_launch: unexpected shapes (n_in %d, in0 %d, out %d, ws %zu); nothing launched\n", n_in, n_in > 0 ? in_sizes[0] : -1, out_size, ws_size); grid = -1; return; }
        int dev = 0, cus = 0, per_cu = 0;
        hipGetDevice(&dev); hipDeviceGetAttribute(&cus, hipDeviceAttributeMultiprocessorCount, dev);
        hipFuncSetAttribute((const void*)fwd_megakernel, hipFuncAttributeMaxDynamicSharedMemorySize, LDS_BYTES);
        hipOccupancyMaxActiveBlocksPerMultiprocessor(&per_cu, (const void*)fwd_megakernel, NTHREADS, LDS_BYTES);
        if (per_cu < 1) per_cu = 1;
        grid = cus * per_cu;
        (void)hipGetLastError();
    }
    if (grid < 0) return;
    Args a{};
    const float** ap = (const float**)&a;
    for (int i = 0; i < 24; ++i) ap[i] = (const float*)d_in[i];
    a.out = (float*)d_out; a.ws = (unsigned char*)d_ws; a.rep3 = NREP(3); a.pad = 0;
#if MK_SPLIT
    for (int ph = 0; ph < NPHASE; ++ph) { a.ph_lo = ph; a.ph_hi = ph + 1; hipLaunchKernelGGL(fwd_megakernel, dim3(grid), dim3(NTHREADS), LDS_BYTES, stream, a); }
#else
    a.ph_lo = 0; a.ph_hi = NPHASE;
    (void)hipMemsetAsync((unsigned char*)d_ws + 4096, 0, 20480, stream);
#ifdef PROBE_TS
    (void)hipMemsetAsync((unsigned char*)d_ws + 2048 + 14 * 8, 0, 16, stream); (void)hipMemsetAsync((unsigned char*)d_ws + 2048 + 16 * 8, 0x7f, 8, stream);
#endif
    void* args[] = {&a};
    hipError_t e = hipLaunchCooperativeKernel((const void*)fwd_megakernel, dim3(grid), dim3(NTHREADS), args, LDS_BYTES, stream);
    if (e != hipSuccess) fprintf(stderr, "cooperative launch failed: %s (grid %d)\n", hipGetErrorString(e), grid);
#endif
}
```

```cpp
#include <hip/hip_runtime.h>
#include <hip/hip_cooperative_groups.h>
#include <cstdio>
#include <cstdint>
namespace cg = cooperative_groups;
namespace pg8 {
#define PG8_LAS __attribute__((address_space(3)))
typedef unsigned short bf16_t;
typedef short bf16x8 __attribute__((ext_vector_type(8)));
typedef float f32x4 __attribute__((ext_vector_type(4)));
typedef unsigned u32x4 __attribute__((ext_vector_type(4)));
constexpr int BM = 256, BK = 64, HALF = 128, HTB = HALF * BK * 2  , STAGE_BYTES = 8 * HTB, NXCD = 8, WGM = 8;

__host__ __device__ __forceinline__ int lds_byte(int r, int c) { const int st = (r >> 4) * 2 + (c >> 5), rr = r & 15, cc = c & 31, ob = rr * 64 + cc * 2; return st * 1024 + (ob ^ (((ob >> 9) & 1) << 5)); }
__host__ __device__ __forceinline__ void stage_rc(int b, int& R, int& C) { const int st = b / 1024, sb = b % 1024, swz = sb ^ (((sb >> 9) & 1) << 5); R = (st >> 1) * 16 + swz / 64; C = (st & 1) * 32 + (swz % 64) / 2; }
__host__ __device__ __forceinline__ int perm32(int rho) { const int n = rho >> 4, i = rho & 15; return 8 * (i >> 2) + 4 * n + (i & 3); }

struct Unit { int pm, pn; int ko = 0; };
struct Gemm { const bf16_t* A; const bf16_t* Bt; int M, N, K; int nt = 0; };

struct StaticOrder {
    int nM, nN, nwg, G, c;
    __host__ __device__ void init(int M, int N, int G_, int c_) { nM = M / BM; nN = N / BM; nwg = nM * nN; G = G_; c = c_; }
    __host__ __device__ bool next(int i, Unit& u) const {
        const long L = (long)i * G + c; if (L >= nwg) return false;
        int wgid = (int)L; { const int q = nwg / NXCD, r = nwg % NXCD, xcd = wgid % NXCD, off = wgid / NXCD; wgid = (xcd < r ? xcd * (q + 1) : r * (q + 1) + (xcd - r) * q) + off; }
        const int nig = WGM * nN, gid = wgid / nig, fm = gid * WGM, gsz = (nM - fm) < WGM ? (nM - fm) : WGM;
        u.pm = fm + ((wgid % nig) % gsz); u.pn = (wgid % nig) / gsz; return true;
    }
    __device__ __forceinline__ void a_ready(const Unit&) const {}
    __device__ __forceinline__ void done(const Unit&) const {}
};


struct TailOrder {
    int first, stride, total;
    __host__ __device__ bool next(int i, Unit& u) const { if (first < 0) return false; const int j = first + i * stride; if (j >= total) return false; u.pm = j >> 3; u.pn = j & 7; return true; }
    __device__ __forceinline__ void a_ready(const Unit&) const {}
    __device__ __forceinline__ void done(const Unit&) const {}
};

struct PairOrder {
    StaticOrder S; int kob;
    __host__ __device__ bool next(int i, Unit& u) const { if (!S.next(i >> 1, u)) return false; u.ko = (i & 1) * kob; return true; }
    __device__ __forceinline__ void a_ready(const Unit&) const {}
    __device__ __forceinline__ void done(const Unit&) const {}
};
__device__ __forceinline__ unsigned cvt_pk_bf16(float lo, float hi) { unsigned r; asm volatile("v_cvt_pk_bf16_f32 %0, %1, %2" : "=v"(r) : "v"(lo), "v"(hi)); return r; }
__device__ __forceinline__ float bf_lo(unsigned w) { return __uint_as_float(w << 16); }
__device__ __forceinline__ float bf_hi(unsigned w) { return __uint_as_float(w & 0xffff0000u); }
__device__ __forceinline__ float sigmoidf_(float x) { return __builtin_amdgcn_rcpf(1.0f + __expf(-x)); }
typedef unsigned u32x2 __attribute__((ext_vector_type(2)));
#define EPI_FENCE() asm volatile("" ::: "memory")
#define EPI_ROWS(...) _Pragma("unroll") for (int ai = 0; ai < 2; ++ai) _Pragma("unroll") for (int m = 0; m < 4; ++m) { const int row = u.pm * BM + ai * HALF + wr * 64 + m * 16 + fr; __VA_ARGS__ }

struct EpiQKG {
    static constexpr bool PERM = true, AFTER_DRAIN = false, MIDK = false;
    bf16_t* O; int ldc;
    __device__ __forceinline__ void operator()(const f32x4 (&acc)[2][2][4][2], const Unit& u, int wr, int wc, int fr, int fq) const {
        const bool gate = u.pn >= 16; const int col0 = u.pn * BM + wc * 32 + 8 * fq;
        EPI_ROWS(
            bf16_t* rowp = O + (size_t)row * ldc + col0;
            _Pragma("unroll") for (int bj = 0; bj < 2; ++bj) { f32x4 v0 = acc[ai][bj][m][0], v1 = acc[ai][bj][m][1];
                if (gate) { _Pragma("unroll") for (int j = 0; j < 4; ++j) { v0[j] = sigmoidf_(v0[j]); v1[j] = sigmoidf_(v1[j]); } }
                u32x4 w; w.x = cvt_pk_bf16(v0[0], v0[1]); w.y = cvt_pk_bf16(v0[2], v0[3]); w.z = cvt_pk_bf16(v1[0], v1[1]); w.w = cvt_pk_bf16(v1[2], v1[3]);
                *(u32x4*)(rowp + bj * HALF) = w; }
            EPI_FENCE();
        )
    }
};
struct EpiVT {
    static constexpr bool PERM = true, AFTER_DRAIN = false, MIDK = false;
    bf16_t* O; int ldc;
    __device__ __forceinline__ void operator()(const f32x4 (&acc)[2][2][4][2], const Unit& u, int wr, int wc, int fr, int fq) const {
        const int cbase = u.pn * BM + wc * 32 + 16 * (fq >> 1) + 4 * (fq & 1);
        EPI_ROWS(
            const int hv = row >> 7, dd = row & 127;
            _Pragma("unroll") for (int bj = 0; bj < 2; ++bj) _Pragma("unroll") for (int n = 0; n < 2; ++n) { const f32x4 v = acc[ai][bj][m][n];
                const int col = cbase + bj * HALF + 8 * n, bb = col >> 12, kt = (col >> 6) & 63, pos = col & 63;
                u32x2 w; w.x = cvt_pk_bf16(v[0], v[1]); w.y = cvt_pk_bf16(v[2], v[3]);
                *(u32x2*)(O + ((((size_t)(bb * 16 + hv)) * 64 + kt) * 128 + dd) * 64 + pos) = w; }
            EPI_FENCE();
        )
    }
};
struct EpiMerge {
    static constexpr bool PERM = true, AFTER_DRAIN = false, MIDK = true;
    const bf16_t* GA; const bf16_t* GB; int ldg; bf16_t* O; int ldc; int midk;
    __device__ __forceinline__ void mid(f32x4 (&acc)[2][2][4][2], const Unit& u, int wr, int wc, int fr, int fq) const {
        const int col0 = u.pn * BM + wc * 32 + 8 * fq;
        EPI_ROWS(
            _Pragma("unroll") for (int bj = 0; bj < 2; ++bj) { const size_t off = (size_t)row * ldg + col0 + bj * HALF;
                const u32x4 a = *(const u32x4*)(GA + off), b = *(const u32x4*)(GB + off);
                float r[8];
                r[0] = bf_lo(a.x) * __builtin_amdgcn_rcpf(fmaxf(bf_lo(b.x), 1e-30f)); r[1] = bf_hi(a.x) * __builtin_amdgcn_rcpf(fmaxf(bf_hi(b.x), 1e-30f));
                r[2] = bf_lo(a.y) * __builtin_amdgcn_rcpf(fmaxf(bf_lo(b.y), 1e-30f)); r[3] = bf_hi(a.y) * __builtin_amdgcn_rcpf(fmaxf(bf_hi(b.y), 1e-30f));
                r[4] = bf_lo(a.z) * __builtin_amdgcn_rcpf(fmaxf(bf_lo(b.z), 1e-30f)); r[5] = bf_hi(a.z) * __builtin_amdgcn_rcpf(fmaxf(bf_hi(b.z), 1e-30f));
                r[6] = bf_lo(a.w) * __builtin_amdgcn_rcpf(fmaxf(bf_lo(b.w), 1e-30f)); r[7] = bf_hi(a.w) * __builtin_amdgcn_rcpf(fmaxf(bf_hi(b.w), 1e-30f));
                _Pragma("unroll") for (int j = 0; j < 4; ++j) { acc[ai][bj][m][0][j] *= r[j]; acc[ai][bj][m][1][j] *= r[4 + j]; } }
            EPI_FENCE();
        )
    }
    __device__ __forceinline__ void operator()(const f32x4 (&acc)[2][2][4][2], const Unit& u, int wr, int wc, int fr, int fq) const {
        const int col0 = u.pn * BM + wc * 32 + 8 * fq;
        EPI_ROWS(
            _Pragma("unroll") for (int bj = 0; bj < 2; ++bj) { const u32x4 b = *(const u32x4*)(GB + (size_t)row * ldg + col0 + bj * HALF);
                f32x4 v0 = acc[ai][bj][m][0], v1 = acc[ai][bj][m][1];
                v0[0] *= fmaxf(bf_lo(b.x), 1e-30f); v0[1] *= fmaxf(bf_hi(b.x), 1e-30f); v0[2] *= fmaxf(bf_lo(b.y), 1e-30f); v0[3] *= fmaxf(bf_hi(b.y), 1e-30f);
                v1[0] *= fmaxf(bf_lo(b.z), 1e-30f); v1[1] *= fmaxf(bf_hi(b.z), 1e-30f); v1[2] *= fmaxf(bf_lo(b.w), 1e-30f); v1[3] *= fmaxf(bf_hi(b.w), 1e-30f);
                u32x4 w; w.x = cvt_pk_bf16(v0[0], v0[1]); w.y = cvt_pk_bf16(v0[2], v0[3]); w.z = cvt_pk_bf16(v1[0], v1[1]); w.w = cvt_pk_bf16(v1[2], v1[3]);
                *(u32x4*)(O + (size_t)row * ldc + col0 + bj * HALF) = w; }
            EPI_FENCE();
        )
    }
};
template <bool BASE_BF16> struct EpiResid {
    static constexpr bool PERM = true, AFTER_DRAIN = false, MIDK = false;
    const void* base; bf16_t* ob; float* rowss; int ldc;
    __device__ __forceinline__ void operator()(const f32x4 (&acc)[2][2][4][2], const Unit& u, int wr, int wc, int fr, int fq) const {
        const int col0 = u.pn * BM + wc * 32 + 8 * fq;
        EPI_ROWS(
            float ss = 0.f;
            _Pragma("unroll") for (int bj = 0; bj < 2; ++bj) { const size_t off = (size_t)row * ldc + col0 + bj * HALF;
                f32x4 b0, b1;
                if (BASE_BF16) { const u32x4 bw = *(const u32x4*)((const bf16_t*)base + off); b0 = (f32x4){bf_lo(bw.x), bf_hi(bw.x), bf_lo(bw.y), bf_hi(bw.y)}; b1 = (f32x4){bf_lo(bw.z), bf_hi(bw.z), bf_lo(bw.w), bf_hi(bw.w)}; }
                else { b0 = __builtin_nontemporal_load((const f32x4*)((const float*)base + off)); b1 = __builtin_nontemporal_load((const f32x4*)((const float*)base + off + 4)); }
                const f32x4 v0 = acc[ai][bj][m][0] + b0, v1 = acc[ai][bj][m][1] + b1;
                ss += (v0[0] * v0[0] + v0[1] * v0[1]) + (v0[2] * v0[2] + v0[3] * v0[3]) + (v1[0] * v1[0] + v1[1] * v1[1]) + (v1[2] * v1[2] + v1[3] * v1[3]);
                u32x4 w; w.x = cvt_pk_bf16(v0[0], v0[1]); w.y = cvt_pk_bf16(v0[2], v0[3]); w.z = cvt_pk_bf16(v1[0], v1[1]); w.w = cvt_pk_bf16(v1[2], v1[3]);
                *(u32x4*)(ob + off) = w; }
            ss += __shfl_xor(ss, 16); ss += __shfl_xor(ss, 32);
            if (fq == 0) atomicAdd(rowss + row, ss);
            EPI_FENCE();
        )
    }
};
struct EpiSwiGLU {
    static constexpr bool PERM = true, AFTER_DRAIN = false, MIDK = false;
    const float* rowss; bf16_t* H; int ldh; float inv_d, eps;
    __device__ __forceinline__ void operator()(const f32x4 (&acc)[2][2][4][2], const Unit& u, int wr, int wc, int fr, int fq) const {
        const int col0 = u.pn * HALF + wc * 32 + 8 * fq;
        EPI_ROWS(
            const float rs = __builtin_amdgcn_rsqf(rowss[row] * inv_d + eps);
            float hv[8];
            _Pragma("unroll") for (int n = 0; n < 2; ++n) _Pragma("unroll") for (int j = 0; j < 4; ++j) { const float g = acc[ai][0][m][n][j] * rs, up = acc[ai][1][m][n][j] * rs; hv[n * 4 + j] = g * sigmoidf_(g) * up; }
            u32x4 w; w.x = cvt_pk_bf16(hv[0], hv[1]); w.y = cvt_pk_bf16(hv[2], hv[3]); w.z = cvt_pk_bf16(hv[4], hv[5]); w.w = cvt_pk_bf16(hv[6], hv[7]);
            *(u32x4*)(H + (size_t)row * ldh + col0) = w;
            EPI_FENCE();
        )
    }
};
struct EpiStoreBf16 {
    static constexpr bool PERM = true, AFTER_DRAIN = false, MIDK = false;
    bf16_t* T; int ldc;
    __device__ __forceinline__ void operator()(const f32x4 (&acc)[2][2][4][2], const Unit& u, int wr, int wc, int fr, int fq) const {
        const int col0 = u.pn * BM + wc * 32 + 8 * fq;
        EPI_ROWS(
            _Pragma("unroll") for (int bj = 0; bj < 2; ++bj) { const f32x4 v0 = acc[ai][bj][m][0], v1 = acc[ai][bj][m][1];
                u32x4 w; w.x = cvt_pk_bf16(v0[0], v0[1]); w.y = cvt_pk_bf16(v0[2], v0[3]); w.z = cvt_pk_bf16(v1[0], v1[1]); w.w = cvt_pk_bf16(v1[2], v1[3]);
                *(u32x4*)(T + (size_t)row * ldc + col0 + bj * HALF) = w; }
            EPI_FENCE();
        )
    }
};
struct EpiPle {
    static constexpr bool PERM = true, AFTER_DRAIN = false, MIDK = false;
    const float* rowss; const bf16_t* T; const bf16_t* X; float* out; int ldc; float inv_d, eps;
    __device__ __forceinline__ void operator()(const f32x4 (&acc)[2][2][4][2], const Unit& u, int wr, int wc, int fr, int fq) const {
        const int col0 = u.pn * BM + wc * 32 + 8 * fq;
        EPI_ROWS(
            const float rs = __builtin_amdgcn_rsqf(rowss[row] * inv_d + eps);
            _Pragma("unroll") for (int bj = 0; bj < 2; ++bj) { const size_t off = (size_t)row * ldc + col0 + bj * HALF;
                const u32x4 tw = *(const u32x4*)(T + off), xw = *(const u32x4*)(X + off);
                const float t[8] = {bf_lo(tw.x), bf_hi(tw.x), bf_lo(tw.y), bf_hi(tw.y), bf_lo(tw.z), bf_hi(tw.z), bf_lo(tw.w), bf_hi(tw.w)};
                const float x[8] = {bf_lo(xw.x), bf_hi(xw.x), bf_lo(xw.y), bf_hi(xw.y), bf_lo(xw.z), bf_hi(xw.z), bf_lo(xw.w), bf_hi(xw.w)};
                f32x4 o0, o1;
                _Pragma("unroll") for (int j = 0; j < 4; ++j) { o0[j] = x[j] + sigmoidf_(acc[ai][bj][m][0][j] * rs) * t[j]; o1[j] = x[4 + j] + sigmoidf_(acc[ai][bj][m][1][j] * rs) * t[4 + j]; }
                __builtin_nontemporal_store(o0, (f32x4*)(out + off)); __builtin_nontemporal_store(o1, (f32x4*)(out + off + 4)); }
            EPI_FENCE();
        )
    }
};
template <class Epi, class Sched, bool ALIGN_EPI = false, bool SP2 = false>
__device__ __forceinline__ void gemm_phase(PG8_LAS unsigned char* lds, const Gemm g, const Sched& S, const Epi& E) {
    int tid_ = threadIdx.x; asm volatile("" : "+v"(tid_));
    const int tid = tid_, wid = __builtin_amdgcn_readfirstlane(tid >> 6), lane = tid & 63, wr = wid >> 2, wc = wid & 3, fr = lane & 15, fq = lane >> 4;
    const int K = g.K, nt = g.nt ? g.nt : K / BK;
    unsigned voffA[2], voffB[2];
#pragma unroll
    for (int i = 0; i < 2; ++i) { int R, C; stage_rc(tid * 16 + i * 8192, R, C); const int Rb = Epi::PERM ? ((R & ~31) + perm32(R & 31)) : R;
        voffA[i] = (unsigned)(R * K + C) * 2u; voffB[i] = (unsigned)(Rb * K + C) * 2u; }
    const size_t kstep = (size_t)(BK * 2);
    const size_t hstep = (size_t)HALF * K * 2;
    const size_t tstep = 2 * hstep;
    const unsigned ldsw = (unsigned)wid * 1024u;
    const int aoff = lds_byte(wr * 64 + fr, fq * 8), boff = lds_byte(wc * 32 + fr, fq * 8);
#define PG8_SA(b, h) (((b) * 2 + (h)) * HTB)
#define PG8_SB(b, h) ((4 + (b) * 2 + (h)) * HTB)
#define PG8_STAGE(bufoff, gbase, voff) do { _Pragma("unroll") for (int _i = 0; _i < 2; ++_i) \
        __builtin_amdgcn_global_load_lds((const unsigned*)((const char*)(gbase) + (voff)[_i]), (PG8_LAS unsigned*)(lds + (bufoff) + ldsw + _i * 8192), 16, 0, 0); } while (0)
#define PG8_LDA(dst, b, h) do { _Pragma("unroll") for (int m = 0; m < 4; ++m) _Pragma("unroll") for (int k = 0; k < 2; ++k) dst[m][k] = *(const PG8_LAS bf16x8*)(lds + PG8_SA(b, h) + aoff + m * 2048 + k * 1024); } while (0)
#define PG8_LDB(dst, b, h) do { _Pragma("unroll") for (int n = 0; n < 2; ++n) _Pragma("unroll") for (int k = 0; k < 2; ++k) dst[n][k] = *(const PG8_LAS bf16x8*)(lds + PG8_SB(b, h) + boff + n * 2048 + k * 1024); } while (0)
#define PG8_MMA(ai, bj, At, Bt) do { __builtin_amdgcn_s_setprio(1); _Pragma("unroll") for (int m = 0; m < 4; ++m) _Pragma("unroll") for (int n = 0; n < 2; ++n) _Pragma("unroll") for (int k = 0; k < 2; ++k) \
        acc[ai][bj][m][n] = __builtin_amdgcn_mfma_f32_16x16x32_bf16(Bt[n][k], At[m][k], acc[ai][bj][m][n], 0, 0, 0); __builtin_amdgcn_s_setprio(0); } while (0)
#define PG8_WAIT_V(n) asm volatile("s_waitcnt vmcnt(" #n ")" ::: "memory")
#define PG8_WAIT_L(n) asm volatile("s_waitcnt lgkmcnt(" #n ")" ::: "memory")
#define PG8_BAR __builtin_amdgcn_s_barrier()
#define PG8_SCHED __builtin_amdgcn_sched_barrier(0)
    Unit cur, nxt; int ui = 0;
    if (!S.next(0, cur)) return;
    f32x4 acc[2][2][4][2];
#pragma unroll
    for (int a = 0; a < 2; ++a)
#pragma unroll
        for (int b = 0; b < 2; ++b)
#pragma unroll
            for (int m = 0; m < 4; ++m)
#pragma unroll
                for (int n = 0; n < 2; ++n) acc[a][b][m][n] = (f32x4){0.f, 0.f, 0.f, 0.f};
    bf16x8 At[4][2], B0[2][2], B1[2][2];
    const char* cA = (const char*)g.A + (size_t)cur.pm * tstep + cur.ko; const char* cB = (const char*)g.Bt + (size_t)cur.pn * tstep + cur.ko;
    S.a_ready(cur);
    if constexpr (SP2) {
        PG8_STAGE(PG8_SB(0, 0), cB, voffB); PG8_STAGE(PG8_SB(0, 1), cB + hstep, voffB); PG8_STAGE(PG8_SA(0, 0), cA, voffA); PG8_STAGE(PG8_SA(0, 1), cA + hstep, voffA);
        if (wr == 1) PG8_BAR;
        PG8_WAIT_V(2); PG8_BAR;
        PG8_STAGE(PG8_SB(1, 0), cB + kstep, voffB); PG8_STAGE(PG8_SA(1, 0), cA + kstep, voffA); PG8_STAGE(PG8_SB(1, 1), cB + hstep + kstep, voffB);
        PG8_WAIT_V(6); PG8_BAR;
    } else {
        PG8_STAGE(PG8_SB(0, 0), cB, voffB); PG8_STAGE(PG8_SA(0, 0), cA, voffA); PG8_STAGE(PG8_SB(0, 1), cB + hstep, voffB); PG8_STAGE(PG8_SA(0, 1), cA + hstep, voffA);
        if (wr == 1) PG8_BAR;
        PG8_WAIT_V(4); PG8_BAR;
        PG8_STAGE(PG8_SB(1, 0), cB + kstep, voffB); PG8_STAGE(PG8_SA(1, 0), cA + kstep, voffA); PG8_STAGE(PG8_SB(1, 1), cB + hstep + kstep, voffB);
        PG8_WAIT_V(6); PG8_BAR;
    }
    for (;;) {
        const bool has_next = S.next(ui + 1, nxt);
        const char* nA = has_next ? (const char*)g.A + (size_t)nxt.pm * tstep + nxt.ko : cA; const char* nB = has_next ? (const char*)g.Bt + (size_t)nxt.pn * tstep + nxt.ko : cB;
        for (int t = 0; t < nt; t += 2) {
            const bool last = (t == nt - 2);
            const char* a1 = cA + (size_t)(t + 1) * kstep;
            const char* a2 = last ? nA : cA + (size_t)(t + 2) * kstep; const char* b2 = last ? nB : cB + (size_t)(t + 2) * kstep;
            const char* a3 = a2 + kstep; const char* b3 = b2 + kstep;
            if (last && has_next) S.a_ready(nxt);
            if constexpr (SP2) {
            PG8_LDB(B0, 0, 0); PG8_LDB(B1, 0, 1); PG8_SCHED; PG8_LDA(At, 0, 0); PG8_STAGE(PG8_SA(1, 1), a1 + hstep, voffA);
            PG8_WAIT_V(8); PG8_WAIT_L(0); PG8_BAR; PG8_MMA(0, 0, At, B0); PG8_MMA(0, 1, At, B1); PG8_BAR; PG8_SCHED;
            PG8_LDA(At, 0, 1); PG8_STAGE(PG8_SB(0, 0), b2, voffB); PG8_STAGE(PG8_SB(0, 1), b2 + hstep, voffB); PG8_STAGE(PG8_SA(0, 0), a2, voffA);
            PG8_WAIT_V(8); PG8_WAIT_L(0); PG8_BAR; PG8_MMA(1, 0, At, B0); PG8_MMA(1, 1, At, B1); PG8_BAR; PG8_SCHED;
            PG8_LDB(B0, 1, 0); PG8_LDB(B1, 1, 1); PG8_SCHED; PG8_LDA(At, 1, 0); PG8_STAGE(PG8_SA(0, 1), a2 + hstep, voffA);
            PG8_WAIT_V(8); PG8_WAIT_L(0); PG8_BAR; PG8_MMA(0, 0, At, B0); PG8_MMA(0, 1, At, B1); PG8_BAR; PG8_SCHED;
            PG8_LDA(At, 1, 1); PG8_STAGE(PG8_SB(1, 0), b3, voffB); PG8_STAGE(PG8_SB(1, 1), b3 + hstep, voffB); PG8_STAGE(PG8_SA(1, 0), a3, voffA);
            PG8_WAIT_V(8); PG8_WAIT_L(0); PG8_BAR; PG8_MMA(1, 0, At, B0); PG8_MMA(1, 1, At, B1); PG8_BAR; PG8_SCHED;
            } else {
            PG8_LDB(B0, 0, 0); PG8_SCHED; PG8_LDA(At, 0, 0); PG8_STAGE(PG8_SA(1, 1), a1 + hstep, voffA);
            PG8_WAIT_L(8); PG8_BAR; PG8_WAIT_L(0); PG8_MMA(0, 0, At, B0); PG8_BAR; PG8_SCHED;
            PG8_LDB(B1, 0, 1); PG8_STAGE(PG8_SB(0, 0), b2, voffB);
            PG8_BAR; PG8_WAIT_L(0); PG8_MMA(0, 1, At, B1); PG8_BAR;
            PG8_LDA(At, 0, 1); PG8_STAGE(PG8_SA(0, 0), a2, voffA);
            PG8_BAR; PG8_WAIT_L(0); PG8_MMA(1, 0, At, B0); PG8_BAR; PG8_SCHED;
            PG8_STAGE(PG8_SB(0, 1), b2 + hstep, voffB);
            PG8_WAIT_V(6); PG8_BAR; PG8_MMA(1, 1, At, B1); PG8_BAR;
            PG8_LDB(B0, 1, 0); PG8_SCHED; PG8_LDA(At, 1, 0); PG8_STAGE(PG8_SA(0, 1), a2 + hstep, voffA);
            PG8_WAIT_L(8); PG8_BAR; PG8_WAIT_L(0); PG8_MMA(0, 0, At, B0); PG8_BAR; PG8_SCHED;
            PG8_LDB(B1, 1, 1); PG8_STAGE(PG8_SB(1, 0), b3, voffB);
            PG8_BAR; PG8_WAIT_L(0); PG8_MMA(0, 1, At, B1); PG8_BAR;
            PG8_LDA(At, 1, 1); PG8_STAGE(PG8_SA(1, 0), a3, voffA);
            PG8_BAR; PG8_WAIT_L(0); PG8_MMA(1, 0, At, B0); PG8_BAR; PG8_SCHED;
            PG8_STAGE(PG8_SB(1, 1), b3 + hstep, voffB);
            PG8_WAIT_V(6); PG8_BAR; PG8_MMA(1, 1, At, B1); PG8_BAR;
            }
        }
        if constexpr (ALIGN_EPI) { if (wr == 0) PG8_BAR; }
        bool keep_acc = false;
        if constexpr (Epi::MIDK) { if (cur.ko == 0) { E.mid(acc, cur, wr, wc, fr, fq); keep_acc = true; } else E(acc, cur, wr, wc, fr, fq); }
        else if constexpr (!Epi::AFTER_DRAIN) { E(acc, cur, wr, wc, fr, fq); S.done(cur); }
        if (!has_next) break;
        if (!keep_acc) {
#pragma unroll
        for (int a = 0; a < 2; ++a)
#pragma unroll
            for (int b = 0; b < 2; ++b)
#pragma unroll
                for (int m = 0; m < 4; ++m)
#pragma unroll
                    for (int n = 0; n < 2; ++n) acc[a][b][m][n] = (f32x4){0.f, 0.f, 0.f, 0.f};
        }
        cur = nxt; cA = nA; cB = nB; ++ui;
        if constexpr (ALIGN_EPI) { if (wr == 1) PG8_BAR; }
    }
    PG8_WAIT_V(0);
    if constexpr (!ALIGN_EPI) { if (wr == 0) PG8_BAR; }
    PG8_BAR;
    if constexpr (Epi::AFTER_DRAIN) { E.fused(acc, cur, wr, wc, fr, fq, lds, wid, lane); S.done(cur); }
#undef PG8_SA
#undef PG8_SB
#undef PG8_STAGE
#undef PG8_LDA
#undef PG8_LDB
#undef PG8_MMA
#undef PG8_WAIT_V
#undef PG8_WAIT_L
#undef PG8_BAR
#undef PG8_SCHED
}
}
constexpr int D = 2048, BATCH = 2, SEQ = 4096, M = BATCH * SEQ, GW = 64, GROWS = SEQ / GW, FF = 5632, PLE = 256;
constexpr int NA_H = 8, NA_DH = 128, DF_H = 8, DF_DQ = 64, DF_DV = 128;
constexpr int NQKG = 8192;
constexpr int QC_NAQ = 0, QC_NAK = 1024, QC_DFQ = 2048, QC_DFK = 3072, QC_GA = 4096, QC_GB = 6144;
constexpr float EPS = 1e-6f, LOG2E = 1.4426950408889634f;
constexpr float LAM_INIT = 0.2f;
constexpr int NWAVES = 8, NTHREADS = 512;
constexpr size_t MiB = 1u << 20;
constexpr size_t WS_RS1 = 64 * 1024, WS_RS2 = 128 * 1024, WS_ROPE = 1 * MiB;
constexpr size_t WS_W1 = 2 * MiB, WS_WNA = 42 * MiB, WS_WDF = 46 * MiB, WS_WO = 50 * MiB, WS_WGU = 58 * MiB, WS_WDN = 102 * MiB, WS_WPG = 124 * MiB, WS_WPP = 132 * MiB;
constexpr size_t WS_A = 133 * MiB;
constexpr size_t WS_B = 261 * MiB;
constexpr size_t WS_C = 293 * MiB;
constexpr size_t WS_PB = 325 * MiB;
constexpr size_t WS_END = 329 * MiB;
constexpr int LDS_BYTES = 147456;
#define LAS __attribute__((address_space(3)))
typedef unsigned short bf16;
typedef unsigned u32x4 __attribute__((ext_vector_type(4)));
typedef unsigned u32x2 __attribute__((ext_vector_type(2)));
typedef float f32x4 __attribute__((ext_vector_type(4)));
typedef float f32x2 __attribute__((ext_vector_type(2)));
typedef float f32x16 __attribute__((ext_vector_type(16)));
typedef short bf16x8 __attribute__((ext_vector_type(8)));
using pg8::cvt_pk_bf16; using pg8::bf_lo; using pg8::bf_hi;

__device__ __forceinline__ float wave_sum(float v) {
#pragma unroll
    for (int o = 1; o < 64; o <<= 1) v += __shfl_xor(v, o);
    return v;
}
__device__ __forceinline__ float wave_max(float v) {
#pragma unroll
    for (int o = 1; o < 64; o <<= 1) v = fmaxf(v, __shfl_xor(v, o));
    return v;
}
__device__ __forceinline__ int crow(int r, int hi) { return (r & 3) + 8 * (r >> 2) + 4 * hi; }

__device__ __forceinline__ int rowmap(int mode, int n0) {
    if (mode == 0) return n0;
    if (mode == 1) {
        if (n0 < 2048) return n0;
        if (n0 < 3072) return 8192 + (n0 - 2048);
        if (n0 < 4096) return 2048 + (n0 - 3072);
        if (n0 < 5120) return 3072 + (n0 - 4096);
        if (n0 < 6144) return 9216 + (n0 - 5120);
        return 4096 + (n0 - 6144);
    }
    return 256 * (n0 >> 7) + (n0 & 127) + (mode == 3 ? 128 : 0);
}
struct P0Item { const float* W; bf16* WT; const float* gk; int K, N, mode, item, Kd, kofs; };
__device__ __forceinline__ void p0_item_load(const P0Item& d, float (&v)[32], int lane) {
    const int nblk = d.N / 32, kb = d.item / nblk, nb = d.item % nblk, k0 = 64 * kb, n0 = 32 * nb;
    const float* src = d.W + (size_t)(k0 + (lane >> 5)) * d.N + n0 + (lane & 31);
#pragma unroll
    for (int i = 0; i < 32; ++i) v[i] = __builtin_nontemporal_load(src + (size_t)(2 * i) * d.N);
}
__device__ __forceinline__ void p0_item_store(const P0Item& d, const float (&v)[32], LAS float* scr, int lane) {
    const int nblk = d.N / 32, kb = d.item / nblk, nb = d.item % nblk, k0 = 64 * kb, n0 = 32 * nb;
    const int r0 = rowmap(d.mode, n0);
    if (d.gk) {
#pragma unroll
        for (int i = 0; i < 32; ++i) { const int kk = 2 * i + (lane >> 5); scr[kk * 33 + (lane & 31)] = v[i] * d.gk[k0 + kk]; }
    } else {
#pragma unroll
        for (int i = 0; i < 32; ++i) { const int kk = 2 * i + (lane >> 5); scr[kk * 33 + (lane & 31)] = v[i]; }
    }
    asm volatile("s_waitcnt lgkmcnt(0)" ::: "memory");
    const int c = lane & 7;
#pragma unroll
    for (int j = 0; j < 4; ++j) { const int n = (lane >> 3) + 8 * j; const LAS float* s = scr + (8 * c) * 33 + n;
        u32x4 o; o.x = cvt_pk_bf16(s[0 * 33], s[1 * 33]); o.y = cvt_pk_bf16(s[2 * 33], s[3 * 33]); o.z = cvt_pk_bf16(s[4 * 33], s[5 * 33]); o.w = cvt_pk_bf16(s[6 * 33], s[7 * 33]);
        *(u32x4*)(d.WT + (size_t)(r0 + n) * d.Kd + d.kofs + k0 + 8 * c) = o; }
    asm volatile("s_waitcnt lgkmcnt(0)" ::: "memory");
}
#define RLX_AGENT __ATOMIC_RELAXED, __HIP_MEMORY_SCOPE_AGENT
#define XB_TMO      128
#define XB_XCNT(j)  (256  + 64 * (j))
#define XB_XSUB(j)  (1280 + 64 * (j))
#define XB_XGEN(j)  (2304 + 64 * (j))
#define XB_TOP      3328
#define XB_TOPGEN   3392
#define XCD_BAR_WORDS 3456
#define XB_SPIN_CAP (1u << 18)

__device__ __forceinline__ unsigned xb_ld(unsigned* p)              { return __hip_atomic_load(p, __ATOMIC_RELAXED, __HIP_MEMORY_SCOPE_AGENT); }
__device__ __forceinline__ unsigned xb_add(unsigned* p, unsigned v) { return __hip_atomic_fetch_add(p, v, __ATOMIC_RELAXED, __HIP_MEMORY_SCOPE_AGENT); }
__device__ __forceinline__ unsigned xb_xcc_id() { return (unsigned)__builtin_amdgcn_s_getreg((3 << 11) | 20) & 0xFu; }
#define XB_SPIN(cond, bar) do { unsigned _sp = 0; while (cond) { __builtin_amdgcn_s_sleep(1); \
    if ((++_sp & 255u) == 0u) { if (xb_ld(&(bar)[XB_TMO])) break; if (_sp > XB_SPIN_CAP) { atomicAdd(&(bar)[XB_TMO], 1u); break; } } } } while (0)

struct XcdBarrier {
    unsigned* bar; unsigned x;
    volatile LAS unsigned* st;
};

__device__ __forceinline__ XcdBarrier xcd_barrier_post(unsigned* bar, volatile LAS unsigned* st) {
    XcdBarrier b; b.bar = bar; b.x = xb_xcc_id(); b.st = st;
    if (threadIdx.x == 0) (void)xb_add(&bar[XB_XCNT(b.x)], 1u);
    return b;
}
__device__ __forceinline__ void xcd_barrier_complete(unsigned* bar, unsigned x, unsigned& nloc, unsigned& nx) {
    const unsigned G = gridDim.x * gridDim.y * gridDim.z;
    unsigned sum, cnt, mine, sp = 0u;
    for (;;) {
        sum = 0u; cnt = 0u; mine = 0u;
#pragma unroll
        for (unsigned j = 0; j < 16; ++j) { const unsigned c = xb_ld(&bar[XB_XCNT(j)]); sum += c; cnt += (c > 0u) ? 1u : 0u; mine = (j == x) ? c : mine; }
        if (sum == G) break;
        __builtin_amdgcn_s_sleep(1);
        if ((++sp & 255u) == 0u) { if (xb_ld(&bar[XB_TMO])) break; if (sp > XB_SPIN_CAP) { atomicAdd(&bar[XB_TMO], 1u); break; } }
    }
    nloc = mine > 0u ? mine : 1u; nx = cnt > 0u ? cnt : 1u;
}

__device__ __forceinline__ void xcd_barrier(const XcdBarrier& b) {
    asm volatile("s_waitcnt vmcnt(0)" ::: "memory");
    __syncthreads();
    if (threadIdx.x == 0) {
        unsigned* bar = b.bar;
        __builtin_amdgcn_s_waitcnt(0);
        unsigned nloc = b.st[0], nx = b.st[1];
        if (nloc == 0u) { xcd_barrier_complete(bar, b.x, nloc, nx); b.st[0] = nloc; b.st[1] = nx; }
        const unsigned old = xb_add(&bar[XB_XSUB(b.x)], 1u);
        const unsigned gen = old / nloc;
        if (old + 1u == (gen + 1u) * nloc) {
            __builtin_amdgcn_fence(__ATOMIC_RELEASE, "agent");
            asm volatile("s_waitcnt vmcnt(0)" ::: "memory");
            const unsigned og = xb_add(&bar[XB_TOP], 1u);
            const unsigned tg = og / nx;
            if (og + 1u == (tg + 1u) * nx) xb_add(&bar[XB_TOPGEN], 1u);
            else XB_SPIN(xb_ld(&bar[XB_TOPGEN]) == tg, bar);
            __builtin_amdgcn_fence(__ATOMIC_ACQUIRE, "agent");
            xb_add(&bar[XB_XGEN(b.x)], 1u);
            asm volatile("s_waitcnt vmcnt(0)" ::: "memory");
        } else {
            XB_SPIN(xb_ld(&bar[XB_XGEN(b.x)]) == gen, bar);
            __builtin_amdgcn_fence(__ATOMIC_ACQUIRE, "agent");
            asm volatile("s_waitcnt vmcnt(0)" ::: "memory");
        }
    }
    __syncthreads();
}
struct Args {
    const float *x, *p, *g_mix, *w_in, *g_na_q, *g_na_k, *na_rpb, *g_df_q, *g_df_k, *lam_q1, *lam_k1, *lam_q2, *lam_k2, *g_df_sub,
                *w_na_out, *w_df_out, *w_o, *g_ffn, *w_gate, *w_up, *w_down, *g_ple, *w_ple_gate, *w_ple_proj;
    float* out; unsigned char* ws; int ph_lo, ph_hi, rep3, pad;
};

__device__ __forceinline__ void na_wave_unit(const bf16* QKG, const bf16* VT, const float* rpb, bf16* NAO, float M2, int b, int h, int r, int half) {
    int tid_ = threadIdx.x; asm volatile("" : "+v"(tid_)); const int lane = tid_ & 63;
    const int q = lane & 31, hi = lane >> 5, c = 32 * half + q;
    const size_t tokq = (size_t)b * SEQ + r * GW + c;
    bf16x8 qf[8];
#pragma unroll
    for (int d0 = 0; d0 < 8; ++d0) qf[d0] = *(const bf16x8*)(QKG + tokq * NQKG + QC_NAQ + h * NA_DH + 16 * d0 + 8 * hi);
    int rs = r - 4; rs = rs < 0 ? 0 : (rs > GROWS - 8 ? GROWS - 8 : rs);
    int cs = c - 8; cs = cs < 0 ? 0 : (cs > GW - 16 ? GW - 16 : cs);
    f32x16 o[4];
#pragma unroll
    for (int i = 0; i < 4; ++i) o[i] = (f32x16){};
    float l = 0.f;
    for (int kr = 0; kr < 8; ++kr) {
        const int krow = rs + kr, dr = krow - r + 7;
        const float* brow = rpb + (h * 15 + dr) * 31;
#pragma unroll
        for (int kb = 0; kb < 2; ++kb) {
            f32x16 s = (f32x16){};
            const bf16* kp = QKG + ((size_t)b * SEQ + krow * GW + 32 * kb + q) * NQKG + QC_NAK + h * NA_DH + 8 * hi;
#pragma unroll
            for (int d0 = 0; d0 < 8; ++d0) { const bf16x8 kf = *(const bf16x8*)(kp + 16 * d0); s = __builtin_amdgcn_mfma_f32_32x32x16_bf16(kf, qf[d0], s, 0, 0, 0); }
            float pv[16];
#pragma unroll
            for (int i = 0; i < 16; ++i) { const int kc = 32 * kb + crow(i, hi); const bool in = (kc >= cs) && (kc < cs + 16); const int dc = in ? (kc - c + 15) : 0;
                const float bias = brow[dc] * LOG2E - M2; const float e = __builtin_amdgcn_exp2f(s[i] + bias); pv[i] = in ? e : 0.f; l += pv[i]; }
            u32x4 w0, w1;
            w0.x = cvt_pk_bf16(pv[0], pv[1]); w0.y = cvt_pk_bf16(pv[2], pv[3]); w0.z = cvt_pk_bf16(pv[4], pv[5]); w0.w = cvt_pk_bf16(pv[6], pv[7]);
            w1.x = cvt_pk_bf16(pv[8], pv[9]); w1.y = cvt_pk_bf16(pv[10], pv[11]); w1.z = cvt_pk_bf16(pv[12], pv[13]); w1.w = cvt_pk_bf16(pv[14], pv[15]);
            const bf16x8 p0 = __builtin_bit_cast(bf16x8, w0), p1 = __builtin_bit_cast(bf16x8, w1);
            const bf16* vp = VT + (size_t)(h * NA_DH + q) * M + (size_t)b * SEQ + krow * GW + 32 * kb + 8 * hi;
#pragma unroll
            for (int db = 0; db < 4; ++db) {
                const bf16x8 v0 = *(const bf16x8*)(vp + (size_t)(32 * db) * M), v1 = *(const bf16x8*)(vp + (size_t)(32 * db) * M + 16);
                o[db] = __builtin_amdgcn_mfma_f32_32x32x16_bf16(v0, p0, o[db], 0, 0, 0);
                o[db] = __builtin_amdgcn_mfma_f32_32x32x16_bf16(v1, p1, o[db], 0, 0, 0);
            }
        }
    }
    l += __shfl_xor(l, 32);
    const float rl = 1.0f / l;
    bf16* op = NAO + tokq * 2048 + h * NA_DH + 4 * hi;
#pragma unroll
    for (int db = 0; db < 4; ++db)
#pragma unroll
        for (int g = 0; g < 4; ++g) { u32x2 w; w.x = cvt_pk_bf16(o[db][4 * g] * rl, o[db][4 * g + 1] * rl); w.y = cvt_pk_bf16(o[db][4 * g + 2] * rl, o[db][4 * g + 3] * rl);
            *(u32x2*)(op + 32 * db + 8 * g) = w; }
}

__device__ __forceinline__ void df_unit(LAS unsigned char* lds, const bf16* QKG, const bf16* KC, const bf16* VT, bf16* DFO, const float* g_sub, float lam, float M2, int b, int h, int qb, unsigned long long* df_wait = nullptr) {
    int tid_ = threadIdx.x; asm volatile("" : "+v"(tid_));
    const int tid = tid_, lane = tid & 63, w = __builtin_amdgcn_readfirstlane(tid >> 6), q = lane & 31, hi = lane >> 5;
    const int mm = w & 1, qg = w >> 1;
    const int q0 = qb * 128 + qg * 32;
    bf16x8 qf[4];
#pragma unroll
    for (int d0 = 0; d0 < 4; ++d0) qf[d0] = *(const bf16x8*)(QKG + ((size_t)b * SEQ + q0 + q) * NQKG + QC_DFQ + h * 128 + mm * 64 + 16 * d0 + 8 * hi);
    const unsigned char* kbase = (const unsigned char*)(KC + ((size_t)(b * 8 + h) * SEQ) * 128);
    const unsigned char* vbase = (const unsigned char*)(VT + ((size_t)(b * 16 + 8 + h) * 64) * 128 * 64);
    unsigned koff[2], voff[2];
#pragma unroll
    for (int i = 0; i < 2; ++i) {
        const int piece = w * 2 + i;
        { const int row = piece * 4 + (lane >> 4), ph = lane & 15, ch = ph ^ (row & 15); koff[i] = (unsigned)(row * 128 + ch * 8) * 2u; }
        { const int row = piece * 8 + (lane >> 3), ph = lane & 7, ch = ph ^ ((row >> 1) & 7); voff[i] = (unsigned)(row * 64 + ch * 8) * 2u; }
    }
#define DF_DMA(kt, stg) do { const unsigned char* kb_ = kbase + (size_t)(kt) * 16384; const unsigned char* vb_ = vbase + (size_t)(kt) * 16384; _Pragma("unroll") for (int _i = 0; _i < 2; ++_i) { \
        __builtin_amdgcn_global_load_lds((const unsigned*)(kb_ + koff[_i]), (LAS unsigned*)(lds + (stg) * 32768 + (w * 2 + _i) * 1024), 16, 0, 0); \
        __builtin_amdgcn_global_load_lds((const unsigned*)(vb_ + voff[_i]), (LAS unsigned*)(lds + (stg) * 32768 + 16384 + (w * 2 + _i) * 1024), 16, 0, 0); } } while (0)
    int kofs[4], vofs[4];
#pragma unroll
    for (int d0 = 0; d0 < 4; ++d0) kofs[d0] = q * 256 + (((mm * 8 + 2 * d0 + hi) ^ (q & 15)) * 16);
#pragma unroll
    for (int g = 0; g < 4; ++g) vofs[g] = 16384 + q * 128 + (((2 * g + hi) ^ ((q >> 1) & 7)) * 16);
    f32x16 o[4];
#pragma unroll
    for (int i = 0; i < 4; ++i) o[i] = (f32x16){};
    float l = 0.f;
    const float shift = (M2 > 60.0f) ? M2 : 0.0f;
    constexpr int NT = SEQ / 64;
    typedef float f32x2_t __attribute__((ext_vector_type(2))); typedef __bf16 bf16x2_t __attribute__((ext_vector_type(2)));
#define CVTPK(lo, hi) __builtin_bit_cast(unsigned, __builtin_convertvector((f32x2_t){(lo), (hi)}, bf16x2_t))
#define DF_S(dst, St_, kb_) do { bf16x8 kf_[4]; _Pragma("unroll") for (int d0 = 0; d0 < 4; ++d0) kf_[d0] = *(const LAS bf16x8*)((St_) + kofs[d0] + (kb_) * 8192); \
        dst = (f32x16){}; _Pragma("unroll") for (int d0 = 0; d0 < 4; ++d0) dst = __builtin_amdgcn_mfma_f32_32x32x16_bf16(kf_[d0], qf[d0], dst, 0, 0, 0); } while (0)
    DF_DMA(0, 0); DF_DMA(1, 1); DF_DMA(2, 2);
    asm volatile("s_waitcnt vmcnt(4)" ::: "memory");
    __builtin_amdgcn_s_barrier();
    asm volatile("" ::: "memory");
    f32x16 sc[2], sn[2];
    DF_S(sc[0], lds, 0); DF_S(sc[1], lds, 1);
    for (int kt = 0; kt < NT; ++kt) {
        if (kt + 3 < NT) DF_DMA(kt + 3, (kt + 3) & 3);
        const LAS unsigned char* St = lds + (kt & 3) * 32768;
        const LAS unsigned char* Sn = lds + ((kt + 1) & 3) * 32768;
        if (kt + 1 < NT) { DF_S(sn[0], Sn, 0); DF_S(sn[1], Sn, 1); }
#pragma unroll
        for (int kb = 0; kb < 2; ++kb) {
            bf16x8 vf[2][4];
#pragma unroll
            for (int jj = 0; jj < 2; ++jj)
#pragma unroll
                for (int db = 0; db < 4; ++db) vf[jj][db] = *(const LAS bf16x8*)(St + vofs[2 * kb + jj] + db * 4096);
            f32x16 s = sc[kb];
            if (shift != 0.f) {
#pragma unroll
                for (int i = 0; i < 16; ++i) s[i] -= shift;
            }
            float ls = 0.f;
#pragma unroll
            for (int i = 0; i < 16; ++i) { s[i] = __builtin_amdgcn_exp2f(s[i]); ls += s[i]; }
            l += ls;
            u32x4 w0, w1;
            w0.x = CVTPK(s[0], s[1]); w0.y = CVTPK(s[2], s[3]); w0.z = CVTPK(s[4], s[5]); w0.w = CVTPK(s[6], s[7]);
            w1.x = CVTPK(s[8], s[9]); w1.y = CVTPK(s[10], s[11]); w1.z = CVTPK(s[12], s[13]); w1.w = CVTPK(s[14], s[15]);
            const bf16x8 p0 = __builtin_bit_cast(bf16x8, w0), p1 = __builtin_bit_cast(bf16x8, w1);
#pragma unroll
            for (int db = 0; db < 4; ++db) o[db] = __builtin_amdgcn_mfma_f32_32x32x16_bf16(vf[0][db], p0, o[db], 0, 0, 0);
#pragma unroll
            for (int db = 0; db < 4; ++db) o[db] = __builtin_amdgcn_mfma_f32_32x32x16_bf16(vf[1][db], p1, o[db], 0, 0, 0);
        }
        sc[0] = sn[0]; sc[1] = sn[1];
#ifdef PROBE_DFWAIT
        const unsigned long long tw0_ = __builtin_amdgcn_s_memrealtime();
#endif
        if (kt + 3 < NT) asm volatile("s_waitcnt vmcnt(4) lgkmcnt(0)" ::: "memory"); else asm volatile("s_waitcnt vmcnt(0) lgkmcnt(0)" ::: "memory");
#if defined(PROBE_DFWAIT) && PROBE_DFWAIT == 2
        const unsigned long long tw1_ = __builtin_amdgcn_s_memrealtime(); if (df_wait) *df_wait += tw1_ - tw0_;
#endif
        __builtin_amdgcn_s_barrier();
        asm volatile("" ::: "memory");
#if defined(PROBE_DFWAIT) && PROBE_DFWAIT == 1
        const unsigned long long tw1_ = __builtin_amdgcn_s_memrealtime(); if (df_wait) *df_wait += tw1_ - tw0_;
#endif
    }
#undef DF_S
#undef CVTPK
#undef DF_DMA
    LAS float* xch = (LAS float*)lds;
    { float lt = l; lt += __shfl_xor(lt, 32);
      const float sc = (mm == 1 ? lam : 1.0f) / lt;
#pragma unroll
      for (int db = 0; db < 4; ++db)
#pragma unroll
          for (int i = 0; i < 16; ++i) o[db][i] *= sc; }
    if (mm == 1) {
#pragma unroll
        for (int db = 0; db < 4; ++db)
#pragma unroll
            for (int i = 0; i < 16; ++i) xch[(qg * 64 + db * 16 + i) * 64 + lane] = o[db][i];
    }
    __syncthreads();
    if (mm == 0) {
        float ss = 0.f;
#pragma unroll
        for (int db = 0; db < 4; ++db)
#pragma unroll
            for (int i = 0; i < 16; ++i) { const float v = o[db][i] - xch[(qg * 64 + db * 16 + i) * 64 + lane]; o[db][i] = v; ss += v * v; }
        ss += __shfl_xor(ss, 32);
        const float rn = __builtin_amdgcn_rsqf(ss * (1.0f / 128.0f) + EPS) * (1.0f - LAM_INIT);
        bf16* op = DFO + ((size_t)b * SEQ + q0 + q) * 2048 + h * 128 + 4 * hi;
#pragma unroll
        for (int db = 0; db < 4; ++db)
#pragma unroll
            for (int g = 0; g < 4; ++g) { const f32x4 gs = *(const f32x4*)(g_sub + 32 * db + 8 * g + 4 * hi);
                u32x2 wv; wv.x = cvt_pk_bf16(o[db][4 * g] * rn * gs[0], o[db][4 * g + 1] * rn * gs[1]); wv.y = cvt_pk_bf16(o[db][4 * g + 2] * rn * gs[2], o[db][4 * g + 3] * rn * gs[3]);
                *(u32x2*)(op + 32 * db + 8 * g) = wv; }
    }
    __syncthreads();
}

__device__ __forceinline__ void na_unit(LAS unsigned char* lds, const bf16* QKG, const bf16* KC, const bf16* VT, const float* rpb, bf16* NAO, float M2, int b, int h, int r0) {
    int tid_ = threadIdx.x; asm volatile("" : "+v"(tid_));
    const int tid = tid_, lane = tid & 63, w = __builtin_amdgcn_readfirstlane(tid >> 6), q = lane & 31, hi = lane >> 5;
    const int rq = r0 + (w >> 1), half = w & 1, c = 32 * half + q;
    const size_t tokq = (size_t)b * SEQ + rq * GW + c;
    bf16x8 qf[8];
#pragma unroll
    for (int d0 = 0; d0 < 8; ++d0) qf[d0] = *(const bf16x8*)(QKG + tokq * NQKG + QC_NAQ + h * NA_DH + 16 * d0 + 8 * hi);
    int rs = rq - 4; rs = rs < 0 ? 0 : (rs > GROWS - 8 ? GROWS - 8 : rs);
    int cs = c - 8; cs = cs < 0 ? 0 : (cs > GW - 16 ? GW - 16 : cs);
    int klo = r0 - 4; klo = klo < 0 ? 0 : (klo > GROWS - 8 ? GROWS - 8 : klo);
    int khi = r0 + 3 - 4; khi = (khi < 0 ? 0 : (khi > GROWS - 8 ? GROWS - 8 : khi)) + 7;
    const int nst = khi - klo + 1;
    const unsigned char* kbase = (const unsigned char*)(KC + ((size_t)(b * 8 + h) * SEQ + klo * GW) * 128);
    const unsigned char* vbase = (const unsigned char*)(VT + ((size_t)(b * 16 + h) * 64 + klo) * 128 * 64);
    unsigned koff[2], voff[2];
#pragma unroll
    for (int i = 0; i < 2; ++i) {
        const int piece = w * 2 + i;
        { const int row = piece * 4 + (lane >> 4), ph = lane & 15, ch = ph ^ (row & 15); koff[i] = (unsigned)(row * 128 + ch * 8) * 2u; }
        { const int row = piece * 8 + (lane >> 3), ph = lane & 7, ch = ph ^ ((row >> 1) & 7); voff[i] = (unsigned)(row * 64 + ch * 8) * 2u; }
    }
#define NA_DMA(t, stg) do { const unsigned char* kb_ = kbase + (size_t)(t) * 16384; const unsigned char* vb_ = vbase + (size_t)(t) * 16384; _Pragma("unroll") for (int _i = 0; _i < 2; ++_i) { \
        __builtin_amdgcn_global_load_lds((const unsigned*)(kb_ + koff[_i]), (LAS unsigned*)(lds + (stg) * 32768 + (w * 2 + _i) * 1024), 16, 0, 0); \
        __builtin_amdgcn_global_load_lds((const unsigned*)(vb_ + voff[_i]), (LAS unsigned*)(lds + (stg) * 32768 + 16384 + (w * 2 + _i) * 1024), 16, 0, 0); } } while (0)
    int kofs[8], vofs[4];
#pragma unroll
    for (int d0 = 0; d0 < 8; ++d0) kofs[d0] = q * 256 + (((2 * d0 + hi) ^ (q & 15)) * 16);
#pragma unroll
    for (int g = 0; g < 4; ++g) vofs[g] = 16384 + q * 128 + (((2 * g + hi) ^ ((q >> 1) & 7)) * 16);
    f32x16 o[4];
#pragma unroll
    for (int i = 0; i < 4; ++i) o[i] = (f32x16){};
    float l = 0.f;
    LAS float* btab = (LAS float*)(lds + 131072 + 1024);
    for (int i = tid; i < 15 * 31; i += NTHREADS) btab[i] = rpb[h * 15 * 31 + i] * LOG2E - M2;
    asm volatile("s_waitcnt vmcnt(0) lgkmcnt(0)" ::: "memory");
    __builtin_amdgcn_s_barrier();
    asm volatile("" ::: "memory");
    NA_DMA(0, 0); NA_DMA(1, 1);
    asm volatile("s_waitcnt vmcnt(4)" ::: "memory");
    __builtin_amdgcn_s_barrier();
    asm volatile("" ::: "memory");
    for (int t = 0; t < nst; ++t) {
        if (t + 2 < nst) NA_DMA(t + 2, (t + 2) & 3);
        const int krow = klo + t;
        if (krow >= rs && krow < rs + 8) {
            const LAS unsigned char* St = lds + (t & 3) * 32768;
            const LAS float* brow = btab + (krow - rq + 7) * 31;
#pragma unroll 1
            for (int kb = 0; kb < 2; ++kb) {
                f32x16 s = (f32x16){};
#pragma unroll
                for (int d0 = 0; d0 < 8; ++d0) { const bf16x8 kf = *(const LAS bf16x8*)(St + kofs[d0] + kb * 8192); s = __builtin_amdgcn_mfma_f32_32x32x16_bf16(kf, qf[d0], s, 0, 0, 0); }
                bf16x8 vf[2][4];
#pragma unroll
                for (int jj = 0; jj < 2; ++jj)
#pragma unroll
                    for (int db = 0; db < 4; ++db) vf[jj][db] = *(const LAS bf16x8*)(St + (kb ? vofs[2 + jj] : vofs[jj]) + db * 4096);
                float pv[16];
                const LAS float* bp = brow + (4 * hi - c + 15 + 32 * kb);
                const int wa = 4 * hi - cs + 32 * kb;
#pragma unroll
                for (int i = 0; i < 16; ++i) { const int e0 = (i & 3) + 8 * (i >> 2); const float bias = bp[e0]; const float e = __builtin_amdgcn_exp2f(s[i] + bias);
                    pv[i] = ((unsigned)(wa + e0) < 16u) ? e : 0.f; l += pv[i]; }
                u32x4 w0, w1;
                w0.x = cvt_pk_bf16(pv[0], pv[1]); w0.y = cvt_pk_bf16(pv[2], pv[3]); w0.z = cvt_pk_bf16(pv[4], pv[5]); w0.w = cvt_pk_bf16(pv[6], pv[7]);
                w1.x = cvt_pk_bf16(pv[8], pv[9]); w1.y = cvt_pk_bf16(pv[10], pv[11]); w1.z = cvt_pk_bf16(pv[12], pv[13]); w1.w = cvt_pk_bf16(pv[14], pv[15]);
                const bf16x8 p0 = __builtin_bit_cast(bf16x8, w0), p1 = __builtin_bit_cast(bf16x8, w1);
#pragma unroll
                for (int db = 0; db < 4; ++db) o[db] = __builtin_amdgcn_mfma_f32_32x32x16_bf16(vf[0][db], p0, o[db], 0, 0, 0);
#pragma unroll
                for (int db = 0; db < 4; ++db) o[db] = __builtin_amdgcn_mfma_f32_32x32x16_bf16(vf[1][db], p1, o[db], 0, 0, 0);
            }
        }
        if (t + 2 < nst) asm volatile("s_waitcnt vmcnt(4) lgkmcnt(0)" ::: "memory"); else asm volatile("s_waitcnt vmcnt(0) lgkmcnt(0)" ::: "memory");
        __builtin_amdgcn_s_barrier();
        asm volatile("" ::: "memory");
    }
#undef NA_DMA
    l += __shfl_xor(l, 32);
    const float rl = 1.0f / l;
    bf16* op = NAO + tokq * 2048 + h * NA_DH + 4 * hi;
#pragma unroll
    for (int db = 0; db < 4; ++db)
#pragma unroll
        for (int g = 0; g < 4; ++g) { u32x2 wv; wv.x = cvt_pk_bf16(o[db][4 * g] * rl, o[db][4 * g + 1] * rl); wv.y = cvt_pk_bf16(o[db][4 * g + 2] * rl, o[db][4 * g + 3] * rl);
            *(u32x2*)(op + 32 * db + 8 * g) = wv; }
}
template <int TB>
__device__ __forceinline__ void qknorm_batch(bf16* QKG, bf16* KCna, bf16* KCdf, int m0, int mstride, const float* gnq, const float* gnk, const float* gdq, const float* gdk, const f32x2* rope, int lane) {
    const float QS_NA = 0.08838834764831845f * LOG2E, QS_DF = 0.125f * LOG2E;
    u32x4 na[TB][4], da[TB][2], db[TB][2];
#pragma unroll
    for (int t = 0; t < TB; ++t) { int mt = m0 + t * mstride; if (mt >= M) mt = M - 1; bf16* row = QKG + (size_t)mt * NQKG;
#pragma unroll
        for (int j = 0; j < 4; ++j) na[t][j] = *(const u32x4*)(row + 512 * j + 8 * lane);
#pragma unroll
        for (int j = 0; j < 2; ++j) { const bf16* p1 = row + 2048 + 1024 * j + 64 * (lane >> 2) + 8 * (lane & 3); da[t][j] = *(const u32x4*)p1; db[t][j] = *(const u32x4*)(p1 + 32); } }
#pragma unroll
    for (int t = 0; t < TB; ++t) { const int mt = m0 + t * mstride; if (mt >= M) break; bf16* row = QKG + (size_t)mt * NQKG; const int pos = mt & (SEQ - 1);
#pragma unroll
        for (int j = 0; j < 4; ++j) {
            const u32x4 w = na[t][j];
            float v[8] = {bf_lo(w.x), bf_hi(w.x), bf_lo(w.y), bf_hi(w.y), bf_lo(w.z), bf_hi(w.z), bf_lo(w.w), bf_hi(w.w)};
            float ss = 0.f;
#pragma unroll
            for (int i = 0; i < 8; ++i) ss += v[i] * v[i];
            ss += __shfl_xor(ss, 1); ss += __shfl_xor(ss, 2); ss += __shfl_xor(ss, 4); ss += __shfl_xor(ss, 8);
            const float rs = __builtin_amdgcn_rsqf(ss * (1.0f / 128.0f) + EPS) * (j < 2 ? QS_NA : 1.0f);
            const float* g = (j < 2 ? gnq : gnk) + 8 * (lane & 15);
#pragma unroll
            for (int i = 0; i < 8; ++i) v[i] = v[i] * rs * g[i];
            u32x4 o; o.x = cvt_pk_bf16(v[0], v[1]); o.y = cvt_pk_bf16(v[2], v[3]); o.z = cvt_pk_bf16(v[4], v[5]); o.w = cvt_pk_bf16(v[6], v[7]);
            if (j < 2) *(u32x4*)(row + 512 * j + 8 * lane) = o;
            else { const int x = 512 * (j - 2) + 8 * lane;
                   *(u32x4*)(KCna + ((size_t)((mt >> 12) * 8 + (x >> 7)) * SEQ + pos) * 128 + (x & 127)) = o; }
        }
#pragma unroll
        for (int j = 0; j < 2; ++j) {
            bf16* p1 = row + 2048 + 1024 * j + 64 * (lane >> 2) + 8 * (lane & 3); bf16* p2 = p1 + 32;
            const u32x4 wa = da[t][j], wb = db[t][j];
            float a[8] = {bf_lo(wa.x), bf_hi(wa.x), bf_lo(wa.y), bf_hi(wa.y), bf_lo(wa.z), bf_hi(wa.z), bf_lo(wa.w), bf_hi(wa.w)};
            float c[8] = {bf_lo(wb.x), bf_hi(wb.x), bf_lo(wb.y), bf_hi(wb.y), bf_lo(wb.z), bf_hi(wb.z), bf_lo(wb.w), bf_hi(wb.w)};
            float ss = 0.f;
#pragma unroll
            for (int i = 0; i < 8; ++i) ss += a[i] * a[i] + c[i] * c[i];
            ss += __shfl_xor(ss, 1); ss += __shfl_xor(ss, 2);
            const float rs = __builtin_amdgcn_rsqf(ss * (1.0f / 64.0f) + EPS);
            const float* g = (j == 0 ? gdq : gdk) + 8 * (lane & 3);
            const f32x2* rp = rope + pos * 32 + 8 * (lane & 3);
            const float qs = (j == 0 ? QS_DF : 1.0f);
            float o1[8], o2[8];
#pragma unroll
            for (int i = 0; i < 8; ++i) { const float x1 = a[i] * rs * g[i], x2 = c[i] * rs * g[32 + i]; const f32x2 cs = rp[i]; o1[i] = (x1 * cs.x - x2 * cs.y) * qs; o2[i] = (x1 * cs.y + x2 * cs.x) * qs; }
            u32x4 oa, ob; oa.x = cvt_pk_bf16(o1[0], o1[1]); oa.y = cvt_pk_bf16(o1[2], o1[3]); oa.z = cvt_pk_bf16(o1[4], o1[5]); oa.w = cvt_pk_bf16(o1[6], o1[7]);
            ob.x = cvt_pk_bf16(o2[0], o2[1]); ob.y = cvt_pk_bf16(o2[2], o2[3]); ob.z = cvt_pk_bf16(o2[4], o2[5]); ob.w = cvt_pk_bf16(o2[6], o2[7]);
            if (j == 0) { *(u32x4*)p1 = oa; *(u32x4*)p2 = ob; }
            else { const int x = 64 * (lane >> 2) + 8 * (lane & 3); bf16* kp = KCdf + ((size_t)((mt >> 12) * 8 + (x >> 7)) * SEQ + pos) * 128 + (x & 127);
                   *(u32x4*)kp = oa; *(u32x4*)(kp + 32) = ob; }
        }
    }
}

__device__ __forceinline__ void grid_barrier(unsigned* cnt, unsigned target) {
    asm volatile("s_waitcnt vmcnt(0) lgkmcnt(0)" ::: "memory");
    __syncthreads();
    if (threadIdx.x == 0) {
        __builtin_amdgcn_fence(__ATOMIC_RELEASE, "agent");
        asm volatile("s_waitcnt vmcnt(0)" ::: "memory");
        __hip_atomic_fetch_add(cnt, 1u, __ATOMIC_RELAXED, __HIP_MEMORY_SCOPE_AGENT);
        while (__hip_atomic_load(cnt, __ATOMIC_RELAXED, __HIP_MEMORY_SCOPE_AGENT) < target) __builtin_amdgcn_s_sleep(2);
        __builtin_amdgcn_fence(__ATOMIC_ACQUIRE, "agent");
        asm volatile("s_waitcnt vmcnt(0)" ::: "memory");
    }
    __syncthreads();
}
constexpr int I_IN = 32 * 320, I_NA = 16 * 64, I_O = 32 * 64, I_G = 32 * 176, I_DN = 88 * 64, I_PP = 4 * 64;
constexpr int N_EARLY = I_IN + 2 * I_NA + I_O + 2 * I_G + I_PP, NITEMS = N_EARLY + I_DN + I_O;
#define P0_DECODE(it_, d_) do { int r = (it_); \
            if (r < I_IN) { d_ = P0Item{ap->w_in, W1t, nullptr, D, 10240, 1, r, D, 0}; break; } r -= I_IN; \
            if (r < I_NA) { d_ = P0Item{ap->w_na_out, Wna, nullptr, 1024, D, 0, r, 2048, 0}; break; } r -= I_NA; \
            if (r < I_NA) { d_ = P0Item{ap->w_df_out, Wna, nullptr, 1024, D, 0, r, 2048, 1024}; break; } r -= I_NA; \
            if (r < I_O) { d_ = P0Item{ap->w_o, Wo, nullptr, D, D, 0, r, D, 0}; break; } r -= I_O; \
            if (r < I_G) { d_ = P0Item{ap->w_gate, Wgu, ap->g_ffn, D, FF, 2, r, D, 0}; break; } r -= I_G; \
            if (r < I_G) { d_ = P0Item{ap->w_up, Wgu, ap->g_ffn, D, FF, 3, r, D, 0}; break; } r -= I_G; \
            if (r < I_PP) { d_ = P0Item{ap->w_ple_proj, Wpp, nullptr, PLE, D, 0, r, PLE, 0}; break; } r -= I_PP; \
            if (r < I_DN) { d_ = P0Item{ap->w_down, Wdn, nullptr, FF, D, 0, r, FF, 0}; break; } r -= I_DN; \
            d_ = P0Item{ap->w_ple_gate, Wpg, ap->g_ple, D, D, 0, r, D, 0}; } while (0)
constexpr int NPHASE = 9;
__global__ void __launch_bounds__(NTHREADS, 2) fwd_megakernel(Args a) {
    extern __shared__ __attribute__((aligned(16))) unsigned char lds_raw[];
    LAS unsigned char* lds = (LAS unsigned char*)lds_raw;
    cg::grid_group grid = cg::this_grid();
    const int G = gridDim.x, bx = blockIdx.x;
    const int vcu = (G % 8 == 0) ? (bx % 8) * (G / 8) + bx / 8 : bx;
    const int NGW = G * NWAVES;
typedef __attribute__((opencl_constant)) const Args* CArgsP;
#define FRESH_ARGS() auto kp_ = __builtin_amdgcn_kernarg_segment_ptr(); asm volatile("" : "+s"(kp_)); const CArgsP ap = (CArgsP)kp_
#define FRESH_TID() int tid_ = threadIdx.x; asm volatile("" : "+v"(tid_)); const int tid = tid_, lane = tid & 63, wave = __builtin_amdgcn_readfirstlane(tid >> 6), gw = vcu * NWAVES + wave; (void)lane; (void)gw
    unsigned char* ws = a.ws;
    float* RS1 = (float*)(ws + WS_RS1); float* RS2 = (float*)(ws + WS_RS2); f32x2* ROPE = (f32x2*)(ws + WS_ROPE);
    bf16 *W1t = (bf16*)(ws + WS_W1), *Wna = (bf16*)(ws + WS_WNA), *Wdf = (bf16*)(ws + WS_WDF), *Wo = (bf16*)(ws + WS_WO), *Wgu = (bf16*)(ws + WS_WGU), *Wdn = (bf16*)(ws + WS_WDN), *Wpg = (bf16*)(ws + WS_WPG), *Wpp = (bf16*)(ws + WS_WPP);
    bf16 *QKG = (bf16*)(ws + WS_A), *HB = (bf16*)(ws + WS_A);
    bf16 *XN = (bf16*)(ws + WS_B), *AO = (bf16*)(ws + WS_B), *X1B = (bf16*)(ws + WS_B), *X2B = (bf16*)(ws + WS_B);
    bf16 *VT = (bf16*)(ws + WS_C), *MRG = (bf16*)(ws + WS_C), *T2B = (bf16*)(ws + WS_C), *PB = (bf16*)(ws + WS_PB);
    bf16* KCna = (bf16*)a.out; bf16* KCdf = KCna + (size_t)M * 1024;
    const int lo = a.ph_lo, hi_ph = a.ph_hi;
    if (lo < 0) grid.sync();
    { volatile LAS unsigned* st0 = (volatile LAS unsigned*)(lds + 131072 + 768); if (threadIdx.x < 2) st0[threadIdx.x] = 0u; __syncthreads(); }
    XcdBarrier xbar = xcd_barrier_post((unsigned*)(ws + 8192), (volatile LAS unsigned*)(lds + 131072 + 768));
#ifndef PHASE_MASK
#define PHASE_MASK 0x1ff
#endif
#define IN(k) (((PHASE_MASK >> (k)) & 1) && lo <= (k) && (k) < hi_ph)
#ifdef PROBE_TS
#define STAMP(k) do { if (bx == 0 && threadIdx.x == 0) ((volatile unsigned long long*)(ws + 2048))[k] = __builtin_amdgcn_s_memrealtime(); } while (0)
#else
#define STAMP(k) do {} while (0)
#endif
#define GBAR(idx) xcd_barrier(xbar)
#define SEAM(k) do { if (IN(k) && IN((k) + 1)) GBAR(k); STAMP((k) + 1); } while (0)
#ifndef PROBE_DUP
#define PROBE_DUP 0
#endif
#define NREP(k) (((PROBE_DUP >> (k)) & 1) ? 2 : 1)

    STAMP(0);
    for (int rep_ = 0; rep_ < NREP(0); ++rep_) {
    if (IN(0)) {
        FRESH_ARGS();
        FRESH_TID();
        if (bx == 0) {
        LAS float* red = (LAS float*)(lds + 131072);
        float mq = 0.f, mk = 0.f, mdq = 0.f, mdk = 0.f, mb = 0.f;
        if (tid < 128) { mq = fabsf(ap->g_na_q[tid]); mk = fabsf(ap->g_na_k[tid]); }
        if (tid < 64) { mdq = fabsf(ap->g_df_q[tid]); mdk = fabsf(ap->g_df_k[tid]); }
        for (int i = tid; i < NA_H * 15 * 31; i += NTHREADS) mb = fmaxf(mb, ap->na_rpb[i]);
        mq = wave_max(mq); mk = wave_max(mk); mdq = wave_max(mdq); mdk = wave_max(mdk); mb = wave_max(mb);
        float d1 = 0.f, d2 = 0.f;
        if (wave == 0) { d1 = wave_sum(ap->lam_q1[lane] * ap->lam_k1[lane]); d2 = wave_sum(ap->lam_q2[lane] * ap->lam_k2[lane]); }
        if (lane == 0) { red[wave * 8 + 0] = mq; red[wave * 8 + 1] = mk; red[wave * 8 + 2] = mdq; red[wave * 8 + 3] = mdk; red[wave * 8 + 4] = mb; red[wave * 8 + 5] = d1; red[wave * 8 + 6] = d2; }
        __syncthreads();
        mq = 0.f; mk = 0.f; mdq = 0.f; mdk = 0.f; mb = 0.f;
#pragma unroll
        for (int w = 0; w < 8; ++w) { mq = fmaxf(mq, red[w * 8]); mk = fmaxf(mk, red[w * 8 + 1]); mdq = fmaxf(mdq, red[w * 8 + 2]); mdk = fmaxf(mdk, red[w * 8 + 3]); mb = fmaxf(mb, red[w * 8 + 4]); }
        if (tid == 0) { float* PARw = (float*)(ws + 3072); PARw[0] = expf(red[5]) - expf(red[6]) + LAM_INIT; PARw[1] = (11.313708498984761f * mq * mk + mb) * LOG2E + 0.125f; PARw[2] = (8.0f * mdq * mdk) * LOG2E + 0.125f; }
        __syncthreads();
        }
        LAS float* scr = (LAS float*)(lds + wave * 16384);
        {
            float cur[32], nxt[32]; P0Item dc, dn;
            int it = gw;
            if (it < N_EARLY) { P0_DECODE(it, dc); p0_item_load(dc, cur, lane); }
            for (; it < N_EARLY; it += NGW) {
                const int nit = it + NGW; const bool more = nit < N_EARLY;
                if (more) { P0_DECODE(nit, dn); p0_item_load(dn, nxt, lane); }
                p0_item_store(dc, cur, scr, lane);
                if (more) { dc = dn;
#pragma unroll
                    for (int i = 0; i < 32; ++i) cur[i] = nxt[i]; }
            }
        }
        for (int m = gw; m < M; m += NGW) {
            const f32x4* xr = (const f32x4*)(ap->x + (size_t)m * D) + lane; const f32x4* gr = (const f32x4*)ap->g_mix + lane;
            f32x4 v[8]; float s = 0.f;
#pragma unroll
            for (int j = 0; j < 8; ++j) { v[j] = __builtin_nontemporal_load(xr + 64 * j); s += (v[j].x * v[j].x + v[j].y * v[j].y) + (v[j].z * v[j].z + v[j].w * v[j].w); }
            const float rs = __builtin_amdgcn_rsqf(wave_sum(s) * (1.0f / D) + EPS);
            u32x2* o8 = (u32x2*)(XN + (size_t)m * D) + lane;
#pragma unroll
            for (int j = 0; j < 8; ++j) { const f32x4 g = gr[64 * j]; u32x2 w; w.x = cvt_pk_bf16(v[j].x * rs * g.x, v[j].y * rs * g.y); w.y = cvt_pk_bf16(v[j].z * rs * g.z, v[j].w * rs * g.w); o8[64 * j] = w; }
        }
        const int gt = vcu * NTHREADS + tid, NGT = G * NTHREADS;
        for (int i = gt; i < M * PLE / 8; i += NGT) { const f32x4 p0 = __builtin_nontemporal_load((const f32x4*)ap->p + 2 * i), p1 = __builtin_nontemporal_load((const f32x4*)ap->p + 2 * i + 1);
            u32x4 w; w.x = cvt_pk_bf16(p0.x, p0.y); w.y = cvt_pk_bf16(p0.z, p0.w); w.z = cvt_pk_bf16(p1.x, p1.y); w.w = cvt_pk_bf16(p1.z, p1.w); ((u32x4*)PB)[i] = w; }
        for (int i = gt; i < SEQ * 32; i += NGT) { const int pos = i >> 5, k = i & 31;
            const float inv = (float)(1.0 / pow(10000.0, (double)k / 32.0)); const float ang = (float)pos * inv;
            f32x2 cs; cs.x = (float)cos((double)ang); cs.y = (float)sin((double)ang); ROPE[i] = cs; }
        for (int i = gt; i < M; i += NGT) { RS1[i] = 0.f; RS2[i] = 0.f; }
    }
    }
    SEAM(0);
    for (int rep_ = 0; rep_ < NREP(1); ++rep_) {
    if (IN(1)) {
        FRESH_ARGS();
        { pg8::Gemm g{XN, W1t, M, NQKG, D}; pg8::StaticOrder S; S.init(M, NQKG, G, bx); pg8::EpiQKG E{QKG, NQKG};
          pg8::gemm_phase<pg8::EpiQKG, pg8::StaticOrder, true, true>(lds, g, S, E); }
        { pg8::Gemm g{W1t + (size_t)NQKG * D, XN, 2048, M, D}; pg8::StaticOrder S; S.init(2048, M, G, bx); pg8::EpiVT E{VT, M};
          pg8::gemm_phase<pg8::EpiVT, pg8::StaticOrder, true, true>(lds, g, S, E); }
    }
    }
    SEAM(1);
    if (IN(2)) {
        FRESH_ARGS();
        FRESH_TID();
        for (int m0 = gw; m0 < M; m0 += 4 * NGW) qknorm_batch<4>(QKG, KCna, KCdf, m0, NGW, ap->g_na_q, ap->g_na_k, ap->g_df_q, ap->g_df_k, ROPE, lane);
    }
    SEAM(2);
    for (int rep_ = 0; rep_ < NREP(3); ++rep_) {
    if (IN(3)) {
        FRESH_ARGS();
        FRESH_TID();
        const float* PAR = (const float*)(ws + 3072);
        const float lam = PAR[0], M2na = PAR[1], M2df = PAR[2];
#ifndef NO_DF
        for (int uu = 2 * vcu; uu < BATCH * DF_H * (SEQ / 128); uu += 2 * G)
            for (int i2 = 0; i2 < 2; ++i2) { const int uidx = uu + i2, bh = uidx >> 5, qb = uidx & 31;
#ifdef PROBE_DFWAIT
                unsigned long long dfw_ = 0;
                df_unit(lds, QKG, KCdf, VT, AO + 1024, ap->g_df_sub, lam, M2df, bh >> 3, bh & 7, qb, &dfw_);
                if (bx == 0 && threadIdx.x == 0) { volatile unsigned long long* TS = (volatile unsigned long long*)(ws + 2048); TS[11] = (i2 ? TS[11] : 0ull) + dfw_; TS[12] = 0ull; }
#else
                df_unit(lds, QKG, KCdf, VT, AO + 1024, ap->g_df_sub, lam, M2df, bh >> 3, bh & 7, qb);
#endif
            }
#endif
        STAMP(10);
#ifdef PROBE_TS
        if (threadIdx.x == 0) { atomicMax((unsigned long long*)(ws + 2048) + 14, (unsigned long long)__builtin_amdgcn_s_memrealtime()); atomicMin((unsigned long long*)(ws + 2048) + 16, (unsigned long long)__builtin_amdgcn_s_memrealtime()); }
#endif
#ifndef NO_NA
        for (int uidx = vcu; uidx < BATCH * NA_H * (GROWS / 4); uidx += G) {
            const int bh = uidx >> 4, rg = uidx & 15;
            na_unit(lds, QKG, KCna, VT, ap->na_rpb, AO, M2na, bh >> 3, bh & 7, rg * 4);
        }
        STAMP(13);
#ifdef PROBE_TS
        if (threadIdx.x == 0) atomicMax((unsigned long long*)(ws + 2048) + 15, (unsigned long long)__builtin_amdgcn_s_memrealtime());
#endif
#endif
    }
    }
    SEAM(3);
    for (int rep_ = 0; rep_ < NREP(4); ++rep_) {
    if (IN(4)) {
        FRESH_ARGS();
        { pg8::Gemm g{AO, Wna, M, D, 2048, 16}; pg8::PairOrder S; S.S.init(M, D, G, bx); S.kob = 1024 * 2; pg8::EpiMerge E{QKG + QC_GA, QKG + QC_GB, NQKG, MRG, D, 16};
          pg8::gemm_phase<pg8::EpiMerge, pg8::PairOrder, true, true>(lds, g, S, E); }
    }
    }
    SEAM(4);
    if (IN(5)) {
        FRESH_ARGS();
        pg8::Gemm g{MRG, Wo, M, D, D}; pg8::StaticOrder S; S.init(M, D, G, bx); pg8::EpiResid<false> E{ap->x, X1B, RS1, D};
        pg8::gemm_phase<pg8::EpiResid<false>, pg8::StaticOrder, true, true>(lds, g, S, E);
    }
    SEAM(5);
    for (int rep_ = 0; rep_ < NREP(6); ++rep_) {
    if (IN(6)) {
        FRESH_ARGS();
        pg8::Gemm g{X1B, Wgu, M, 2 * FF, D}; pg8::StaticOrder S; S.init(M, 2 * FF, G, bx); pg8::EpiSwiGLU E{RS1, HB, FF, 1.0f / D, EPS};
        pg8::gemm_phase<pg8::EpiSwiGLU, pg8::StaticOrder, true, true>(lds, g, S, E);
        { constexpr int NU6 = (M / 256) * (2 * FF / 256), NU8 = (M / 256) * (D / 256);
          const int rem = NU6 % G, nshort = rem ? G - rem : G;
          pg8::TailOrder T; T.first = (rem == 0) ? bx : (bx >= rem ? bx - rem : -1); T.stride = nshort; T.total = NU8;
          int kple = PLE; asm volatile("" : "+s"(kple));
          pg8::Gemm g2{PB, Wpp, M, D, kple}; pg8::EpiStoreBf16 E2{T2B, D};
          pg8::gemm_phase<pg8::EpiStoreBf16, pg8::TailOrder, true, true>(lds, g2, T, E2);
          if (T.first >= 0) { FRESH_TID();
              LAS float* scr = (LAS float*)(lds + wave * 16384);
              const int sw = ((rem == 0) ? bx : bx - rem) * NWAVES + wave, nsw = nshort * NWAVES;
              float cur[32], nxt[32]; P0Item dc, dn;
              int it = N_EARLY + sw;
              if (it < NITEMS) { P0_DECODE(it, dc); p0_item_load(dc, cur, lane); }
              for (; it < NITEMS; it += nsw) {
                  const int nit = it + nsw; const bool more = nit < NITEMS;
                  if (more) { P0_DECODE(nit, dn); p0_item_load(dn, nxt, lane); }
                  p0_item_store(dc, cur, scr, lane);
                  if (more) { dc = dn;
#pragma unroll
                      for (int i = 0; i < 32; ++i) cur[i] = nxt[i]; }
              } } }
    }
    }
    SEAM(6);
    if (IN(7)) {
        FRESH_ARGS();
        pg8::Gemm g{HB, Wdn, M, D, FF}; pg8::StaticOrder S; S.init(M, D, G, bx); pg8::EpiResid<true> E{X1B, X2B, RS2, D};
        pg8::gemm_phase<pg8::EpiResid<true>, pg8::StaticOrder, true, true>(lds, g, S, E);
    }
    SEAM(7);
    if (IN(8)) {
        FRESH_ARGS();
#ifndef NO_P8B
        { pg8::Gemm g{X2B, Wpg, M, D, D}; pg8::StaticOrder S; S.init(M, D, G, bx); pg8::EpiPle E{RS2, T2B, X2B, ap->out, D, 1.0f / D, EPS};
          pg8::gemm_phase<pg8::EpiPle, pg8::StaticOrder, true, true>(lds, g, S, E); }
#endif
    }
#ifdef PROBE_TS
    STAMP(9);
    GBAR(8);
    { const unsigned long long* TS = (const unsigned long long*)(ws + 2048);
      const unsigned long long ta = __hip_atomic_load(TS + PROBE_A, __ATOMIC_RELAXED, __HIP_MEMORY_SCOPE_AGENT), tb = __hip_atomic_load(TS + PROBE_B, __ATOMIC_RELAXED, __HIP_MEMORY_SCOPE_AGENT);
      const int K = PROBE_CONST ? PROBE_CONST : (int)((tb - ta) / 8);
      FRESH_ARGS();
      for (int i = vcu * NTHREADS + (int)threadIdx.x; i < K && i < 42000; i += G * NTHREADS) ap->out[(size_t)i * 397] += 0.125f; }
#endif
#undef IN
#undef SEAM
}

#ifndef MK_SPLIT
#define MK_SPLIT 0
#endif
extern "C" void kernel_launch(void* const* d_in, const int* in_sizes, int n_in, void* d_out, int out_size, void* d_ws, size_t ws_size, hipStream_t stream) {
    static int grid = 0;
    if (grid == 0) {
        if (n_in != 24 || in_sizes[0] != M * D || out_size != M * D || ws_size < WS_END) { fprintf(stderr, "kernel_launch: unexpected shapes (n_in %d, in0 %d, out %d, ws %zu); nothing launched\n", n_in, n_in > 0 ? in_sizes[0] : -1, out_size, ws_size); grid = -1; return; }
        int dev = 0, cus = 0, per_cu = 0;
        hipGetDevice(&dev); hipDeviceGetAttribute(&cus, hipDeviceAttributeMultiprocessorCount, dev);
        hipFuncSetAttribute((const void*)fwd_megakernel, hipFuncAttributeMaxDynamicSharedMemorySize, LDS_BYTES);
        hipOccupancyMaxActiveBlocksPerMultiprocessor(&per_cu, (const void*)fwd_megakernel, NTHREADS, LDS_BYTES);
        if (per_cu < 1) per_cu = 1;
        grid = cus * per_cu;
        (void)hipGetLastError();
    }
    if (grid < 0) return;
    Args a{};
    const float** ap = (const float**)&a;
    for (int i = 0; i < 24; ++i) ap[i] = (const float*)d_in[i];
    a.out = (float*)d_out; a.ws = (unsigned char*)d_ws; a.rep3 = NREP(3); a.pad = 0;
#if MK_SPLIT
    for (int ph = 0; ph < NPHASE; ++ph) { a.ph_lo = ph; a.ph_hi = ph + 1; hipLaunchKernelGGL(fwd_megakernel, dim3(grid), dim3(NTHREADS), LDS_BYTES, stream, a); }
#else
    a.ph_lo = 0; a.ph_hi = NPHASE;
    (void)hipMemsetAsync((unsigned char*)d_ws + 4096, 0, 20480, stream);
#ifdef PROBE_TS
    (void)hipMemsetAsync((unsigned char*)d_ws + 2048 + 14 * 8, 0, 16, stream); (void)hipMemsetAsync((unsigned char*)d_ws + 2048 + 16 * 8, 0x7f, 8, stream);
#endif
    void* args[] = {&a};
    hipError_t e = hipLaunchCooperativeKernel((const void*)fwd_megakernel, dim3(grid), dim3(NTHREADS), args, LDS_BYTES, stream);
    if (e != hipSuccess) fprintf(stderr, "cooperative launch failed: %s (grid %d)\n", hipGetErrorString(e), grid);
#endif
}
```

```cpp
#include <hip/hip_runtime.h>
#include <hip/hip_cooperative_groups.h>
#include <cstdio>
#include <cstdint>
namespace cg = cooperative_groups;
namespace pg8 {
#define PG8_LAS __attribute__((address_space(3)))
typedef unsigned short bf16_t;
typedef short bf16x8 __attribute__((ext_vector_type(8)));
typedef float f32x4 __attribute__((ext_vector_type(4)));
typedef unsigned u32x4 __attribute__((ext_vector_type(4)));
constexpr int BM = 256, BK = 64, HALF = 128, HTB = HALF * BK * 2  , STAGE_BYTES = 8 * HTB, NXCD = 8, WGM = 8;

__host__ __device__ __forceinline__ int lds_byte(int r, int c) { const int st = (r >> 4) * 2 + (c >> 5), rr = r & 15, cc = c & 31, ob = rr * 64 + cc * 2; return st * 1024 + (ob ^ (((ob >> 9) & 1) << 5)); }
__host__ __device__ __forceinline__ void stage_rc(int b, int& R, int& C) { const int st = b / 1024, sb = b % 1024, swz = sb ^ (((sb >> 9) & 1) << 5); R = (st >> 1) * 16 + swz / 64; C = (st & 1) * 32 + (swz % 64) / 2; }
__host__ __device__ __forceinline__ int perm32(int rho) { const int n = rho >> 4, i = rho & 15; return 8 * (i >> 2) + 4 * n + (i & 3); }

struct Unit { int pm, pn; int ko = 0; };
struct Gemm { const bf16_t* A; const bf16_t* Bt; int M, N, K; int nt = 0; };

struct StaticOrder {
    int nM, nN, nwg, G, c;
    __host__ __device__ void init(int M, int N, int G_, int c_) { nM = M / BM; nN = N / BM; nwg = nM * nN; G = G_; c = c_; }
    __host__ __device__ bool next(int i, Unit& u) const {
        const long L = (long)i * G + c; if (L >= nwg) return false;
        int wgid = (int)L; { const int q = nwg / NXCD, r = nwg % NXCD, xcd = wgid % NXCD, off = wgid / NXCD; wgid = (xcd < r ? xcd * (q + 1) : r * (q + 1) + (xcd - r) * q) + off; }
        const int nig = WGM * nN, gid = wgid / nig, fm = gid * WGM, gsz = (nM - fm) < WGM ? (nM - fm) : WGM;
        u.pm = fm + ((wgid % nig) % gsz); u.pn = (wgid % nig) / gsz; return true;
    }
    __device__ __forceinline__ void a_ready(const Unit&) const {}
    __device__ __forceinline__ void done(const Unit&) const {}
};


struct TailOrder {
    int first, stride, total;
    __host__ __device__ bool next(int i, Unit& u) const { if (first < 0) return false; const int j = first + i * stride; if (j >= total) return false; u.pm = j >> 3; u.pn = j & 7; return true; }
    __device__ __forceinline__ void a_ready(const Unit&) const {}
    __device__ __forceinline__ void done(const Unit&) const {}
};

struct PairOrder {
    StaticOrder S; int kob;
    __host__ __device__ bool next(int i, Unit& u) const { if (!S.next(i >> 1, u)) return false; u.ko = (i & 1) * kob; return true; }
    __device__ __forceinline__ void a_ready(const Unit&) const {}
    __device__ __forceinline__ void done(const Unit&) const {}
};
__device__ __forceinline__ unsigned cvt_pk_bf16(float lo, float hi) { unsigned r; asm volatile("v_cvt_pk_bf16_f32 %0, %1, %2" : "=v"(r) : "v"(lo), "v"(hi)); return r; }
__device__ __forceinline__ float bf_lo(unsigned w) { return __uint_as_float(w << 16); }
__device__ __forceinline__ float bf_hi(unsigned w) { return __uint_as_float(w & 0xffff0000u); }
__device__ __forceinline__ float sigmoidf_(float x) { return __builtin_amdgcn_rcpf(1.0f + __expf(-x)); }
typedef unsigned u32x2 __attribute__((ext_vector_type(2)));
#define EPI_FENCE() asm volatile("" ::: "memory")
#define EPI_ROWS(...) _Pragma("unroll") for (int ai = 0; ai < 2; ++ai) _Pragma("unroll") for (int m = 0; m < 4; ++m) { const int row = u.pm * BM + ai * HALF + wr * 64 + m * 16 + fr; __VA_ARGS__ }

struct EpiQKG {
    static constexpr bool PERM = true, AFTER_DRAIN = false, MIDK = false;
    bf16_t* O; int ldc;
    __device__ __forceinline__ void operator()(const f32x4 (&acc)[2][2][4][2], const Unit& u, int wr, int wc, int fr, int fq) const {
        const bool gate = u.pn >= 16; const int col0 = u.pn * BM + wc * 32 + 8 * fq;
        EPI_ROWS(
            bf16_t* rowp = O + (size_t)row * ldc + col0;
            _Pragma("unroll") for (int bj = 0; bj < 2; ++bj) { f32x4 v0 = acc[ai][bj][m][0], v1 = acc[ai][bj][m][1];
                if (gate) { _Pragma("unroll") for (int j = 0; j < 4; ++j) { v0[j] = sigmoidf_(v0[j]); v1[j] = sigmoidf_(v1[j]); } }
                u32x4 w; w.x = cvt_pk_bf16(v0[0], v0[1]); w.y = cvt_pk_bf16(v0[2], v0[3]); w.z = cvt_pk_bf16(v1[0], v1[1]); w.w = cvt_pk_bf16(v1[2], v1[3]);
                *(u32x4*)(rowp + bj * HALF) = w; }
            EPI_FENCE();
        )
    }
};
struct EpiVT {
    static constexpr bool PERM = true, AFTER_DRAIN = false, MIDK = false;
    bf16_t* O; int ldc;
    __device__ __forceinline__ void operator()(const f32x4 (&acc)[2][2][4][2], const Unit& u, int wr, int wc, int fr, int fq) const {
        const int cbase = u.pn * BM + wc * 32 + 16 * (fq >> 1) + 4 * (fq & 1);
        EPI_ROWS(
            const int hv = row >> 7, dd = row & 127;
            _Pragma("unroll") for (int bj = 0; bj < 2; ++bj) _Pragma("unroll") for (int n = 0; n < 2; ++n) { const f32x4 v = acc[ai][bj][m][n];
                const int col = cbase + bj * HALF + 8 * n, bb = col >> 12, kt = (col >> 6) & 63, pos = col & 63;
                u32x2 w; w.x = cvt_pk_bf16(v[0], v[1]); w.y = cvt_pk_bf16(v[2], v[3]);
                *(u32x2*)(O + ((((size_t)(bb * 16 + hv)) * 64 + kt) * 128 + dd) * 64 + pos) = w; }
            EPI_FENCE();
        )
    }
};
struct EpiMerge {
    static constexpr bool PERM = true, AFTER_DRAIN = false, MIDK = true;
    const bf16_t* GA; const bf16_t* GB; int ldg; bf16_t* O; int ldc; int midk;
    __device__ __forceinline__ void mid(f32x4 (&acc)[2][2][4][2], const Unit& u, int wr, int wc, int fr, int fq) const {
        const int col0 = u.pn * BM + wc * 32 + 8 * fq;
        EPI_ROWS(
            _Pragma("unroll") for (int bj = 0; bj < 2; ++bj) { const size_t off = (size_t)row * ldg + col0 + bj * HALF;
                const u32x4 a = *(const u32x4*)(GA + off), b = *(const u32x4*)(GB + off);
                float r[8];
                r[0] = bf_lo(a.x) * __builtin_amdgcn_rcpf(fmaxf(bf_lo(b.x), 1e-30f)); r[1] = bf_hi(a.x) * __builtin_amdgcn_rcpf(fmaxf(bf_hi(b.x), 1e-30f));
                r[2] = bf_lo(a.y) * __builtin_amdgcn_rcpf(fmaxf(bf_lo(b.y), 1e-30f)); r[3] = bf_hi(a.y) * __builtin_amdgcn_rcpf(fmaxf(bf_hi(b.y), 1e-30f));
                r[4] = bf_lo(a.z) * __builtin_amdgcn_rcpf(fmaxf(bf_lo(b.z), 1e-30f)); r[5] = bf_hi(a.z) * __builtin_amdgcn_rcpf(fmaxf(bf_hi(b.z), 1e-30f));
                r[6] = bf_lo(a.w) * __builtin_amdgcn_rcpf(fmaxf(bf_lo(b.w), 1e-30f)); r[7] = bf_hi(a.w) * __builtin_amdgcn_rcpf(fmaxf(bf_hi(b.w), 1e-30f));
                _Pragma("unroll") for (int j = 0; j < 4; ++j) { acc[ai][bj][m][0][j] *= r[j]; acc[ai][bj][m][1][j] *= r[4 + j]; } }
            EPI_FENCE();
        )
    }
    __device__ __forceinline__ void operator()(const f32x4 (&acc)[2][2][4][2], const Unit& u, int wr, int wc, int fr, int fq) const {
        const int col0 = u.pn * BM + wc * 32 + 8 * fq;
        EPI_ROWS(
            _Pragma("unroll") for (int bj = 0; bj < 2; ++bj) { const u32x4 b = *(const u32x4*)(GB + (size_t)row * ldg + col0 + bj * HALF);
                f32x4 v0 = acc[ai][bj][m][0], v1 = acc[ai][bj][m][1];
                v0[0] *= fmaxf(bf_lo(b.x), 1e-30f); v0[1] *= fmaxf(bf_hi(b.x), 1e-30f); v0[2] *= fmaxf(bf_lo(b.y), 1e-30f); v0[3] *= fmaxf(bf_hi(b.y), 1e-30f);
                v1[0] *= fmaxf(bf_lo(b.z), 1e-30f); v1[1] *= fmaxf(bf_hi(b.z), 1e-30f); v1[2] *= fmaxf(bf_lo(b.w), 1e-30f); v1[3] *= fmaxf(bf_hi(b.w), 1e-30f);
                u32x4 w; w.x = cvt_pk_bf16(v0[0], v0[1]); w.y = cvt_pk_bf16(v0[2], v0[3]); w.z = cvt_pk_bf16(v1[0], v1[1]); w.w = cvt_pk_bf16(v1[2], v1[3]);
                *(u32x4*)(O + (size_t)row * ldc + col0 + bj * HALF) = w; }
            EPI_FENCE();
        )
    }
};
template <bool BASE_BF16> struct EpiResid {
    static constexpr bool PERM = true, AFTER_DRAIN = false, MIDK = false;
    const void* base; bf16_t* ob; float* rowss; int ldc;
    __device__ __forceinline__ void operator()(const f32x4 (&acc)[2][2][4][2], const Unit& u, int wr, int wc, int fr, int fq) const {
        const int col0 = u.pn * BM + wc * 32 + 8 * fq;
        EPI_ROWS(
            float ss = 0.f;
            _Pragma("unroll") for (int bj = 0; bj < 2; ++bj) { const size_t off = (size_t)row * ldc + col0 + bj * HALF;
                f32x4 b0, b1;
                if (BASE_BF16) { const u32x4 bw = *(const u32x4*)((const bf16_t*)base + off); b0 = (f32x4){bf_lo(bw.x), bf_hi(bw.x), bf_lo(bw.y), bf_hi(bw.y)}; b1 = (f32x4){bf_lo(bw.z), bf_hi(bw.z), bf_lo(bw.w), bf_hi(bw.w)}; }
                else { b0 = __builtin_nontemporal_load((const f32x4*)((const float*)base + off)); b1 = __builtin_nontemporal_load((const f32x4*)((const float*)base + off + 4)); }
                const f32x4 v0 = acc[ai][bj][m][0] + b0, v1 = acc[ai][bj][m][1] + b1;
                ss += (v0[0] * v0[0] + v0[1] * v0[1]) + (v0[2] * v0[2] + v0[3] * v0[3]) + (v1[0] * v1[0] + v1[1] * v1[1]) + (v1[2] * v1[2] + v1[3] * v1[3]);
                u32x4 w; w.x = cvt_pk_bf16(v0[0], v0[1]); w.y = cvt_pk_bf16(v0[2], v0[3]); w.z = cvt_pk_bf16(v1[0], v1[1]); w.w = cvt_pk_bf16(v1[2], v1[3]);
                *(u32x4*)(ob + off) = w; }
            ss += __shfl_xor(ss, 16); ss += __shfl_xor(ss, 32);
            if (fq == 0) atomicAdd(rowss + row, ss);
            EPI_FENCE();
        )
    }
};
struct EpiSwiGLU {
    static constexpr bool PERM = true, AFTER_DRAIN = false, MIDK = false;
    const float* rowss; bf16_t* H; int ldh; float inv_d, eps;
    __device__ __forceinline__ void operator()(const f32x4 (&acc)[2][2][4][2], const Unit& u, int wr, int wc, int fr, int fq) const {
        const int col0 = u.pn * HALF + wc * 32 + 8 * fq;
        EPI_ROWS(
            const float rs = __builtin_amdgcn_rsqf(rowss[row] * inv_d + eps);
            float hv[8];
            _Pragma("unroll") for (int n = 0; n < 2; ++n) _Pragma("unroll") for (int j = 0; j < 4; ++j) { const float g = acc[ai][0][m][n][j] * rs, up = acc[ai][1][m][n][j] * rs; hv[n * 4 + j] = g * sigmoidf_(g) * up; }
            u32x4 w; w.x = cvt_pk_bf16(hv[0], hv[1]); w.y = cvt_pk_bf16(hv[2], hv[3]); w.z = cvt_pk_bf16(hv[4], hv[5]); w.w = cvt_pk_bf16(hv[6], hv[7]);
            *(u32x4*)(H + (size_t)row * ldh + col0) = w;
            EPI_FENCE();
        )
    }
};
struct EpiStoreBf16 {
    static constexpr bool PERM = true, AFTER_DRAIN = false, MIDK = false;
    bf16_t* T; int ldc;
    __device__ __forceinline__ void operator()(const f32x4 (&acc)[2][2][4][2], const Unit& u, int wr, int wc, int fr, int fq) const {
        const int col0 = u.pn * BM + wc * 32 + 8 * fq;
        EPI_ROWS(
            _Pragma("unroll") for (int bj = 0; bj < 2; ++bj) { const f32x4 v0 = acc[ai][bj][m][0], v1 = acc[ai][bj][m][1];
                u32x4 w; w.x = cvt_pk_bf16(v0[0], v0[1]); w.y = cvt_pk_bf16(v0[2], v0[3]); w.z = cvt_pk_bf16(v1[0], v1[1]); w.w = cvt_pk_bf16(v1[2], v1[3]);
                *(u32x4*)(T + (size_t)row * ldc + col0 + bj * HALF) = w; }
            EPI_FENCE();
        )
    }
};
struct EpiPle {
    static constexpr bool PERM = true, AFTER_DRAIN = false, MIDK = false;
    const float* rowss; const bf16_t* T; const bf16_t* X; float* out; int ldc; float inv_d, eps;
    __device__ __forceinline__ void operator()(const f32x4 (&acc)[2][2][4][2], const Unit& u, int wr, int wc, int fr, int fq) const {
        const int col0 = u.pn * BM + wc * 32 + 8 * fq;
        EPI_ROWS(
            const float rs = __builtin_amdgcn_rsqf(rowss[row] * inv_d + eps);
            _Pragma("unroll") for (int bj = 0; bj < 2; ++bj) { const size_t off = (size_t)row * ldc + col0 + bj * HALF;
                const u32x4 tw = *(const u32x4*)(T + off), xw = *(const u32x4*)(X + off);
                const float t[8] = {bf_lo(tw.x), bf_hi(tw.x), bf_lo(tw.y), bf_hi(tw.y), bf_lo(tw.z), bf_hi(tw.z), bf_lo(tw.w), bf_hi(tw.w)};
                const float x[8] = {bf_lo(xw.x), bf_hi(xw.x), bf_lo(xw.y), bf_hi(xw.y), bf_lo(xw.z), bf_hi(xw.z), bf_lo(xw.w), bf_hi(xw.w)};
                f32x4 o0, o1;
                _Pragma("unroll") for (int j = 0; j < 4; ++j) { o0[j] = x[j] + sigmoidf_(acc[ai][bj][m][0][j] * rs) * t[j]; o1[j] = x[4 + j] + sigmoidf_(acc[ai][bj][m][1][j] * rs) * t[4 + j]; }
                __builtin_nontemporal_store(o0, (f32x4*)(out + off)); __builtin_nontemporal_store(o1, (f32x4*)(out + off + 4)); }
            EPI_FENCE();
        )
    }
};
template <class Epi, class Sched, bool ALIGN_EPI = false, bool SP2 = false>
__device__ __forceinline__ void gemm_phase(PG8_LAS unsigned char* lds, const Gemm g, const Sched& S, const Epi& E) {
    int tid_ = threadIdx.x; asm volatile("" : "+v"(tid_));
    const int tid = tid_, wid = __builtin_amdgcn_readfirstlane(tid >> 6), lane = tid & 63, wr = wid >> 2, wc = wid & 3, fr = lane & 15, fq = lane >> 4;
    const int K = g.K, nt = g.nt ? g.nt : K / BK;
    unsigned voffA[2], voffB[2];
#pragma unroll
    for (int i = 0; i < 2; ++i) { int R, C; stage_rc(tid * 16 + i * 8192, R, C); const int Rb = Epi::PERM ? ((R & ~31) + perm32(R & 31)) : R;
        voffA[i] = (unsigned)(R * K + C) * 2u; voffB[i] = (unsigned)(Rb * K + C) * 2u; }
    const size_t kstep = (size_t)(BK * 2);
    const size_t hstep = (size_t)HALF * K * 2;
    const size_t tstep = 2 * hstep;
    const unsigned ldsw = (unsigned)wid * 1024u;
    const int aoff = lds_byte(wr * 64 + fr, fq * 8), boff = lds_byte(wc * 32 + fr, fq * 8);
#define PG8_SA(b, h) (((b) * 2 + (h)) * HTB)
#define PG8_SB(b, h) ((4 + (b) * 2 + (h)) * HTB)
#define PG8_STAGE(bufoff, gbase, voff) do { _Pragma("unroll") for (int _i = 0; _i < 2; ++_i) \
        __builtin_amdgcn_global_load_lds((const unsigned*)((const char*)(gbase) + (voff)[_i]), (PG8_LAS unsigned*)(lds + (bufoff) + ldsw + _i * 8192), 16, 0, 0); } while (0)
#define PG8_LDA(dst, b, h) do { _Pragma("unroll") for (int m = 0; m < 4; ++m) _Pragma("unroll") for (int k = 0; k < 2; ++k) dst[m][k] = *(const PG8_LAS bf16x8*)(lds + PG8_SA(b, h) + aoff + m * 2048 + k * 1024); } while (0)
#define PG8_LDB(dst, b, h) do { _Pragma("unroll") for (int n = 0; n < 2; ++n) _Pragma("unroll") for (int k = 0; k < 2; ++k) dst[n][k] = *(const PG8_LAS bf16x8*)(lds + PG8_SB(b, h) + boff + n * 2048 + k * 1024); } while (0)
#define PG8_MMA(ai, bj, At, Bt) do { __builtin_amdgcn_s_setprio(1); _Pragma("unroll") for (int m = 0; m < 4; ++m) _Pragma("unroll") for (int n = 0; n < 2; ++n) _Pragma("unroll") for (int k = 0; k < 2; ++k) \
        acc[ai][bj][m][n] = __builtin_amdgcn_mfma_f32_16x16x32_bf16(Bt[n][k], At[m][k], acc[ai][bj][m][n], 0, 0, 0); __builtin_amdgcn_s_setprio(0); } while (0)
#define PG8_WAIT_V(n) asm volatile("s_waitcnt vmcnt(" #n ")" ::: "memory")
#define PG8_WAIT_L(n) asm volatile("s_waitcnt lgkmcnt(" #n ")" ::: "memory")
#define PG8_BAR __builtin_amdgcn_s_barrier()
#define PG8_SCHED __builtin_amdgcn_sched_barrier(0)
    Unit cur, nxt; int ui = 0;
    if (!S.next(0, cur)) return;
    f32x4 acc[2][2][4][2];
#pragma unroll
    for (int a = 0; a < 2; ++a)
#pragma unroll
        for (int b = 0; b < 2; ++b)
#pragma unroll
            for (int m = 0; m < 4; ++m)
#pragma unroll
                for (int n = 0; n < 2; ++n) acc[a][b][m][n] = (f32x4){0.f, 0.f, 0.f, 0.f};
    bf16x8 At[4][2], B0[2][2], B1[2][2];
    const char* cA = (const char*)g.A + (size_t)cur.pm * tstep + cur.ko; const char* cB = (const char*)g.Bt + (size_t)cur.pn * tstep + cur.ko;
    S.a_ready(cur);
    if constexpr (SP2) {
        PG8_STAGE(PG8_SB(0, 0), cB, voffB); PG8_STAGE(PG8_SB(0, 1), cB + hstep, voffB); PG8_STAGE(PG8_SA(0, 0), cA, voffA); PG8_STAGE(PG8_SA(0, 1), cA + hstep, voffA);
        if (wr == 1) PG8_BAR;
        PG8_WAIT_V(2); PG8_BAR;
        PG8_STAGE(PG8_SB(1, 0), cB + kstep, voffB); PG8_STAGE(PG8_SA(1, 0), cA + kstep, voffA); PG8_STAGE(PG8_SB(1, 1), cB + hstep + kstep, voffB);
        PG8_WAIT_V(6); PG8_BAR;
    } else {
        PG8_STAGE(PG8_SB(0, 0), cB, voffB); PG8_STAGE(PG8_SA(0, 0), cA, voffA); PG8_STAGE(PG8_SB(0, 1), cB + hstep, voffB); PG8_STAGE(PG8_SA(0, 1), cA + hstep, voffA);
        if (wr == 1) PG8_BAR;
        PG8_WAIT_V(4); PG8_BAR;
        PG8_STAGE(PG8_SB(1, 0), cB + kstep, voffB); PG8_STAGE(PG8_SA(1, 0), cA + kstep, voffA); PG8_STAGE(PG8_SB(1, 1), cB + hstep + kstep, voffB);
        PG8_WAIT_V(6); PG8_BAR;
    }
    for (;;) {
        const bool has_next = S.next(ui + 1, nxt);
        const char* nA = has_next ? (const char*)g.A + (size_t)nxt.pm * tstep + nxt.ko : cA; const char* nB = has_next ? (const char*)g.Bt + (size_t)nxt.pn * tstep + nxt.ko : cB;
        for (int t = 0; t < nt; t += 2) {
            const bool last = (t == nt - 2);
            const char* a1 = cA + (size_t)(t + 1) * kstep;
            const char* a2 = last ? nA : cA + (size_t)(t + 2) * kstep; const char* b2 = last ? nB : cB + (size_t)(t + 2) * kstep;
            const char* a3 = a2 + kstep; const char* b3 = b2 + kstep;
            if (last && has_next) S.a_ready(nxt);
            if constexpr (SP2) {
            PG8_LDB(B0, 0, 0); PG8_LDB(B1, 0, 1); PG8_SCHED; PG8_LDA(At, 0, 0); PG8_STAGE(PG8_SA(1, 1), a1 + hstep, voffA);
            PG8_WAIT_V(8); PG8_WAIT_L(0); PG8_BAR; PG8_MMA(0, 0, At, B0); PG8_MMA(0, 1, At, B1); PG8_BAR; PG8_SCHED;
            PG8_LDA(At, 0, 1); PG8_STAGE(PG8_SB(0, 0), b2, voffB); PG8_STAGE(PG8_SB(0, 1), b2 + hstep, voffB); PG8_STAGE(PG8_SA(0, 0), a2, voffA);
            PG8_WAIT_V(8); PG8_WAIT_L(0); PG8_BAR; PG8_MMA(1, 0, At, B0); PG8_MMA(1, 1, At, B1); PG8_BAR; PG8_SCHED;
            PG8_LDB(B0, 1, 0); PG8_LDB(B1, 1, 1); PG8_SCHED; PG8_LDA(At, 1, 0); PG8_STAGE(PG8_SA(0, 1), a2 + hstep, voffA);
            PG8_WAIT_V(8); PG8_WAIT_L(0); PG8_BAR; PG8_MMA(0, 0, At, B0); PG8_MMA(0, 1, At, B1); PG8_BAR; PG8_SCHED;
            PG8_LDA(At, 1, 1); PG8_STAGE(PG8_SB(1, 0), b3, voffB); PG8_STAGE(PG8_SB(1, 1), b3 + hstep, voffB); PG8_STAGE(PG8_SA(1, 0), a3, voffA);
            PG8_WAIT_V(8); PG8_WAIT_L(0); PG8_BAR; PG8_MMA(1, 0, At, B0); PG8_MMA(1, 1, At, B1); PG8_BAR; PG8_SCHED;
            } else {
            PG8_LDB(B0, 0, 0); PG8_SCHED; PG8_LDA(At, 0, 0); PG8_STAGE(PG8_SA(1, 1), a1 + hstep, voffA);
            PG8_WAIT_L(8); PG8_BAR; PG8_WAIT_L(0); PG8_MMA(0, 0, At, B0); PG8_BAR; PG8_SCHED;
            PG8_LDB(B1, 0, 1); PG8_STAGE(PG8_SB(0, 0), b2, voffB);
            PG8_BAR; PG8_WAIT_L(0); PG8_MMA(0, 1, At, B1); PG8_BAR;
            PG8_LDA(At, 0, 1); PG8_STAGE(PG8_SA(0, 0), a2, voffA);
            PG8_BAR; PG8_WAIT_L(0); PG8_MMA(1, 0, At, B0); PG8_BAR; PG8_SCHED;
            PG8_STAGE(PG8_SB(0, 1), b2 + hstep, voffB);
            PG8_WAIT_V(6); PG8_BAR; PG8_MMA(1, 1, At, B1); PG8_BAR;
            PG8_LDB(B0, 1, 0); PG8_SCHED; PG8_LDA(At, 1, 0); PG8_STAGE(PG8_SA(0, 1), a2 + hstep, voffA);
            PG8_WAIT_L(8); PG8_BAR; PG8_WAIT_L(0); PG8_MMA(0, 0, At, B0); PG8_BAR; PG8_SCHED;
            PG8_LDB(B1, 1, 1); PG8_STAGE(PG8_SB(1, 0), b3, voffB);
            PG8_BAR; PG8_WAIT_L(0); PG8_MMA(0, 1, At, B1); PG8_BAR;
            PG8_LDA(At, 1, 1); PG8_STAGE(PG8_SA(1, 0), a3, voffA);
            PG8_BAR; PG8_WAIT_L(0); PG8_MMA(1, 0, At, B0); PG8_BAR; PG8_SCHED;
            PG8_STAGE(PG8_SB(1, 1), b3 + hstep, voffB);
            PG8_WAIT_V(6); PG8_BAR; PG8_MMA(1, 1, At, B1); PG8_BAR;
            }
        }
        if constexpr (ALIGN_EPI) { if (wr == 0) PG8_BAR; }
        bool keep_acc = false;
        if constexpr (Epi::MIDK) { if (cur.ko == 0) { E.mid(acc, cur, wr, wc, fr, fq); keep_acc = true; } else E(acc, cur, wr, wc, fr, fq); }
        else if constexpr (!Epi::AFTER_DRAIN) { E(acc, cur, wr, wc, fr, fq); S.done(cur); }
        if (!has_next) break;
        if (!keep_acc) {
#pragma unroll
        for (int a = 0; a < 2; ++a)
#pragma unroll
            for (int b = 0; b < 2; ++b)
#pragma unroll
                for (int m = 0; m < 4; ++m)
#pragma unroll
                    for (int n = 0; n < 2; ++n) acc[a][b][m][n] = (f32x4){0.f, 0.f, 0.f, 0.f};
        }
        cur = nxt; cA = nA; cB = nB; ++ui;
        if constexpr (ALIGN_EPI) { if (wr == 1) PG8_BAR; }
    }
    PG8_WAIT_V(0);
    if constexpr (!ALIGN_EPI) { if (wr == 0) PG8_BAR; }
    PG8_BAR;
    if constexpr (Epi::AFTER_DRAIN) { E.fused(acc, cur, wr, wc, fr, fq, lds, wid, lane); S.done(cur); }
#undef PG8_SA
#undef PG8_SB
#undef PG8_STAGE
#undef PG8_LDA
#undef PG8_LDB
#undef PG8_MMA
#undef PG8_WAIT_V
#undef PG8_WAIT_L
#undef PG8_BAR
#undef PG8_SCHED
}
}
constexpr int D = 2048, BATCH = 2, SEQ = 4096, M = BATCH * SEQ, GW = 64, GROWS = SEQ / GW, FF = 5632, PLE = 256;
constexpr int NA_H = 8, NA_DH = 128, DF_H = 8, DF_DQ = 64, DF_DV = 128;
constexpr int NQKG = 8192;
constexpr int QC_NAQ = 0, QC_NAK = 1024, QC_DFQ = 2048, QC_DFK = 3072, QC_GA = 4096, QC_GB = 6144;
constexpr float EPS = 1e-6f, LOG2E = 1.4426950408889634f;
constexpr float LAM_INIT = 0.2f;
constexpr int NWAVES = 8, NTHREADS = 512;
constexpr size_t MiB = 1u << 20;
constexpr size_t WS_RS1 = 64 * 1024, WS_RS2 = 128 * 1024, WS_ROPE = 1 * MiB;
constexpr size_t WS_W1 = 2 * MiB, WS_WNA = 42 * MiB, WS_WDF = 46 * MiB, WS_WO = 50 * MiB, WS_WGU = 58 * MiB, WS_WDN = 102 * MiB, WS_WPG = 124 * MiB, WS_WPP = 132 * MiB;
constexpr size_t WS_A = 133 * MiB;
constexpr size_t WS_B = 261 * MiB;
constexpr size_t WS_C = 293 * MiB;
constexpr size_t WS_PB = 325 * MiB;
constexpr size_t WS_END = 329 * MiB;
constexpr int LDS_BYTES = 147456;
#define LAS __attribute__((address_space(3)))
typedef unsigned short bf16;
typedef unsigned u32x4 __attribute__((ext_vector_type(4)));
typedef unsigned u32x2 __attribute__((ext_vector_type(2)));
typedef float f32x4 __attribute__((ext_vector_type(4)));
typedef float f32x2 __attribute__((ext_vector_type(2)));
typedef float f32x16 __attribute__((ext_vector_type(16)));
typedef short bf16x8 __attribute__((ext_vector_type(8)));
using pg8::cvt_pk_bf16; using pg8::bf_lo; using pg8::bf_hi;

__device__ __forceinline__ float wave_sum(float v) {
#pragma unroll
    for (int o = 1; o < 64; o <<= 1) v += __shfl_xor(v, o);
    return v;
}
__device__ __forceinline__ float wave_max(float v) {
#pragma unroll
    for (int o = 1; o < 64; o <<= 1) v = fmaxf(v, __shfl_xor(v, o));
    return v;
}
__device__ __forceinline__ int crow(int r, int hi) { return (r & 3) + 8 * (r >> 2) + 4 * hi; }

__device__ __forceinline__ int rowmap(int mode, int n0) {
    if (mode == 0) return n0;
    if (mode == 1) {
        if (n0 < 2048) return n0;
        if (n0 < 3072) return 8192 + (n0 - 2048);
        if (n0 < 4096) return 2048 + (n0 - 3072);
        if (n0 < 5120) return 3072 + (n0 - 4096);
        if (n0 < 6144) return 9216 + (n0 - 5120);
        return 4096 + (n0 - 6144);
    }
    return 256 * (n0 >> 7) + (n0 & 127) + (mode == 3 ? 128 : 0);
}
struct P0Item { const float* W; bf16* WT; const float* gk; int K, N, mode, item, Kd, kofs; };
__device__ __forceinline__ void p0_item_load(const P0Item& d, float (&v)[32], int lane) {
    const int nblk = d.N / 32, kb = d.item / nblk, nb = d.item % nblk, k0 = 64 * kb, n0 = 32 * nb;
    const float* src = d.W + (size_t)(k0 + (lane >> 5)) * d.N + n0 + (lane & 31);
#pragma unroll
    for (int i = 0; i < 32; ++i) v[i] = __builtin_nontemporal_load(src + (size_t)(2 * i) * d.N);
}
__device__ __forceinline__ void p0_item_store(const P0Item& d, const float (&v)[32], LAS float* scr, int lane) {
    const int nblk = d.N / 32, kb = d.item / nblk, nb = d.item % nblk, k0 = 64 * kb, n0 = 32 * nb;
    const int r0 = rowmap(d.mode, n0);
    if (d.gk) {
#pragma unroll
        for (int i = 0; i < 32; ++i) { const int kk = 2 * i + (lane >> 5); scr[kk * 33 + (lane & 31)] = v[i] * d.gk[k0 + kk]; }
    } else {
#pragma unroll
        for (int i = 0; i < 32; ++i) { const int kk = 2 * i + (lane >> 5); scr[kk * 33 + (lane & 31)] = v[i]; }
    }
    asm volatile("s_waitcnt lgkmcnt(0)" ::: "memory");
    const int c = lane & 7;
#pragma unroll
    for (int j = 0; j < 4; ++j) { const int n = (lane >> 3) + 8 * j; const LAS float* s = scr + (8 * c) * 33 + n;
        u32x4 o; o.x = cvt_pk_bf16(s[0 * 33], s[1 * 33]); o.y = cvt_pk_bf16(s[2 * 33], s[3 * 33]); o.z = cvt_pk_bf16(s[4 * 33], s[5 * 33]); o.w = cvt_pk_bf16(s[6 * 33], s[7 * 33]);
        *(u32x4*)(d.WT + (size_t)(r0 + n) * d.Kd + d.kofs + k0 + 8 * c) = o; }
    asm volatile("s_waitcnt lgkmcnt(0)" ::: "memory");
}
#define RLX_AGENT __ATOMIC_RELAXED, __HIP_MEMORY_SCOPE_AGENT
#define XB_TMO      128
#define XB_XCNT(j)  (256  + 64 * (j))
#define XB_XSUB(j)  (1280 + 64 * (j))
#define XB_XGEN(j)  (2304 + 64 * (j))
#define XB_TOP      3328
#define XB_TOPGEN   3392
#define XCD_BAR_WORDS 3456
#define XB_SPIN_CAP (1u << 18)

__device__ __forceinline__ unsigned xb_ld(unsigned* p)              { return __hip_atomic_load(p, __ATOMIC_RELAXED, __HIP_MEMORY_SCOPE_AGENT); }
__device__ __forceinline__ unsigned xb_add(unsigned* p, unsigned v) { return __hip_atomic_fetch_add(p, v, __ATOMIC_RELAXED, __HIP_MEMORY_SCOPE_AGENT); }
__device__ __forceinline__ unsigned xb_xcc_id() { return (unsigned)__builtin_amdgcn_s_getreg((3 << 11) | 20) & 0xFu; }
#define XB_SPIN(cond, bar) do { unsigned _sp = 0; while (cond) { __builtin_amdgcn_s_sleep(1); \
    if ((++_sp & 255u) == 0u) { if (xb_ld(&(bar)[XB_TMO])) break; if (_sp > XB_SPIN_CAP) { atomicAdd(&(bar)[XB_TMO], 1u); break; } } } } while (0)

struct XcdBarrier {
    unsigned* bar; unsigned x;
    volatile LAS unsigned* st;
};

__device__ __forceinline__ XcdBarrier xcd_barrier_post(unsigned* bar, volatile LAS unsigned* st) {
    XcdBarrier b; b.bar = bar; b.x = xb_xcc_id(); b.st = st;
    if (threadIdx.x == 0) (void)xb_add(&bar[XB_XCNT(b.x)], 1u);
    return b;
}
__device__ __forceinline__ void xcd_barrier_complete(unsigned* bar, unsigned x, unsigned& nloc, unsigned& nx) {
    const unsigned G = gridDim.x * gridDim.y * gridDim.z;
    unsigned sum, cnt, mine, sp = 0u;
    for (;;) {
        sum = 0u; cnt = 0u; mine = 0u;
#pragma unroll
        for (unsigned j = 0; j < 16; ++j) { const unsigned c = xb_ld(&bar[XB_XCNT(j)]); sum += c; cnt += (c > 0u) ? 1u : 0u; mine = (j == x) ? c : mine; }
        if (sum == G) break;
        __builtin_amdgcn_s_sleep(1);
        if ((++sp & 255u) == 0u) { if (xb_ld(&bar[XB_TMO])) break; if (sp > XB_SPIN_CAP) { atomicAdd(&bar[XB_TMO], 1u); break; } }
    }
    nloc = mine > 0u ? mine : 1u; nx = cnt > 0u ? cnt : 1u;
}

__device__ __forceinline__ void xcd_barrier(const XcdBarrier& b) {
    asm volatile("s_waitcnt vmcnt(0)" ::: "memory");
    __syncthreads();
    if (threadIdx.x == 0) {
        unsigned* bar = b.bar;
        __builtin_amdgcn_s_waitcnt(0);
        unsigned nloc = b.st[0], nx = b.st[1];
        if (nloc == 0u) { xcd_barrier_complete(bar, b.x, nloc, nx); b.st[0] = nloc; b.st[1] = nx; }
        const unsigned old = xb_add(&bar[XB_XSUB(b.x)], 1u);
        const unsigned gen = old / nloc;
        if (old + 1u == (gen + 1u) * nloc) {
            __builtin_amdgcn_fence(__ATOMIC_RELEASE, "agent");
            asm volatile("s_waitcnt vmcnt(0)" ::: "memory");
            const unsigned og = xb_add(&bar[XB_TOP], 1u);
            const unsigned tg = og / nx;
            if (og + 1u == (tg + 1u) * nx) xb_add(&bar[XB_TOPGEN], 1u);
            else XB_SPIN(xb_ld(&bar[XB_TOPGEN]) == tg, bar);
            __builtin_amdgcn_fence(__ATOMIC_ACQUIRE, "agent");
            xb_add(&bar[XB_XGEN(b.x)], 1u);
            asm volatile("s_waitcnt vmcnt(0)" ::: "memory");
        } else {
            XB_SPIN(xb_ld(&bar[XB_XGEN(b.x)]) == gen, bar);
            __builtin_amdgcn_fence(__ATOMIC_ACQUIRE, "agent");
            asm volatile("s_waitcnt vmcnt(0)" ::: "memory");
        }
    }
    __syncthreads();
}
struct Args {
    const float *x, *p, *g_mix, *w_in, *g_na_q, *g_na_k, *na_rpb, *g_df_q, *g_df_k, *lam_q1, *lam_k1, *lam_q2, *lam_k2, *g_df_sub,
                *w_na_out, *w_df_out, *w_o, *g_ffn, *w_gate, *w_up, *w_down, *g_ple, *w_ple_gate, *w_ple_proj;
    float* out; unsigned char* ws; int ph_lo, ph_hi, rep3, pad;
};

__device__ __forceinline__ void na_wave_unit(const bf16* QKG, const bf16* VT, const float* rpb, bf16* NAO, float M2, int b, int h, int r, int half) {
    int tid_ = threadIdx.x; asm volatile("" : "+v"(tid_)); const int lane = tid_ & 63;
    const int q = lane & 31, hi = lane >> 5, c = 32 * half + q;
    const size_t tokq = (size_t)b * SEQ + r * GW + c;
    bf16x8 qf[8];
#pragma unroll
    for (int d0 = 0; d0 < 8; ++d0) qf[d0] = *(const bf16x8*)(QKG + tokq * NQKG + QC_NAQ + h * NA_DH + 16 * d0 + 8 * hi);
    int rs = r - 4; rs = rs < 0 ? 0 : (rs > GROWS - 8 ? GROWS - 8 : rs);
    int cs = c - 8; cs = cs < 0 ? 0 : (cs > GW - 16 ? GW - 16 : cs);
    f32x16 o[4];
#pragma unroll
    for (int i = 0; i < 4; ++i) o[i] = (f32x16){};
    float l = 0.f;
    for (int kr = 0; kr < 8; ++kr) {
        const int krow = rs + kr, dr = krow - r + 7;
        const float* brow = rpb + (h * 15 + dr) * 31;
#pragma unroll
        for (int kb = 0; kb < 2; ++kb) {
            f32x16 s = (f32x16){};
            const bf16* kp = QKG + ((size_t)b * SEQ + krow * GW + 32 * kb + q) * NQKG + QC_NAK + h * NA_DH + 8 * hi;
#pragma unroll
            for (int d0 = 0; d0 < 8; ++d0) { const bf16x8 kf = *(const bf16x8*)(kp + 16 * d0); s = __builtin_amdgcn_mfma_f32_32x32x16_bf16(kf, qf[d0], s, 0, 0, 0); }
            float pv[16];
#pragma unroll
            for (int i = 0; i < 16; ++i) { const int kc = 32 * kb + crow(i, hi); const bool in = (kc >= cs) && (kc < cs + 16); const int dc = in ? (kc - c + 15) : 0;
                const float bias = brow[dc] * LOG2E - M2; const float e = __builtin_amdgcn_exp2f(s[i] + bias); pv[i] = in ? e : 0.f; l += pv[i]; }
            u32x4 w0, w1;
            w0.x = cvt_pk_bf16(pv[0], pv[1]); w0.y = cvt_pk_bf16(pv[2], pv[3]); w0.z = cvt_pk_bf16(pv[4], pv[5]); w0.w = cvt_pk_bf16(pv[6], pv[7]);
            w1.x = cvt_pk_bf16(pv[8], pv[9]); w1.y = cvt_pk_bf16(pv[10], pv[11]); w1.z = cvt_pk_bf16(pv[12], pv[13]); w1.w = cvt_pk_bf16(pv[14], pv[15]);
            const bf16x8 p0 = __builtin_bit_cast(bf16x8, w0), p1 = __builtin_bit_cast(bf16x8, w1);
            const bf16* vp = VT + (size_t)(h * NA_DH + q) * M + (size_t)b * SEQ + krow * GW + 32 * kb + 8 * hi;
#pragma unroll
            for (int db = 0; db < 4; ++db) {
                const bf16x8 v0 = *(const bf16x8*)(vp + (size_t)(32 * db) * M), v1 = *(const bf16x8*)(vp + (size_t)(32 * db) * M + 16);
                o[db] = __builtin_amdgcn_mfma_f32_32x32x16_bf16(v0, p0, o[db], 0, 0, 0);
                o[db] = __builtin_amdgcn_mfma_f32_32x32x16_bf16(v1, p1, o[db], 0, 0, 0);
            }
        }
    }
    l += __shfl_xor(l, 32);
    const float rl = 1.0f / l;
    bf16* op = NAO + tokq * 2048 + h * NA_DH + 4 * hi;
#pragma unroll
    for (int db = 0; db < 4; ++db)
#pragma unroll
        for (int g = 0; g < 4; ++g) { u32x2 w; w.x = cvt_pk_bf16(o[db][4 * g] * rl, o[db][4 * g + 1] * rl); w.y = cvt_pk_bf16(o[db][4 * g + 2] * rl, o[db][4 * g + 3] * rl);
            *(u32x2*)(op + 32 * db + 8 * g) = w; }
}

__device__ __forceinline__ void df_unit(LAS unsigned char* lds, const bf16* QKG, const bf16* KC, const bf16* VT, bf16* DFO, const float* g_sub, const float* gq, const f32x2* rope, float lam, float M2, int b, int h, int qb, unsigned long long* df_wait = nullptr) {
    int tid_ = threadIdx.x; asm volatile("" : "+v"(tid_));
    const int tid = tid_, lane = tid & 63, w = __builtin_amdgcn_readfirstlane(tid >> 6), q = lane & 31, hi = lane >> 5;
    const int mm = w & 1, qg = w >> 1;
    const int q0 = qb * 128 + qg * 32;
    bf16x8 qf[4];
    {
      u32x4 qr[4]; float ss = 0.f; float xv[4][8];
#pragma unroll
      for (int d0 = 0; d0 < 4; ++d0) { qr[d0] = *(const u32x4*)(QKG + ((size_t)b * SEQ + q0 + q) * NQKG + QC_DFQ + h * 128 + mm * 64 + 16 * d0 + 8 * hi);
          xv[d0][0] = bf_lo(qr[d0].x); xv[d0][1] = bf_hi(qr[d0].x); xv[d0][2] = bf_lo(qr[d0].y); xv[d0][3] = bf_hi(qr[d0].y); xv[d0][4] = bf_lo(qr[d0].z); xv[d0][5] = bf_hi(qr[d0].z); xv[d0][6] = bf_lo(qr[d0].w); xv[d0][7] = bf_hi(qr[d0].w);
#pragma unroll
          for (int j = 0; j < 8; ++j) ss += xv[d0][j] * xv[d0][j]; }
      ss += __shfl_xor(ss, 32);
      const float rs = __builtin_amdgcn_rsqf(ss * (1.0f / 64.0f) + EPS);
      const float QS = 0.125f * LOG2E;
      const f32x2* rp = rope + (size_t)(q0 + q) * 32;
#pragma unroll
      for (int d0 = 0; d0 < 2; ++d0) { float o1[8], o2[8];
#pragma unroll
          for (int j = 0; j < 8; ++j) { const int i = 16 * d0 + 8 * hi + j; const f32x2 cs = rp[i];
              const float x1 = xv[d0][j] * rs * gq[i], x2 = xv[d0 + 2][j] * rs * gq[32 + i];
              o1[j] = (x1 * cs.x - x2 * cs.y) * QS; o2[j] = (x1 * cs.y + x2 * cs.x) * QS; }
          u32x4 wa, wb; wa.x = cvt_pk_bf16(o1[0], o1[1]); wa.y = cvt_pk_bf16(o1[2], o1[3]); wa.z = cvt_pk_bf16(o1[4], o1[5]); wa.w = cvt_pk_bf16(o1[6], o1[7]);
          wb.x = cvt_pk_bf16(o2[0], o2[1]); wb.y = cvt_pk_bf16(o2[2], o2[3]); wb.z = cvt_pk_bf16(o2[4], o2[5]); wb.w = cvt_pk_bf16(o2[6], o2[7]);
          qf[d0] = __builtin_bit_cast(bf16x8, wa); qf[d0 + 2] = __builtin_bit_cast(bf16x8, wb); } }
    const unsigned char* kbase = (const unsigned char*)(KC + ((size_t)(b * 8 + h) * SEQ) * 128);
    const unsigned char* vbase = (const unsigned char*)(VT + ((size_t)(b * 16 + 8 + h) * 64) * 128 * 64);
    unsigned koff[2], voff[2];
#pragma unroll
    for (int i = 0; i < 2; ++i) {
        const int piece = w * 2 + i;
        { const int row = piece * 4 + (lane >> 4), ph = lane & 15, ch = ph ^ (row & 15); koff[i] = (unsigned)(row * 128 + ch * 8) * 2u; }
        { const int row = piece * 8 + (lane >> 3), ph = lane & 7, ch = ph ^ ((row >> 1) & 7); voff[i] = (unsigned)(row * 64 + ch * 8) * 2u; }
    }
#define DF_DMA(kt, stg) do { const unsigned char* kb_ = kbase + (size_t)(kt) * 16384; const unsigned char* vb_ = vbase + (size_t)(kt) * 16384; _Pragma("unroll") for (int _i = 0; _i < 2; ++_i) { \
        __builtin_amdgcn_global_load_lds((const unsigned*)(kb_ + koff[_i]), (LAS unsigned*)(lds + (stg) * 32768 + (w * 2 + _i) * 1024), 16, 0, 0); \
        __builtin_amdgcn_global_load_lds((const unsigned*)(vb_ + voff[_i]), (LAS unsigned*)(lds + (stg) * 32768 + 16384 + (w * 2 + _i) * 1024), 16, 0, 0); } } while (0)
    int kofs[4], vofs[4];
#pragma unroll
    for (int d0 = 0; d0 < 4; ++d0) kofs[d0] = q * 256 + (((mm * 8 + 2 * d0 + hi) ^ (q & 15)) * 16);
#pragma unroll
    for (int g = 0; g < 4; ++g) vofs[g] = 16384 + q * 128 + (((2 * g + hi) ^ ((q >> 1) & 7)) * 16);
    f32x16 o[4];
#pragma unroll
    for (int i = 0; i < 4; ++i) o[i] = (f32x16){};
    float l = 0.f;
    const float shift = (M2 > 60.0f) ? M2 : 0.0f;
    constexpr int NT = SEQ / 64;
    typedef float f32x2_t __attribute__((ext_vector_type(2))); typedef __bf16 bf16x2_t __attribute__((ext_vector_type(2)));
#define CVTPK(lo, hi) __builtin_bit_cast(unsigned, __builtin_convertvector((f32x2_t){(lo), (hi)}, bf16x2_t))
#define DF_S(dst, St_, kb_) do { bf16x8 kf_[4]; _Pragma("unroll") for (int d0 = 0; d0 < 4; ++d0) kf_[d0] = *(const LAS bf16x8*)((St_) + kofs[d0] + (kb_) * 8192); \
        dst = (f32x16){}; _Pragma("unroll") for (int d0 = 0; d0 < 4; ++d0) dst = __builtin_amdgcn_mfma_f32_32x32x16_bf16(kf_[d0], qf[d0], dst, 0, 0, 0); } while (0)
    DF_DMA(0, 0); DF_DMA(1, 1); DF_DMA(2, 2);
    asm volatile("s_waitcnt vmcnt(4)" ::: "memory");
    __builtin_amdgcn_s_barrier();
    asm volatile("" ::: "memory");
    f32x16 sc[2], sn[2];
    DF_S(sc[0], lds, 0); DF_S(sc[1], lds, 1);
    for (int kt = 0; kt < NT; ++kt) {
        if (kt + 3 < NT) DF_DMA(kt + 3, (kt + 3) & 3);
        const LAS unsigned char* St = lds + (kt & 3) * 32768;
        const LAS unsigned char* Sn = lds + ((kt + 1) & 3) * 32768;
        if (kt + 1 < NT) { DF_S(sn[0], Sn, 0); DF_S(sn[1], Sn, 1); }
#pragma unroll
        for (int kb = 0; kb < 2; ++kb) {
            bf16x8 vf[2][4];
#pragma unroll
            for (int jj = 0; jj < 2; ++jj)
#pragma unroll
                for (int db = 0; db < 4; ++db) vf[jj][db] = *(const LAS bf16x8*)(St + vofs[2 * kb + jj] + db * 4096);
            f32x16 s = sc[kb];
            if (shift != 0.f) {
#pragma unroll
                for (int i = 0; i < 16; ++i) s[i] -= shift;
            }
            float ls = 0.f;
#pragma unroll
            for (int i = 0; i < 16; ++i) { s[i] = __builtin_amdgcn_exp2f(s[i]); ls += s[i]; }
            l += ls;
            u32x4 w0, w1;
            w0.x = CVTPK(s[0], s[1]); w0.y = CVTPK(s[2], s[3]); w0.z = CVTPK(s[4], s[5]); w0.w = CVTPK(s[6], s[7]);
            w1.x = CVTPK(s[8], s[9]); w1.y = CVTPK(s[10], s[11]); w1.z = CVTPK(s[12], s[13]); w1.w = CVTPK(s[14], s[15]);
            const bf16x8 p0 = __builtin_bit_cast(bf16x8, w0), p1 = __builtin_bit_cast(bf16x8, w1);
#pragma unroll
            for (int db = 0; db < 4; ++db) o[db] = __builtin_amdgcn_mfma_f32_32x32x16_bf16(vf[0][db], p0, o[db], 0, 0, 0);
#pragma unroll
            for (int db = 0; db < 4; ++db) o[db] = __builtin_amdgcn_mfma_f32_32x32x16_bf16(vf[1][db], p1, o[db], 0, 0, 0);
        }
        sc[0] = sn[0]; sc[1] = sn[1];
#ifdef PROBE_DFWAIT
        const unsigned long long tw0_ = __builtin_amdgcn_s_memrealtime();
#endif
        if (kt + 3 < NT) asm volatile("s_waitcnt vmcnt(4) lgkmcnt(0)" ::: "memory"); else asm volatile("s_waitcnt vmcnt(0) lgkmcnt(0)" ::: "memory");
#if defined(PROBE_DFWAIT) && PROBE_DFWAIT == 2
        const unsigned long long tw1_ = __builtin_amdgcn_s_memrealtime(); if (df_wait) *df_wait += tw1_ - tw0_;
#endif
        __builtin_amdgcn_s_barrier();
        asm volatile("" ::: "memory");
#if defined(PROBE_DFWAIT) && PROBE_DFWAIT == 1
        const unsigned long long tw1_ = __builtin_amdgcn_s_memrealtime(); if (df_wait) *df_wait += tw1_ - tw0_;
#endif
    }
#undef DF_S
#undef CVTPK
#undef DF_DMA
    LAS float* xch = (LAS float*)lds;
    { float lt = l; lt += __shfl_xor(lt, 32);
      const float sc = (mm == 1 ? lam : 1.0f) / lt;
#pragma unroll
      for (int db = 0; db < 4; ++db)
#pragma unroll
          for (int i = 0; i < 16; ++i) o[db][i] *= sc; }
    if (mm == 1) {
#pragma unroll
        for (int db = 0; db < 4; ++db)
#pragma unroll
            for (int i = 0; i < 16; ++i) xch[(qg * 64 + db * 16 + i) * 64 + lane] = o[db][i];
    }
    __syncthreads();
    if (mm == 0) {
        float ss = 0.f;
#pragma unroll
        for (int db = 0; db < 4; ++db)
#pragma unroll
            for (int i = 0; i < 16; ++i) { const float v = o[db][i] - xch[(qg * 64 + db * 16 + i) * 64 + lane]; o[db][i] = v; ss += v * v; }
        ss += __shfl_xor(ss, 32);
        const float rn = __builtin_amdgcn_rsqf(ss * (1.0f / 128.0f) + EPS) * (1.0f - LAM_INIT);
        bf16* op = DFO + ((size_t)b * SEQ + q0 + q) * 2048 + h * 128 + 4 * hi;
#pragma unroll
        for (int db = 0; db < 4; ++db)
#pragma unroll
            for (int g = 0; g < 4; ++g) { const f32x4 gs = *(const f32x4*)(g_sub + 32 * db + 8 * g + 4 * hi);
                u32x2 wv; wv.x = cvt_pk_bf16(o[db][4 * g] * rn * gs[0], o[db][4 * g + 1] * rn * gs[1]); wv.y = cvt_pk_bf16(o[db][4 * g + 2] * rn * gs[2], o[db][4 * g + 3] * rn * gs[3]);
                *(u32x2*)(op + 32 * db + 8 * g) = wv; }
    }
    __syncthreads();
}

__device__ __forceinline__ void na_unit(LAS unsigned char* lds, const bf16* QKG, const bf16* KC, const bf16* VT, const float* rpb, const float* gq, bf16* NAO, float M2, int b, int h, int r0) {
    int tid_ = threadIdx.x; asm volatile("" : "+v"(tid_));
    const int tid = tid_, lane = tid & 63, w = __builtin_amdgcn_readfirstlane(tid >> 6), q = lane & 31, hi = lane >> 5;
    const int rq = r0 + (w >> 1), half = w & 1, c = 32 * half + q;
    const size_t tokq = (size_t)b * SEQ + rq * GW + c;
    bf16x8 qf[8];
    {
      u32x4 qr[8]; float ss = 0.f;
#pragma unroll
      for (int d0 = 0; d0 < 8; ++d0) { qr[d0] = *(const u32x4*)(QKG + tokq * NQKG + QC_NAQ + h * NA_DH + 16 * d0 + 8 * hi);
          const float v[8] = {bf_lo(qr[d0].x), bf_hi(qr[d0].x), bf_lo(qr[d0].y), bf_hi(qr[d0].y), bf_lo(qr[d0].z), bf_hi(qr[d0].z), bf_lo(qr[d0].w), bf_hi(qr[d0].w)};
#pragma unroll
          for (int j = 0; j < 8; ++j) ss += v[j] * v[j]; }
      ss += __shfl_xor(ss, 32);
      const float rn = __builtin_amdgcn_rsqf(ss * (1.0f / 128.0f) + EPS) * (0.08838834764831845f * LOG2E);
#pragma unroll
      for (int d0 = 0; d0 < 8; ++d0) { const float* g1 = gq + 16 * d0 + 8 * hi;
          const float v[8] = {bf_lo(qr[d0].x), bf_hi(qr[d0].x), bf_lo(qr[d0].y), bf_hi(qr[d0].y), bf_lo(qr[d0].z), bf_hi(qr[d0].z), bf_lo(qr[d0].w), bf_hi(qr[d0].w)};
          u32x4 o; o.x = cvt_pk_bf16(v[0] * rn * g1[0], v[1] * rn * g1[1]); o.y = cvt_pk_bf16(v[2] * rn * g1[2], v[3] * rn * g1[3]);
          o.z = cvt_pk_bf16(v[4] * rn * g1[4], v[5] * rn * g1[5]); o.w = cvt_pk_bf16(v[6] * rn * g1[6], v[7] * rn * g1[7]);
          qf[d0] = __builtin_bit_cast(bf16x8, o); } }
    int rs = rq - 4; rs = rs < 0 ? 0 : (rs > GROWS - 8 ? GROWS - 8 : rs);
    int cs = c - 8; cs = cs < 0 ? 0 : (cs > GW - 16 ? GW - 16 : cs);
    int klo = r0 - 4; klo = klo < 0 ? 0 : (klo > GROWS - 8 ? GROWS - 8 : klo);
    int khi = r0 + 3 - 4; khi = (khi < 0 ? 0 : (khi > GROWS - 8 ? GROWS - 8 : khi)) + 7;
    const int nst = khi - klo + 1;
    const unsigned char* kbase = (const unsigned char*)(KC + ((size_t)(b * 8 + h) * SEQ + klo * GW) * 128);
    const unsigned char* vbase = (const unsigned char*)(VT + ((size_t)(b * 16 + h) * 64 + klo) * 128 * 64);
    unsigned koff[2], voff[2];
#pragma unroll
    for (int i = 0; i < 2; ++i) {
        const int piece = w * 2 + i;
        { const int row = piece * 4 + (lane >> 4), ph = lane & 15, ch = ph ^ (row & 15); koff[i] = (unsigned)(row * 128 + ch * 8) * 2u; }
        { const int row = piece * 8 + (lane >> 3), ph = lane & 7, ch = ph ^ ((row >> 1) & 7); voff[i] = (unsigned)(row * 64 + ch * 8) * 2u; }
    }
#define NA_DMA(t, stg) do { const unsigned char* kb_ = kbase + (size_t)(t) * 16384; const unsigned char* vb_ = vbase + (size_t)(t) * 16384; _Pragma("unroll") for (int _i = 0; _i < 2; ++_i) { \
        __builtin_amdgcn_global_load_lds((const unsigned*)(kb_ + koff[_i]), (LAS unsigned*)(lds + (stg) * 32768 + (w * 2 + _i) * 1024), 16, 0, 0); \
        __builtin_amdgcn_global_load_lds((const unsigned*)(vb_ + voff[_i]), (LAS unsigned*)(lds + (stg) * 32768 + 16384 + (w * 2 + _i) * 1024), 16, 0, 0); } } while (0)
    int kofs[8], vofs[4];
#pragma unroll
    for (int d0 = 0; d0 < 8; ++d0) kofs[d0] = q * 256 + (((2 * d0 + hi) ^ (q & 15)) * 16);
#pragma unroll
    for (int g = 0; g < 4; ++g) vofs[g] = 16384 + q * 128 + (((2 * g + hi) ^ ((q >> 1) & 7)) * 16);
    f32x16 o[4];
#pragma unroll
    for (int i = 0; i < 4; ++i) o[i] = (f32x16){};
    float l = 0.f;
    LAS float* btab = (LAS float*)(lds + 131072 + 1024);
    for (int i = tid; i < 15 * 31; i += NTHREADS) btab[i] = rpb[h * 15 * 31 + i] * LOG2E - M2;
    asm volatile("s_waitcnt vmcnt(0) lgkmcnt(0)" ::: "memory");
    __builtin_amdgcn_s_barrier();
    asm volatile("" ::: "memory");
    NA_DMA(0, 0); NA_DMA(1, 1);
    asm volatile("s_waitcnt vmcnt(4)" ::: "memory");
    __builtin_amdgcn_s_barrier();
    asm volatile("" ::: "memory");
    for (int t = 0; t < nst; ++t) {
        if (t + 2 < nst) NA_DMA(t + 2, (t + 2) & 3);
        const int krow = klo + t;
        if (krow >= rs && krow < rs + 8) {
            const LAS unsigned char* St = lds + (t & 3) * 32768;
            const LAS float* brow = btab + (krow - rq + 7) * 31;
#pragma unroll 1
            for (int kb = 0; kb < 2; ++kb) {
                f32x16 s = (f32x16){};
#pragma unroll
                for (int d0 = 0; d0 < 8; ++d0) { const bf16x8 kf = *(const LAS bf16x8*)(St + kofs[d0] + kb * 8192); s = __builtin_amdgcn_mfma_f32_32x32x16_bf16(kf, qf[d0], s, 0, 0, 0); }
                bf16x8 vf[2][4];
#pragma unroll
                for (int jj = 0; jj < 2; ++jj)
#pragma unroll
                    for (int db = 0; db < 4; ++db) vf[jj][db] = *(const LAS bf16x8*)(St + (kb ? vofs[2 + jj] : vofs[jj]) + db * 4096);
                float pv[16];
                const LAS float* bp = brow + (4 * hi - c + 15 + 32 * kb);
                const int wa = 4 * hi - cs + 32 * kb;
#pragma unroll
                for (int i = 0; i < 16; ++i) { const int e0 = (i & 3) + 8 * (i >> 2); const float bias = bp[e0]; const float e = __builtin_amdgcn_exp2f(s[i] + bias);
                    pv[i] = ((unsigned)(wa + e0) < 16u) ? e : 0.f; l += pv[i]; }
                u32x4 w0, w1;
                w0.x = cvt_pk_bf16(pv[0], pv[1]); w0.y = cvt_pk_bf16(pv[2], pv[3]); w0.z = cvt_pk_bf16(pv[4], pv[5]); w0.w = cvt_pk_bf16(pv[6], pv[7]);
                w1.x = cvt_pk_bf16(pv[8], pv[9]); w1.y = cvt_pk_bf16(pv[10], pv[11]); w1.z = cvt_pk_bf16(pv[12], pv[13]); w1.w = cvt_pk_bf16(pv[14], pv[15]);
                const bf16x8 p0 = __builtin_bit_cast(bf16x8, w0), p1 = __builtin_bit_cast(bf16x8, w1);
#pragma unroll
                for (int db = 0; db < 4; ++db) o[db] = __builtin_amdgcn_mfma_f32_32x32x16_bf16(vf[0][db], p0, o[db], 0, 0, 0);
#pragma unroll
                for (int db = 0; db < 4; ++db) o[db] = __builtin_amdgcn_mfma_f32_32x32x16_bf16(vf[1][db], p1, o[db], 0, 0, 0);
            }
        }
        if (t + 2 < nst) asm volatile("s_waitcnt vmcnt(4) lgkmcnt(0)" ::: "memory"); else asm volatile("s_waitcnt vmcnt(0) lgkmcnt(0)" ::: "memory");
        __builtin_amdgcn_s_barrier();
        asm volatile("" ::: "memory");
    }
#undef NA_DMA
    l += __shfl_xor(l, 32);
    const float rl = 1.0f / l;
    bf16* op = NAO + tokq * 2048 + h * NA_DH + 4 * hi;
#pragma unroll
    for (int db = 0; db < 4; ++db)
#pragma unroll
        for (int g = 0; g < 4; ++g) { u32x2 wv; wv.x = cvt_pk_bf16(o[db][4 * g] * rl, o[db][4 * g + 1] * rl); wv.y = cvt_pk_bf16(o[db][4 * g + 2] * rl, o[db][4 * g + 3] * rl);
            *(u32x2*)(op + 32 * db + 8 * g) = wv; }
}
template <int TB>
__device__ __forceinline__ void qknorm_batch(bf16* QKG, bf16* KCna, bf16* KCdf, int m0, int mstride, const float* gnk, const float* gdk, const f32x2* rope, int lane) {
    u32x4 na[TB][2], da[TB], db[TB];
#pragma unroll
    for (int t = 0; t < TB; ++t) { int mt = m0 + t * mstride; if (mt >= M) mt = M - 1; const bf16* row = QKG + (size_t)mt * NQKG;
#pragma unroll
        for (int j = 0; j < 2; ++j) na[t][j] = *(const u32x4*)(row + QC_NAK + 512 * j + 8 * lane);
        const bf16* p1 = row + QC_DFK + 64 * (lane >> 2) + 8 * (lane & 3); da[t] = *(const u32x4*)p1; db[t] = *(const u32x4*)(p1 + 32); }
#pragma unroll
    for (int t = 0; t < TB; ++t) { const int mt = m0 + t * mstride; if (mt >= M) break; const int pos = mt & (SEQ - 1);
#pragma unroll
        for (int j = 0; j < 2; ++j) {
            const u32x4 w = na[t][j];
            float v[8] = {bf_lo(w.x), bf_hi(w.x), bf_lo(w.y), bf_hi(w.y), bf_lo(w.z), bf_hi(w.z), bf_lo(w.w), bf_hi(w.w)};
            float ss = 0.f;
#pragma unroll
            for (int i = 0; i < 8; ++i) ss += v[i] * v[i];
            ss += __shfl_xor(ss, 1); ss += __shfl_xor(ss, 2); ss += __shfl_xor(ss, 4); ss += __shfl_xor(ss, 8);
            const float rs = __builtin_amdgcn_rsqf(ss * (1.0f / 128.0f) + EPS);
            const float* g = gnk + 8 * (lane & 15);
#pragma unroll
            for (int i = 0; i < 8; ++i) v[i] = v[i] * rs * g[i];
            u32x4 o; o.x = cvt_pk_bf16(v[0], v[1]); o.y = cvt_pk_bf16(v[2], v[3]); o.z = cvt_pk_bf16(v[4], v[5]); o.w = cvt_pk_bf16(v[6], v[7]);
            const int x = 512 * j + 8 * lane;
            *(u32x4*)(KCna + ((size_t)((mt >> 12) * 8 + (x >> 7)) * SEQ + pos) * 128 + (x & 127)) = o;
        }
        {
            const u32x4 wa = da[t], wb = db[t];
            float a[8] = {bf_lo(wa.x), bf_hi(wa.x), bf_lo(wa.y), bf_hi(wa.y), bf_lo(wa.z), bf_hi(wa.z), bf_lo(wa.w), bf_hi(wa.w)};
            float c[8] = {bf_lo(wb.x), bf_hi(wb.x), bf_lo(wb.y), bf_hi(wb.y), bf_lo(wb.z), bf_hi(wb.z), bf_lo(wb.w), bf_hi(wb.w)};
            float ss = 0.f;
#pragma unroll
            for (int i = 0; i < 8; ++i) ss += a[i] * a[i] + c[i] * c[i];
            ss += __shfl_xor(ss, 1); ss += __shfl_xor(ss, 2);
            const float rs = __builtin_amdgcn_rsqf(ss * (1.0f / 64.0f) + EPS);
            const float* g = gdk + 8 * (lane & 3);
            const f32x2* rp = rope + pos * 32 + 8 * (lane & 3);
            float o1[8], o2[8];
#pragma unroll
            for (int i = 0; i < 8; ++i) { const float x1 = a[i] * rs * g[i], x2 = c[i] * rs * g[32 + i]; const f32x2 cs = rp[i]; o1[i] = x1 * cs.x - x2 * cs.y; o2[i] = x1 * cs.y + x2 * cs.x; }
            u32x4 oa, ob; oa.x = cvt_pk_bf16(o1[0], o1[1]); oa.y = cvt_pk_bf16(o1[2], o1[3]); oa.z = cvt_pk_bf16(o1[4], o1[5]); oa.w = cvt_pk_bf16(o1[6], o1[7]);
            ob.x = cvt_pk_bf16(o2[0], o2[1]); ob.y = cvt_pk_bf16(o2[2], o2[3]); ob.z = cvt_pk_bf16(o2[4], o2[5]); ob.w = cvt_pk_bf16(o2[6], o2[7]);
            const int x = 64 * (lane >> 2) + 8 * (lane & 3); bf16* kp = KCdf + ((size_t)((mt >> 12) * 8 + (x >> 7)) * SEQ + pos) * 128 + (x & 127);
            *(u32x4*)kp = oa; *(u32x4*)(kp + 32) = ob;
        }
    }
}

__device__ __forceinline__ void grid_barrier(unsigned* cnt, unsigned target) {
    asm volatile("s_waitcnt vmcnt(0) lgkmcnt(0)" ::: "memory");
    __syncthreads();
    if (threadIdx.x == 0) {
        __builtin_amdgcn_fence(__ATOMIC_RELEASE, "agent");
        asm volatile("s_waitcnt vmcnt(0)" ::: "memory");
        __hip_atomic_fetch_add(cnt, 1u, __ATOMIC_RELAXED, __HIP_MEMORY_SCOPE_AGENT);
        while (__hip_atomic_load(cnt, __ATOMIC_RELAXED, __HIP_MEMORY_SCOPE_AGENT) < target) __builtin_amdgcn_s_sleep(2);
        __builtin_amdgcn_fence(__ATOMIC_ACQUIRE, "agent");
        asm volatile("s_waitcnt vmcnt(0)" ::: "memory");
    }
    __syncthreads();
}
constexpr int I_IN = 32 * 320, I_NA = 16 * 64, I_O = 32 * 64, I_G = 32 * 176, I_DN = 88 * 64, I_PP = 4 * 64;
constexpr int N_EARLY = I_IN + 2 * I_NA + I_O + 2 * I_G + I_PP, NITEMS = N_EARLY + I_DN + I_O;
#define P0_DECODE(it_, d_) do { int r = (it_); \
            if (r < I_IN) { d_ = P0Item{ap->w_in, W1t, nullptr, D, 10240, 1, r, D, 0}; break; } r -= I_IN; \
            if (r < I_NA) { d_ = P0Item{ap->w_na_out, Wna, nullptr, 1024, D, 0, r, 2048, 0}; break; } r -= I_NA; \
            if (r < I_NA) { d_ = P0Item{ap->w_df_out, Wna, nullptr, 1024, D, 0, r, 2048, 1024}; break; } r -= I_NA; \
            if (r < I_O) { d_ = P0Item{ap->w_o, Wo, nullptr, D, D, 0, r, D, 0}; break; } r -= I_O; \
            if (r < I_G) { d_ = P0Item{ap->w_gate, Wgu, ap->g_ffn, D, FF, 2, r, D, 0}; break; } r -= I_G; \
            if (r < I_G) { d_ = P0Item{ap->w_up, Wgu, ap->g_ffn, D, FF, 3, r, D, 0}; break; } r -= I_G; \
            if (r < I_PP) { d_ = P0Item{ap->w_ple_proj, Wpp, nullptr, PLE, D, 0, r, PLE, 0}; break; } r -= I_PP; \
            if (r < I_DN) { d_ = P0Item{ap->w_down, Wdn, nullptr, FF, D, 0, r, FF, 0}; break; } r -= I_DN; \
            d_ = P0Item{ap->w_ple_gate, Wpg, ap->g_ple, D, D, 0, r, D, 0}; } while (0)
constexpr int NPHASE = 9;
__global__ void __launch_bounds__(NTHREADS, 2) fwd_megakernel(Args a) {
    extern __shared__ __attribute__((aligned(16))) unsigned char lds_raw[];
    LAS unsigned char* lds = (LAS unsigned char*)lds_raw;
    cg::grid_group grid = cg::this_grid();
    const int G = gridDim.x, bx = blockIdx.x;
    const int vcu = (G % 8 == 0) ? (bx % 8) * (G / 8) + bx / 8 : bx;
    const int NGW = G * NWAVES;
typedef __attribute__((opencl_constant)) const Args* CArgsP;
#define FRESH_ARGS() auto kp_ = __builtin_amdgcn_kernarg_segment_ptr(); asm volatile("" : "+s"(kp_)); const CArgsP ap = (CArgsP)kp_
#define FRESH_TID() int tid_ = threadIdx.x; asm volatile("" : "+v"(tid_)); const int tid = tid_, lane = tid & 63, wave = __builtin_amdgcn_readfirstlane(tid >> 6), gw = vcu * NWAVES + wave; (void)lane; (void)gw
    unsigned char* ws = a.ws;
    float* RS1 = (float*)(ws + WS_RS1); float* RS2 = (float*)(ws + WS_RS2); f32x2* ROPE = (f32x2*)(ws + WS_ROPE);
    bf16 *W1t = (bf16*)(ws + WS_W1), *Wna = (bf16*)(ws + WS_WNA), *Wdf = (bf16*)(ws + WS_WDF), *Wo = (bf16*)(ws + WS_WO), *Wgu = (bf16*)(ws + WS_WGU), *Wdn = (bf16*)(ws + WS_WDN), *Wpg = (bf16*)(ws + WS_WPG), *Wpp = (bf16*)(ws + WS_WPP);
    bf16 *QKG = (bf16*)(ws + WS_A), *HB = (bf16*)(ws + WS_A);
    bf16 *XN = (bf16*)(ws + WS_B), *AO = (bf16*)(ws + WS_B), *X1B = (bf16*)(ws + WS_B), *X2B = (bf16*)(ws + WS_B);
    bf16 *VT = (bf16*)(ws + WS_C), *MRG = (bf16*)(ws + WS_C), *T2B = (bf16*)(ws + WS_C), *PB = (bf16*)(ws + WS_PB);
    bf16* KCna = (bf16*)a.out; bf16* KCdf = KCna + (size_t)M * 1024;
    const int lo = a.ph_lo, hi_ph = a.ph_hi;
    if (lo < 0) grid.sync();
    { volatile LAS unsigned* st0 = (volatile LAS unsigned*)(lds + 131072 + 768); if (threadIdx.x < 2) st0[threadIdx.x] = 0u; __syncthreads(); }
    XcdBarrier xbar = xcd_barrier_post((unsigned*)(ws + 8192), (volatile LAS unsigned*)(lds + 131072 + 768));
#ifndef PHASE_MASK
#define PHASE_MASK 0x1ff
#endif
#define IN(k) (((PHASE_MASK >> (k)) & 1) && lo <= (k) && (k) < hi_ph)
#ifdef PROBE_TS
#define STAMP(k) do { if (bx == 0 && threadIdx.x == 0) ((volatile unsigned long long*)(ws + 2048))[k] = __builtin_amdgcn_s_memrealtime(); } while (0)
#else
#define STAMP(k) do {} while (0)
#endif
#define GBAR(idx) xcd_barrier(xbar)
#define SEAM(k) do { if (IN(k) && IN((k) + 1)) GBAR(k); STAMP((k) + 1); } while (0)
#ifndef PROBE_DUP
#define PROBE_DUP 0
#endif
#define NREP(k) (((PROBE_DUP >> (k)) & 1) ? 2 : 1)

    STAMP(0);
    for (int rep_ = 0; rep_ < NREP(0); ++rep_) {
    if (IN(0)) {
        FRESH_ARGS();
        FRESH_TID();
        if (bx == 0) {
        LAS float* red = (LAS float*)(lds + 131072);
        float mq = 0.f, mk = 0.f, mdq = 0.f, mdk = 0.f, mb = 0.f;
        if (tid < 128) { mq = fabsf(ap->g_na_q[tid]); mk = fabsf(ap->g_na_k[tid]); }
        if (tid < 64) { mdq = fabsf(ap->g_df_q[tid]); mdk = fabsf(ap->g_df_k[tid]); }
        for (int i = tid; i < NA_H * 15 * 31; i += NTHREADS) mb = fmaxf(mb, ap->na_rpb[i]);
        mq = wave_max(mq); mk = wave_max(mk); mdq = wave_max(mdq); mdk = wave_max(mdk); mb = wave_max(mb);
        float d1 = 0.f, d2 = 0.f;
        if (wave == 0) { d1 = wave_sum(ap->lam_q1[lane] * ap->lam_k1[lane]); d2 = wave_sum(ap->lam_q2[lane] * ap->lam_k2[lane]); }
        if (lane == 0) { red[wave * 8 + 0] = mq; red[wave * 8 + 1] = mk; red[wave * 8 + 2] = mdq; red[wave * 8 + 3] = mdk; red[wave * 8 + 4] = mb; red[wave * 8 + 5] = d1; red[wave * 8 + 6] = d2; }
        __syncthreads();
        mq = 0.f; mk = 0.f; mdq = 0.f; mdk = 0.f; mb = 0.f;
#pragma unroll
        for (int w = 0; w < 8; ++w) { mq = fmaxf(mq, red[w * 8]); mk = fmaxf(mk, red[w * 8 + 1]); mdq = fmaxf(mdq, red[w * 8 + 2]); mdk = fmaxf(mdk, red[w * 8 + 3]); mb = fmaxf(mb, red[w * 8 + 4]); }
        if (tid == 0) { float* PARw = (float*)(ws + 3072); PARw[0] = expf(red[5]) - expf(red[6]) + LAM_INIT; PARw[1] = (11.313708498984761f * mq * mk + mb) * LOG2E + 0.125f; PARw[2] = (8.0f * mdq * mdk) * LOG2E + 0.125f; }
        __syncthreads();
        }
        LAS float* scr = (LAS float*)(lds + wave * 16384);
        {
            float cur[32], nxt[32]; P0Item dc, dn;
            int it = gw;
            if (it < N_EARLY) { P0_DECODE(it, dc); p0_item_load(dc, cur, lane); }
            for (; it < N_EARLY; it += NGW) {
                const int nit = it + NGW; const bool more = nit < N_EARLY;
                if (more) { P0_DECODE(nit, dn); p0_item_load(dn, nxt, lane); }
                p0_item_store(dc, cur, scr, lane);
                if (more) { dc = dn;
#pragma unroll
                    for (int i = 0; i < 32; ++i) cur[i] = nxt[i]; }
            }
        }
        for (int m = gw; m < M; m += NGW) {
            const f32x4* xr = (const f32x4*)(ap->x + (size_t)m * D) + lane; const f32x4* gr = (const f32x4*)ap->g_mix + lane;
            f32x4 v[8]; float s = 0.f;
#pragma unroll
            for (int j = 0; j < 8; ++j) { v[j] = __builtin_nontemporal_load(xr + 64 * j); s += (v[j].x * v[j].x + v[j].y * v[j].y) + (v[j].z * v[j].z + v[j].w * v[j].w); }
            const float rs = __builtin_amdgcn_rsqf(wave_sum(s) * (1.0f / D) + EPS);
            u32x2* o8 = (u32x2*)(XN + (size_t)m * D) + lane;
#pragma unroll
            for (int j = 0; j < 8; ++j) { const f32x4 g = gr[64 * j]; u32x2 w; w.x = cvt_pk_bf16(v[j].x * rs * g.x, v[j].y * rs * g.y); w.y = cvt_pk_bf16(v[j].z * rs * g.z, v[j].w * rs * g.w); o8[64 * j] = w; }
        }
        const int gt = vcu * NTHREADS + tid, NGT = G * NTHREADS;
        for (int i = gt; i < M * PLE / 8; i += NGT) { const f32x4 p0 = __builtin_nontemporal_load((const f32x4*)ap->p + 2 * i), p1 = __builtin_nontemporal_load((const f32x4*)ap->p + 2 * i + 1);
            u32x4 w; w.x = cvt_pk_bf16(p0.x, p0.y); w.y = cvt_pk_bf16(p0.z, p0.w); w.z = cvt_pk_bf16(p1.x, p1.y); w.w = cvt_pk_bf16(p1.z, p1.w); ((u32x4*)PB)[i] = w; }
        for (int i = gt; i < SEQ * 32; i += NGT) { const int pos = i >> 5, k = i & 31;
            const float inv = (float)(1.0 / pow(10000.0, (double)k / 32.0)); const float ang = (float)pos * inv;
            f32x2 cs; cs.x = (float)cos((double)ang); cs.y = (float)sin((double)ang); ROPE[i] = cs; }
        for (int i = gt; i < M; i += NGT) { RS1[i] = 0.f; RS2[i] = 0.f; }
    }
    }
    SEAM(0);
    for (int rep_ = 0; rep_ < NREP(1); ++rep_) {
    if (IN(1)) {
        FRESH_ARGS();
        { pg8::Gemm g{XN, W1t, M, NQKG, D}; pg8::StaticOrder S; S.init(M, NQKG, G, bx); pg8::EpiQKG E{QKG, NQKG};
          pg8::gemm_phase<pg8::EpiQKG, pg8::StaticOrder, true, true>(lds, g, S, E); }
        { pg8::Gemm g{W1t + (size_t)NQKG * D, XN, 2048, M, D}; pg8::StaticOrder S; S.init(2048, M, G, bx); pg8::EpiVT E{VT, M};
          pg8::gemm_phase<pg8::EpiVT, pg8::StaticOrder, true, true>(lds, g, S, E); }
    }
    }
    SEAM(1);
    if (IN(2)) {
        FRESH_ARGS();
        FRESH_TID();
        for (int m0 = gw; m0 < M; m0 += 4 * NGW) qknorm_batch<4>(QKG, KCna, KCdf, m0, NGW, ap->g_na_k, ap->g_df_k, ROPE, lane);
    }
    SEAM(2);
    for (int rep_ = 0; rep_ < NREP(3); ++rep_) {
    if (IN(3)) {
        FRESH_ARGS();
        FRESH_TID();
        const float* PAR = (const float*)(ws + 3072);
        const float lam = PAR[0], M2na = PAR[1], M2df = PAR[2];
#ifndef NO_DF
        for (int uu = 2 * vcu; uu < BATCH * DF_H * (SEQ / 128); uu += 2 * G)
            for (int i2 = 0; i2 < 2; ++i2) { const int uidx = uu + i2, bh = uidx >> 5, qb = uidx & 31;
#ifdef PROBE_DFWAIT
                unsigned long long dfw_ = 0;
                df_unit(lds, QKG, KCdf, VT, AO + 1024, ap->g_df_sub, ap->g_df_q, ROPE, lam, M2df, bh >> 3, bh & 7, qb, &dfw_);
                if (bx == 0 && threadIdx.x == 0) { volatile unsigned long long* TS = (volatile unsigned long long*)(ws + 2048); TS[11] = (i2 ? TS[11] : 0ull) + dfw_; TS[12] = 0ull; }
#else
                df_unit(lds, QKG, KCdf, VT, AO + 1024, ap->g_df_sub, ap->g_df_q, ROPE, lam, M2df, bh >> 3, bh & 7, qb);
#endif
            }
#endif
        STAMP(10);
#ifdef PROBE_TS
        if (threadIdx.x == 0) { atomicMax((unsigned long long*)(ws + 2048) + 14, (unsigned long long)__builtin_amdgcn_s_memrealtime()); atomicMin((unsigned long long*)(ws + 2048) + 16, (unsigned long long)__builtin_amdgcn_s_memrealtime()); }
#endif
#ifndef NO_NA
        for (int uidx = vcu; uidx < BATCH * NA_H * (GROWS / 4); uidx += G) {
            const int bh = uidx >> 4, rg = uidx & 15;
            na_unit(lds, QKG, KCna, VT, ap->na_rpb, ap->g_na_q, AO, M2na, bh >> 3, bh & 7, rg * 4);
        }
        STAMP(13);
#ifdef PROBE_TS
        if (threadIdx.x == 0) atomicMax((unsigned long long*)(ws + 2048) + 15, (unsigned long long)__builtin_amdgcn_s_memrealtime());
#endif
#endif
    }
    }
    SEAM(3);
    for (int rep_ = 0; rep_ < NREP(4); ++rep_) {
    if (IN(4)) {
        FRESH_ARGS();
        { pg8::Gemm g{AO, Wna, M, D, 2048, 16}; pg8::PairOrder S; S.S.init(M, D, G, bx); S.kob = 1024 * 2; pg8::EpiMerge E{QKG + QC_GA, QKG + QC_GB, NQKG, MRG, D, 16};
          pg8::gemm_phase<pg8::EpiMerge, pg8::PairOrder, true, true>(lds, g, S, E); }
    }
    }
    SEAM(4);
    if (IN(5)) {
        FRESH_ARGS();
        pg8::Gemm g{MRG, Wo, M, D, D}; pg8::StaticOrder S; S.init(M, D, G, bx); pg8::EpiResid<false> E{ap->x, X1B, RS1, D};
        pg8::gemm_phase<pg8::EpiResid<false>, pg8::StaticOrder, true, true>(lds, g, S, E);
    }
    SEAM(5);
    for (int rep_ = 0; rep_ < NREP(6); ++rep_) {
    if (IN(6)) {
        FRESH_ARGS();
        pg8::Gemm g{X1B, Wgu, M, 2 * FF, D}; pg8::StaticOrder S; S.init(M, 2 * FF, G, bx); pg8::EpiSwiGLU E{RS1, HB, FF, 1.0f / D, EPS};
        pg8::gemm_phase<pg8::EpiSwiGLU, pg8::StaticOrder, true, true>(lds, g, S, E);
        { constexpr int NU6 = (M / 256) * (2 * FF / 256), NU8 = (M / 256) * (D / 256);
          const int rem = NU6 % G, nshort = rem ? G - rem : G;
          pg8::TailOrder T; T.first = (rem == 0) ? bx : (bx >= rem ? bx - rem : -1); T.stride = nshort; T.total = NU8;
          int kple = PLE; asm volatile("" : "+s"(kple));
          pg8::Gemm g2{PB, Wpp, M, D, kple}; pg8::EpiStoreBf16 E2{T2B, D};
          pg8::gemm_phase<pg8::EpiStoreBf16, pg8::TailOrder, true, true>(lds, g2, T, E2);
          if (T.first >= 0) { FRESH_TID();
              LAS float* scr = (LAS float*)(lds + wave * 16384);
              const int sw = ((rem == 0) ? bx : bx - rem) * NWAVES + wave, nsw = nshort * NWAVES;
              float cur[32], nxt[32]; P0Item dc, dn;
              int it = N_EARLY + sw;
              if (it < NITEMS) { P0_DECODE(it, dc); p0_item_load(dc, cur, lane); }
              for (; it < NITEMS; it += nsw) {
                  const int nit = it + nsw; const bool more = nit < NITEMS;
                  if (more) { P0_DECODE(nit, dn); p0_item_load(dn, nxt, lane); }
                  p0_item_store(dc, cur, scr, lane);
                  if (more) { dc = dn;
#pragma unroll
                      for (int i = 0; i < 32; ++i) cur[i] = nxt[i]; }
              } } }
    }
    }
    SEAM(6);
    if (IN(7)) {
        FRESH_ARGS();
        pg8::Gemm g{HB, Wdn, M, D, FF}; pg8::StaticOrder S; S.init(M, D, G, bx); pg8::EpiResid<true> E{X1B, X2B, RS2, D};
        pg8::gemm_phase<pg8::EpiResid<true>, pg8::StaticOrder, true, true>(lds, g, S, E);
    }
    SEAM(7);
    if (IN(8)) {
        FRESH_ARGS();
#ifndef NO_P8B
        { pg8::Gemm g{X2B, Wpg, M, D, D}; pg8::StaticOrder S; S.init(M, D, G, bx); pg8::EpiPle E{RS2, T2B, X2B, ap->out, D, 1.0f / D, EPS};
          pg8::gemm_phase<pg8::EpiPle, pg8::StaticOrder, true, true>(lds, g, S, E); }
#endif
    }
#ifdef PROBE_TS
    STAMP(9);
    GBAR(8);
    { const unsigned long long* TS = (const unsigned long long*)(ws + 2048);
      const unsigned long long ta = __hip_atomic_load(TS + PROBE_A, __ATOMIC_RELAXED, __HIP_MEMORY_SCOPE_AGENT), tb = __hip_atomic_load(TS + PROBE_B, __ATOMIC_RELAXED, __HIP_MEMORY_SCOPE_AGENT);
      const int K = PROBE_CONST ? PROBE_CONST : (int)((tb - ta) / 8);
      FRESH_ARGS();
      for (int i = vcu * NTHREADS + (int)threadIdx.x; i < K && i < 42000; i += G * NTHREADS) ap->out[(size_t)i * 397] += 0.125f; }
#endif
#undef IN
#undef SEAM
}

#ifndef MK_SPLIT
#define MK_SPLIT 0
#endif
extern "C" void kernel_launch(void* const* d_in, const int* in_sizes, int n_in, void* d_out, int out_size, void* d_ws, size_t ws_size, hipStream_t stream) {
    static int grid = 0;
    if (grid == 0) {
        if (n_in != 24 || in_sizes[0] != M * D || out_size != M * D || ws_size < WS_END) { fprintf(stderr, "kernel_launch: unexpected shapes (n_in %d, in0 %d, out %d, ws %zu); nothing launched\n", n_in, n_in > 0 ? in_sizes[0] : -1, out_size, ws_size); grid = -1; return; }
        int dev = 0, cus = 0, per_cu = 0;
        hipGetDevice(&dev); hipDeviceGetAttribute(&cus, hipDeviceAttributeMultiprocessorCount, dev);
        hipFuncSetAttribute((const void*)fwd_megakernel, hipFuncAttributeMaxDynamicSharedMemorySize, LDS_BYTES);
        hipOccupancyMaxActiveBlocksPerMultiprocessor(&per_cu, (const void*)fwd_megakernel, NTHREADS, LDS_BYTES);
        if (per_cu < 1) per_cu = 1;
        grid = cus * per_cu;
        (void)hipGetLastError();
    }
    if (grid < 0) return;
    Args a{};
    const float** ap = (const float**)&a;
    for (int i = 0; i < 24; ++i) ap[i] = (const float*)d_in[i];
    a.out = (float*)d_out; a.ws = (unsigned char*)d_ws; a.rep3 = NREP(3); a.pad = 0;
#if MK_SPLIT
    for (int ph = 0; ph < NPHASE; ++ph) { a.ph_lo = ph; a.ph_hi = ph + 1; hipLaunchKernelGGL(fwd_megakernel, dim3(grid), dim3(NTHREADS), LDS_BYTES, stream, a); }
#else
    a.ph_lo = 0; a.ph_hi = NPHASE;
    (void)hipMemsetAsync((unsigned char*)d_ws + 4096, 0, 20480, stream);
#ifdef PROBE_TS
    (void)hipMemsetAsync((unsigned char*)d_ws + 2048 + 14 * 8, 0, 16, stream); (void)hipMemsetAsync((unsigned char*)d_ws + 2048 + 16 * 8, 0x7f, 8, stream);
#endif
    void* args[] = {&a};
    hipError_t e = hipLaunchCooperativeKernel((const void*)fwd_megakernel, dim3(grid), dim3(NTHREADS), args, LDS_BYTES, stream);
    if (e != hipSuccess) fprintf(stderr, "cooperative launch failed: %s (grid %d)\n", hipGetErrorString(e), grid);
#endif
}
```

```cpp
#include <hip/hip_runtime.h>
#include <hip/hip_cooperative_groups.h>
#include <cstdio>
#include <cstdint>
namespace cg = cooperative_groups;
namespace pg8 {
#define PG8_LAS __attribute__((address_space(3)))
typedef unsigned short bf16_t;
typedef short bf16x8 __attribute__((ext_vector_type(8)));
typedef float f32x4 __attribute__((ext_vector_type(4)));
typedef unsigned u32x4 __attribute__((ext_vector_type(4)));
constexpr int BM = 256, BK = 64, HALF = 128, HTB = HALF * BK * 2  , STAGE_BYTES = 8 * HTB, NXCD = 8, WGM = 8;

__host__ __device__ __forceinline__ int lds_byte(int r, int c) { const int st = (r >> 4) * 2 + (c >> 5), rr = r & 15, cc = c & 31, ob = rr * 64 + cc * 2; return st * 1024 + (ob ^ (((ob >> 9) & 1) << 5)); }
__host__ __device__ __forceinline__ void stage_rc(int b, int& R, int& C) { const int st = b / 1024, sb = b % 1024, swz = sb ^ (((sb >> 9) & 1) << 5); R = (st >> 1) * 16 + swz / 64; C = (st & 1) * 32 + (swz % 64) / 2; }
__host__ __device__ __forceinline__ int perm32(int rho) { const int n = rho >> 4, i = rho & 15; return 8 * (i >> 2) + 4 * n + (i & 3); }

struct Unit { int pm, pn; int ko = 0; };
struct Gemm { const bf16_t* A; const bf16_t* Bt; int M, N, K; int nt = 0; };

struct StaticOrder {
    int nM, nN, nwg, G, c;
    __host__ __device__ void init(int M, int N, int G_, int c_) { nM = M / BM; nN = N / BM; nwg = nM * nN; G = G_; c = c_; }
    __host__ __device__ bool next(int i, Unit& u) const {
        const long L = (long)i * G + c; if (L >= nwg) return false;
        int wgid = (int)L; { const int q = nwg / NXCD, r = nwg % NXCD, xcd = wgid % NXCD, off = wgid / NXCD; wgid = (xcd < r ? xcd * (q + 1) : r * (q + 1) + (xcd - r) * q) + off; }
        const int nig = WGM * nN, gid = wgid / nig, fm = gid * WGM, gsz = (nM - fm) < WGM ? (nM - fm) : WGM;
        u.pm = fm + ((wgid % nig) % gsz); u.pn = (wgid % nig) / gsz; return true;
    }
    __device__ __forceinline__ void a_ready(const Unit&) const {}
    __device__ __forceinline__ void done(const Unit&) const {}
};


struct TailOrder {
    int first, stride, total;
    __host__ __device__ bool next(int i, Unit& u) const { if (first < 0) return false; const int j = first + i * stride; if (j >= total) return false; u.pm = j >> 3; u.pn = j & 7; return true; }
    __device__ __forceinline__ void a_ready(const Unit&) const {}
    __device__ __forceinline__ void done(const Unit&) const {}
};

struct PairOrder {
    StaticOrder S; int kob;
    __host__ __device__ bool next(int i, Unit& u) const { if (!S.next(i >> 1, u)) return false; u.ko = (i & 1) * kob; return true; }
    __device__ __forceinline__ void a_ready(const Unit&) const {}
    __device__ __forceinline__ void done(const Unit&) const {}
};
__device__ __forceinline__ unsigned cvt_pk_bf16(float lo, float hi) { unsigned r; asm volatile("v_cvt_pk_bf16_f32 %0, %1, %2" : "=v"(r) : "v"(lo), "v"(hi)); return r; }
__device__ __forceinline__ float bf_lo(unsigned w) { return __uint_as_float(w << 16); }
__device__ __forceinline__ float bf_hi(unsigned w) { return __uint_as_float(w & 0xffff0000u); }
__device__ __forceinline__ float sigmoidf_(float x) { return __builtin_amdgcn_rcpf(1.0f + __expf(-x)); }
typedef unsigned u32x2 __attribute__((ext_vector_type(2)));
#define EPI_FENCE() asm volatile("" ::: "memory")
#define EPI_ROWS(...) _Pragma("unroll") for (int ai = 0; ai < 2; ++ai) _Pragma("unroll") for (int m = 0; m < 4; ++m) { const int row = u.pm * BM + ai * HALF + wr * 64 + m * 16 + fr; __VA_ARGS__ }

struct EpiQKG {
    static constexpr bool PERM = true, AFTER_DRAIN = false, MIDK = false;
    bf16_t* O; int ldc;
    __device__ __forceinline__ void operator()(const f32x4 (&acc)[2][2][4][2], const Unit& u, int wr, int wc, int fr, int fq) const {
        const bool gate = u.pn >= 16; const int col0 = u.pn * BM + wc * 32 + 8 * fq;
        EPI_ROWS(
            bf16_t* rowp = O + (size_t)row * ldc + col0;
            _Pragma("unroll") for (int bj = 0; bj < 2; ++bj) { f32x4 v0 = acc[ai][bj][m][0], v1 = acc[ai][bj][m][1];
                if (gate) { _Pragma("unroll") for (int j = 0; j < 4; ++j) { v0[j] = sigmoidf_(v0[j]); v1[j] = sigmoidf_(v1[j]); } }
                u32x4 w; w.x = cvt_pk_bf16(v0[0], v0[1]); w.y = cvt_pk_bf16(v0[2], v0[3]); w.z = cvt_pk_bf16(v1[0], v1[1]); w.w = cvt_pk_bf16(v1[2], v1[3]);
                *(u32x4*)(rowp + bj * HALF) = w; }
            EPI_FENCE();
        )
    }
};
struct EpiVT {
    static constexpr bool PERM = true, AFTER_DRAIN = false, MIDK = false;
    bf16_t* O; int ldc;
    __device__ __forceinline__ void operator()(const f32x4 (&acc)[2][2][4][2], const Unit& u, int wr, int wc, int fr, int fq) const {
        const int cbase = u.pn * BM + wc * 32 + 16 * (fq >> 1) + 4 * (fq & 1);
        EPI_ROWS(
            const int hv = row >> 7, dd = row & 127;
            _Pragma("unroll") for (int bj = 0; bj < 2; ++bj) _Pragma("unroll") for (int n = 0; n < 2; ++n) { const f32x4 v = acc[ai][bj][m][n];
                const int col = cbase + bj * HALF + 8 * n, bb = col >> 12, kt = (col >> 6) & 63, pos = col & 63;
                u32x2 w; w.x = cvt_pk_bf16(v[0], v[1]); w.y = cvt_pk_bf16(v[2], v[3]);
                *(u32x2*)(O + ((((size_t)(bb * 16 + hv)) * 64 + kt) * 128 + dd) * 64 + pos) = w; }
            EPI_FENCE();
        )
    }
};
struct EpiMerge {
    static constexpr bool PERM = true, AFTER_DRAIN = false, MIDK = true;
    const bf16_t* GA; const bf16_t* GB; int ldg; bf16_t* O; int ldc; int midk;
    __device__ __forceinline__ void mid(f32x4 (&acc)[2][2][4][2], const Unit& u, int wr, int wc, int fr, int fq) const {
        const int col0 = u.pn * BM + wc * 32 + 8 * fq;
        EPI_ROWS(
            _Pragma("unroll") for (int bj = 0; bj < 2; ++bj) { const size_t off = (size_t)row * ldg + col0 + bj * HALF;
                const u32x4 a = *(const u32x4*)(GA + off), b = *(const u32x4*)(GB + off);
                float r[8];
                r[0] = bf_lo(a.x) * __builtin_amdgcn_rcpf(fmaxf(bf_lo(b.x), 1e-30f)); r[1] = bf_hi(a.x) * __builtin_amdgcn_rcpf(fmaxf(bf_hi(b.x), 1e-30f));
                r[2] = bf_lo(a.y) * __builtin_amdgcn_rcpf(fmaxf(bf_lo(b.y), 1e-30f)); r[3] = bf_hi(a.y) * __builtin_amdgcn_rcpf(fmaxf(bf_hi(b.y), 1e-30f));
                r[4] = bf_lo(a.z) * __builtin_amdgcn_rcpf(fmaxf(bf_lo(b.z), 1e-30f)); r[5] = bf_hi(a.z) * __builtin_amdgcn_rcpf(fmaxf(bf_hi(b.z), 1e-30f));
                r[6] = bf_lo(a.w) * __builtin_amdgcn_rcpf(fmaxf(bf_lo(b.w), 1e-30f)); r[7] = bf_hi(a.w) * __builtin_amdgcn_rcpf(fmaxf(bf_hi(b.w), 1e-30f));
                _Pragma("unroll") for (int j = 0; j < 4; ++j) { acc[ai][bj][m][0][j] *= r[j]; acc[ai][bj][m][1][j] *= r[4 + j]; } }
            EPI_FENCE();
        )
    }
    __device__ __forceinline__ void operator()(const f32x4 (&acc)[2][2][4][2], const Unit& u, int wr, int wc, int fr, int fq) const {
        const int col0 = u.pn * BM + wc * 32 + 8 * fq;
        EPI_ROWS(
            _Pragma("unroll") for (int bj = 0; bj < 2; ++bj) { const u32x4 b = *(const u32x4*)(GB + (size_t)row * ldg + col0 + bj * HALF);
                f32x4 v0 = acc[ai][bj][m][0], v1 = acc[ai][bj][m][1];
                v0[0] *= fmaxf(bf_lo(b.x), 1e-30f); v0[1] *= fmaxf(bf_hi(b.x), 1e-30f); v0[2] *= fmaxf(bf_lo(b.y), 1e-30f); v0[3] *= fmaxf(bf_hi(b.y), 1e-30f);
                v1[0] *= fmaxf(bf_lo(b.z), 1e-30f); v1[1] *= fmaxf(bf_hi(b.z), 1e-30f); v1[2] *= fmaxf(bf_lo(b.w), 1e-30f); v1[3] *= fmaxf(bf_hi(b.w), 1e-30f);
                u32x4 w; w.x = cvt_pk_bf16(v0[0], v0[1]); w.y = cvt_pk_bf16(v0[2], v0[3]); w.z = cvt_pk_bf16(v1[0], v1[1]); w.w = cvt_pk_bf16(v1[2], v1[3]);
                *(u32x4*)(O + (size_t)row * ldc + col0 + bj * HALF) = w; }
            EPI_FENCE();
        )
    }
};
template <bool BASE_BF16> struct EpiResid {
    static constexpr bool PERM = true, AFTER_DRAIN = false, MIDK = false;
    const void* base; bf16_t* ob; float* rowss; int ldc;
    __device__ __forceinline__ void operator()(const f32x4 (&acc)[2][2][4][2], const Unit& u, int wr, int wc, int fr, int fq) const {
        const int col0 = u.pn * BM + wc * 32 + 8 * fq;
        EPI_ROWS(
            float ss = 0.f;
            _Pragma("unroll") for (int bj = 0; bj < 2; ++bj) { const size_t off = (size_t)row * ldc + col0 + bj * HALF;
                f32x4 b0, b1;
                if (BASE_BF16) { const u32x4 bw = *(const u32x4*)((const bf16_t*)base + off); b0 = (f32x4){bf_lo(bw.x), bf_hi(bw.x), bf_lo(bw.y), bf_hi(bw.y)}; b1 = (f32x4){bf_lo(bw.z), bf_hi(bw.z), bf_lo(bw.w), bf_hi(bw.w)}; }
                else { b0 = __builtin_nontemporal_load((const f32x4*)((const float*)base + off)); b1 = __builtin_nontemporal_load((const f32x4*)((const float*)base + off + 4)); }
                const f32x4 v0 = acc[ai][bj][m][0] + b0, v1 = acc[ai][bj][m][1] + b1;
                ss += (v0[0] * v0[0] + v0[1] * v0[1]) + (v0[2] * v0[2] + v0[3] * v0[3]) + (v1[0] * v1[0] + v1[1] * v1[1]) + (v1[2] * v1[2] + v1[3] * v1[3]);
                u32x4 w; w.x = cvt_pk_bf16(v0[0], v0[1]); w.y = cvt_pk_bf16(v0[2], v0[3]); w.z = cvt_pk_bf16(v1[0], v1[1]); w.w = cvt_pk_bf16(v1[2], v1[3]);
                *(u32x4*)(ob + off) = w; }
            ss += __shfl_xor(ss, 16); ss += __shfl_xor(ss, 32);
            if (fq == 0) atomicAdd(rowss + row, ss);
            EPI_FENCE();
        )
    }
};
struct EpiSwiGLU {
    static constexpr bool PERM = true, AFTER_DRAIN = false, MIDK = false;
    const float* rowss; bf16_t* H; int ldh; float inv_d, eps;
    __device__ __forceinline__ void operator()(const f32x4 (&acc)[2][2][4][2], const Unit& u, int wr, int wc, int fr, int fq) const {
        const int col0 = u.pn * HALF + wc * 32 + 8 * fq;
        EPI_ROWS(
            const float rs = __builtin_amdgcn_rsqf(rowss[row] * inv_d + eps);
            float hv[8];
            _Pragma("unroll") for (int n = 0; n < 2; ++n) _Pragma("unroll") for (int j = 0; j < 4; ++j) { const float g = acc[ai][0][m][n][j] * rs, up = acc[ai][1][m][n][j] * rs; hv[n * 4 + j] = g * sigmoidf_(g) * up; }
            u32x4 w; w.x = cvt_pk_bf16(hv[0], hv[1]); w.y = cvt_pk_bf16(hv[2], hv[3]); w.z = cvt_pk_bf16(hv[4], hv[5]); w.w = cvt_pk_bf16(hv[6], hv[7]);
            *(u32x4*)(H + (size_t)row * ldh + col0) = w;
            EPI_FENCE();
        )
    }
};
struct EpiStoreBf16 {
    static constexpr bool PERM = true, AFTER_DRAIN = false, MIDK = false;
    bf16_t* T; int ldc;
    __device__ __forceinline__ void operator()(const f32x4 (&acc)[2][2][4][2], const Unit& u, int wr, int wc, int fr, int fq) const {
        const int col0 = u.pn * BM + wc * 32 + 8 * fq;
        EPI_ROWS(
            _Pragma("unroll") for (int bj = 0; bj < 2; ++bj) { const f32x4 v0 = acc[ai][bj][m][0], v1 = acc[ai][bj][m][1];
                u32x4 w; w.x = cvt_pk_bf16(v0[0], v0[1]); w.y = cvt_pk_bf16(v0[2], v0[3]); w.z = cvt_pk_bf16(v1[0], v1[1]); w.w = cvt_pk_bf16(v1[2], v1[3]);
                *(u32x4*)(T + (size_t)row * ldc + col0 + bj * HALF) = w; }
            EPI_FENCE();
        )
    }
};
struct EpiPle {
    static constexpr bool PERM = true, AFTER_DRAIN = false, MIDK = false;
    const float* rowss; const bf16_t* T; const bf16_t* X; float* out; int ldc; float inv_d, eps;
    __device__ __forceinline__ void operator()(const f32x4 (&acc)[2][2][4][2], const Unit& u, int wr, int wc, int fr, int fq) const {
        const int col0 = u.pn * BM + wc * 32 + 8 * fq;
        EPI_ROWS(
            const float rs = __builtin_amdgcn_rsqf(rowss[row] * inv_d + eps);
            _Pragma("unroll") for (int bj = 0; bj < 2; ++bj) { const size_t off = (size_t)row * ldc + col0 + bj * HALF;
                const u32x4 tw = *(const u32x4*)(T + off), xw = *(const u32x4*)(X + off);
                const float t[8] = {bf_lo(tw.x), bf_hi(tw.x), bf_lo(tw.y), bf_hi(tw.y), bf_lo(tw.z), bf_hi(tw.z), bf_lo(tw.w), bf_hi(tw.w)};
                const float x[8] = {bf_lo(xw.x), bf_hi(xw.x), bf_lo(xw.y), bf_hi(xw.y), bf_lo(xw.z), bf_hi(xw.z), bf_lo(xw.w), bf_hi(xw.w)};
                f32x4 o0, o1;
                _Pragma("unroll") for (int j = 0; j < 4; ++j) { o0[j] = x[j] + sigmoidf_(acc[ai][bj][m][0][j] * rs) * t[j]; o1[j] = x[4 + j] + sigmoidf_(acc[ai][bj][m][1][j] * rs) * t[4 + j]; }
                __builtin_nontemporal_store(o0, (f32x4*)(out + off)); __builtin_nontemporal_store(o1, (f32x4*)(out + off + 4)); }
            EPI_FENCE();
        )
    }
};
template <class Epi, class Sched, bool ALIGN_EPI = false, bool SP2 = false>
__device__ __forceinline__ void gemm_phase(PG8_LAS unsigned char* lds, const Gemm g, const Sched& S, const Epi& E) {
    int tid_ = threadIdx.x; asm volatile("" : "+v"(tid_));
    const int tid = tid_, wid = __builtin_amdgcn_readfirstlane(tid >> 6), lane = tid & 63, wr = wid >> 2, wc = wid & 3, fr = lane & 15, fq = lane >> 4;
    const int K = g.K, nt = g.nt ? g.nt : K / BK;
    unsigned voffA[2], voffB[2];
#pragma unroll
    for (int i = 0; i < 2; ++i) { int R, C; stage_rc(tid * 16 + i * 8192, R, C); const int Rb = Epi::PERM ? ((R & ~31) + perm32(R & 31)) : R;
        voffA[i] = (unsigned)(R * K + C) * 2u; voffB[i] = (unsigned)(Rb * K + C) * 2u; }
    const size_t kstep = (size_t)(BK * 2);
    const size_t hstep = (size_t)HALF * K * 2;
    const size_t tstep = 2 * hstep;
    const unsigned ldsw = (unsigned)wid * 1024u;
    const int aoff = lds_byte(wr * 64 + fr, fq * 8), boff = lds_byte(wc * 32 + fr, fq * 8);
#define PG8_SA(b, h) (((b) * 2 + (h)) * HTB)
#define PG8_SB(b, h) ((4 + (b) * 2 + (h)) * HTB)
#define PG8_STAGE(bufoff, gbase, voff) do { _Pragma("unroll") for (int _i = 0; _i < 2; ++_i) \
        __builtin_amdgcn_global_load_lds((const unsigned*)((const char*)(gbase) + (voff)[_i]), (PG8_LAS unsigned*)(lds + (bufoff) + ldsw + _i * 8192), 16, 0, 0); } while (0)
#define PG8_LDA(dst, b, h) do { _Pragma("unroll") for (int m = 0; m < 4; ++m) _Pragma("unroll") for (int k = 0; k < 2; ++k) dst[m][k] = *(const PG8_LAS bf16x8*)(lds + PG8_SA(b, h) + aoff + m * 2048 + k * 1024); } while (0)
#define PG8_LDB(dst, b, h) do { _Pragma("unroll") for (int n = 0; n < 2; ++n) _Pragma("unroll") for (int k = 0; k < 2; ++k) dst[n][k] = *(const PG8_LAS bf16x8*)(lds + PG8_SB(b, h) + boff + n * 2048 + k * 1024); } while (0)
#define PG8_MMA(ai, bj, At, Bt) do { __builtin_amdgcn_s_setprio(1); _Pragma("unroll") for (int m = 0; m < 4; ++m) _Pragma("unroll") for (int n = 0; n < 2; ++n) _Pragma("unroll") for (int k = 0; k < 2; ++k) \
        acc[ai][bj][m][n] = __builtin_amdgcn_mfma_f32_16x16x32_bf16(Bt[n][k], At[m][k], acc[ai][bj][m][n], 0, 0, 0); __builtin_amdgcn_s_setprio(0); } while (0)
#define PG8_WAIT_V(n) asm volatile("s_waitcnt vmcnt(" #n ")" ::: "memory")
#define PG8_WAIT_L(n) asm volatile("s_waitcnt lgkmcnt(" #n ")" ::: "memory")
#define PG8_BAR __builtin_amdgcn_s_barrier()
#define PG8_SCHED __builtin_amdgcn_sched_barrier(0)
    Unit cur, nxt; int ui = 0;
    if (!S.next(0, cur)) return;
    f32x4 acc[2][2][4][2];
#pragma unroll
    for (int a = 0; a < 2; ++a)
#pragma unroll
        for (int b = 0; b < 2; ++b)
#pragma unroll
            for (int m = 0; m < 4; ++m)
#pragma unroll
                for (int n = 0; n < 2; ++n) acc[a][b][m][n] = (f32x4){0.f, 0.f, 0.f, 0.f};
    bf16x8 At[4][2], B0[2][2], B1[2][2];
    const char* cA = (const char*)g.A + (size_t)cur.pm * tstep + cur.ko; const char* cB = (const char*)g.Bt + (size_t)cur.pn * tstep + cur.ko;
    S.a_ready(cur);
    if constexpr (SP2) {
        PG8_STAGE(PG8_SB(0, 0), cB, voffB); PG8_STAGE(PG8_SB(0, 1), cB + hstep, voffB); PG8_STAGE(PG8_SA(0, 0), cA, voffA); PG8_STAGE(PG8_SA(0, 1), cA + hstep, voffA);
        if (wr == 1) PG8_BAR;
        PG8_WAIT_V(2); PG8_BAR;
        PG8_STAGE(PG8_SB(1, 0), cB + kstep, voffB); PG8_STAGE(PG8_SA(1, 0), cA + kstep, voffA); PG8_STAGE(PG8_SB(1, 1), cB + hstep + kstep, voffB);
        PG8_WAIT_V(6); PG8_BAR;
    } else {
        PG8_STAGE(PG8_SB(0, 0), cB, voffB); PG8_STAGE(PG8_SA(0, 0), cA, voffA); PG8_STAGE(PG8_SB(0, 1), cB + hstep, voffB); PG8_STAGE(PG8_SA(0, 1), cA + hstep, voffA);
        if (wr == 1) PG8_BAR;
        PG8_WAIT_V(4); PG8_BAR;
        PG8_STAGE(PG8_SB(1, 0), cB + kstep, voffB); PG8_STAGE(PG8_SA(1, 0), cA + kstep, voffA); PG8_STAGE(PG8_SB(1, 1), cB + hstep + kstep, voffB);
        PG8_WAIT_V(6); PG8_BAR;
    }
    for (;;) {
        const bool has_next = S.next(ui + 1, nxt);
        const char* nA = has_next ? (const char*)g.A + (size_t)nxt.pm * tstep + nxt.ko : cA; const char* nB = has_next ? (const char*)g.Bt + (size_t)nxt.pn * tstep + nxt.ko : cB;
        for (int t = 0; t < nt; t += 2) {
            const bool last = (t == nt - 2);
            const char* a1 = cA + (size_t)(t + 1) * kstep;
            const char* a2 = last ? nA : cA + (size_t)(t + 2) * kstep; const char* b2 = last ? nB : cB + (size_t)(t + 2) * kstep;
            const char* a3 = a2 + kstep; const char* b3 = b2 + kstep;
            if (last && has_next) S.a_ready(nxt);
            if constexpr (SP2) {
            PG8_LDB(B0, 0, 0); PG8_LDB(B1, 0, 1); PG8_SCHED; PG8_LDA(At, 0, 0); PG8_STAGE(PG8_SA(1, 1), a1 + hstep, voffA);
            PG8_WAIT_V(8); PG8_WAIT_L(0); PG8_BAR; PG8_MMA(0, 0, At, B0); PG8_MMA(0, 1, At, B1); PG8_BAR; PG8_SCHED;
            PG8_LDA(At, 0, 1); PG8_STAGE(PG8_SB(0, 0), b2, voffB); PG8_STAGE(PG8_SB(0, 1), b2 + hstep, voffB); PG8_STAGE(PG8_SA(0, 0), a2, voffA);
            PG8_WAIT_V(8); PG8_WAIT_L(0); PG8_BAR; PG8_MMA(1, 0, At, B0); PG8_MMA(1, 1, At, B1); PG8_BAR; PG8_SCHED;
            PG8_LDB(B0, 1, 0); PG8_LDB(B1, 1, 1); PG8_SCHED; PG8_LDA(At, 1, 0); PG8_STAGE(PG8_SA(0, 1), a2 + hstep, voffA);
            PG8_WAIT_V(8); PG8_WAIT_L(0); PG8_BAR; PG8_MMA(0, 0, At, B0); PG8_MMA(0, 1, At, B1); PG8_BAR; PG8_SCHED;
            PG8_LDA(At, 1, 1); PG8_STAGE(PG8_SB(1, 0), b3, voffB); PG8_STAGE(PG8_SB(1, 1), b3 + hstep, voffB); PG8_STAGE(PG8_SA(1, 0), a3, voffA);
            PG8_WAIT_V(8); PG8_WAIT_L(0); PG8_BAR; PG8_MMA(1, 0, At, B0); PG8_MMA(1, 1, At, B1); PG8_BAR; PG8_SCHED;
            } else {
            PG8_LDB(B0, 0, 0); PG8_SCHED; PG8_LDA(At, 0, 0); PG8_STAGE(PG8_SA(1, 1), a1 + hstep, voffA);
            PG8_WAIT_L(8); PG8_BAR; PG8_WAIT_L(0); PG8_MMA(0, 0, At, B0); PG8_BAR; PG8_SCHED;
            PG8_LDB(B1, 0, 1); PG8_STAGE(PG8_SB(0, 0), b2, voffB);
            PG8_BAR; PG8_WAIT_L(0); PG8_MMA(0, 1, At, B1); PG8_BAR;
            PG8_LDA(At, 0, 1); PG8_STAGE(PG8_SA(0, 0), a2, voffA);
            PG8_BAR; PG8_WAIT_L(0); PG8_MMA(1, 0, At, B0); PG8_BAR; PG8_SCHED;
            PG8_STAGE(PG8_SB(0, 1), b2 + hstep, voffB);
            PG8_WAIT_V(6); PG8_BAR; PG8_MMA(1, 1, At, B1); PG8_BAR;
            PG8_LDB(B0, 1, 0); PG8_SCHED; PG8_LDA(At, 1, 0); PG8_STAGE(PG8_SA(0, 1), a2 + hstep, voffA);
            PG8_WAIT_L(8); PG8_BAR; PG8_WAIT_L(0); PG8_MMA(0, 0, At, B0); PG8_BAR; PG8_SCHED;
            PG8_LDB(B1, 1, 1); PG8_STAGE(PG8_SB(1, 0), b3, voffB);
            PG8_BAR; PG8_WAIT_L(0); PG8_MMA(0, 1, At, B1); PG8_BAR;
            PG8_LDA(At, 1, 1); PG8_STAGE(PG8_SA(1, 0), a3, voffA);
            PG8_BAR; PG8_WAIT_L(0); PG8_MMA(1, 0, At, B0); PG8_BAR; PG8_SCHED;
            PG8_STAGE(PG8_SB(1, 1), b3 + hstep, voffB);
            PG8_WAIT_V(6); PG8_BAR; PG8_MMA(1, 1, At, B1); PG8_BAR;
            }
        }
        if constexpr (ALIGN_EPI) { if (wr == 0) PG8_BAR; }
        bool keep_acc = false;
        if constexpr (Epi::MIDK) { if (cur.ko == 0) { E.mid(acc, cur, wr, wc, fr, fq); keep_acc = true; } else E(acc, cur, wr, wc, fr, fq); }
        else if constexpr (!Epi::AFTER_DRAIN) { E(acc, cur, wr, wc, fr, fq); S.done(cur); }
        if (!has_next) break;
        if (!keep_acc) {
#pragma unroll
        for (int a = 0; a < 2; ++a)
#pragma unroll
            for (int b = 0; b < 2; ++b)
#pragma unroll
                for (int m = 0; m < 4; ++m)
#pragma unroll
                    for (int n = 0; n < 2; ++n) acc[a][b][m][n] = (f32x4){0.f, 0.f, 0.f, 0.f};
        }
        cur = nxt; cA = nA; cB = nB; ++ui;
        if constexpr (ALIGN_EPI) { if (wr == 1) PG8_BAR; }
    }
    PG8_WAIT_V(0);
    if constexpr (!ALIGN_EPI) { if (wr == 0) PG8_BAR; }
    PG8_BAR;
    if constexpr (Epi::AFTER_DRAIN) { E.fused(acc, cur, wr, wc, fr, fq, lds, wid, lane); S.done(cur); }
#undef PG8_SA
#undef PG8_SB
#undef PG8_STAGE
#undef PG8_LDA
#undef PG8_LDB
#undef PG8_MMA
#undef PG8_WAIT_V
#undef PG8_WAIT_L
#undef PG8_BAR
#undef PG8_SCHED
}
}
constexpr int D = 2048, BATCH = 2, SEQ = 4096, M = BATCH * SEQ, GW = 64, GROWS = SEQ / GW, FF = 5632, PLE = 256;
constexpr int NA_H = 8, NA_DH = 128, DF_H = 8, DF_DQ = 64, DF_DV = 128;
constexpr int NQKG = 8192;
constexpr int QC_NAQ = 0, QC_NAK = 1024, QC_DFQ = 2048, QC_DFK = 3072, QC_GA = 4096, QC_GB = 6144;
constexpr float EPS = 1e-6f, LOG2E = 1.4426950408889634f;
constexpr float LAM_INIT = 0.2f;
constexpr int NWAVES = 8, NTHREADS = 512;
constexpr size_t MiB = 1u << 20;
constexpr size_t WS_RS1 = 64 * 1024, WS_RS2 = 128 * 1024, WS_ROPE = 1 * MiB;
constexpr size_t WS_W1 = 2 * MiB, WS_WNA = 42 * MiB, WS_WDF = 46 * MiB, WS_WO = 50 * MiB, WS_WGU = 58 * MiB, WS_WDN = 102 * MiB, WS_WPG = 124 * MiB, WS_WPP = 132 * MiB;
constexpr size_t WS_A = 133 * MiB;
constexpr size_t WS_B = 261 * MiB;
constexpr size_t WS_C = 293 * MiB;
constexpr size_t WS_PB = 325 * MiB;
constexpr size_t WS_END = 329 * MiB;
constexpr int LDS_BYTES = 147456;
#define LAS __attribute__((address_space(3)))
typedef unsigned short bf16;
typedef unsigned u32x4 __attribute__((ext_vector_type(4)));
typedef unsigned u32x2 __attribute__((ext_vector_type(2)));
typedef float f32x4 __attribute__((ext_vector_type(4)));
typedef float f32x2 __attribute__((ext_vector_type(2)));
typedef float f32x16 __attribute__((ext_vector_type(16)));
typedef short bf16x8 __attribute__((ext_vector_type(8)));
using pg8::cvt_pk_bf16; using pg8::bf_lo; using pg8::bf_hi;

__device__ __forceinline__ float wave_sum(float v) {
#pragma unroll
    for (int o = 1; o < 64; o <<= 1) v += __shfl_xor(v, o);
    return v;
}
__device__ __forceinline__ float wave_max(float v) {
#pragma unroll
    for (int o = 1; o < 64; o <<= 1) v = fmaxf(v, __shfl_xor(v, o));
    return v;
}
__device__ __forceinline__ int crow(int r, int hi) { return (r & 3) + 8 * (r >> 2) + 4 * hi; }

__device__ __forceinline__ int rowmap(int mode, int n0) {
    if (mode == 0) return n0;
    if (mode == 1) {
        if (n0 < 2048) return n0;
        if (n0 < 3072) return 8192 + (n0 - 2048);
        if (n0 < 4096) return 2048 + (n0 - 3072);
        if (n0 < 5120) return 3072 + (n0 - 4096);
        if (n0 < 6144) return 9216 + (n0 - 5120);
        return 4096 + (n0 - 6144);
    }
    return 256 * (n0 >> 7) + (n0 & 127) + (mode == 3 ? 128 : 0);
}
struct P0Item { const float* W; bf16* WT; const float* gk; int K, N, mode, item, Kd, kofs; };
__device__ __forceinline__ void p0_item_load(const P0Item& d, float (&v)[32], int lane) {
    const int nblk = d.N / 32, kb = d.item / nblk, nb = d.item % nblk, k0 = 64 * kb, n0 = 32 * nb;
    const float* src = d.W + (size_t)(k0 + (lane >> 5)) * d.N + n0 + (lane & 31);
#pragma unroll
    for (int i = 0; i < 32; ++i) v[i] = __builtin_nontemporal_load(src + (size_t)(2 * i) * d.N);
}
__device__ __forceinline__ void p0_item_store(const P0Item& d, const float (&v)[32], LAS float* scr, int lane) {
    const int nblk = d.N / 32, kb = d.item / nblk, nb = d.item % nblk, k0 = 64 * kb, n0 = 32 * nb;
    const int r0 = rowmap(d.mode, n0);
    if (d.gk) {
#pragma unroll
        for (int i = 0; i < 32; ++i) { const int kk = 2 * i + (lane >> 5); scr[kk * 33 + (lane & 31)] = v[i] * d.gk[k0 + kk]; }
    } else {
#pragma unroll
        for (int i = 0; i < 32; ++i) { const int kk = 2 * i + (lane >> 5); scr[kk * 33 + (lane & 31)] = v[i]; }
    }
    asm volatile("s_waitcnt lgkmcnt(0)" ::: "memory");
    const int c = lane & 7;
#pragma unroll
    for (int j = 0; j < 4; ++j) { const int n = (lane >> 3) + 8 * j; const LAS float* s = scr + (8 * c) * 33 + n;
        u32x4 o; o.x = cvt_pk_bf16(s[0 * 33], s[1 * 33]); o.y = cvt_pk_bf16(s[2 * 33], s[3 * 33]); o.z = cvt_pk_bf16(s[4 * 33], s[5 * 33]); o.w = cvt_pk_bf16(s[6 * 33], s[7 * 33]);
        *(u32x4*)(d.WT + (size_t)(r0 + n) * d.Kd + d.kofs + k0 + 8 * c) = o; }
    asm volatile("s_waitcnt lgkmcnt(0)" ::: "memory");
}
#define RLX_AGENT __ATOMIC_RELAXED, __HIP_MEMORY_SCOPE_AGENT
#define XB_TMO      128
#define XB_XCNT(j)  (256  + 64 * (j))
#define XB_XSUB(j)  (1280 + 64 * (j))
#define XB_XGEN(j)  (2304 + 64 * (j))
#define XB_TOP      3328
#define XB_TOPGEN   3392
#define XCD_BAR_WORDS 3456
#define XB_SPIN_CAP (1u << 18)

__device__ __forceinline__ unsigned xb_ld(unsigned* p)              { return __hip_atomic_load(p, __ATOMIC_RELAXED, __HIP_MEMORY_SCOPE_AGENT); }
__device__ __forceinline__ unsigned xb_add(unsigned* p, unsigned v) { return __hip_atomic_fetch_add(p, v, __ATOMIC_RELAXED, __HIP_MEMORY_SCOPE_AGENT); }
__device__ __forceinline__ unsigned xb_xcc_id() { return (unsigned)__builtin_amdgcn_s_getreg((3 << 11) | 20) & 0xFu; }
#define XB_SPIN(cond, bar) do { unsigned _sp = 0; while (cond) { __builtin_amdgcn_s_sleep(1); \
    if ((++_sp & 255u) == 0u) { if (xb_ld(&(bar)[XB_TMO])) break; if (_sp > XB_SPIN_CAP) { atomicAdd(&(bar)[XB_TMO], 1u); break; } } } } while (0)

struct XcdBarrier {
    unsigned* bar; unsigned x;
    volatile LAS unsigned* st;
};

__device__ __forceinline__ XcdBarrier xcd_barrier_post(unsigned* bar, volatile LAS unsigned* st) {
    XcdBarrier b; b.bar = bar; b.x = xb_xcc_id(); b.st = st;
    if (threadIdx.x == 0) (void)xb_add(&bar[XB_XCNT(b.x)], 1u);
    return b;
}
__device__ __forceinline__ void xcd_barrier_complete(unsigned* bar, unsigned x, unsigned& nloc, unsigned& nx) {
    const unsigned G = gridDim.x * gridDim.y * gridDim.z;
    unsigned sum, cnt, mine, sp = 0u;
    for (;;) {
        sum = 0u; cnt = 0u; mine = 0u;
#pragma unroll
        for (unsigned j = 0; j < 16; ++j) { const unsigned c = xb_ld(&bar[XB_XCNT(j)]); sum += c; cnt += (c > 0u) ? 1u : 0u; mine = (j == x) ? c : mine; }
        if (sum == G) break;
        __builtin_amdgcn_s_sleep(1);
        if ((++sp & 255u) == 0u) { if (xb_ld(&bar[XB_TMO])) break; if (sp > XB_SPIN_CAP) { atomicAdd(&bar[XB_TMO], 1u); break; } }
    }
    nloc = mine > 0u ? mine : 1u; nx = cnt > 0u ? cnt : 1u;
}

__device__ __forceinline__ void xcd_barrier(const XcdBarrier& b) {
    asm volatile("s_waitcnt vmcnt(0)" ::: "memory");
    __syncthreads();
    if (threadIdx.x == 0) {
        unsigned* bar = b.bar;
        __builtin_amdgcn_s_waitcnt(0);
        unsigned nloc = b.st[0], nx = b.st[1];
        if (nloc == 0u) { xcd_barrier_complete(bar, b.x, nloc, nx); b.st[0] = nloc; b.st[1] = nx; }
        const unsigned old = xb_add(&bar[XB_XSUB(b.x)], 1u);
        const unsigned gen = old / nloc;
        if (old + 1u == (gen + 1u) * nloc) {
            __builtin_amdgcn_fence(__ATOMIC_RELEASE, "agent");
            asm volatile("s_waitcnt vmcnt(0)" ::: "memory");
            const unsigned og = xb_add(&bar[XB_TOP], 1u);
            const unsigned tg = og / nx;
            if (og + 1u == (tg + 1u) * nx) xb_add(&bar[XB_TOPGEN], 1u);
            else XB_SPIN(xb_ld(&bar[XB_TOPGEN]) == tg, bar);
            __builtin_amdgcn_fence(__ATOMIC_ACQUIRE, "agent");
            xb_add(&bar[XB_XGEN(b.x)], 1u);
            asm volatile("s_waitcnt vmcnt(0)" ::: "memory");
        } else {
            XB_SPIN(xb_ld(&bar[XB_XGEN(b.x)]) == gen, bar);
            __builtin_amdgcn_fence(__ATOMIC_ACQUIRE, "agent");
            asm volatile("s_waitcnt vmcnt(0)" ::: "memory");
        }
    }
    __syncthreads();
}
struct Args {
    const float *x, *p, *g_mix, *w_in, *g_na_q, *g_na_k, *na_rpb, *g_df_q, *g_df_k, *lam_q1, *lam_k1, *lam_q2, *lam_k2, *g_df_sub,
                *w_na_out, *w_df_out, *w_o, *g_ffn, *w_gate, *w_up, *w_down, *g_ple, *w_ple_gate, *w_ple_proj;
    float* out; unsigned char* ws; int ph_lo, ph_hi, rep3, pad;
};

__device__ __forceinline__ void na_wave_unit(const bf16* QKG, const bf16* VT, const float* rpb, bf16* NAO, float M2, int b, int h, int r, int half) {
    int tid_ = threadIdx.x; asm volatile("" : "+v"(tid_)); const int lane = tid_ & 63;
    const int q = lane & 31, hi = lane >> 5, c = 32 * half + q;
    const size_t tokq = (size_t)b * SEQ + r * GW + c;
    bf16x8 qf[8];
#pragma unroll
    for (int d0 = 0; d0 < 8; ++d0) qf[d0] = *(const bf16x8*)(QKG + tokq * NQKG + QC_NAQ + h * NA_DH + 16 * d0 + 8 * hi);
    int rs = r - 4; rs = rs < 0 ? 0 : (rs > GROWS - 8 ? GROWS - 8 : rs);
    int cs = c - 8; cs = cs < 0 ? 0 : (cs > GW - 16 ? GW - 16 : cs);
    f32x16 o[4];
#pragma unroll
    for (int i = 0; i < 4; ++i) o[i] = (f32x16){};
    float l = 0.f;
    for (int kr = 0; kr < 8; ++kr) {
        const int krow = rs + kr, dr = krow - r + 7;
        const float* brow = rpb + (h * 15 + dr) * 31;
#pragma unroll
        for (int kb = 0; kb < 2; ++kb) {
            f32x16 s = (f32x16){};
            const bf16* kp = QKG + ((size_t)b * SEQ + krow * GW + 32 * kb + q) * NQKG + QC_NAK + h * NA_DH + 8 * hi;
#pragma unroll
            for (int d0 = 0; d0 < 8; ++d0) { const bf16x8 kf = *(const bf16x8*)(kp + 16 * d0); s = __builtin_amdgcn_mfma_f32_32x32x16_bf16(kf, qf[d0], s, 0, 0, 0); }
            float pv[16];
#pragma unroll
            for (int i = 0; i < 16; ++i) { const int kc = 32 * kb + crow(i, hi); const bool in = (kc >= cs) && (kc < cs + 16); const int dc = in ? (kc - c + 15) : 0;
                const float bias = brow[dc] * LOG2E - M2; const float e = __builtin_amdgcn_exp2f(s[i] + bias); pv[i] = in ? e : 0.f; l += pv[i]; }
            u32x4 w0, w1;
            w0.x = cvt_pk_bf16(pv[0], pv[1]); w0.y = cvt_pk_bf16(pv[2], pv[3]); w0.z = cvt_pk_bf16(pv[4], pv[5]); w0.w = cvt_pk_bf16(pv[6], pv[7]);
            w1.x = cvt_pk_bf16(pv[8], pv[9]); w1.y = cvt_pk_bf16(pv[10], pv[11]); w1.z = cvt_pk_bf16(pv[12], pv[13]); w1.w = cvt_pk_bf16(pv[14], pv[15]);
            const bf16x8 p0 = __builtin_bit_cast(bf16x8, w0), p1 = __builtin_bit_cast(bf16x8, w1);
            const bf16* vp = VT + (size_t)(h * NA_DH + q) * M + (size_t)b * SEQ + krow * GW + 32 * kb + 8 * hi;
#pragma unroll
            for (int db = 0; db < 4; ++db) {
                const bf16x8 v0 = *(const bf16x8*)(vp + (size_t)(32 * db) * M), v1 = *(const bf16x8*)(vp + (size_t)(32 * db) * M + 16);
                o[db] = __builtin_amdgcn_mfma_f32_32x32x16_bf16(v0, p0, o[db], 0, 0, 0);
                o[db] = __builtin_amdgcn_mfma_f32_32x32x16_bf16(v1, p1, o[db], 0, 0, 0);
            }
        }
    }
    l += __shfl_xor(l, 32);
    const float rl = 1.0f / l;
    bf16* op = NAO + tokq * 2048 + h * NA_DH + 4 * hi;
#pragma unroll
    for (int db = 0; db < 4; ++db)
#pragma unroll
        for (int g = 0; g < 4; ++g) { u32x2 w; w.x = cvt_pk_bf16(o[db][4 * g] * rl, o[db][4 * g + 1] * rl); w.y = cvt_pk_bf16(o[db][4 * g + 2] * rl, o[db][4 * g + 3] * rl);
            *(u32x2*)(op + 32 * db + 8 * g) = w; }
}

__device__ __forceinline__ void df_unit(LAS unsigned char* lds, const bf16* QKG, const bf16* KC, const bf16* VT, bf16* DFO, const float* g_sub, const float* gq, const f32x2* rope, float lam, float M2, int b, int h, int qb, unsigned long long* df_wait = nullptr) {
    int tid_ = threadIdx.x; asm volatile("" : "+v"(tid_));
    const int tid = tid_, lane = tid & 63, w = __builtin_amdgcn_readfirstlane(tid >> 6), q = lane & 31, hi = lane >> 5;
    const int mm = w & 1, qg = w >> 1;
    const int q0 = qb * 128 + qg * 32;
    bf16x8 qf[4];
    {
      u32x4 qr[4]; float ss = 0.f; float xv[4][8];
#pragma unroll
      for (int d0 = 0; d0 < 4; ++d0) { qr[d0] = *(const u32x4*)(QKG + ((size_t)b * SEQ + q0 + q) * NQKG + QC_DFQ + h * 128 + mm * 64 + 16 * d0 + 8 * hi);
          xv[d0][0] = bf_lo(qr[d0].x); xv[d0][1] = bf_hi(qr[d0].x); xv[d0][2] = bf_lo(qr[d0].y); xv[d0][3] = bf_hi(qr[d0].y); xv[d0][4] = bf_lo(qr[d0].z); xv[d0][5] = bf_hi(qr[d0].z); xv[d0][6] = bf_lo(qr[d0].w); xv[d0][7] = bf_hi(qr[d0].w);
#pragma unroll
          for (int j = 0; j < 8; ++j) ss += xv[d0][j] * xv[d0][j]; }
      ss += __shfl_xor(ss, 32);
      const float rs = __builtin_amdgcn_rsqf(ss * (1.0f / 64.0f) + EPS);
      const float QS = 0.125f * LOG2E;
      const f32x2* rp = rope + (size_t)(q0 + q) * 32;
#pragma unroll
      for (int d0 = 0; d0 < 2; ++d0) { float o1[8], o2[8];
#pragma unroll
          for (int j = 0; j < 8; ++j) { const int i = 16 * d0 + 8 * hi + j; const f32x2 cs = rp[i];
              const float x1 = xv[d0][j] * rs * gq[i], x2 = xv[d0 + 2][j] * rs * gq[32 + i];
              o1[j] = (x1 * cs.x - x2 * cs.y) * QS; o2[j] = (x1 * cs.y + x2 * cs.x) * QS; }
          u32x4 wa, wb; wa.x = cvt_pk_bf16(o1[0], o1[1]); wa.y = cvt_pk_bf16(o1[2], o1[3]); wa.z = cvt_pk_bf16(o1[4], o1[5]); wa.w = cvt_pk_bf16(o1[6], o1[7]);
          wb.x = cvt_pk_bf16(o2[0], o2[1]); wb.y = cvt_pk_bf16(o2[2], o2[3]); wb.z = cvt_pk_bf16(o2[4], o2[5]); wb.w = cvt_pk_bf16(o2[6], o2[7]);
          qf[d0] = __builtin_bit_cast(bf16x8, wa); qf[d0 + 2] = __builtin_bit_cast(bf16x8, wb); } }
    const unsigned char* kbase = (const unsigned char*)(KC + ((size_t)(b * 8 + h) * SEQ) * 128);
    const unsigned char* vbase = (const unsigned char*)(VT + ((size_t)(b * 16 + 8 + h) * 64) * 128 * 64);
    unsigned koff[2], voff[2];
#pragma unroll
    for (int i = 0; i < 2; ++i) {
        const int piece = w * 2 + i;
        { const int row = piece * 4 + (lane >> 4), ph = lane & 15, ch = ph ^ (row & 15); koff[i] = (unsigned)(row * 128 + ch * 8) * 2u; }
        { const int row = piece * 8 + (lane >> 3), ph = lane & 7, ch = ph ^ ((row >> 1) & 7); voff[i] = (unsigned)(row * 64 + ch * 8) * 2u; }
    }
#define DF_DMA(kt, stg) do { const unsigned char* kb_ = kbase + (size_t)(kt) * 16384; const unsigned char* vb_ = vbase + (size_t)(kt) * 16384; _Pragma("unroll") for (int _i = 0; _i < 2; ++_i) { \
        __builtin_amdgcn_global_load_lds((const unsigned*)(kb_ + koff[_i]), (LAS unsigned*)(lds + (stg) * 32768 + (w * 2 + _i) * 1024), 16, 0, 0); \
        __builtin_amdgcn_global_load_lds((const unsigned*)(vb_ + voff[_i]), (LAS unsigned*)(lds + (stg) * 32768 + 16384 + (w * 2 + _i) * 1024), 16, 0, 0); } } while (0)
    int kofs[4], vofs[4];
#pragma unroll
    for (int d0 = 0; d0 < 4; ++d0) kofs[d0] = q * 256 + (((mm * 8 + 2 * d0 + hi) ^ (q & 15)) * 16);
#pragma unroll
    for (int g = 0; g < 4; ++g) vofs[g] = 16384 + q * 128 + (((2 * g + hi) ^ ((q >> 1) & 7)) * 16);
    f32x16 o[4];
#pragma unroll
    for (int i = 0; i < 4; ++i) o[i] = (f32x16){};
    float l = 0.f;
    const float shift = (M2 > 60.0f) ? M2 : 0.0f;
    constexpr int NT = SEQ / 64;
    typedef float f32x2_t __attribute__((ext_vector_type(2))); typedef __bf16 bf16x2_t __attribute__((ext_vector_type(2)));
#define CVTPK(lo, hi) __builtin_bit_cast(unsigned, __builtin_convertvector((f32x2_t){(lo), (hi)}, bf16x2_t))
#define DF_S(dst, St_, kb_) do { bf16x8 kf_[4]; _Pragma("unroll") for (int d0 = 0; d0 < 4; ++d0) kf_[d0] = *(const LAS bf16x8*)((St_) + kofs[d0] + (kb_) * 8192); \
        dst = (f32x16){}; _Pragma("unroll") for (int d0 = 0; d0 < 4; ++d0) dst = __builtin_amdgcn_mfma_f32_32x32x16_bf16(kf_[d0], qf[d0], dst, 0, 0, 0); } while (0)
#define DF_TILE(Stile, sv0, sv1) do { _Pragma("unroll") for (int kb = 0; kb < 2; ++kb) { \
            bf16x8 vf[2][4]; \
            _Pragma("unroll") for (int jj = 0; jj < 2; ++jj) _Pragma("unroll") for (int db = 0; db < 4; ++db) vf[jj][db] = *(const LAS bf16x8*)((Stile) + vofs[2 * kb + jj] + db * 4096); \
            f32x16 s = kb ? sv1 : sv0; \
            if (shift != 0.f) { _Pragma("unroll") for (int i = 0; i < 16; ++i) s[i] -= shift; } \
            float ls = 0.f; \
            _Pragma("unroll") for (int i = 0; i < 16; ++i) { s[i] = __builtin_amdgcn_exp2f(s[i]); ls += s[i]; } \
            l += ls; \
            u32x4 w0, w1; \
            w0.x = CVTPK(s[0], s[1]); w0.y = CVTPK(s[2], s[3]); w0.z = CVTPK(s[4], s[5]); w0.w = CVTPK(s[6], s[7]); \
            w1.x = CVTPK(s[8], s[9]); w1.y = CVTPK(s[10], s[11]); w1.z = CVTPK(s[12], s[13]); w1.w = CVTPK(s[14], s[15]); \
            const bf16x8 p0 = __builtin_bit_cast(bf16x8, w0), p1 = __builtin_bit_cast(bf16x8, w1); \
            _Pragma("unroll") for (int db = 0; db < 4; ++db) o[db] = __builtin_amdgcn_mfma_f32_32x32x16_bf16(vf[0][db], p0, o[db], 0, 0, 0); \
            _Pragma("unroll") for (int db = 0; db < 4; ++db) o[db] = __builtin_amdgcn_mfma_f32_32x32x16_bf16(vf[1][db], p1, o[db], 0, 0, 0); } } while (0)
    constexpr int NTS = NT / 2;
    DF_DMA(0, 0); DF_DMA(1, 1);
    asm volatile("s_waitcnt vmcnt(0)" ::: "memory");
    __builtin_amdgcn_s_barrier();
    asm volatile("" ::: "memory");
    for (int st = 0; st < NTS; ++st) {
        const int sb = (st & 1) * 2;
        if (st + 1 < NTS) { DF_DMA(2 * st + 2, sb ^ 2); DF_DMA(2 * st + 3, (sb ^ 2) + 1); }
        const LAS unsigned char* T0 = lds + sb * 32768;
        const LAS unsigned char* T1 = T0 + 32768;
        f32x16 a0, a1, b0, b1;
        DF_S(a0, T0, 0); DF_S(a1, T0, 1);
        DF_S(b0, T1, 0); DF_S(b1, T1, 1);
        if (w >= 4) __builtin_amdgcn_s_setprio(1); else __builtin_amdgcn_s_setprio(0);
        DF_TILE(T0, a0, a1);
        if (w >= 4) __builtin_amdgcn_s_setprio(0); else __builtin_amdgcn_s_setprio(1);
        DF_TILE(T1, b0, b1);
        __builtin_amdgcn_s_setprio(0);
        asm volatile("s_waitcnt vmcnt(0) lgkmcnt(0)" ::: "memory");
        __builtin_amdgcn_s_barrier();
        asm volatile("" ::: "memory");
    }
#undef DF_TILE
#undef DF_S
#undef CVTPK
#undef DF_DMA
    LAS float* xch = (LAS float*)lds;
    { float lt = l; lt += __shfl_xor(lt, 32);
      const float sc = (mm == 1 ? lam : 1.0f) / lt;
#pragma unroll
      for (int db = 0; db < 4; ++db)
#pragma unroll
          for (int i = 0; i < 16; ++i) o[db][i] *= sc; }
    if (mm == 1) {
#pragma unroll
        for (int db = 0; db < 4; ++db)
#pragma unroll
            for (int i = 0; i < 16; ++i) xch[(qg * 64 + db * 16 + i) * 64 + lane] = o[db][i];
    }
    __syncthreads();
    if (mm == 0) {
        float ss = 0.f;
#pragma unroll
        for (int db = 0; db < 4; ++db)
#pragma unroll
            for (int i = 0; i < 16; ++i) { const float v = o[db][i] - xch[(qg * 64 + db * 16 + i) * 64 + lane]; o[db][i] = v; ss += v * v; }
        ss += __shfl_xor(ss, 32);
        const float rn = __builtin_amdgcn_rsqf(ss * (1.0f / 128.0f) + EPS) * (1.0f - LAM_INIT);
        bf16* op = DFO + ((size_t)b * SEQ + q0 + q) * 2048 + h * 128 + 4 * hi;
#pragma unroll
        for (int db = 0; db < 4; ++db)
#pragma unroll
            for (int g = 0; g < 4; ++g) { const f32x4 gs = *(const f32x4*)(g_sub + 32 * db + 8 * g + 4 * hi);
                u32x2 wv; wv.x = cvt_pk_bf16(o[db][4 * g] * rn * gs[0], o[db][4 * g + 1] * rn * gs[1]); wv.y = cvt_pk_bf16(o[db][4 * g + 2] * rn * gs[2], o[db][4 * g + 3] * rn * gs[3]);
                *(u32x2*)(op + 32 * db + 8 * g) = wv; }
    }
    __syncthreads();
}

__device__ __forceinline__ void na_unit(LAS unsigned char* lds, const bf16* QKG, const bf16* KC, const bf16* VT, const float* rpb, const float* gq, bf16* NAO, float M2, int b, int h, int r0) {
    int tid_ = threadIdx.x; asm volatile("" : "+v"(tid_));
    const int tid = tid_, lane = tid & 63, w = __builtin_amdgcn_readfirstlane(tid >> 6), q = lane & 31, hi = lane >> 5;
    const int rq = r0 + (w >> 1), half = w & 1, c = 32 * half + q;
    const size_t tokq = (size_t)b * SEQ + rq * GW + c;
    bf16x8 qf[8];
    {
      u32x4 qr[8]; float ss = 0.f;
#pragma unroll
      for (int d0 = 0; d0 < 8; ++d0) { qr[d0] = *(const u32x4*)(QKG + tokq * NQKG + QC_NAQ + h * NA_DH + 16 * d0 + 8 * hi);
          const float v[8] = {bf_lo(qr[d0].x), bf_hi(qr[d0].x), bf_lo(qr[d0].y), bf_hi(qr[d0].y), bf_lo(qr[d0].z), bf_hi(qr[d0].z), bf_lo(qr[d0].w), bf_hi(qr[d0].w)};
#pragma unroll
          for (int j = 0; j < 8; ++j) ss += v[j] * v[j]; }
      ss += __shfl_xor(ss, 32);
      const float rn = __builtin_amdgcn_rsqf(ss * (1.0f / 128.0f) + EPS) * (0.08838834764831845f * LOG2E);
#pragma unroll
      for (int d0 = 0; d0 < 8; ++d0) { const float* g1 = gq + 16 * d0 + 8 * hi;
          const float v[8] = {bf_lo(qr[d0].x), bf_hi(qr[d0].x), bf_lo(qr[d0].y), bf_hi(qr[d0].y), bf_lo(qr[d0].z), bf_hi(qr[d0].z), bf_lo(qr[d0].w), bf_hi(qr[d0].w)};
          u32x4 o; o.x = cvt_pk_bf16(v[0] * rn * g1[0], v[1] * rn * g1[1]); o.y = cvt_pk_bf16(v[2] * rn * g1[2], v[3] * rn * g1[3]);
          o.z = cvt_pk_bf16(v[4] * rn * g1[4], v[5] * rn * g1[5]); o.w = cvt_pk_bf16(v[6] * rn * g1[6], v[7] * rn * g1[7]);
          qf[d0] = __builtin_bit_cast(bf16x8, o); } }
    int rs = rq - 4; rs = rs < 0 ? 0 : (rs > GROWS - 8 ? GROWS - 8 : rs);
    int cs = c - 8; cs = cs < 0 ? 0 : (cs > GW - 16 ? GW - 16 : cs);
    int klo = r0 - 4; klo = klo < 0 ? 0 : (klo > GROWS - 8 ? GROWS - 8 : klo);
    int khi = r0 + 3 - 4; khi = (khi < 0 ? 0 : (khi > GROWS - 8 ? GROWS - 8 : khi)) + 7;
    const int nst = khi - klo + 1;
    const unsigned char* kbase = (const unsigned char*)(KC + ((size_t)(b * 8 + h) * SEQ + klo * GW) * 128);
    const unsigned char* vbase = (const unsigned char*)(VT + ((size_t)(b * 16 + h) * 64 + klo) * 128 * 64);
    unsigned koff[2], voff[2];
#pragma unroll
    for (int i = 0; i < 2; ++i) {
        const int piece = w * 2 + i;
        { const int row = piece * 4 + (lane >> 4), ph = lane & 15, ch = ph ^ (row & 15); koff[i] = (unsigned)(row * 128 + ch * 8) * 2u; }
        { const int row = piece * 8 + (lane >> 3), ph = lane & 7, ch = ph ^ ((row >> 1) & 7); voff[i] = (unsigned)(row * 64 + ch * 8) * 2u; }
    }
#define NA_DMA(t, stg) do { const unsigned char* kb_ = kbase + (size_t)(t) * 16384; const unsigned char* vb_ = vbase + (size_t)(t) * 16384; _Pragma("unroll") for (int _i = 0; _i < 2; ++_i) { \
        __builtin_amdgcn_global_load_lds((const unsigned*)(kb_ + koff[_i]), (LAS unsigned*)(lds + (stg) * 32768 + (w * 2 + _i) * 1024), 16, 0, 0); \
        __builtin_amdgcn_global_load_lds((const unsigned*)(vb_ + voff[_i]), (LAS unsigned*)(lds + (stg) * 32768 + 16384 + (w * 2 + _i) * 1024), 16, 0, 0); } } while (0)
    int kofs[8], vofs[4];
#pragma unroll
    for (int d0 = 0; d0 < 8; ++d0) kofs[d0] = q * 256 + (((2 * d0 + hi) ^ (q & 15)) * 16);
#pragma unroll
    for (int g = 0; g < 4; ++g) vofs[g] = 16384 + q * 128 + (((2 * g + hi) ^ ((q >> 1) & 7)) * 16);
    f32x16 o[4];
#pragma unroll
    for (int i = 0; i < 4; ++i) o[i] = (f32x16){};
    float l = 0.f;
    LAS float* btab = (LAS float*)(lds + 131072 + 1024);
    for (int i = tid; i < 15 * 31; i += NTHREADS) btab[i] = rpb[h * 15 * 31 + i] * LOG2E - M2;
    asm volatile("s_waitcnt vmcnt(0) lgkmcnt(0)" ::: "memory");
    __builtin_amdgcn_s_barrier();
    asm volatile("" ::: "memory");
    NA_DMA(0, 0); NA_DMA(1, 1);
    asm volatile("s_waitcnt vmcnt(4)" ::: "memory");
    __builtin_amdgcn_s_barrier();
    asm volatile("" ::: "memory");
    for (int t = 0; t < nst; ++t) {
        if (t + 2 < nst) NA_DMA(t + 2, (t + 2) & 3);
        const int krow = klo + t;
        if (krow >= rs && krow < rs + 8) {
            const LAS unsigned char* St = lds + (t & 3) * 32768;
            const LAS float* brow = btab + (krow - rq + 7) * 31;
#pragma unroll 1
            for (int kb = 0; kb < 2; ++kb) {
                f32x16 s = (f32x16){};
#pragma unroll
                for (int d0 = 0; d0 < 8; ++d0) { const bf16x8 kf = *(const LAS bf16x8*)(St + kofs[d0] + kb * 8192); s = __builtin_amdgcn_mfma_f32_32x32x16_bf16(kf, qf[d0], s, 0, 0, 0); }
                bf16x8 vf[2][4];
#pragma unroll
                for (int jj = 0; jj < 2; ++jj)
#pragma unroll
                    for (int db = 0; db < 4; ++db) vf[jj][db] = *(const LAS bf16x8*)(St + (kb ? vofs[2 + jj] : vofs[jj]) + db * 4096);
                float pv[16];
                const LAS float* bp = brow + (4 * hi - c + 15 + 32 * kb);
                const int wa = 4 * hi - cs + 32 * kb;
#pragma unroll
                for (int i = 0; i < 16; ++i) { const int e0 = (i & 3) + 8 * (i >> 2); const float bias = bp[e0]; const float e = __builtin_amdgcn_exp2f(s[i] + bias);
                    pv[i] = ((unsigned)(wa + e0) < 16u) ? e : 0.f; l += pv[i]; }
                u32x4 w0, w1;
                w0.x = cvt_pk_bf16(pv[0], pv[1]); w0.y = cvt_pk_bf16(pv[2], pv[3]); w0.z = cvt_pk_bf16(pv[4], pv[5]); w0.w = cvt_pk_bf16(pv[6], pv[7]);
                w1.x = cvt_pk_bf16(pv[8], pv[9]); w1.y = cvt_pk_bf16(pv[10], pv[11]); w1.z = cvt_pk_bf16(pv[12], pv[13]); w1.w = cvt_pk_bf16(pv[14], pv[15]);
                const bf16x8 p0 = __builtin_bit_cast(bf16x8, w0), p1 = __builtin_bit_cast(bf16x8, w1);
#pragma unroll
                for (int db = 0; db < 4; ++db) o[db] = __builtin_amdgcn_mfma_f32_32x32x16_bf16(vf[0][db], p0, o[db], 0, 0, 0);
#pragma unroll
                for (int db = 0; db < 4; ++db) o[db] = __builtin_amdgcn_mfma_f32_32x32x16_bf16(vf[1][db], p1, o[db], 0, 0, 0);
            }
        }
        if (t + 2 < nst) asm volatile("s_waitcnt vmcnt(4) lgkmcnt(0)" ::: "memory"); else asm volatile("s_waitcnt vmcnt(0) lgkmcnt(0)" ::: "memory");
        __builtin_amdgcn_s_barrier();
        asm volatile("" ::: "memory");
    }
#undef NA_DMA
    l += __shfl_xor(l, 32);
    const float rl = 1.0f / l;
    bf16* op = NAO + tokq * 2048 + h * NA_DH + 4 * hi;
#pragma unroll
    for (int db = 0; db < 4; ++db)
#pragma unroll
        for (int g = 0; g < 4; ++g) { u32x2 wv; wv.x = cvt_pk_bf16(o[db][4 * g] * rl, o[db][4 * g + 1] * rl); wv.y = cvt_pk_bf16(o[db][4 * g + 2] * rl, o[db][4 * g + 3] * rl);
            *(u32x2*)(op + 32 * db + 8 * g) = wv; }
}
template <int TB>
__device__ __forceinline__ void qknorm_batch(bf16* QKG, bf16* KCna, bf16* KCdf, int m0, int mstride, const float* gnk, const float* gdk, const f32x2* rope, int lane) {
    u32x4 na[TB][2], da[TB], db[TB];
#pragma unroll
    for (int t = 0; t < TB; ++t) { int mt = m0 + t * mstride; if (mt >= M) mt = M - 1; const bf16* row = QKG + (size_t)mt * NQKG;
#pragma unroll
        for (int j = 0; j < 2; ++j) na[t][j] = *(const u32x4*)(row + QC_NAK + 512 * j + 8 * lane);
        const bf16* p1 = row + QC_DFK + 64 * (lane >> 2) + 8 * (lane & 3); da[t] = *(const u32x4*)p1; db[t] = *(const u32x4*)(p1 + 32); }
#pragma unroll
    for (int t = 0; t < TB; ++t) { const int mt = m0 + t * mstride; if (mt >= M) break; const int pos = mt & (SEQ - 1);
#pragma unroll
        for (int j = 0; j < 2; ++j) {
            const u32x4 w = na[t][j];
            float v[8] = {bf_lo(w.x), bf_hi(w.x), bf_lo(w.y), bf_hi(w.y), bf_lo(w.z), bf_hi(w.z), bf_lo(w.w), bf_hi(w.w)};
            float ss = 0.f;
#pragma unroll
            for (int i = 0; i < 8; ++i) ss += v[i] * v[i];
            ss += __shfl_xor(ss, 1); ss += __shfl_xor(ss, 2); ss += __shfl_xor(ss, 4); ss += __shfl_xor(ss, 8);
            const float rs = __builtin_amdgcn_rsqf(ss * (1.0f / 128.0f) + EPS);
            const float* g = gnk + 8 * (lane & 15);
#pragma unroll
            for (int i = 0; i < 8; ++i) v[i] = v[i] * rs * g[i];
            u32x4 o; o.x = cvt_pk_bf16(v[0], v[1]); o.y = cvt_pk_bf16(v[2], v[3]); o.z = cvt_pk_bf16(v[4], v[5]); o.w = cvt_pk_bf16(v[6], v[7]);
            const int x = 512 * j + 8 * lane;
            *(u32x4*)(KCna + ((size_t)((mt >> 12) * 8 + (x >> 7)) * SEQ + pos) * 128 + (x & 127)) = o;
        }
        {
            const u32x4 wa = da[t], wb = db[t];
            float a[8] = {bf_lo(wa.x), bf_hi(wa.x), bf_lo(wa.y), bf_hi(wa.y), bf_lo(wa.z), bf_hi(wa.z), bf_lo(wa.w), bf_hi(wa.w)};
            float c[8] = {bf_lo(wb.x), bf_hi(wb.x), bf_lo(wb.y), bf_hi(wb.y), bf_lo(wb.z), bf_hi(wb.z), bf_lo(wb.w), bf_hi(wb.w)};
            float ss = 0.f;
#pragma unroll
            for (int i = 0; i < 8; ++i) ss += a[i] * a[i] + c[i] * c[i];
            ss += __shfl_xor(ss, 1); ss += __shfl_xor(ss, 2);
            const float rs = __builtin_amdgcn_rsqf(ss * (1.0f / 64.0f) + EPS);
            const float* g = gdk + 8 * (lane & 3);
            const f32x2* rp = rope + pos * 32 + 8 * (lane & 3);
            float o1[8], o2[8];
#pragma unroll
            for (int i = 0; i < 8; ++i) { const float x1 = a[i] * rs * g[i], x2 = c[i] * rs * g[32 + i]; const f32x2 cs = rp[i]; o1[i] = x1 * cs.x - x2 * cs.y; o2[i] = x1 * cs.y + x2 * cs.x; }
            u32x4 oa, ob; oa.x = cvt_pk_bf16(o1[0], o1[1]); oa.y = cvt_pk_bf16(o1[2], o1[3]); oa.z = cvt_pk_bf16(o1[4], o1[5]); oa.w = cvt_pk_bf16(o1[6], o1[7]);
            ob.x = cvt_pk_bf16(o2[0], o2[1]); ob.y = cvt_pk_bf16(o2[2], o2[3]); ob.z = cvt_pk_bf16(o2[4], o2[5]); ob.w = cvt_pk_bf16(o2[6], o2[7]);
            const int x = 64 * (lane >> 2) + 8 * (lane & 3); bf16* kp = KCdf + ((size_t)((mt >> 12) * 8 + (x >> 7)) * SEQ + pos) * 128 + (x & 127);
            *(u32x4*)kp = oa; *(u32x4*)(kp + 32) = ob;
        }
    }
}

__device__ __forceinline__ void grid_barrier(unsigned* cnt, unsigned target) {
    asm volatile("s_waitcnt vmcnt(0) lgkmcnt(0)" ::: "memory");
    __syncthreads();
    if (threadIdx.x == 0) {
        __builtin_amdgcn_fence(__ATOMIC_RELEASE, "agent");
        asm volatile("s_waitcnt vmcnt(0)" ::: "memory");
        __hip_atomic_fetch_add(cnt, 1u, __ATOMIC_RELAXED, __HIP_MEMORY_SCOPE_AGENT);
        while (__hip_atomic_load(cnt, __ATOMIC_RELAXED, __HIP_MEMORY_SCOPE_AGENT) < target) __builtin_amdgcn_s_sleep(2);
        __builtin_amdgcn_fence(__ATOMIC_ACQUIRE, "agent");
        asm volatile("s_waitcnt vmcnt(0)" ::: "memory");
    }
    __syncthreads();
}
constexpr int I_IN = 32 * 320, I_NA = 16 * 64, I_O = 32 * 64, I_G = 32 * 176, I_DN = 88 * 64, I_PP = 4 * 64;
constexpr int N_EARLY = I_IN + 2 * I_NA + I_O + 2 * I_G + I_PP, NITEMS = N_EARLY + I_DN + I_O;
#define P0_DECODE(it_, d_) do { int r = (it_); \
            if (r < I_IN) { d_ = P0Item{ap->w_in, W1t, nullptr, D, 10240, 1, r, D, 0}; break; } r -= I_IN; \
            if (r < I_NA) { d_ = P0Item{ap->w_na_out, Wna, nullptr, 1024, D, 0, r, 2048, 0}; break; } r -= I_NA; \
            if (r < I_NA) { d_ = P0Item{ap->w_df_out, Wna, nullptr, 1024, D, 0, r, 2048, 1024}; break; } r -= I_NA; \
            if (r < I_O) { d_ = P0Item{ap->w_o, Wo, nullptr, D, D, 0, r, D, 0}; break; } r -= I_O; \
            if (r < I_G) { d_ = P0Item{ap->w_gate, Wgu, ap->g_ffn, D, FF, 2, r, D, 0}; break; } r -= I_G; \
            if (r < I_G) { d_ = P0Item{ap->w_up, Wgu, ap->g_ffn, D, FF, 3, r, D, 0}; break; } r -= I_G; \
            if (r < I_PP) { d_ = P0Item{ap->w_ple_proj, Wpp, nullptr, PLE, D, 0, r, PLE, 0}; break; } r -= I_PP; \
            if (r < I_DN) { d_ = P0Item{ap->w_down, Wdn, nullptr, FF, D, 0, r, FF, 0}; break; } r -= I_DN; \
            d_ = P0Item{ap->w_ple_gate, Wpg, ap->g_ple, D, D, 0, r, D, 0}; } while (0)
constexpr int NPHASE = 9;
__global__ void __launch_bounds__(NTHREADS, 2) fwd_megakernel(Args a) {
    extern __shared__ __attribute__((aligned(16))) unsigned char lds_raw[];
    LAS unsigned char* lds = (LAS unsigned char*)lds_raw;
    cg::grid_group grid = cg::this_grid();
    const int G = gridDim.x, bx = blockIdx.x;
    const int vcu = (G % 8 == 0) ? (bx % 8) * (G / 8) + bx / 8 : bx;
    const int NGW = G * NWAVES;
typedef __attribute__((opencl_constant)) const Args* CArgsP;
#define FRESH_ARGS() auto kp_ = __builtin_amdgcn_kernarg_segment_ptr(); asm volatile("" : "+s"(kp_)); const CArgsP ap = (CArgsP)kp_
#define FRESH_TID() int tid_ = threadIdx.x; asm volatile("" : "+v"(tid_)); const int tid = tid_, lane = tid & 63, wave = __builtin_amdgcn_readfirstlane(tid >> 6), gw = vcu * NWAVES + wave; (void)lane; (void)gw
    unsigned char* ws = a.ws;
    float* RS1 = (float*)(ws + WS_RS1); float* RS2 = (float*)(ws + WS_RS2); f32x2* ROPE = (f32x2*)(ws + WS_ROPE);
    bf16 *W1t = (bf16*)(ws + WS_W1), *Wna = (bf16*)(ws + WS_WNA), *Wdf = (bf16*)(ws + WS_WDF), *Wo = (bf16*)(ws + WS_WO), *Wgu = (bf16*)(ws + WS_WGU), *Wdn = (bf16*)(ws + WS_WDN), *Wpg = (bf16*)(ws + WS_WPG), *Wpp = (bf16*)(ws + WS_WPP);
    bf16 *QKG = (bf16*)(ws + WS_A), *HB = (bf16*)(ws + WS_A);
    bf16 *XN = (bf16*)(ws + WS_B), *AO = (bf16*)(ws + WS_B), *X1B = (bf16*)(ws + WS_B), *X2B = (bf16*)(ws + WS_B);
    bf16 *VT = (bf16*)(ws + WS_C), *MRG = (bf16*)(ws + WS_C), *T2B = (bf16*)(ws + WS_C), *PB = (bf16*)(ws + WS_PB);
    bf16* KCna = (bf16*)a.out; bf16* KCdf = KCna + (size_t)M * 1024;
    const int lo = a.ph_lo, hi_ph = a.ph_hi;
    if (lo < 0) grid.sync();
    { volatile LAS unsigned* st0 = (volatile LAS unsigned*)(lds + 131072 + 768); if (threadIdx.x < 2) st0[threadIdx.x] = 0u; __syncthreads(); }
    XcdBarrier xbar = xcd_barrier_post((unsigned*)(ws + 8192), (volatile LAS unsigned*)(lds + 131072 + 768));
#ifndef PHASE_MASK
#define PHASE_MASK 0x1ff
#endif
#define IN(k) (((PHASE_MASK >> (k)) & 1) && lo <= (k) && (k) < hi_ph)
#ifdef PROBE_TS
#define STAMP(k) do { if (bx == 0 && threadIdx.x == 0) ((volatile unsigned long long*)(ws + 2048))[k] = __builtin_amdgcn_s_memrealtime(); } while (0)
#else
#define STAMP(k) do {} while (0)
#endif
#define GBAR(idx) xcd_barrier(xbar)
#define SEAM(k) do { if (IN(k) && IN((k) + 1)) GBAR(k); STAMP((k) + 1); } while (0)
#ifndef PROBE_DUP
#define PROBE_DUP 0
#endif
#define NREP(k) (((PROBE_DUP >> (k)) & 1) ? 2 : 1)

    STAMP(0);
    for (int rep_ = 0; rep_ < NREP(0); ++rep_) {
    if (IN(0)) {
        FRESH_ARGS();
        FRESH_TID();
        if (bx == 0) {
        LAS float* red = (LAS float*)(lds + 131072);
        float mq = 0.f, mk = 0.f, mdq = 0.f, mdk = 0.f, mb = 0.f;
        if (tid < 128) { mq = fabsf(ap->g_na_q[tid]); mk = fabsf(ap->g_na_k[tid]); }
        if (tid < 64) { mdq = fabsf(ap->g_df_q[tid]); mdk = fabsf(ap->g_df_k[tid]); }
        for (int i = tid; i < NA_H * 15 * 31; i += NTHREADS) mb = fmaxf(mb, ap->na_rpb[i]);
        mq = wave_max(mq); mk = wave_max(mk); mdq = wave_max(mdq); mdk = wave_max(mdk); mb = wave_max(mb);
        float d1 = 0.f, d2 = 0.f;
        if (wave == 0) { d1 = wave_sum(ap->lam_q1[lane] * ap->lam_k1[lane]); d2 = wave_sum(ap->lam_q2[lane] * ap->lam_k2[lane]); }
        if (lane == 0) { red[wave * 8 + 0] = mq; red[wave * 8 + 1] = mk; red[wave * 8 + 2] = mdq; red[wave * 8 + 3] = mdk; red[wave * 8 + 4] = mb; red[wave * 8 + 5] = d1; red[wave * 8 + 6] = d2; }
        __syncthreads();
        mq = 0.f; mk = 0.f; mdq = 0.f; mdk = 0.f; mb = 0.f;
#pragma unroll
        for (int w = 0; w < 8; ++w) { mq = fmaxf(mq, red[w * 8]); mk = fmaxf(mk, red[w * 8 + 1]); mdq = fmaxf(mdq, red[w * 8 + 2]); mdk = fmaxf(mdk, red[w * 8 + 3]); mb = fmaxf(mb, red[w * 8 + 4]); }
        if (tid == 0) { float* PARw = (float*)(ws + 3072); PARw[0] = expf(red[5]) - expf(red[6]) + LAM_INIT; PARw[1] = (11.313708498984761f * mq * mk + mb) * LOG2E + 0.125f; PARw[2] = (8.0f * mdq * mdk) * LOG2E + 0.125f; }
        __syncthreads();
        }
        LAS float* scr = (LAS float*)(lds + wave * 16384);
        {
            float cur[32], nxt[32]; P0Item dc, dn;
            int it = gw;
            if (it < N_EARLY) { P0_DECODE(it, dc); p0_item_load(dc, cur, lane); }
            for (; it < N_EARLY; it += NGW) {
                const int nit = it + NGW; const bool more = nit < N_EARLY;
                if (more) { P0_DECODE(nit, dn); p0_item_load(dn, nxt, lane); }
                p0_item_store(dc, cur, scr, lane);
                if (more) { dc = dn;
#pragma unroll
                    for (int i = 0; i < 32; ++i) cur[i] = nxt[i]; }
            }
        }
        for (int m = gw; m < M; m += NGW) {
            const f32x4* xr = (const f32x4*)(ap->x + (size_t)m * D) + lane; const f32x4* gr = (const f32x4*)ap->g_mix + lane;
            f32x4 v[8]; float s = 0.f;
#pragma unroll
            for (int j = 0; j < 8; ++j) { v[j] = __builtin_nontemporal_load(xr + 64 * j); s += (v[j].x * v[j].x + v[j].y * v[j].y) + (v[j].z * v[j].z + v[j].w * v[j].w); }
            const float rs = __builtin_amdgcn_rsqf(wave_sum(s) * (1.0f / D) + EPS);
            u32x2* o8 = (u32x2*)(XN + (size_t)m * D) + lane;
#pragma unroll
            for (int j = 0; j < 8; ++j) { const f32x4 g = gr[64 * j]; u32x2 w; w.x = cvt_pk_bf16(v[j].x * rs * g.x, v[j].y * rs * g.y); w.y = cvt_pk_bf16(v[j].z * rs * g.z, v[j].w * rs * g.w); o8[64 * j] = w; }
        }
        const int gt = vcu * NTHREADS + tid, NGT = G * NTHREADS;
        for (int i = gt; i < M * PLE / 8; i += NGT) { const f32x4 p0 = __builtin_nontemporal_load((const f32x4*)ap->p + 2 * i), p1 = __builtin_nontemporal_load((const f32x4*)ap->p + 2 * i + 1);
            u32x4 w; w.x = cvt_pk_bf16(p0.x, p0.y); w.y = cvt_pk_bf16(p0.z, p0.w); w.z = cvt_pk_bf16(p1.x, p1.y); w.w = cvt_pk_bf16(p1.z, p1.w); ((u32x4*)PB)[i] = w; }
        for (int i = gt; i < SEQ * 32; i += NGT) { const int pos = i >> 5, k = i & 31;
            const float inv = (float)(1.0 / pow(10000.0, (double)k / 32.0)); const float ang = (float)pos * inv;
            f32x2 cs; cs.x = (float)cos((double)ang); cs.y = (float)sin((double)ang); ROPE[i] = cs; }
        for (int i = gt; i < M; i += NGT) { RS1[i] = 0.f; RS2[i] = 0.f; }
    }
    }
    SEAM(0);
    for (int rep_ = 0; rep_ < NREP(1); ++rep_) {
    if (IN(1)) {
        FRESH_ARGS();
        { pg8::Gemm g{XN, W1t, M, NQKG, D}; pg8::StaticOrder S; S.init(M, NQKG, G, bx); pg8::EpiQKG E{QKG, NQKG};
          pg8::gemm_phase<pg8::EpiQKG, pg8::StaticOrder, true, true>(lds, g, S, E); }
        { pg8::Gemm g{W1t + (size_t)NQKG * D, XN, 2048, M, D}; pg8::StaticOrder S; S.init(2048, M, G, bx); pg8::EpiVT E{VT, M};
          pg8::gemm_phase<pg8::EpiVT, pg8::StaticOrder, true, true>(lds, g, S, E); }
    }
    }
    SEAM(1);
    if (IN(2)) {
        FRESH_ARGS();
        FRESH_TID();
        for (int m0 = gw; m0 < M; m0 += 4 * NGW) qknorm_batch<4>(QKG, KCna, KCdf, m0, NGW, ap->g_na_k, ap->g_df_k, ROPE, lane);
    }
    SEAM(2);
    for (int rep_ = 0; rep_ < NREP(3); ++rep_) {
    if (IN(3)) {
        FRESH_ARGS();
        FRESH_TID();
        const float* PAR = (const float*)(ws + 3072);
        const float lam = PAR[0], M2na = PAR[1], M2df = PAR[2];
#ifndef NO_DF
        for (int uu = 2 * vcu; uu < BATCH * DF_H * (SEQ / 128); uu += 2 * G)
            for (int i2 = 0; i2 < 2; ++i2) { const int uidx = uu + i2, bh = uidx >> 5, qb = uidx & 31;
#ifdef PROBE_DFWAIT
                unsigned long long dfw_ = 0;
                df_unit(lds, QKG, KCdf, VT, AO + 1024, ap->g_df_sub, ap->g_df_q, ROPE, lam, M2df, bh >> 3, bh & 7, qb, &dfw_);
                if (bx == 0 && threadIdx.x == 0) { volatile unsigned long long* TS = (volatile unsigned long long*)(ws + 2048); TS[11] = (i2 ? TS[11] : 0ull) + dfw_; TS[12] = 0ull; }
#else
                df_unit(lds, QKG, KCdf, VT, AO + 1024, ap->g_df_sub, ap->g_df_q, ROPE, lam, M2df, bh >> 3, bh & 7, qb);
#endif
            }
#endif
        STAMP(10);
#ifdef PROBE_TS
        if (threadIdx.x == 0) { atomicMax((unsigned long long*)(ws + 2048) + 14, (unsigned long long)__builtin_amdgcn_s_memrealtime()); atomicMin((unsigned long long*)(ws + 2048) + 16, (unsigned long long)__builtin_amdgcn_s_memrealtime()); }
#endif
#ifndef NO_NA
        for (int uidx = vcu; uidx < BATCH * NA_H * (GROWS / 4); uidx += G) {
            const int bh = uidx >> 4, rg = uidx & 15;
            na_unit(lds, QKG, KCna, VT, ap->na_rpb, ap->g_na_q, AO, M2na, bh >> 3, bh & 7, rg * 4);
        }
        STAMP(13);
#ifdef PROBE_TS
        if (threadIdx.x == 0) atomicMax((unsigned long long*)(ws + 2048) + 15, (unsigned long long)__builtin_amdgcn_s_memrealtime());
#endif
#endif
    }
    }
    SEAM(3);
    for (int rep_ = 0; rep_ < NREP(4); ++rep_) {
    if (IN(4)) {
        FRESH_ARGS();
        { pg8::Gemm g{AO, Wna, M, D, 2048, 16}; pg8::PairOrder S; S.S.init(M, D, G, bx); S.kob = 1024 * 2; pg8::EpiMerge E{QKG + QC_GA, QKG + QC_GB, NQKG, MRG, D, 16};
          pg8::gemm_phase<pg8::EpiMerge, pg8::PairOrder, true, true>(lds, g, S, E); }
    }
    }
    SEAM(4);
    if (IN(5)) {
        FRESH_ARGS();
        pg8::Gemm g{MRG, Wo, M, D, D}; pg8::StaticOrder S; S.init(M, D, G, bx); pg8::EpiResid<false> E{ap->x, X1B, RS1, D};
        pg8::gemm_phase<pg8::EpiResid<false>, pg8::StaticOrder, true, true>(lds, g, S, E);
    }
    SEAM(5);
    for (int rep_ = 0; rep_ < NREP(6); ++rep_) {
    if (IN(6)) {
        FRESH_ARGS();
        pg8::Gemm g{X1B, Wgu, M, 2 * FF, D}; pg8::StaticOrder S; S.init(M, 2 * FF, G, bx); pg8::EpiSwiGLU E{RS1, HB, FF, 1.0f / D, EPS};
        pg8::gemm_phase<pg8::EpiSwiGLU, pg8::StaticOrder, true, true>(lds, g, S, E);
        { constexpr int NU6 = (M / 256) * (2 * FF / 256), NU8 = (M / 256) * (D / 256);
          const int rem = NU6 % G, nshort = rem ? G - rem : G;
          pg8::TailOrder T; T.first = (rem == 0) ? bx : (bx >= rem ? bx - rem : -1); T.stride = nshort; T.total = NU8;
          int kple = PLE; asm volatile("" : "+s"(kple));
          pg8::Gemm g2{PB, Wpp, M, D, kple}; pg8::EpiStoreBf16 E2{T2B, D};
          pg8::gemm_phase<pg8::EpiStoreBf16, pg8::TailOrder, true, true>(lds, g2, T, E2);
          if (T.first >= 0) { FRESH_TID();
              LAS float* scr = (LAS float*)(lds + wave * 16384);
              const int sw = ((rem == 0) ? bx : bx - rem) * NWAVES + wave, nsw = nshort * NWAVES;
              float cur[32], nxt[32]; P0Item dc, dn;
              int it = N_EARLY + sw;
              if (it < NITEMS) { P0_DECODE(it, dc); p0_item_load(dc, cur, lane); }
              for (; it < NITEMS; it += nsw) {
                  const int nit = it + nsw; const bool more = nit < NITEMS;
                  if (more) { P0_DECODE(nit, dn); p0_item_load(dn, nxt, lane); }
                  p0_item_store(dc, cur, scr, lane);
                  if (more) { dc = dn;
#pragma unroll
                      for (int i = 0; i < 32; ++i) cur[i] = nxt[i]; }
              } } }
    }
    }
    SEAM(6);
    if (IN(7)) {
        FRESH_ARGS();
        pg8::Gemm g{HB, Wdn, M, D, FF}; pg8::StaticOrder S; S.init(M, D, G, bx); pg8::EpiResid<true> E{X1B, X2B, RS2, D};
        pg8::gemm_phase<pg8::EpiResid<true>, pg8::StaticOrder, true, true>(lds, g, S, E);
    }
    SEAM(7);
    if (IN(8)) {
        FRESH_ARGS();
#ifndef NO_P8B
        { pg8::Gemm g{X2B, Wpg, M, D, D}; pg8::StaticOrder S; S.init(M, D, G, bx); pg8::EpiPle E{RS2, T2B, X2B, ap->out, D, 1.0f / D, EPS};
          pg8::gemm_phase<pg8::EpiPle, pg8::StaticOrder, true, true>(lds, g, S, E); }
#endif
    }
#ifdef PROBE_TS
    STAMP(9);
    GBAR(8);
    { const unsigned long long* TS = (const unsigned long long*)(ws + 2048);
      const unsigned long long ta = __hip_atomic_load(TS + PROBE_A, __ATOMIC_RELAXED, __HIP_MEMORY_SCOPE_AGENT), tb = __hip_atomic_load(TS + PROBE_B, __ATOMIC_RELAXED, __HIP_MEMORY_SCOPE_AGENT);
      const int K = PROBE_CONST ? PROBE_CONST : (int)((tb - ta) / 8);
      FRESH_ARGS();
      for (int i = vcu * NTHREADS + (int)threadIdx.x; i < K && i < 42000; i += G * NTHREADS) ap->out[(size_t)i * 397] += 0.125f; }
#endif
#undef IN
#undef SEAM
}

#ifndef MK_SPLIT
#define MK_SPLIT 0
#endif
extern "C" void kernel_launch(void* const* d_in, const int* in_sizes, int n_in, void* d_out, int out_size, void* d_ws, size_t ws_size, hipStream_t stream) {
    static int grid = 0;
    if (grid == 0) {
        if (n_in != 24 || in_sizes[0] != M * D || out_size != M * D || ws_size < WS_END) { fprintf(stderr, "kernel_launch: unexpected shapes (n_in %d, in0 %d, out %d, ws %zu); nothing launched\n", n_in, n_in > 0 ? in_sizes[0] : -1, out_size, ws_size); grid = -1; return; }
        int dev = 0, cus = 0, per_cu = 0;
        hipGetDevice(&dev); hipDeviceGetAttribute(&cus, hipDeviceAttributeMultiprocessorCount, dev);
        hipFuncSetAttribute((const void*)fwd_megakernel, hipFuncAttributeMaxDynamicSharedMemorySize, LDS_BYTES);
        hipOccupancyMaxActiveBlocksPerMultiprocessor(&per_cu, (const void*)fwd_megakernel, NTHREADS, LDS_BYTES);
        if (per_cu < 1) per_cu = 1;
        grid = cus * per_cu;
        (void)hipGetLastError();
    }
    if (grid < 0) return;
    Args a{};
    const float** ap = (const float**)&a;
    for (int i = 0; i < 24; ++i) ap[i] = (const float*)d_in[i];
    a.out = (float*)d_out; a.ws = (unsigned char*)d_ws; a.rep3 = NREP(3); a.pad = 0;
#if MK_SPLIT
    for (int ph = 0; ph < NPHASE; ++ph) { a.ph_lo = ph; a.ph_hi = ph + 1; hipLaunchKernelGGL(fwd_megakernel, dim3(grid), dim3(NTHREADS), LDS_BYTES, stream, a); }
#else
    a.ph_lo = 0; a.ph_hi = NPHASE;
    (void)hipMemsetAsync((unsigned char*)d_ws + 4096, 0, 20480, stream);
#ifdef PROBE_TS
    (void)hipMemsetAsync((unsigned char*)d_ws + 2048 + 14 * 8, 0, 16, stream); (void)hipMemsetAsync((unsigned char*)d_ws + 2048 + 16 * 8, 0x7f, 8, stream);
#endif
    void* args[] = {&a};
    hipError_t e = hipLaunchCooperativeKernel((const void*)fwd_megakernel, dim3(grid), dim3(NTHREADS), args, LDS_BYTES, stream);
    if (e != hipSuccess) fprintf(stderr, "cooperative launch failed: %s (grid %d)\n", hipGetErrorString(e), grid);
#endif
}
```

```cpp
#include <hip/hip_runtime.h>
#include <hip/hip_cooperative_groups.h>
#include <cstdio>
#include <cstdint>
namespace cg = cooperative_groups;
namespace pg8 {
#define PG8_LAS __attribute__((address_space(3)))
typedef unsigned short bf16_t;
typedef short bf16x8 __attribute__((ext_vector_type(8)));
typedef float f32x4 __attribute__((ext_vector_type(4)));
typedef unsigned u32x4 __attribute__((ext_vector_type(4)));
constexpr int BM = 256, BK = 64, HALF = 128, HTB = HALF * BK * 2  , STAGE_BYTES = 8 * HTB, NXCD = 8, WGM = 8;

__host__ __device__ __forceinline__ int lds_byte(int r, int c) { const int st = (r >> 4) * 2 + (c >> 5), rr = r & 15, cc = c & 31, ob = rr * 64 + cc * 2; return st * 1024 + (ob ^ (((ob >> 9) & 1) << 5)); }
__host__ __device__ __forceinline__ void stage_rc(int b, int& R, int& C) { const int st = b / 1024, sb = b % 1024, swz = sb ^ (((sb >> 9) & 1) << 5); R = (st >> 1) * 16 + swz / 64; C = (st & 1) * 32 + (swz % 64) / 2; }
__host__ __device__ __forceinline__ int perm32(int rho) { const int n = rho >> 4, i = rho & 15; return 8 * (i >> 2) + 4 * n + (i & 3); }

struct Unit { int pm, pn; int ko = 0; };
struct Gemm { const bf16_t* A; const bf16_t* Bt; int M, N, K; int nt = 0; };

struct StaticOrder {
    int nM, nN, nwg, G, c;
    __host__ __device__ void init(int M, int N, int G_, int c_) { nM = M / BM; nN = N / BM; nwg = nM * nN; G = G_; c = c_; }
    __host__ __device__ bool next(int i, Unit& u) const {
        const long L = (long)i * G + c; if (L >= nwg) return false;
        int wgid = (int)L; { const int q = nwg / NXCD, r = nwg % NXCD, xcd = wgid % NXCD, off = wgid / NXCD; wgid = (xcd < r ? xcd * (q + 1) : r * (q + 1) + (xcd - r) * q) + off; }
        const int nig = WGM * nN, gid = wgid / nig, fm = gid * WGM, gsz = (nM - fm) < WGM ? (nM - fm) : WGM;
        u.pm = fm + ((wgid % nig) % gsz); u.pn = (wgid % nig) / gsz; return true;
    }
    __device__ __forceinline__ void a_ready(const Unit&) const {}
    __device__ __forceinline__ void done(const Unit&) const {}
};


struct TailOrder {
    int first, stride, total;
    __host__ __device__ bool next(int i, Unit& u) const { if (first < 0) return false; const int j = first + i * stride; if (j >= total) return false; u.pm = j >> 3; u.pn = j & 7; return true; }
    __device__ __forceinline__ void a_ready(const Unit&) const {}
    __device__ __forceinline__ void done(const Unit&) const {}
};

struct PairOrder {
    StaticOrder S; int kob;
    __host__ __device__ bool next(int i, Unit& u) const { if (!S.next(i >> 1, u)) return false; u.ko = (i & 1) * kob; return true; }
    __device__ __forceinline__ void a_ready(const Unit&) const {}
    __device__ __forceinline__ void done(const Unit&) const {}
};
__device__ __forceinline__ unsigned cvt_pk_bf16(float lo, float hi) { unsigned r; asm volatile("v_cvt_pk_bf16_f32 %0, %1, %2" : "=v"(r) : "v"(lo), "v"(hi)); return r; }
__device__ __forceinline__ float bf_lo(unsigned w) { return __uint_as_float(w << 16); }
__device__ __forceinline__ float bf_hi(unsigned w) { return __uint_as_float(w & 0xffff0000u); }
__device__ __forceinline__ float sigmoidf_(float x) { return __builtin_amdgcn_rcpf(1.0f + __expf(-x)); }
typedef unsigned u32x2 __attribute__((ext_vector_type(2)));
#define EPI_FENCE() asm volatile("" ::: "memory")
#define EPI_ROWS(...) _Pragma("unroll") for (int ai = 0; ai < 2; ++ai) _Pragma("unroll") for (int m = 0; m < 4; ++m) { const int row = u.pm * BM + ai * HALF + wr * 64 + m * 16 + fr; __VA_ARGS__ }

struct EpiQKG {
    static constexpr bool PERM = true, AFTER_DRAIN = false, MIDK = false;
    bf16_t* O; int ldc;
    __device__ __forceinline__ void operator()(const f32x4 (&acc)[2][2][4][2], const Unit& u, int wr, int wc, int fr, int fq) const {
        const bool gate = u.pn >= 16; const int col0 = u.pn * BM + wc * 32 + 8 * fq;
        EPI_ROWS(
            bf16_t* rowp = O + (size_t)row * ldc + col0;
            _Pragma("unroll") for (int bj = 0; bj < 2; ++bj) { f32x4 v0 = acc[ai][bj][m][0], v1 = acc[ai][bj][m][1];
                if (gate) { _Pragma("unroll") for (int j = 0; j < 4; ++j) { v0[j] = sigmoidf_(v0[j]); v1[j] = sigmoidf_(v1[j]); } }
                u32x4 w; w.x = cvt_pk_bf16(v0[0], v0[1]); w.y = cvt_pk_bf16(v0[2], v0[3]); w.z = cvt_pk_bf16(v1[0], v1[1]); w.w = cvt_pk_bf16(v1[2], v1[3]);
                *(u32x4*)(rowp + bj * HALF) = w; }
            EPI_FENCE();
        )
    }
};
struct EpiVT {
    static constexpr bool PERM = true, AFTER_DRAIN = false, MIDK = false;
    bf16_t* O; int ldc;
    __device__ __forceinline__ void operator()(const f32x4 (&acc)[2][2][4][2], const Unit& u, int wr, int wc, int fr, int fq) const {
        const int cbase = u.pn * BM + wc * 32 + 16 * (fq >> 1) + 4 * (fq & 1);
        EPI_ROWS(
            const int hv = row >> 7, dd = row & 127;
            _Pragma("unroll") for (int bj = 0; bj < 2; ++bj) _Pragma("unroll") for (int n = 0; n < 2; ++n) { const f32x4 v = acc[ai][bj][m][n];
                const int col = cbase + bj * HALF + 8 * n, bb = col >> 12, kt = (col >> 6) & 63, pos = col & 63;
                u32x2 w; w.x = cvt_pk_bf16(v[0], v[1]); w.y = cvt_pk_bf16(v[2], v[3]);
                *(u32x2*)(O + ((((size_t)(bb * 16 + hv)) * 64 + kt) * 128 + dd) * 64 + pos) = w; }
            EPI_FENCE();
        )
    }
};
struct EpiMerge {
    static constexpr bool PERM = true, AFTER_DRAIN = false, MIDK = true;
    const bf16_t* GA; const bf16_t* GB; int ldg; bf16_t* O; int ldc; int midk;
    __device__ __forceinline__ void mid(f32x4 (&acc)[2][2][4][2], const Unit& u, int wr, int wc, int fr, int fq) const {
        const int col0 = u.pn * BM + wc * 32 + 8 * fq;
        EPI_ROWS(
            _Pragma("unroll") for (int bj = 0; bj < 2; ++bj) { const size_t off = (size_t)row * ldg + col0 + bj * HALF;
                const u32x4 a = *(const u32x4*)(GA + off), b = *(const u32x4*)(GB + off);
                float r[8];
                r[0] = bf_lo(a.x) * __builtin_amdgcn_rcpf(fmaxf(bf_lo(b.x), 1e-30f)); r[1] = bf_hi(a.x) * __builtin_amdgcn_rcpf(fmaxf(bf_hi(b.x), 1e-30f));
                r[2] = bf_lo(a.y) * __builtin_amdgcn_rcpf(fmaxf(bf_lo(b.y), 1e-30f)); r[3] = bf_hi(a.y) * __builtin_amdgcn_rcpf(fmaxf(bf_hi(b.y), 1e-30f));
                r[4] = bf_lo(a.z) * __builtin_amdgcn_rcpf(fmaxf(bf_lo(b.z), 1e-30f)); r[5] = bf_hi(a.z) * __builtin_amdgcn_rcpf(fmaxf(bf_hi(b.z), 1e-30f));
                r[6] = bf_lo(a.w) * __builtin_amdgcn_rcpf(fmaxf(bf_lo(b.w), 1e-30f)); r[7] = bf_hi(a.w) * __builtin_amdgcn_rcpf(fmaxf(bf_hi(b.w), 1e-30f));
                _Pragma("unroll") for (int j = 0; j < 4; ++j) { acc[ai][bj][m][0][j] *= r[j]; acc[ai][bj][m][1][j] *= r[4 + j]; } }
            EPI_FENCE();
        )
    }
    __device__ __forceinline__ void operator()(const f32x4 (&acc)[2][2][4][2], const Unit& u, int wr, int wc, int fr, int fq) const {
        const int col0 = u.pn * BM + wc * 32 + 8 * fq;
        EPI_ROWS(
            _Pragma("unroll") for (int bj = 0; bj < 2; ++bj) { const u32x4 b = *(const u32x4*)(GB + (size_t)row * ldg + col0 + bj * HALF);
                f32x4 v0 = acc[ai][bj][m][0], v1 = acc[ai][bj][m][1];
                v0[0] *= fmaxf(bf_lo(b.x), 1e-30f); v0[1] *= fmaxf(bf_hi(b.x), 1e-30f); v0[2] *= fmaxf(bf_lo(b.y), 1e-30f); v0[3] *= fmaxf(bf_hi(b.y), 1e-30f);
                v1[0] *= fmaxf(bf_lo(b.z), 1e-30f); v1[1] *= fmaxf(bf_hi(b.z), 1e-30f); v1[2] *= fmaxf(bf_lo(b.w), 1e-30f); v1[3] *= fmaxf(bf_hi(b.w), 1e-30f);
                u32x4 w; w.x = cvt_pk_bf16(v0[0], v0[1]); w.y = cvt_pk_bf16(v0[2], v0[3]); w.z = cvt_pk_bf16(v1[0], v1[1]); w.w = cvt_pk_bf16(v1[2], v1[3]);
                *(u32x4*)(O + (size_t)row * ldc + col0 + bj * HALF) = w; }
            EPI_FENCE();
        )
    }
};
template <bool BASE_BF16> struct EpiResid {
    static constexpr bool PERM = true, AFTER_DRAIN = false, MIDK = false;
    const void* base; bf16_t* ob; float* rowss; int ldc;
    __device__ __forceinline__ void operator()(const f32x4 (&acc)[2][2][4][2], const Unit& u, int wr, int wc, int fr, int fq) const {
        const int col0 = u.pn * BM + wc * 32 + 8 * fq;
        EPI_ROWS(
            float ss = 0.f;
            _Pragma("unroll") for (int bj = 0; bj < 2; ++bj) { const size_t off = (size_t)row * ldc + col0 + bj * HALF;
                f32x4 b0, b1;
                if (BASE_BF16) { const u32x4 bw = *(const u32x4*)((const bf16_t*)base + off); b0 = (f32x4){bf_lo(bw.x), bf_hi(bw.x), bf_lo(bw.y), bf_hi(bw.y)}; b1 = (f32x4){bf_lo(bw.z), bf_hi(bw.z), bf_lo(bw.w), bf_hi(bw.w)}; }
                else { b0 = __builtin_nontemporal_load((const f32x4*)((const float*)base + off)); b1 = __builtin_nontemporal_load((const f32x4*)((const float*)base + off + 4)); }
                const f32x4 v0 = acc[ai][bj][m][0] + b0, v1 = acc[ai][bj][m][1] + b1;
                ss += (v0[0] * v0[0] + v0[1] * v0[1]) + (v0[2] * v0[2] + v0[3] * v0[3]) + (v1[0] * v1[0] + v1[1] * v1[1]) + (v1[2] * v1[2] + v1[3] * v1[3]);
                u32x4 w; w.x = cvt_pk_bf16(v0[0], v0[1]); w.y = cvt_pk_bf16(v0[2], v0[3]); w.z = cvt_pk_bf16(v1[0], v1[1]); w.w = cvt_pk_bf16(v1[2], v1[3]);
                *(u32x4*)(ob + off) = w; }
            ss += __shfl_xor(ss, 16); ss += __shfl_xor(ss, 32);
            if (fq == 0) atomicAdd(rowss + row, ss);
            EPI_FENCE();
        )
    }
};
struct EpiSwiGLU {
    static constexpr bool PERM = true, AFTER_DRAIN = false, MIDK = false;
    const float* rowss; bf16_t* H; int ldh; float inv_d, eps;
    __device__ __forceinline__ void operator()(const f32x4 (&acc)[2][2][4][2], const Unit& u, int wr, int wc, int fr, int fq) const {
        const int col0 = u.pn * HALF + wc * 32 + 8 * fq;
        EPI_ROWS(
            const float rs = __builtin_amdgcn_rsqf(rowss[row] * inv_d + eps);
            float hv[8];
            _Pragma("unroll") for (int n = 0; n < 2; ++n) _Pragma("unroll") for (int j = 0; j < 4; ++j) { const float g = acc[ai][0][m][n][j] * rs, up = acc[ai][1][m][n][j] * rs; hv[n * 4 + j] = g * sigmoidf_(g) * up; }
            u32x4 w; w.x = cvt_pk_bf16(hv[0], hv[1]); w.y = cvt_pk_bf16(hv[2], hv[3]); w.z = cvt_pk_bf16(hv[4], hv[5]); w.w = cvt_pk_bf16(hv[6], hv[7]);
            *(u32x4*)(H + (size_t)row * ldh + col0) = w;
            EPI_FENCE();
        )
    }
};
struct EpiStoreBf16 {
    static constexpr bool PERM = true, AFTER_DRAIN = false, MIDK = false;
    bf16_t* T; int ldc;
    __device__ __forceinline__ void operator()(const f32x4 (&acc)[2][2][4][2], const Unit& u, int wr, int wc, int fr, int fq) const {
        const int col0 = u.pn * BM + wc * 32 + 8 * fq;
        EPI_ROWS(
            _Pragma("unroll") for (int bj = 0; bj < 2; ++bj) { const f32x4 v0 = acc[ai][bj][m][0], v1 = acc[ai][bj][m][1];
                u32x4 w; w.x = cvt_pk_bf16(v0[0], v0[1]); w.y = cvt_pk_bf16(v0[2], v0[3]); w.z = cvt_pk_bf16(v1[0], v1[1]); w.w = cvt_pk_bf16(v1[2], v1[3]);
                *(u32x4*)(T + (size_t)row * ldc + col0 + bj * HALF) = w; }
            EPI_FENCE();
        )
    }
};
struct EpiPle {
    static constexpr bool PERM = true, AFTER_DRAIN = false, MIDK = false;
    const float* rowss; const bf16_t* T; const bf16_t* X; float* out; int ldc; float inv_d, eps;
    __device__ __forceinline__ void operator()(const f32x4 (&acc)[2][2][4][2], const Unit& u, int wr, int wc, int fr, int fq) const {
        const int col0 = u.pn * BM + wc * 32 + 8 * fq;
        EPI_ROWS(
            const float rs = __builtin_amdgcn_rsqf(rowss[row] * inv_d + eps);
            _Pragma("unroll") for (int bj = 0; bj < 2; ++bj) { const size_t off = (size_t)row * ldc + col0 + bj * HALF;
                const u32x4 tw = *(const u32x4*)(T + off), xw = *(const u32x4*)(X + off);
                const float t[8] = {bf_lo(tw.x), bf_hi(tw.x), bf_lo(tw.y), bf_hi(tw.y), bf_lo(tw.z), bf_hi(tw.z), bf_lo(tw.w), bf_hi(tw.w)};
                const float x[8] = {bf_lo(xw.x), bf_hi(xw.x), bf_lo(xw.y), bf_hi(xw.y), bf_lo(xw.z), bf_hi(xw.z), bf_lo(xw.w), bf_hi(xw.w)};
                f32x4 o0, o1;
                _Pragma("unroll") for (int j = 0; j < 4; ++j) { o0[j] = x[j] + sigmoidf_(acc[ai][bj][m][0][j] * rs) * t[j]; o1[j] = x[4 + j] + sigmoidf_(acc[ai][bj][m][1][j] * rs) * t[4 + j]; }
                __builtin_nontemporal_store(o0, (f32x4*)(out + off)); __builtin_nontemporal_store(o1, (f32x4*)(out + off + 4)); }
            EPI_FENCE();
        )
    }
};
template <class Epi, class Sched, bool ALIGN_EPI = false, bool SP2 = false>
__device__ __forceinline__ void gemm_phase(PG8_LAS unsigned char* lds, const Gemm g, const Sched& S, const Epi& E) {
    int tid_ = threadIdx.x; asm volatile("" : "+v"(tid_));
    const int tid = tid_, wid = __builtin_amdgcn_readfirstlane(tid >> 6), lane = tid & 63, wr = wid >> 2, wc = wid & 3, fr = lane & 15, fq = lane >> 4;
    const int K = g.K, nt = g.nt ? g.nt : K / BK;
    unsigned voffA[2], voffB[2];
#pragma unroll
    for (int i = 0; i < 2; ++i) { int R, C; stage_rc(tid * 16 + i * 8192, R, C); const int Rb = Epi::PERM ? ((R & ~31) + perm32(R & 31)) : R;
        voffA[i] = (unsigned)(R * K + C) * 2u; voffB[i] = (unsigned)(Rb * K + C) * 2u; }
    const size_t kstep = (size_t)(BK * 2);
    const size_t hstep = (size_t)HALF * K * 2;
    const size_t tstep = 2 * hstep;
    const unsigned ldsw = (unsigned)wid * 1024u;
    const int aoff = lds_byte(wr * 64 + fr, fq * 8), boff = lds_byte(wc * 32 + fr, fq * 8);
#define PG8_SA(b, h) (((b) * 2 + (h)) * HTB)
#define PG8_SB(b, h) ((4 + (b) * 2 + (h)) * HTB)
#define PG8_STAGE(bufoff, gbase, voff) do { _Pragma("unroll") for (int _i = 0; _i < 2; ++_i) \
        __builtin_amdgcn_global_load_lds((const unsigned*)((const char*)(gbase) + (voff)[_i]), (PG8_LAS unsigned*)(lds + (bufoff) + ldsw + _i * 8192), 16, 0, 0); } while (0)
#define PG8_LDA(dst, b, h) do { _Pragma("unroll") for (int m = 0; m < 4; ++m) _Pragma("unroll") for (int k = 0; k < 2; ++k) dst[m][k] = *(const PG8_LAS bf16x8*)(lds + PG8_SA(b, h) + aoff + m * 2048 + k * 1024); } while (0)
#define PG8_LDB(dst, b, h) do { _Pragma("unroll") for (int n = 0; n < 2; ++n) _Pragma("unroll") for (int k = 0; k < 2; ++k) dst[n][k] = *(const PG8_LAS bf16x8*)(lds + PG8_SB(b, h) + boff + n * 2048 + k * 1024); } while (0)
#define PG8_MMA(ai, bj, At, Bt) do { __builtin_amdgcn_s_setprio(1); _Pragma("unroll") for (int m = 0; m < 4; ++m) _Pragma("unroll") for (int n = 0; n < 2; ++n) _Pragma("unroll") for (int k = 0; k < 2; ++k) \
        acc[ai][bj][m][n] = __builtin_amdgcn_mfma_f32_16x16x32_bf16(Bt[n][k], At[m][k], acc[ai][bj][m][n], 0, 0, 0); __builtin_amdgcn_s_setprio(0); } while (0)
#define PG8_WAIT_V(n) asm volatile("s_waitcnt vmcnt(" #n ")" ::: "memory")
#define PG8_WAIT_L(n) asm volatile("s_waitcnt lgkmcnt(" #n ")" ::: "memory")
#define PG8_BAR __builtin_amdgcn_s_barrier()
#define PG8_SCHED __builtin_amdgcn_sched_barrier(0)
    Unit cur, nxt; int ui = 0;
    if (!S.next(0, cur)) return;
    f32x4 acc[2][2][4][2];
#pragma unroll
    for (int a = 0; a < 2; ++a)
#pragma unroll
        for (int b = 0; b < 2; ++b)
#pragma unroll
            for (int m = 0; m < 4; ++m)
#pragma unroll
                for (int n = 0; n < 2; ++n) acc[a][b][m][n] = (f32x4){0.f, 0.f, 0.f, 0.f};
    bf16x8 At[4][2], B0[2][2], B1[2][2];
    const char* cA = (const char*)g.A + (size_t)cur.pm * tstep + cur.ko; const char* cB = (const char*)g.Bt + (size_t)cur.pn * tstep + cur.ko;
    S.a_ready(cur);
    if constexpr (SP2) {
        PG8_STAGE(PG8_SB(0, 0), cB, voffB); PG8_STAGE(PG8_SB(0, 1), cB + hstep, voffB); PG8_STAGE(PG8_SA(0, 0), cA, voffA); PG8_STAGE(PG8_SA(0, 1), cA + hstep, voffA);
        if (wr == 1) PG8_BAR;
        PG8_WAIT_V(2); PG8_BAR;
        PG8_STAGE(PG8_SB(1, 0), cB + kstep, voffB); PG8_STAGE(PG8_SA(1, 0), cA + kstep, voffA); PG8_STAGE(PG8_SB(1, 1), cB + hstep + kstep, voffB);
        PG8_WAIT_V(6); PG8_BAR;
    } else {
        PG8_STAGE(PG8_SB(0, 0), cB, voffB); PG8_STAGE(PG8_SA(0, 0), cA, voffA); PG8_STAGE(PG8_SB(0, 1), cB + hstep, voffB); PG8_STAGE(PG8_SA(0, 1), cA + hstep, voffA);
        if (wr == 1) PG8_BAR;
        PG8_WAIT_V(4); PG8_BAR;
        PG8_STAGE(PG8_SB(1, 0), cB + kstep, voffB); PG8_STAGE(PG8_SA(1, 0), cA + kstep, voffA); PG8_STAGE(PG8_SB(1, 1), cB + hstep + kstep, voffB);
        PG8_WAIT_V(6); PG8_BAR;
    }
    for (;;) {
        const bool has_next = S.next(ui + 1, nxt);
        const char* nA = has_next ? (const char*)g.A + (size_t)nxt.pm * tstep + nxt.ko : cA; const char* nB = has_next ? (const char*)g.Bt + (size_t)nxt.pn * tstep + nxt.ko : cB;
        for (int t = 0; t < nt; t += 2) {
            const bool last = (t == nt - 2);
            const char* a1 = cA + (size_t)(t + 1) * kstep;
            const char* a2 = last ? nA : cA + (size_t)(t + 2) * kstep; const char* b2 = last ? nB : cB + (size_t)(t + 2) * kstep;
            const char* a3 = a2 + kstep; const char* b3 = b2 + kstep;
            if (last && has_next) S.a_ready(nxt);
            if constexpr (SP2) {
            PG8_LDB(B0, 0, 0); PG8_LDB(B1, 0, 1); PG8_SCHED; PG8_LDA(At, 0, 0); PG8_STAGE(PG8_SA(1, 1), a1 + hstep, voffA);
            PG8_WAIT_V(8); PG8_WAIT_L(0); PG8_BAR; PG8_MMA(0, 0, At, B0); PG8_MMA(0, 1, At, B1); PG8_BAR; PG8_SCHED;
            PG8_LDA(At, 0, 1); PG8_STAGE(PG8_SB(0, 0), b2, voffB); PG8_STAGE(PG8_SB(0, 1), b2 + hstep, voffB); PG8_STAGE(PG8_SA(0, 0), a2, voffA);
            PG8_WAIT_V(8); PG8_WAIT_L(0); PG8_BAR; PG8_MMA(1, 0, At, B0); PG8_MMA(1, 1, At, B1); PG8_BAR; PG8_SCHED;
            PG8_LDB(B0, 1, 0); PG8_LDB(B1, 1, 1); PG8_SCHED; PG8_LDA(At, 1, 0); PG8_STAGE(PG8_SA(0, 1), a2 + hstep, voffA);
            PG8_WAIT_V(8); PG8_WAIT_L(0); PG8_BAR; PG8_MMA(0, 0, At, B0); PG8_MMA(0, 1, At, B1); PG8_BAR; PG8_SCHED;
            PG8_LDA(At, 1, 1); PG8_STAGE(PG8_SB(1, 0), b3, voffB); PG8_STAGE(PG8_SB(1, 1), b3 + hstep, voffB); PG8_STAGE(PG8_SA(1, 0), a3, voffA);
            PG8_WAIT_V(8); PG8_WAIT_L(0); PG8_BAR; PG8_MMA(1, 0, At, B0); PG8_MMA(1, 1, At, B1); PG8_BAR; PG8_SCHED;
            } else {
            PG8_LDB(B0, 0, 0); PG8_SCHED; PG8_LDA(At, 0, 0); PG8_STAGE(PG8_SA(1, 1), a1 + hstep, voffA);
            PG8_WAIT_L(8); PG8_BAR; PG8_WAIT_L(0); PG8_MMA(0, 0, At, B0); PG8_BAR; PG8_SCHED;
            PG8_LDB(B1, 0, 1); PG8_STAGE(PG8_SB(0, 0), b2, voffB);
            PG8_BAR; PG8_WAIT_L(0); PG8_MMA(0, 1, At, B1); PG8_BAR;
            PG8_LDA(At, 0, 1); PG8_STAGE(PG8_SA(0, 0), a2, voffA);
            PG8_BAR; PG8_WAIT_L(0); PG8_MMA(1, 0, At, B0); PG8_BAR; PG8_SCHED;
            PG8_STAGE(PG8_SB(0, 1), b2 + hstep, voffB);
            PG8_WAIT_V(6); PG8_BAR; PG8_MMA(1, 1, At, B1); PG8_BAR;
            PG8_LDB(B0, 1, 0); PG8_SCHED; PG8_LDA(At, 1, 0); PG8_STAGE(PG8_SA(0, 1), a2 + hstep, voffA);
            PG8_WAIT_L(8); PG8_BAR; PG8_WAIT_L(0); PG8_MMA(0, 0, At, B0); PG8_BAR; PG8_SCHED;
            PG8_LDB(B1, 1, 1); PG8_STAGE(PG8_SB(1, 0), b3, voffB);
            PG8_BAR; PG8_WAIT_L(0); PG8_MMA(0, 1, At, B1); PG8_BAR;
            PG8_LDA(At, 1, 1); PG8_STAGE(PG8_SA(1, 0), a3, voffA);
            PG8_BAR; PG8_WAIT_L(0); PG8_MMA(1, 0, At, B0); PG8_BAR; PG8_SCHED;
            PG8_STAGE(PG8_SB(1, 1), b3 + hstep, voffB);
            PG8_WAIT_V(6); PG8_BAR; PG8_MMA(1, 1, At, B1); PG8_BAR;
            }
        }
        if constexpr (ALIGN_EPI) { if (wr == 0) PG8_BAR; }
        bool keep_acc = false;
        if constexpr (Epi::MIDK) { if (cur.ko == 0) { E.mid(acc, cur, wr, wc, fr, fq); keep_acc = true; } else E(acc, cur, wr, wc, fr, fq); }
        else if constexpr (!Epi::AFTER_DRAIN) { E(acc, cur, wr, wc, fr, fq); S.done(cur); }
        if (!has_next) break;
        if (!keep_acc) {
#pragma unroll
        for (int a = 0; a < 2; ++a)
#pragma unroll
            for (int b = 0; b < 2; ++b)
#pragma unroll
                for (int m = 0; m < 4; ++m)
#pragma unroll
                    for (int n = 0; n < 2; ++n) acc[a][b][m][n] = (f32x4){0.f, 0.f, 0.f, 0.f};
        }
        cur = nxt; cA = nA; cB = nB; ++ui;
        if constexpr (ALIGN_EPI) { if (wr == 1) PG8_BAR; }
    }
    PG8_WAIT_V(0);
    if constexpr (!ALIGN_EPI) { if (wr == 0) PG8_BAR; }
    PG8_BAR;
    if constexpr (Epi::AFTER_DRAIN) { E.fused(acc, cur, wr, wc, fr, fq, lds, wid, lane); S.done(cur); }
#undef PG8_SA
#undef PG8_SB
#undef PG8_STAGE
#undef PG8_LDA
#undef PG8_LDB
#undef PG8_MMA
#undef PG8_WAIT_V
#undef PG8_WAIT_L
#undef PG8_BAR
#undef PG8_SCHED
}
}
constexpr int D = 2048, BATCH = 2, SEQ = 4096, M = BATCH * SEQ, GW = 64, GROWS = SEQ / GW, FF = 5632, PLE = 256;
constexpr int NA_H = 8, NA_DH = 128, DF_H = 8, DF_DQ = 64, DF_DV = 128;
constexpr int NQKG = 8192;
constexpr int QC_NAQ = 0, QC_NAK = 1024, QC_DFQ = 2048, QC_DFK = 3072, QC_GA = 4096, QC_GB = 6144;
constexpr float EPS = 1e-6f, LOG2E = 1.4426950408889634f;
constexpr float LAM_INIT = 0.2f;
constexpr int NWAVES = 8, NTHREADS = 512;
constexpr size_t MiB = 1u << 20;
constexpr size_t WS_RS1 = 64 * 1024, WS_RS2 = 128 * 1024, WS_ROPE = 1 * MiB;
constexpr size_t WS_W1 = 2 * MiB, WS_WNA = 42 * MiB, WS_WDF = 46 * MiB, WS_WO = 50 * MiB, WS_WGU = 58 * MiB, WS_WDN = 102 * MiB, WS_WPG = 124 * MiB, WS_WPP = 132 * MiB;
constexpr size_t WS_A = 133 * MiB;
constexpr size_t WS_B = 261 * MiB;
constexpr size_t WS_C = 293 * MiB;
constexpr size_t WS_PB = 325 * MiB;
constexpr size_t WS_END = 329 * MiB;
constexpr int LDS_BYTES = 147456;
#define LAS __attribute__((address_space(3)))
typedef unsigned short bf16;
typedef unsigned u32x4 __attribute__((ext_vector_type(4)));
typedef unsigned u32x2 __attribute__((ext_vector_type(2)));
typedef float f32x4 __attribute__((ext_vector_type(4)));
typedef float f32x2 __attribute__((ext_vector_type(2)));
typedef float f32x16 __attribute__((ext_vector_type(16)));
typedef short bf16x8 __attribute__((ext_vector_type(8)));
using pg8::cvt_pk_bf16; using pg8::bf_lo; using pg8::bf_hi;

__device__ __forceinline__ float wave_sum(float v) {
#pragma unroll
    for (int o = 1; o < 64; o <<= 1) v += __shfl_xor(v, o);
    return v;
}
__device__ __forceinline__ float wave_max(float v) {
#pragma unroll
    for (int o = 1; o < 64; o <<= 1) v = fmaxf(v, __shfl_xor(v, o));
    return v;
}
__device__ __forceinline__ int crow(int r, int hi) { return (r & 3) + 8 * (r >> 2) + 4 * hi; }

__device__ __forceinline__ int rowmap(int mode, int n0) {
    if (mode == 0) return n0;
    if (mode == 1) {
        if (n0 < 2048) return n0;
        if (n0 < 3072) return 8192 + (n0 - 2048);
        if (n0 < 4096) return 2048 + (n0 - 3072);
        if (n0 < 5120) return 3072 + (n0 - 4096);
        if (n0 < 6144) return 9216 + (n0 - 5120);
        return 4096 + (n0 - 6144);
    }
    return 256 * (n0 >> 7) + (n0 & 127) + (mode == 3 ? 128 : 0);
}
struct P0Item { const float* W; bf16* WT; const float* gk; int K, N, mode, item, Kd, kofs; };
__device__ __forceinline__ void p0_item_load(const P0Item& d, float (&v)[32], int lane) {
    const int nblk = d.N / 32, kb = d.item / nblk, nb = d.item % nblk, k0 = 64 * kb, n0 = 32 * nb;
    const float* src = d.W + (size_t)(k0 + (lane >> 5)) * d.N + n0 + (lane & 31);
#pragma unroll
    for (int i = 0; i < 32; ++i) v[i] = __builtin_nontemporal_load(src + (size_t)(2 * i) * d.N);
}
__device__ __forceinline__ void p0_item_store(const P0Item& d, const float (&v)[32], LAS float* scr, int lane) {
    const int nblk = d.N / 32, kb = d.item / nblk, nb = d.item % nblk, k0 = 64 * kb, n0 = 32 * nb;
    const int r0 = rowmap(d.mode, n0);
    if (d.gk) {
#pragma unroll
        for (int i = 0; i < 32; ++i) { const int kk = 2 * i + (lane >> 5); scr[kk * 33 + (lane & 31)] = v[i] * d.gk[k0 + kk]; }
    } else {
#pragma unroll
        for (int i = 0; i < 32; ++i) { const int kk = 2 * i + (lane >> 5); scr[kk * 33 + (lane & 31)] = v[i]; }
    }
    asm volatile("s_waitcnt lgkmcnt(0)" ::: "memory");
    const int c = lane & 7;
#pragma unroll
    for (int j = 0; j < 4; ++j) { const int n = (lane >> 3) + 8 * j; const LAS float* s = scr + (8 * c) * 33 + n;
        u32x4 o; o.x = cvt_pk_bf16(s[0 * 33], s[1 * 33]); o.y = cvt_pk_bf16(s[2 * 33], s[3 * 33]); o.z = cvt_pk_bf16(s[4 * 33], s[5 * 33]); o.w = cvt_pk_bf16(s[6 * 33], s[7 * 33]);
        *(u32x4*)(d.WT + (size_t)(r0 + n) * d.Kd + d.kofs + k0 + 8 * c) = o; }
    asm volatile("s_waitcnt lgkmcnt(0)" ::: "memory");
}
#define RLX_AGENT __ATOMIC_RELAXED, __HIP_MEMORY_SCOPE_AGENT
#define XB_TMO      128
#define XB_XCNT(j)  (256  + 64 * (j))
#define XB_XSUB(j)  (1280 + 64 * (j))
#define XB_XGEN(j)  (2304 + 64 * (j))
#define XB_TOP      3328
#define XB_TOPGEN   3392
#define XCD_BAR_WORDS 3456
#define XB_SPIN_CAP (1u << 18)

__device__ __forceinline__ unsigned xb_ld(unsigned* p)              { return __hip_atomic_load(p, __ATOMIC_RELAXED, __HIP_MEMORY_SCOPE_AGENT); }
__device__ __forceinline__ unsigned xb_add(unsigned* p, unsigned v) { return __hip_atomic_fetch_add(p, v, __ATOMIC_RELAXED, __HIP_MEMORY_SCOPE_AGENT); }
__device__ __forceinline__ unsigned xb_xcc_id() { return (unsigned)__builtin_amdgcn_s_getreg((3 << 11) | 20) & 0xFu; }
#define XB_SPIN(cond, bar) do { unsigned _sp = 0; while (cond) { __builtin_amdgcn_s_sleep(1); \
    if ((++_sp & 255u) == 0u) { if (xb_ld(&(bar)[XB_TMO])) break; if (_sp > XB_SPIN_CAP) { atomicAdd(&(bar)[XB_TMO], 1u); break; } } } } while (0)

struct XcdBarrier {
    unsigned* bar; unsigned x;
    volatile LAS unsigned* st;
};

__device__ __forceinline__ XcdBarrier xcd_barrier_post(unsigned* bar, volatile LAS unsigned* st) {
    XcdBarrier b; b.bar = bar; b.x = xb_xcc_id(); b.st = st;
    if (threadIdx.x == 0) (void)xb_add(&bar[XB_XCNT(b.x)], 1u);
    return b;
}
__device__ __forceinline__ void xcd_barrier_complete(unsigned* bar, unsigned x, unsigned& nloc, unsigned& nx) {
    const unsigned G = gridDim.x * gridDim.y * gridDim.z;
    unsigned sum, cnt, mine, sp = 0u;
    for (;;) {
        sum = 0u; cnt = 0u; mine = 0u;
#pragma unroll
        for (unsigned j = 0; j < 16; ++j) { const unsigned c = xb_ld(&bar[XB_XCNT(j)]); sum += c; cnt += (c > 0u) ? 1u : 0u; mine = (j == x) ? c : mine; }
        if (sum == G) break;
        __builtin_amdgcn_s_sleep(1);
        if ((++sp & 255u) == 0u) { if (xb_ld(&bar[XB_TMO])) break; if (sp > XB_SPIN_CAP) { atomicAdd(&bar[XB_TMO], 1u); break; } }
    }
    nloc = mine > 0u ? mine : 1u; nx = cnt > 0u ? cnt : 1u;
}

__device__ __forceinline__ void xcd_barrier(const XcdBarrier& b) {
    asm volatile("s_waitcnt vmcnt(0)" ::: "memory");
    __syncthreads();
    if (threadIdx.x == 0) {
        unsigned* bar = b.bar;
        __builtin_amdgcn_s_waitcnt(0);
        unsigned nloc = b.st[0], nx = b.st[1];
        if (nloc == 0u) { xcd_barrier_complete(bar, b.x, nloc, nx); b.st[0] = nloc; b.st[1] = nx; }
        const unsigned old = xb_add(&bar[XB_XSUB(b.x)], 1u);
        const unsigned gen = old / nloc;
        if (old + 1u == (gen + 1u) * nloc) {
            __builtin_amdgcn_fence(__ATOMIC_RELEASE, "agent");
            asm volatile("s_waitcnt vmcnt(0)" ::: "memory");
            const unsigned og = xb_add(&bar[XB_TOP], 1u);
            const unsigned tg = og / nx;
            if (og + 1u == (tg + 1u) * nx) xb_add(&bar[XB_TOPGEN], 1u);
            else XB_SPIN(xb_ld(&bar[XB_TOPGEN]) == tg, bar);
            __builtin_amdgcn_fence(__ATOMIC_ACQUIRE, "agent");
            xb_add(&bar[XB_XGEN(b.x)], 1u);
            asm volatile("s_waitcnt vmcnt(0)" ::: "memory");
        } else {
            XB_SPIN(xb_ld(&bar[XB_XGEN(b.x)]) == gen, bar);
            __builtin_amdgcn_fence(__ATOMIC_ACQUIRE, "agent");
            asm volatile("s_waitcnt vmcnt(0)" ::: "memory");
        }
    }
    __syncthreads();
}
struct Args {
    const float *x, *p, *g_mix, *w_in, *g_na_q, *g_na_k, *na_rpb, *g_df_q, *g_df_k, *lam_q1, *lam_k1, *lam_q2, *lam_k2, *g_df_sub,
                *w_na_out, *w_df_out, *w_o, *g_ffn, *w_gate, *w_up, *w_down, *g_ple, *w_ple_gate, *w_ple_proj;
    float* out; unsigned char* ws; int ph_lo, ph_hi, rep3, pad;
};

__device__ __forceinline__ void na_wave_unit(const bf16* QKG, const bf16* VT, const float* rpb, bf16* NAO, float M2, int b, int h, int r, int half) {
    int tid_ = threadIdx.x; asm volatile("" : "+v"(tid_)); const int lane = tid_ & 63;
    const int q = lane & 31, hi = lane >> 5, c = 32 * half + q;
    const size_t tokq = (size_t)b * SEQ + r * GW + c;
    bf16x8 qf[8];
#pragma unroll
    for (int d0 = 0; d0 < 8; ++d0) qf[d0] = *(const bf16x8*)(QKG + tokq * NQKG + QC_NAQ + h * NA_DH + 16 * d0 + 8 * hi);
    int rs = r - 4; rs = rs < 0 ? 0 : (rs > GROWS - 8 ? GROWS - 8 : rs);
    int cs = c - 8; cs = cs < 0 ? 0 : (cs > GW - 16 ? GW - 16 : cs);
    f32x16 o[4];
#pragma unroll
    for (int i = 0; i < 4; ++i) o[i] = (f32x16){};
    float l = 0.f;
    for (int kr = 0; kr < 8; ++kr) {
        const int krow = rs + kr, dr = krow - r + 7;
        const float* brow = rpb + (h * 15 + dr) * 31;
#pragma unroll
        for (int kb = 0; kb < 2; ++kb) {
            f32x16 s = (f32x16){};
            const bf16* kp = QKG + ((size_t)b * SEQ + krow * GW + 32 * kb + q) * NQKG + QC_NAK + h * NA_DH + 8 * hi;
#pragma unroll
            for (int d0 = 0; d0 < 8; ++d0) { const bf16x8 kf = *(const bf16x8*)(kp + 16 * d0); s = __builtin_amdgcn_mfma_f32_32x32x16_bf16(kf, qf[d0], s, 0, 0, 0); }
            float pv[16];
#pragma unroll
            for (int i = 0; i < 16; ++i) { const int kc = 32 * kb + crow(i, hi); const bool in = (kc >= cs) && (kc < cs + 16); const int dc = in ? (kc - c + 15) : 0;
                const float bias = brow[dc] * LOG2E - M2; const float e = __builtin_amdgcn_exp2f(s[i] + bias); pv[i] = in ? e : 0.f; l += pv[i]; }
            u32x4 w0, w1;
            w0.x = cvt_pk_bf16(pv[0], pv[1]); w0.y = cvt_pk_bf16(pv[2], pv[3]); w0.z = cvt_pk_bf16(pv[4], pv[5]); w0.w = cvt_pk_bf16(pv[6], pv[7]);
            w1.x = cvt_pk_bf16(pv[8], pv[9]); w1.y = cvt_pk_bf16(pv[10], pv[11]); w1.z = cvt_pk_bf16(pv[12], pv[13]); w1.w = cvt_pk_bf16(pv[14], pv[15]);
            const bf16x8 p0 = __builtin_bit_cast(bf16x8, w0), p1 = __builtin_bit_cast(bf16x8, w1);
            const bf16* vp = VT + (size_t)(h * NA_DH + q) * M + (size_t)b * SEQ + krow * GW + 32 * kb + 8 * hi;
#pragma unroll
            for (int db = 0; db < 4; ++db) {
                const bf16x8 v0 = *(const bf16x8*)(vp + (size_t)(32 * db) * M), v1 = *(const bf16x8*)(vp + (size_t)(32 * db) * M + 16);
                o[db] = __builtin_amdgcn_mfma_f32_32x32x16_bf16(v0, p0, o[db], 0, 0, 0);
                o[db] = __builtin_amdgcn_mfma_f32_32x32x16_bf16(v1, p1, o[db], 0, 0, 0);
            }
        }
    }
    l += __shfl_xor(l, 32);
    const float rl = 1.0f / l;
    bf16* op = NAO + tokq * 2048 + h * NA_DH + 4 * hi;
#pragma unroll
    for (int db = 0; db < 4; ++db)
#pragma unroll
        for (int g = 0; g < 4; ++g) { u32x2 w; w.x = cvt_pk_bf16(o[db][4 * g] * rl, o[db][4 * g + 1] * rl); w.y = cvt_pk_bf16(o[db][4 * g + 2] * rl, o[db][4 * g + 3] * rl);
            *(u32x2*)(op + 32 * db + 8 * g) = w; }
}

__device__ __forceinline__ void df_unit(LAS unsigned char* lds, const bf16* QKG, const bf16* KC, const bf16* VT, bf16* DFO, const float* g_sub, const float* gq, const f32x2* rope, float lam, float M2, int b, int h, int qb, unsigned long long* df_wait = nullptr) {
    int tid_ = threadIdx.x; asm volatile("" : "+v"(tid_));
    const int tid = tid_, lane = tid & 63, w = __builtin_amdgcn_readfirstlane(tid >> 6), q = lane & 31, hi = lane >> 5;
    const int mm = w & 1, qg = w >> 1;
    const int q0 = qb * 128 + qg * 32;
    bf16x8 qf[4];
    {
      u32x4 qr[4]; float ss = 0.f; float xv[4][8];
#pragma unroll
      for (int d0 = 0; d0 < 4; ++d0) { qr[d0] = *(const u32x4*)(QKG + ((size_t)b * SEQ + q0 + q) * NQKG + QC_DFQ + h * 128 + mm * 64 + 16 * d0 + 8 * hi);
          xv[d0][0] = bf_lo(qr[d0].x); xv[d0][1] = bf_hi(qr[d0].x); xv[d0][2] = bf_lo(qr[d0].y); xv[d0][3] = bf_hi(qr[d0].y); xv[d0][4] = bf_lo(qr[d0].z); xv[d0][5] = bf_hi(qr[d0].z); xv[d0][6] = bf_lo(qr[d0].w); xv[d0][7] = bf_hi(qr[d0].w);
#pragma unroll
          for (int j = 0; j < 8; ++j) ss += xv[d0][j] * xv[d0][j]; }
      ss += __shfl_xor(ss, 32);
      const float rs = __builtin_amdgcn_rsqf(ss * (1.0f / 64.0f) + EPS);
      const float QS = 0.125f * LOG2E;
      const f32x2* rp = rope + (size_t)(q0 + q) * 32;
#pragma unroll
      for (int d0 = 0; d0 < 2; ++d0) { float o1[8], o2[8];
#pragma unroll
          for (int j = 0; j < 8; ++j) { const int i = 16 * d0 + 8 * hi + j; const f32x2 cs = rp[i];
              const float x1 = xv[d0][j] * rs * gq[i], x2 = xv[d0 + 2][j] * rs * gq[32 + i];
              o1[j] = (x1 * cs.x - x2 * cs.y) * QS; o2[j] = (x1 * cs.y + x2 * cs.x) * QS; }
          u32x4 wa, wb; wa.x = cvt_pk_bf16(o1[0], o1[1]); wa.y = cvt_pk_bf16(o1[2], o1[3]); wa.z = cvt_pk_bf16(o1[4], o1[5]); wa.w = cvt_pk_bf16(o1[6], o1[7]);
          wb.x = cvt_pk_bf16(o2[0], o2[1]); wb.y = cvt_pk_bf16(o2[2], o2[3]); wb.z = cvt_pk_bf16(o2[4], o2[5]); wb.w = cvt_pk_bf16(o2[6], o2[7]);
          qf[d0] = __builtin_bit_cast(bf16x8, wa); qf[d0 + 2] = __builtin_bit_cast(bf16x8, wb); } }
    const unsigned char* kbase = (const unsigned char*)(KC + ((size_t)(b * 8 + h) * SEQ) * 128);
    const unsigned char* vbase = (const unsigned char*)(VT + ((size_t)(b * 16 + 8 + h) * 64) * 128 * 64);
    unsigned koff[2], voff[2];
#pragma unroll
    for (int i = 0; i < 2; ++i) {
        const int piece = w * 2 + i;
        { const int row = piece * 4 + (lane >> 4), ph = lane & 15, ch = ph ^ (row & 15); koff[i] = (unsigned)(row * 128 + ch * 8) * 2u; }
        { const int row = piece * 8 + (lane >> 3), ph = lane & 7, ch = ph ^ ((row >> 1) & 7); voff[i] = (unsigned)(row * 64 + ch * 8) * 2u; }
    }
#define DF_DMA(kt, stg) do { const unsigned char* kb_ = kbase + (size_t)(kt) * 16384; const unsigned char* vb_ = vbase + (size_t)(kt) * 16384; _Pragma("unroll") for (int _i = 0; _i < 2; ++_i) { \
        __builtin_amdgcn_global_load_lds((const unsigned*)(kb_ + koff[_i]), (LAS unsigned*)(lds + (stg) * 32768 + (w * 2 + _i) * 1024), 16, 0, 0); \
        __builtin_amdgcn_global_load_lds((const unsigned*)(vb_ + voff[_i]), (LAS unsigned*)(lds + (stg) * 32768 + 16384 + (w * 2 + _i) * 1024), 16, 0, 0); } } while (0)
    int kofs[4], vofs[4];
#pragma unroll
    for (int d0 = 0; d0 < 4; ++d0) kofs[d0] = q * 256 + (((mm * 8 + 2 * d0 + hi) ^ (q & 15)) * 16);
#pragma unroll
    for (int g = 0; g < 4; ++g) vofs[g] = 16384 + q * 128 + (((2 * g + hi) ^ ((q >> 1) & 7)) * 16);
    f32x16 o[4];
#pragma unroll
    for (int i = 0; i < 4; ++i) o[i] = (f32x16){};
    float l = 0.f;
    const float shift = (M2 > 60.0f) ? M2 : 0.0f;
    constexpr int NT = SEQ / 64;
    typedef float f32x2_t __attribute__((ext_vector_type(2))); typedef __bf16 bf16x2_t __attribute__((ext_vector_type(2)));
#define CVTPK(lo, hi) __builtin_bit_cast(unsigned, __builtin_convertvector((f32x2_t){(lo), (hi)}, bf16x2_t))
#define DF_S(dst, St_, kb_) do { bf16x8 kf_[4]; _Pragma("unroll") for (int d0 = 0; d0 < 4; ++d0) kf_[d0] = *(const LAS bf16x8*)((St_) + kofs[d0] + (kb_) * 8192); \
        dst = (f32x16){}; _Pragma("unroll") for (int d0 = 0; d0 < 4; ++d0) dst = __builtin_amdgcn_mfma_f32_32x32x16_bf16(kf_[d0], qf[d0], dst, 0, 0, 0); } while (0)
#define DF_TILE(Stile, sv0, sv1) do { _Pragma("unroll") for (int kb = 0; kb < 2; ++kb) { \
            bf16x8 vf[2][4]; \
            _Pragma("unroll") for (int jj = 0; jj < 2; ++jj) _Pragma("unroll") for (int db = 0; db < 4; ++db) vf[jj][db] = *(const LAS bf16x8*)((Stile) + vofs[2 * kb + jj] + db * 4096); \
            f32x16 s = kb ? sv1 : sv0; \
            if (shift != 0.f) { _Pragma("unroll") for (int i = 0; i < 16; ++i) s[i] -= shift; } \
            float ls = 0.f; \
            _Pragma("unroll") for (int i = 0; i < 16; ++i) { s[i] = __builtin_amdgcn_exp2f(s[i]); ls += s[i]; } \
            l += ls; \
            u32x4 w0, w1; \
            w0.x = CVTPK(s[0], s[1]); w0.y = CVTPK(s[2], s[3]); w0.z = CVTPK(s[4], s[5]); w0.w = CVTPK(s[6], s[7]); \
            w1.x = CVTPK(s[8], s[9]); w1.y = CVTPK(s[10], s[11]); w1.z = CVTPK(s[12], s[13]); w1.w = CVTPK(s[14], s[15]); \
            const bf16x8 p0 = __builtin_bit_cast(bf16x8, w0), p1 = __builtin_bit_cast(bf16x8, w1); \
            _Pragma("unroll") for (int db = 0; db < 4; ++db) o[db] = __builtin_amdgcn_mfma_f32_32x32x16_bf16(vf[0][db], p0, o[db], 0, 0, 0); \
            _Pragma("unroll") for (int db = 0; db < 4; ++db) o[db] = __builtin_amdgcn_mfma_f32_32x32x16_bf16(vf[1][db], p1, o[db], 0, 0, 0); } } while (0)
    constexpr int NTS = NT / 2;
    DF_DMA(0, 0); DF_DMA(1, 1);
    asm volatile("s_waitcnt vmcnt(0)" ::: "memory");
    __builtin_amdgcn_s_barrier();
    asm volatile("" ::: "memory");
    for (int st = 0; st < NTS; ++st) {
        const int sb = (st & 1) * 2;
        if (st + 1 < NTS) { DF_DMA(2 * st + 2, sb ^ 2); DF_DMA(2 * st + 3, (sb ^ 2) + 1); }
        const LAS unsigned char* T0 = lds + sb * 32768;
        const LAS unsigned char* T1 = T0 + 32768;
        f32x16 a0, a1, b0, b1;
        DF_S(a0, T0, 0); DF_S(a1, T0, 1);
        DF_S(b0, T1, 0); DF_S(b1, T1, 1);
        DF_TILE(T0, a0, a1);
        DF_TILE(T1, b0, b1);
        asm volatile("s_waitcnt vmcnt(0) lgkmcnt(0)" ::: "memory");
        __builtin_amdgcn_s_barrier();
        asm volatile("" ::: "memory");
    }
#undef DF_TILE
#undef DF_S
#undef CVTPK
#undef DF_DMA
    LAS float* xch = (LAS float*)lds;
    { float lt = l; lt += __shfl_xor(lt, 32);
      const float sc = (mm == 1 ? lam : 1.0f) / lt;
#pragma unroll
      for (int db = 0; db < 4; ++db)
#pragma unroll
          for (int i = 0; i < 16; ++i) o[db][i] *= sc; }
    if (mm == 1) {
#pragma unroll
        for (int db = 0; db < 4; ++db)
#pragma unroll
            for (int i = 0; i < 16; ++i) xch[(qg * 64 + db * 16 + i) * 64 + lane] = o[db][i];
    }
    __syncthreads();
    if (mm == 0) {
        float ss = 0.f;
#pragma unroll
        for (int db = 0; db < 4; ++db)
#pragma unroll
            for (int i = 0; i < 16; ++i) { const float v = o[db][i] - xch[(qg * 64 + db * 16 + i) * 64 + lane]; o[db][i] = v; ss += v * v; }
        ss += __shfl_xor(ss, 32);
        const float rn = __builtin_amdgcn_rsqf(ss * (1.0f / 128.0f) + EPS) * (1.0f - LAM_INIT);
        bf16* op = DFO + ((size_t)b * SEQ + q0 + q) * 2048 + h * 128 + 4 * hi;
#pragma unroll
        for (int db = 0; db < 4; ++db)
#pragma unroll
            for (int g = 0; g < 4; ++g) { const f32x4 gs = *(const f32x4*)(g_sub + 32 * db + 8 * g + 4 * hi);
                u32x2 wv; wv.x = cvt_pk_bf16(o[db][4 * g] * rn * gs[0], o[db][4 * g + 1] * rn * gs[1]); wv.y = cvt_pk_bf16(o[db][4 * g + 2] * rn * gs[2], o[db][4 * g + 3] * rn * gs[3]);
                *(u32x2*)(op + 32 * db + 8 * g) = wv; }
    }
    __syncthreads();
}

__device__ __forceinline__ void na_unit(LAS unsigned char* lds, const bf16* QKG, const bf16* KC, const bf16* VT, const float* rpb, const float* gq, bf16* NAO, float M2, int b, int h, int r0) {
    int tid_ = threadIdx.x; asm volatile("" : "+v"(tid_));
    const int tid = tid_, lane = tid & 63, w = __builtin_amdgcn_readfirstlane(tid >> 6), q = lane & 31, hi = lane >> 5;
    const int rq = r0 + (w >> 1), half = w & 1, c = 32 * half + q;
    const size_t tokq = (size_t)b * SEQ + rq * GW + c;
    bf16x8 qf[8];
    {
      u32x4 qr[8]; float ss = 0.f;
#pragma unroll
      for (int d0 = 0; d0 < 8; ++d0) { qr[d0] = *(const u32x4*)(QKG + tokq * NQKG + QC_NAQ + h * NA_DH + 16 * d0 + 8 * hi);
          const float v[8] = {bf_lo(qr[d0].x), bf_hi(qr[d0].x), bf_lo(qr[d0].y), bf_hi(qr[d0].y), bf_lo(qr[d0].z), bf_hi(qr[d0].z), bf_lo(qr[d0].w), bf_hi(qr[d0].w)};
#pragma unroll
          for (int j = 0; j < 8; ++j) ss += v[j] * v[j]; }
      ss += __shfl_xor(ss, 32);
      const float rn = __builtin_amdgcn_rsqf(ss * (1.0f / 128.0f) + EPS) * (0.08838834764831845f * LOG2E);
#pragma unroll
      for (int d0 = 0; d0 < 8; ++d0) { const float* g1 = gq + 16 * d0 + 8 * hi;
          const float v[8] = {bf_lo(qr[d0].x), bf_hi(qr[d0].x), bf_lo(qr[d0].y), bf_hi(qr[d0].y), bf_lo(qr[d0].z), bf_hi(qr[d0].z), bf_lo(qr[d0].w), bf_hi(qr[d0].w)};
          u32x4 o; o.x = cvt_pk_bf16(v[0] * rn * g1[0], v[1] * rn * g1[1]); o.y = cvt_pk_bf16(v[2] * rn * g1[2], v[3] * rn * g1[3]);
          o.z = cvt_pk_bf16(v[4] * rn * g1[4], v[5] * rn * g1[5]); o.w = cvt_pk_bf16(v[6] * rn * g1[6], v[7] * rn * g1[7]);
          qf[d0] = __builtin_bit_cast(bf16x8, o); } }
    int rs = rq - 4; rs = rs < 0 ? 0 : (rs > GROWS - 8 ? GROWS - 8 : rs);
    int cs = c - 8; cs = cs < 0 ? 0 : (cs > GW - 16 ? GW - 16 : cs);
    int klo = r0 - 4; klo = klo < 0 ? 0 : (klo > GROWS - 8 ? GROWS - 8 : klo);
    int khi = r0 + 3 - 4; khi = (khi < 0 ? 0 : (khi > GROWS - 8 ? GROWS - 8 : khi)) + 7;
    const int nst = khi - klo + 1;
    const unsigned char* kbase = (const unsigned char*)(KC + ((size_t)(b * 8 + h) * SEQ + klo * GW) * 128);
    const unsigned char* vbase = (const unsigned char*)(VT + ((size_t)(b * 16 + h) * 64 + klo) * 128 * 64);
    unsigned koff[2], voff[2];
#pragma unroll
    for (int i = 0; i < 2; ++i) {
        const int piece = w * 2 + i;
        { const int row = piece * 4 + (lane >> 4), ph = lane & 15, ch = ph ^ (row & 15); koff[i] = (unsigned)(row * 128 + ch * 8) * 2u; }
        { const int row = piece * 8 + (lane >> 3), ph = lane & 7, ch = ph ^ ((row >> 1) & 7); voff[i] = (unsigned)(row * 64 + ch * 8) * 2u; }
    }
#define NA_DMA(t, stg) do { const unsigned char* kb_ = kbase + (size_t)(t) * 16384; const unsigned char* vb_ = vbase + (size_t)(t) * 16384; _Pragma("unroll") for (int _i = 0; _i < 2; ++_i) { \
        __builtin_amdgcn_global_load_lds((const unsigned*)(kb_ + koff[_i]), (LAS unsigned*)(lds + (stg) * 32768 + (w * 2 + _i) * 1024), 16, 0, 0); \
        __builtin_amdgcn_global_load_lds((const unsigned*)(vb_ + voff[_i]), (LAS unsigned*)(lds + (stg) * 32768 + 16384 + (w * 2 + _i) * 1024), 16, 0, 0); } } while (0)
    int kofs[8], vofs[4];
#pragma unroll
    for (int d0 = 0; d0 < 8; ++d0) kofs[d0] = q * 256 + (((2 * d0 + hi) ^ (q & 15)) * 16);
#pragma unroll
    for (int g = 0; g < 4; ++g) vofs[g] = 16384 + q * 128 + (((2 * g + hi) ^ ((q >> 1) & 7)) * 16);
    f32x16 o[4];
#pragma unroll
    for (int i = 0; i < 4; ++i) o[i] = (f32x16){};
    float l = 0.f;
    LAS float* btab = (LAS float*)(lds + 131072 + 1024);
    for (int i = tid; i < 15 * 31; i += NTHREADS) btab[i] = rpb[h * 15 * 31 + i] * LOG2E - M2;
    asm volatile("s_waitcnt vmcnt(0) lgkmcnt(0)" ::: "memory");
    __builtin_amdgcn_s_barrier();
    asm volatile("" ::: "memory");
    NA_DMA(0, 0); NA_DMA(1, 1);
    asm volatile("s_waitcnt vmcnt(4)" ::: "memory");
    __builtin_amdgcn_s_barrier();
    asm volatile("" ::: "memory");
    for (int t = 0; t < nst; ++t) {
        if (t + 2 < nst) NA_DMA(t + 2, (t + 2) & 3);
        const int krow = klo + t;
        if (krow >= rs && krow < rs + 8) {
            const LAS unsigned char* St = lds + (t & 3) * 32768;
            const LAS float* brow = btab + (krow - rq + 7) * 31;
#pragma unroll 1
            for (int kb = 0; kb < 2; ++kb) {
                f32x16 s = (f32x16){};
#pragma unroll
                for (int d0 = 0; d0 < 8; ++d0) { const bf16x8 kf = *(const LAS bf16x8*)(St + kofs[d0] + kb * 8192); s = __builtin_amdgcn_mfma_f32_32x32x16_bf16(kf, qf[d0], s, 0, 0, 0); }
                bf16x8 vf[2][4];
#pragma unroll
                for (int jj = 0; jj < 2; ++jj)
#pragma unroll
                    for (int db = 0; db < 4; ++db) vf[jj][db] = *(const LAS bf16x8*)(St + (kb ? vofs[2 + jj] : vofs[jj]) + db * 4096);
                float pv[16];
                const LAS float* bp = brow + (4 * hi - c + 15 + 32 * kb);
                const int wa = 4 * hi - cs + 32 * kb;
#pragma unroll
                for (int i = 0; i < 16; ++i) { const int e0 = (i & 3) + 8 * (i >> 2); const float bias = bp[e0]; const float e = __builtin_amdgcn_exp2f(s[i] + bias);
                    pv[i] = ((unsigned)(wa + e0) < 16u) ? e : 0.f; l += pv[i]; }
                u32x4 w0, w1;
                w0.x = cvt_pk_bf16(pv[0], pv[1]); w0.y = cvt_pk_bf16(pv[2], pv[3]); w0.z = cvt_pk_bf16(pv[4], pv[5]); w0.w = cvt_pk_bf16(pv[6], pv[7]);
                w1.x = cvt_pk_bf16(pv[8], pv[9]); w1.y = cvt_pk_bf16(pv[10], pv[11]); w1.z = cvt_pk_bf16(pv[12], pv[13]); w1.w = cvt_pk_bf16(pv[14], pv[15]);
                const bf16x8 p0 = __builtin_bit_cast(bf16x8, w0), p1 = __builtin_bit_cast(bf16x8, w1);
#pragma unroll
                for (int db = 0; db < 4; ++db) o[db] = __builtin_amdgcn_mfma_f32_32x32x16_bf16(vf[0][db], p0, o[db], 0, 0, 0);
#pragma unroll
                for (int db = 0; db < 4; ++db) o[db] = __builtin_amdgcn_mfma_f32_32x32x16_bf16(vf[1][db], p1, o[db], 0, 0, 0);
            }
        }
        if (t + 2 < nst) asm volatile("s_waitcnt vmcnt(4) lgkmcnt(0)" ::: "memory"); else asm volatile("s_waitcnt vmcnt(0) lgkmcnt(0)" ::: "memory");
        __builtin_amdgcn_s_barrier();
        asm volatile("" ::: "memory");
    }
#undef NA_DMA
    l += __shfl_xor(l, 32);
    const float rl = 1.0f / l;
    bf16* op = NAO + tokq * 2048 + h * NA_DH + 4 * hi;
#pragma unroll
    for (int db = 0; db < 4; ++db)
#pragma unroll
        for (int g = 0; g < 4; ++g) { u32x2 wv; wv.x = cvt_pk_bf16(o[db][4 * g] * rl, o[db][4 * g + 1] * rl); wv.y = cvt_pk_bf16(o[db][4 * g + 2] * rl, o[db][4 * g + 3] * rl);
            *(u32x2*)(op + 32 * db + 8 * g) = wv; }
}
template <int TB>
__device__ __forceinline__ void qknorm_batch(bf16* QKG, bf16* KCna, bf16* KCdf, int m0, int mstride, const float* gnk, const float* gdk, const f32x2* rope, int lane) {
    u32x4 na[TB][2], da[TB], db[TB];
#pragma unroll
    for (int t = 0; t < TB; ++t) { int mt = m0 + t * mstride; if (mt >= M) mt = M - 1; const bf16* row = QKG + (size_t)mt * NQKG;
#pragma unroll
        for (int j = 0; j < 2; ++j) na[t][j] = *(const u32x4*)(row + QC_NAK + 512 * j + 8 * lane);
        const bf16* p1 = row + QC_DFK + 64 * (lane >> 2) + 8 * (lane & 3); da[t] = *(const u32x4*)p1; db[t] = *(const u32x4*)(p1 + 32); }
#pragma unroll
    for (int t = 0; t < TB; ++t) { const int mt = m0 + t * mstride; if (mt >= M) break; const int pos = mt & (SEQ - 1);
#pragma unroll
        for (int j = 0; j < 2; ++j) {
            const u32x4 w = na[t][j];
            float v[8] = {bf_lo(w.x), bf_hi(w.x), bf_lo(w.y), bf_hi(w.y), bf_lo(w.z), bf_hi(w.z), bf_lo(w.w), bf_hi(w.w)};
            float ss = 0.f;
#pragma unroll
            for (int i = 0; i < 8; ++i) ss += v[i] * v[i];
            ss += __shfl_xor(ss, 1); ss += __shfl_xor(ss, 2); ss += __shfl_xor(ss, 4); ss += __shfl_xor(ss, 8);
            const float rs = __builtin_amdgcn_rsqf(ss * (1.0f / 128.0f) + EPS);
            const float* g = gnk + 8 * (lane & 15);
#pragma unroll
            for (int i = 0; i < 8; ++i) v[i] = v[i] * rs * g[i];
            u32x4 o; o.x = cvt_pk_bf16(v[0], v[1]); o.y = cvt_pk_bf16(v[2], v[3]); o.z = cvt_pk_bf16(v[4], v[5]); o.w = cvt_pk_bf16(v[6], v[7]);
            const int x = 512 * j + 8 * lane;
            *(u32x4*)(KCna + ((size_t)((mt >> 12) * 8 + (x >> 7)) * SEQ + pos) * 128 + (x & 127)) = o;
        }
        {
            const u32x4 wa = da[t], wb = db[t];
            float a[8] = {bf_lo(wa.x), bf_hi(wa.x), bf_lo(wa.y), bf_hi(wa.y), bf_lo(wa.z), bf_hi(wa.z), bf_lo(wa.w), bf_hi(wa.w)};
            float c[8] = {bf_lo(wb.x), bf_hi(wb.x), bf_lo(wb.y), bf_hi(wb.y), bf_lo(wb.z), bf_hi(wb.z), bf_lo(wb.w), bf_hi(wb.w)};
            float ss = 0.f;
#pragma unroll
            for (int i = 0; i < 8; ++i) ss += a[i] * a[i] + c[i] * c[i];
            ss += __shfl_xor(ss, 1); ss += __shfl_xor(ss, 2);
            const float rs = __builtin_amdgcn_rsqf(ss * (1.0f / 64.0f) + EPS);
            const float* g = gdk + 8 * (lane & 3);
            const f32x2* rp = rope + pos * 32 + 8 * (lane & 3);
            float o1[8], o2[8];
#pragma unroll
            for (int i = 0; i < 8; ++i) { const float x1 = a[i] * rs * g[i], x2 = c[i] * rs * g[32 + i]; const f32x2 cs = rp[i]; o1[i] = x1 * cs.x - x2 * cs.y; o2[i] = x1 * cs.y + x2 * cs.x; }
            u32x4 oa, ob; oa.x = cvt_pk_bf16(o1[0], o1[1]); oa.y = cvt_pk_bf16(o1[2], o1[3]); oa.z = cvt_pk_bf16(o1[4], o1[5]); oa.w = cvt_pk_bf16(o1[6], o1[7]);
            ob.x = cvt_pk_bf16(o2[0], o2[1]); ob.y = cvt_pk_bf16(o2[2], o2[3]); ob.z = cvt_pk_bf16(o2[4], o2[5]); ob.w = cvt_pk_bf16(o2[6], o2[7]);
            const int x = 64 * (lane >> 2) + 8 * (lane & 3); bf16* kp = KCdf + ((size_t)((mt >> 12) * 8 + (x >> 7)) * SEQ + pos) * 128 + (x & 127);
            *(u32x4*)kp = oa; *(u32x4*)(kp + 32) = ob;
        }
    }
}

__device__ __forceinline__ void grid_barrier(unsigned* cnt, unsigned target) {
    asm volatile("s_waitcnt vmcnt(0) lgkmcnt(0)" ::: "memory");
    __syncthreads();
    if (threadIdx.x == 0) {
        __builtin_amdgcn_fence(__ATOMIC_RELEASE, "agent");
        asm volatile("s_waitcnt vmcnt(0)" ::: "memory");
        __hip_atomic_fetch_add(cnt, 1u, __ATOMIC_RELAXED, __HIP_MEMORY_SCOPE_AGENT);
        while (__hip_atomic_load(cnt, __ATOMIC_RELAXED, __HIP_MEMORY_SCOPE_AGENT) < target) __builtin_amdgcn_s_sleep(2);
        __builtin_amdgcn_fence(__ATOMIC_ACQUIRE, "agent");
        asm volatile("s_waitcnt vmcnt(0)" ::: "memory");
    }
    __syncthreads();
}
constexpr int I_IN = 32 * 320, I_NA = 16 * 64, I_O = 32 * 64, I_G = 32 * 176, I_DN = 88 * 64, I_PP = 4 * 64;
constexpr int N_EARLY = I_IN + 2 * I_NA + I_O + 2 * I_G + I_PP, NITEMS = N_EARLY + I_DN + I_O;
#define P0_DECODE(it_, d_) do { int r = (it_); \
            if (r < I_IN) { d_ = P0Item{ap->w_in, W1t, nullptr, D, 10240, 1, r, D, 0}; break; } r -= I_IN; \
            if (r < I_NA) { d_ = P0Item{ap->w_na_out, Wna, nullptr, 1024, D, 0, r, 2048, 0}; break; } r -= I_NA; \
            if (r < I_NA) { d_ = P0Item{ap->w_df_out, Wna, nullptr, 1024, D, 0, r, 2048, 1024}; break; } r -= I_NA; \
            if (r < I_O) { d_ = P0Item{ap->w_o, Wo, nullptr, D, D, 0, r, D, 0}; break; } r -= I_O; \
            if (r < I_G) { d_ = P0Item{ap->w_gate, Wgu, ap->g_ffn, D, FF, 2, r, D, 0}; break; } r -= I_G; \
            if (r < I_G) { d_ = P0Item{ap->w_up, Wgu, ap->g_ffn, D, FF, 3, r, D, 0}; break; } r -= I_G; \
            if (r < I_PP) { d_ = P0Item{ap->w_ple_proj, Wpp, nullptr, PLE, D, 0, r, PLE, 0}; break; } r -= I_PP; \
            if (r < I_DN) { d_ = P0Item{ap->w_down, Wdn, nullptr, FF, D, 0, r, FF, 0}; break; } r -= I_DN; \
            d_ = P0Item{ap->w_ple_gate, Wpg, ap->g_ple, D, D, 0, r, D, 0}; } while (0)
constexpr int NPHASE = 9;
__global__ void __launch_bounds__(NTHREADS, 2) fwd_megakernel(Args a) {
    extern __shared__ __attribute__((aligned(16))) unsigned char lds_raw[];
    LAS unsigned char* lds = (LAS unsigned char*)lds_raw;
    cg::grid_group grid = cg::this_grid();
    const int G = gridDim.x, bx = blockIdx.x;
    const int vcu = (G % 8 == 0) ? (bx % 8) * (G / 8) + bx / 8 : bx;
    const int NGW = G * NWAVES;
typedef __attribute__((opencl_constant)) const Args* CArgsP;
#define FRESH_ARGS() auto kp_ = __builtin_amdgcn_kernarg_segment_ptr(); asm volatile("" : "+s"(kp_)); const CArgsP ap = (CArgsP)kp_
#define FRESH_TID() int tid_ = threadIdx.x; asm volatile("" : "+v"(tid_)); const int tid = tid_, lane = tid & 63, wave = __builtin_amdgcn_readfirstlane(tid >> 6), gw = vcu * NWAVES + wave; (void)lane; (void)gw
    unsigned char* ws = a.ws;
    float* RS1 = (float*)(ws + WS_RS1); float* RS2 = (float*)(ws + WS_RS2); f32x2* ROPE = (f32x2*)(ws + WS_ROPE);
    bf16 *W1t = (bf16*)(ws + WS_W1), *Wna = (bf16*)(ws + WS_WNA), *Wdf = (bf16*)(ws + WS_WDF), *Wo = (bf16*)(ws + WS_WO), *Wgu = (bf16*)(ws + WS_WGU), *Wdn = (bf16*)(ws + WS_WDN), *Wpg = (bf16*)(ws + WS_WPG), *Wpp = (bf16*)(ws + WS_WPP);
    bf16 *QKG = (bf16*)(ws + WS_A), *HB = (bf16*)(ws + WS_A);
    bf16 *XN = (bf16*)(ws + WS_B), *AO = (bf16*)(ws + WS_B), *X1B = (bf16*)(ws + WS_B), *X2B = (bf16*)(ws + WS_B);
    bf16 *VT = (bf16*)(ws + WS_C), *MRG = (bf16*)(ws + WS_C), *T2B = (bf16*)(ws + WS_C), *PB = (bf16*)(ws + WS_PB);
    bf16* KCna = (bf16*)a.out; bf16* KCdf = KCna + (size_t)M * 1024;
    const int lo = a.ph_lo, hi_ph = a.ph_hi;
    if (lo < 0) grid.sync();
    { volatile LAS unsigned* st0 = (volatile LAS unsigned*)(lds + 131072 + 768); if (threadIdx.x < 2) st0[threadIdx.x] = 0u; __syncthreads(); }
    XcdBarrier xbar = xcd_barrier_post((unsigned*)(ws + 8192), (volatile LAS unsigned*)(lds + 131072 + 768));
#ifndef PHASE_MASK
#define PHASE_MASK 0x1ff
#endif
#define IN(k) (((PHASE_MASK >> (k)) & 1) && lo <= (k) && (k) < hi_ph)
#ifdef PROBE_TS
#define STAMP(k) do { if (bx == 0 && threadIdx.x == 0) ((volatile unsigned long long*)(ws + 2048))[k] = __builtin_amdgcn_s_memrealtime(); } while (0)
#else
#define STAMP(k) do {} while (0)
#endif
#define GBAR(idx) xcd_barrier(xbar)
#define SEAM(k) do { if (IN(k) && IN((k) + 1)) GBAR(k); STAMP((k) + 1); } while (0)
#ifndef PROBE_DUP
#define PROBE_DUP 0
#endif
#define NREP(k) (((PROBE_DUP >> (k)) & 1) ? 2 : 1)

    STAMP(0);
    for (int rep_ = 0; rep_ < NREP(0); ++rep_) {
    if (IN(0)) {
        FRESH_ARGS();
        FRESH_TID();
        if (bx == 0) {
        LAS float* red = (LAS float*)(lds + 131072);
        float mq = 0.f, mk = 0.f, mdq = 0.f, mdk = 0.f, mb = 0.f;
        if (tid < 128) { mq = fabsf(ap->g_na_q[tid]); mk = fabsf(ap->g_na_k[tid]); }
        if (tid < 64) { mdq = fabsf(ap->g_df_q[tid]); mdk = fabsf(ap->g_df_k[tid]); }
        for (int i = tid; i < NA_H * 15 * 31; i += NTHREADS) mb = fmaxf(mb, ap->na_rpb[i]);
        mq = wave_max(mq); mk = wave_max(mk); mdq = wave_max(mdq); mdk = wave_max(mdk); mb = wave_max(mb);
        float d1 = 0.f, d2 = 0.f;
        if (wave == 0) { d1 = wave_sum(ap->lam_q1[lane] * ap->lam_k1[lane]); d2 = wave_sum(ap->lam_q2[lane] * ap->lam_k2[lane]); }
        if (lane == 0) { red[wave * 8 + 0] = mq; red[wave * 8 + 1] = mk; red[wave * 8 + 2] = mdq; red[wave * 8 + 3] = mdk; red[wave * 8 + 4] = mb; red[wave * 8 + 5] = d1; red[wave * 8 + 6] = d2; }
        __syncthreads();
        mq = 0.f; mk = 0.f; mdq = 0.f; mdk = 0.f; mb = 0.f;
#pragma unroll
        for (int w = 0; w < 8; ++w) { mq = fmaxf(mq, red[w * 8]); mk = fmaxf(mk, red[w * 8 + 1]); mdq = fmaxf(mdq, red[w * 8 + 2]); mdk = fmaxf(mdk, red[w * 8 + 3]); mb = fmaxf(mb, red[w * 8 + 4]); }
        if (tid == 0) { float* PARw = (float*)(ws + 3072); PARw[0] = expf(red[5]) - expf(red[6]) + LAM_INIT; PARw[1] = (11.313708498984761f * mq * mk + mb) * LOG2E + 0.125f; PARw[2] = (8.0f * mdq * mdk) * LOG2E + 0.125f; }
        __syncthreads();
        }
        LAS float* scr = (LAS float*)(lds + wave * 16384);
        {
            float cur[32], nxt[32]; P0Item dc, dn;
            int it = gw;
            if (it < N_EARLY) { P0_DECODE(it, dc); p0_item_load(dc, cur, lane); }
            for (; it < N_EARLY; it += NGW) {
                const int nit = it + NGW; const bool more = nit < N_EARLY;
                if (more) { P0_DECODE(nit, dn); p0_item_load(dn, nxt, lane); }
                p0_item_store(dc, cur, scr, lane);
                if (more) { dc = dn;
#pragma unroll
                    for (int i = 0; i < 32; ++i) cur[i] = nxt[i]; }
            }
        }
        for (int m = gw; m < M; m += NGW) {
            const f32x4* xr = (const f32x4*)(ap->x + (size_t)m * D) + lane; const f32x4* gr = (const f32x4*)ap->g_mix + lane;
            f32x4 v[8]; float s = 0.f;
#pragma unroll
            for (int j = 0; j < 8; ++j) { v[j] = __builtin_nontemporal_load(xr + 64 * j); s += (v[j].x * v[j].x + v[j].y * v[j].y) + (v[j].z * v[j].z + v[j].w * v[j].w); }
            const float rs = __builtin_amdgcn_rsqf(wave_sum(s) * (1.0f / D) + EPS);
            u32x2* o8 = (u32x2*)(XN + (size_t)m * D) + lane;
#pragma unroll
            for (int j = 0; j < 8; ++j) { const f32x4 g = gr[64 * j]; u32x2 w; w.x = cvt_pk_bf16(v[j].x * rs * g.x, v[j].y * rs * g.y); w.y = cvt_pk_bf16(v[j].z * rs * g.z, v[j].w * rs * g.w); o8[64 * j] = w; }
        }
        const int gt = vcu * NTHREADS + tid, NGT = G * NTHREADS;
        for (int i = gt; i < M * PLE / 8; i += NGT) { const f32x4 p0 = __builtin_nontemporal_load((const f32x4*)ap->p + 2 * i), p1 = __builtin_nontemporal_load((const f32x4*)ap->p + 2 * i + 1);
            u32x4 w; w.x = cvt_pk_bf16(p0.x, p0.y); w.y = cvt_pk_bf16(p0.z, p0.w); w.z = cvt_pk_bf16(p1.x, p1.y); w.w = cvt_pk_bf16(p1.z, p1.w); ((u32x4*)PB)[i] = w; }
        for (int i = gt; i < SEQ * 32; i += NGT) { const int pos = i >> 5, k = i & 31;
            const float inv = (float)(1.0 / pow(10000.0, (double)k / 32.0)); const float ang = (float)pos * inv;
            f32x2 cs; cs.x = (float)cos((double)ang); cs.y = (float)sin((double)ang); ROPE[i] = cs; }
        for (int i = gt; i < M; i += NGT) { RS1[i] = 0.f; RS2[i] = 0.f; }
    }
    }
    SEAM(0);
    for (int rep_ = 0; rep_ < NREP(1); ++rep_) {
    if (IN(1)) {
        FRESH_ARGS();
        { pg8::Gemm g{XN, W1t, M, NQKG, D}; pg8::StaticOrder S; S.init(M, NQKG, G, bx); pg8::EpiQKG E{QKG, NQKG};
          pg8::gemm_phase<pg8::EpiQKG, pg8::StaticOrder, true, true>(lds, g, S, E); }
        { pg8::Gemm g{W1t + (size_t)NQKG * D, XN, 2048, M, D}; pg8::StaticOrder S; S.init(2048, M, G, bx); pg8::EpiVT E{VT, M};
          pg8::gemm_phase<pg8::EpiVT, pg8::StaticOrder, true, true>(lds, g, S, E); }
    }
    }
    SEAM(1);
    if (IN(2)) {
        FRESH_ARGS();
        FRESH_TID();
        for (int m0 = gw; m0 < M; m0 += 4 * NGW) qknorm_batch<4>(QKG, KCna, KCdf, m0, NGW, ap->g_na_k, ap->g_df_k, ROPE, lane);
    }
    SEAM(2);
    for (int rep_ = 0; rep_ < NREP(3); ++rep_) {
    if (IN(3)) {
        FRESH_ARGS();
        FRESH_TID();
        const float* PAR = (const float*)(ws + 3072);
        const float lam = PAR[0], M2na = PAR[1], M2df = PAR[2];
#ifndef NO_DF
        for (int uu = 2 * vcu; uu < BATCH * DF_H * (SEQ / 128); uu += 2 * G)
            for (int i2 = 0; i2 < 2; ++i2) { const int uidx = uu + i2, bh = uidx >> 5, qb = uidx & 31;
#ifdef PROBE_DFWAIT
                unsigned long long dfw_ = 0;
                df_unit(lds, QKG, KCdf, VT, AO + 1024, ap->g_df_sub, ap->g_df_q, ROPE, lam, M2df, bh >> 3, bh & 7, qb, &dfw_);
                if (bx == 0 && threadIdx.x == 0) { volatile unsigned long long* TS = (volatile unsigned long long*)(ws + 2048); TS[11] = (i2 ? TS[11] : 0ull) + dfw_; TS[12] = 0ull; }
#else
                df_unit(lds, QKG, KCdf, VT, AO + 1024, ap->g_df_sub, ap->g_df_q, ROPE, lam, M2df, bh >> 3, bh & 7, qb);
#endif
            }
#endif
        STAMP(10);
#ifdef PROBE_TS
        if (threadIdx.x == 0) { atomicMax((unsigned long long*)(ws + 2048) + 14, (unsigned long long)__builtin_amdgcn_s_memrealtime()); atomicMin((unsigned long long*)(ws + 2048) + 16, (unsigned long long)__builtin_amdgcn_s_memrealtime()); }
#endif
#ifndef NO_NA
        for (int uidx = vcu; uidx < BATCH * NA_H * (GROWS / 4); uidx += G) {
            const int bh = uidx >> 4, rg = uidx & 15;
            na_unit(lds, QKG, KCna, VT, ap->na_rpb, ap->g_na_q, AO, M2na, bh >> 3, bh & 7, rg * 4);
        }
        STAMP(13);
#ifdef PROBE_TS
        if (threadIdx.x == 0) atomicMax((unsigned long long*)(ws + 2048) + 15, (unsigned long long)__builtin_amdgcn_s_memrealtime());
#endif
#endif
    }
    }
    SEAM(3);
    for (int rep_ = 0; rep_ < NREP(4); ++rep_) {
    if (IN(4)) {
        FRESH_ARGS();
        { pg8::Gemm g{AO, Wna, M, D, 2048, 16}; pg8::PairOrder S; S.S.init(M, D, G, bx); S.kob = 1024 * 2; pg8::EpiMerge E{QKG + QC_GA, QKG + QC_GB, NQKG, MRG, D, 16};
          pg8::gemm_phase<pg8::EpiMerge, pg8::PairOrder, true, true>(lds, g, S, E); }
    }
    }
    SEAM(4);
    if (IN(5)) {
        FRESH_ARGS();
        pg8::Gemm g{MRG, Wo, M, D, D}; pg8::StaticOrder S; S.init(M, D, G, bx); pg8::EpiResid<false> E{ap->x, X1B, RS1, D};
        pg8::gemm_phase<pg8::EpiResid<false>, pg8::StaticOrder, true, true>(lds, g, S, E);
    }
    SEAM(5);
    for (int rep_ = 0; rep_ < NREP(6); ++rep_) {
    if (IN(6)) {
        FRESH_ARGS();
        pg8::Gemm g{X1B, Wgu, M, 2 * FF, D}; pg8::StaticOrder S; S.init(M, 2 * FF, G, bx); pg8::EpiSwiGLU E{RS1, HB, FF, 1.0f / D, EPS};
        pg8::gemm_phase<pg8::EpiSwiGLU, pg8::StaticOrder, true, true>(lds, g, S, E);
        { constexpr int NU6 = (M / 256) * (2 * FF / 256), NU8 = (M / 256) * (D / 256);
          const int rem = NU6 % G, nshort = rem ? G - rem : G;
          pg8::TailOrder T; T.first = (rem == 0) ? bx : (bx >= rem ? bx - rem : -1); T.stride = nshort; T.total = NU8;
          int kple = PLE; asm volatile("" : "+s"(kple));
          pg8::Gemm g2{PB, Wpp, M, D, kple}; pg8::EpiStoreBf16 E2{T2B, D};
          pg8::gemm_phase<pg8::EpiStoreBf16, pg8::TailOrder, true, true>(lds, g2, T, E2);
          if (T.first >= 0) { FRESH_TID();
              LAS float* scr = (LAS float*)(lds + wave * 16384);
              const int sw = ((rem == 0) ? bx : bx - rem) * NWAVES + wave, nsw = nshort * NWAVES;
              float cur[32], nxt[32]; P0Item dc, dn;
              int it = N_EARLY + sw;
              if (it < NITEMS) { P0_DECODE(it, dc); p0_item_load(dc, cur, lane); }
              for (; it < NITEMS; it += nsw) {
                  const int nit = it + nsw; const bool more = nit < NITEMS;
                  if (more) { P0_DECODE(nit, dn); p0_item_load(dn, nxt, lane); }
                  p0_item_store(dc, cur, scr, lane);
                  if (more) { dc = dn;
#pragma unroll
                      for (int i = 0; i < 32; ++i) cur[i] = nxt[i]; }
              } } }
    }
    }
    SEAM(6);
    if (IN(7)) {
        FRESH_ARGS();
        pg8::Gemm g{HB, Wdn, M, D, FF}; pg8::StaticOrder S; S.init(M, D, G, bx); pg8::EpiResid<true> E{X1B, X2B, RS2, D};
        pg8::gemm_phase<pg8::EpiResid<true>, pg8::StaticOrder, true, true>(lds, g, S, E);
    }
    SEAM(7);
    if (IN(8)) {
        FRESH_ARGS();
#ifndef NO_P8B
        { pg8::Gemm g{X2B, Wpg, M, D, D}; pg8::StaticOrder S; S.init(M, D, G, bx); pg8::EpiPle E{RS2, T2B, X2B, ap->out, D, 1.0f / D, EPS};
          pg8::gemm_phase<pg8::EpiPle, pg8::StaticOrder, true, true>(lds, g, S, E); }
#endif
    }
#ifdef PROBE_TS
    STAMP(9);
    GBAR(8);
    { const unsigned long long* TS = (const unsigned long long*)(ws + 2048);
      const unsigned long long ta = __hip_atomic_load(TS + PROBE_A, __ATOMIC_RELAXED, __HIP_MEMORY_SCOPE_AGENT), tb = __hip_atomic_load(TS + PROBE_B, __ATOMIC_RELAXED, __HIP_MEMORY_SCOPE_AGENT);
      const int K = PROBE_CONST ? PROBE_CONST : (int)((tb - ta) / 8);
      FRESH_ARGS();
      for (int i = vcu * NTHREADS + (int)threadIdx.x; i < K && i < 42000; i += G * NTHREADS) ap->out[(size_t)i * 397] += 0.125f; }
#endif
#undef IN
#undef SEAM
}

#ifndef MK_SPLIT
#define MK_SPLIT 0
#endif
extern "C" void kernel_launch(void* const* d_in, const int* in_sizes, int n_in, void* d_out, int out_size, void* d_ws, size_t ws_size, hipStream_t stream) {
    static int grid = 0;
    if (grid == 0) {
        if (n_in != 24 || in_sizes[0] != M * D || out_size != M * D || ws_size < WS_END) { fprintf(stderr, "kernel_launch: unexpected shapes (n_in %d, in0 %d, out %d, ws %zu); nothing launched\n", n_in, n_in > 0 ? in_sizes[0] : -1, out_size, ws_size); grid = -1; return; }
        int dev = 0, cus = 0, per_cu = 0;
        hipGetDevice(&dev); hipDeviceGetAttribute(&cus, hipDeviceAttributeMultiprocessorCount, dev);
        hipFuncSetAttribute((const void*)fwd_megakernel, hipFuncAttributeMaxDynamicSharedMemorySize, LDS_BYTES);
        hipOccupancyMaxActiveBlocksPerMultiprocessor(&per_cu, (const void*)fwd_megakernel, NTHREADS, LDS_BYTES);
        if (per_cu < 1) per_cu = 1;
        grid = cus * per_cu;
        (void)hipGetLastError();
    }
    if (grid < 0) return;
    Args a{};
    const float** ap = (const float**)&a;
    for (int i = 0; i < 24; ++i) ap[i] = (const float*)d_in[i];
    a.out = (float*)d_out; a.ws = (unsigned char*)d_ws; a.rep3 = NREP(3); a.pad = 0;
#if MK_SPLIT
    for (int ph = 0; ph < NPHASE; ++ph) { a.ph_lo = ph; a.ph_hi = ph + 1; hipLaunchKernelGGL(fwd_megakernel, dim3(grid), dim3(NTHREADS), LDS_BYTES, stream, a); }
#else
    a.ph_lo = 0; a.ph_hi = NPHASE;
    (void)hipMemsetAsync((unsigned char*)d_ws + 4096, 0, 20480, stream);
#ifdef PROBE_TS
    (void)hipMemsetAsync((unsigned char*)d_ws + 2048 + 14 * 8, 0, 16, stream); (void)hipMemsetAsync((unsigned char*)d_ws + 2048 + 16 * 8, 0x7f, 8, stream);
#endif
    void* args[] = {&a};
    hipError_t e = hipLaunchCooperativeKernel((const void*)fwd_megakernel, dim3(grid), dim3(NTHREADS), args, LDS_BYTES, stream);
    if (e != hipSuccess) fprintf(stderr, "cooperative launch failed: %s (grid %d)\n", hipGetErrorString(e), grid);
#endif
}
```

```cpp
#include <hip/hip_runtime.h>
#include <hip/hip_cooperative_groups.h>
#include <cstdio>
#include <cstdint>
namespace cg = cooperative_groups;
namespace pg8 {
#define PG8_LAS __attribute__((address_space(3)))
typedef unsigned short bf16_t;
typedef short bf16x8 __attribute__((ext_vector_type(8)));
typedef float f32x4 __attribute__((ext_vector_type(4)));
typedef unsigned u32x4 __attribute__((ext_vector_type(4)));
constexpr int BM = 256, BK = 64, HALF = 128, HTB = HALF * BK * 2  , STAGE_BYTES = 8 * HTB, NXCD = 8, WGM = 8;

__host__ __device__ __forceinline__ int lds_byte(int r, int c) { const int st = (r >> 4) * 2 + (c >> 5), rr = r & 15, cc = c & 31, ob = rr * 64 + cc * 2; return st * 1024 + (ob ^ (((ob >> 9) & 1) << 5)); }
__host__ __device__ __forceinline__ void stage_rc(int b, int& R, int& C) { const int st = b / 1024, sb = b % 1024, swz = sb ^ (((sb >> 9) & 1) << 5); R = (st >> 1) * 16 + swz / 64; C = (st & 1) * 32 + (swz % 64) / 2; }
__host__ __device__ __forceinline__ int perm32(int rho) { const int n = rho >> 4, i = rho & 15; return 8 * (i >> 2) + 4 * n + (i & 3); }

struct Unit { int pm, pn; int ko = 0; };
struct Gemm { const bf16_t* A; const bf16_t* Bt; int M, N, K; int nt = 0; };

struct StaticOrder {
    int nM, nN, nwg, G, c;
    __host__ __device__ void init(int M, int N, int G_, int c_) { nM = M / BM; nN = N / BM; nwg = nM * nN; G = G_; c = c_; }
    __host__ __device__ bool next(int i, Unit& u) const {
        const long L = (long)i * G + c; if (L >= nwg) return false;
        int wgid = (int)L; { const int q = nwg / NXCD, r = nwg % NXCD, xcd = wgid % NXCD, off = wgid / NXCD; wgid = (xcd < r ? xcd * (q + 1) : r * (q + 1) + (xcd - r) * q) + off; }
        const int nig = WGM * nN, gid = wgid / nig, fm = gid * WGM, gsz = (nM - fm) < WGM ? (nM - fm) : WGM;
        u.pm = fm + ((wgid % nig) % gsz); u.pn = (wgid % nig) / gsz; return true;
    }
    __device__ __forceinline__ void a_ready(const Unit&) const {}
    __device__ __forceinline__ void done(const Unit&) const {}
};


struct TailOrder {
    int first, stride, total;
    __host__ __device__ bool next(int i, Unit& u) const { if (first < 0) return false; const int j = first + i * stride; if (j >= total) return false; u.pm = j >> 3; u.pn = j & 7; return true; }
    __device__ __forceinline__ void a_ready(const Unit&) const {}
    __device__ __forceinline__ void done(const Unit&) const {}
};

struct PairOrder {
    StaticOrder S; int kob;
    __host__ __device__ bool next(int i, Unit& u) const { if (!S.next(i >> 1, u)) return false; u.ko = (i & 1) * kob; return true; }
    __device__ __forceinline__ void a_ready(const Unit&) const {}
    __device__ __forceinline__ void done(const Unit&) const {}
};
__device__ __forceinline__ unsigned cvt_pk_bf16(float lo, float hi) { unsigned r; asm volatile("v_cvt_pk_bf16_f32 %0, %1, %2" : "=v"(r) : "v"(lo), "v"(hi)); return r; }
__device__ __forceinline__ float bf_lo(unsigned w) { return __uint_as_float(w << 16); }
__device__ __forceinline__ float bf_hi(unsigned w) { return __uint_as_float(w & 0xffff0000u); }
__device__ __forceinline__ float sigmoidf_(float x) { return __builtin_amdgcn_rcpf(1.0f + __expf(-x)); }
typedef unsigned u32x2 __attribute__((ext_vector_type(2)));
#define EPI_FENCE() do { if (m & 1) asm volatile("" ::: "memory"); } while (0)
#define EPI_ROWS(...) _Pragma("unroll") for (int ai = 0; ai < 2; ++ai) _Pragma("unroll") for (int m = 0; m < 4; ++m) { const int row = u.pm * BM + ai * HALF + wr * 64 + m * 16 + fr; __VA_ARGS__ }

struct EpiQKG {
    static constexpr bool PERM = true, AFTER_DRAIN = false, MIDK = false;
    bf16_t* O; int ldc;
    __device__ __forceinline__ void operator()(const f32x4 (&acc)[2][2][4][2], const Unit& u, int wr, int wc, int fr, int fq) const {
        const bool gate = u.pn >= 16; const int col0 = u.pn * BM + wc * 32 + 8 * fq;
        EPI_ROWS(
            bf16_t* rowp = O + (size_t)row * ldc + col0;
            _Pragma("unroll") for (int bj = 0; bj < 2; ++bj) { f32x4 v0 = acc[ai][bj][m][0], v1 = acc[ai][bj][m][1];
                if (gate) { _Pragma("unroll") for (int j = 0; j < 4; ++j) { v0[j] = sigmoidf_(v0[j]); v1[j] = sigmoidf_(v1[j]); } }
                u32x4 w; w.x = cvt_pk_bf16(v0[0], v0[1]); w.y = cvt_pk_bf16(v0[2], v0[3]); w.z = cvt_pk_bf16(v1[0], v1[1]); w.w = cvt_pk_bf16(v1[2], v1[3]);
                *(u32x4*)(rowp + bj * HALF) = w; }
            EPI_FENCE();
        )
    }
};
struct EpiVT {
    static constexpr bool PERM = true, AFTER_DRAIN = false, MIDK = false;
    bf16_t* O; int ldc;
    __device__ __forceinline__ void operator()(const f32x4 (&acc)[2][2][4][2], const Unit& u, int wr, int wc, int fr, int fq) const {
        const int cbase = u.pn * BM + wc * 32 + 16 * (fq >> 1) + 4 * (fq & 1);
        EPI_ROWS(
            const int hv = row >> 7, dd = row & 127;
            _Pragma("unroll") for (int bj = 0; bj < 2; ++bj) _Pragma("unroll") for (int n = 0; n < 2; ++n) { const f32x4 v = acc[ai][bj][m][n];
                const int col = cbase + bj * HALF + 8 * n, bb = col >> 12, kt = (col >> 6) & 63, pos = col & 63;
                u32x2 w; w.x = cvt_pk_bf16(v[0], v[1]); w.y = cvt_pk_bf16(v[2], v[3]);
                *(u32x2*)(O + ((((size_t)(bb * 16 + hv)) * 64 + kt) * 128 + dd) * 64 + pos) = w; }
            EPI_FENCE();
        )
    }
};
struct EpiMerge {
    static constexpr bool PERM = true, AFTER_DRAIN = false, MIDK = true;
    const bf16_t* GA; const bf16_t* GB; int ldg; bf16_t* O; int ldc; int midk;
    __device__ __forceinline__ void mid(f32x4 (&acc)[2][2][4][2], const Unit& u, int wr, int wc, int fr, int fq) const {
        const int col0 = u.pn * BM + wc * 32 + 8 * fq;
        EPI_ROWS(
            _Pragma("unroll") for (int bj = 0; bj < 2; ++bj) { const size_t off = (size_t)row * ldg + col0 + bj * HALF;
                const u32x4 a = *(const u32x4*)(GA + off), b = *(const u32x4*)(GB + off);
                float r[8];
                r[0] = bf_lo(a.x) * __builtin_amdgcn_rcpf(fmaxf(bf_lo(b.x), 1e-30f)); r[1] = bf_hi(a.x) * __builtin_amdgcn_rcpf(fmaxf(bf_hi(b.x), 1e-30f));
                r[2] = bf_lo(a.y) * __builtin_amdgcn_rcpf(fmaxf(bf_lo(b.y), 1e-30f)); r[3] = bf_hi(a.y) * __builtin_amdgcn_rcpf(fmaxf(bf_hi(b.y), 1e-30f));
                r[4] = bf_lo(a.z) * __builtin_amdgcn_rcpf(fmaxf(bf_lo(b.z), 1e-30f)); r[5] = bf_hi(a.z) * __builtin_amdgcn_rcpf(fmaxf(bf_hi(b.z), 1e-30f));
                r[6] = bf_lo(a.w) * __builtin_amdgcn_rcpf(fmaxf(bf_lo(b.w), 1e-30f)); r[7] = bf_hi(a.w) * __builtin_amdgcn_rcpf(fmaxf(bf_hi(b.w), 1e-30f));
                _Pragma("unroll") for (int j = 0; j < 4; ++j) { acc[ai][bj][m][0][j] *= r[j]; acc[ai][bj][m][1][j] *= r[4 + j]; } }
            EPI_FENCE();
        )
    }
    __device__ __forceinline__ void operator()(const f32x4 (&acc)[2][2][4][2], const Unit& u, int wr, int wc, int fr, int fq) const {
        const int col0 = u.pn * BM + wc * 32 + 8 * fq;
        EPI_ROWS(
            _Pragma("unroll") for (int bj = 0; bj < 2; ++bj) { const u32x4 b = *(const u32x4*)(GB + (size_t)row * ldg + col0 + bj * HALF);
                f32x4 v0 = acc[ai][bj][m][0], v1 = acc[ai][bj][m][1];
                v0[0] *= fmaxf(bf_lo(b.x), 1e-30f); v0[1] *= fmaxf(bf_hi(b.x), 1e-30f); v0[2] *= fmaxf(bf_lo(b.y), 1e-30f); v0[3] *= fmaxf(bf_hi(b.y), 1e-30f);
                v1[0] *= fmaxf(bf_lo(b.z), 1e-30f); v1[1] *= fmaxf(bf_hi(b.z), 1e-30f); v1[2] *= fmaxf(bf_lo(b.w), 1e-30f); v1[3] *= fmaxf(bf_hi(b.w), 1e-30f);
                u32x4 w; w.x = cvt_pk_bf16(v0[0], v0[1]); w.y = cvt_pk_bf16(v0[2], v0[3]); w.z = cvt_pk_bf16(v1[0], v1[1]); w.w = cvt_pk_bf16(v1[2], v1[3]);
                *(u32x4*)(O + (size_t)row * ldc + col0 + bj * HALF) = w; }
            EPI_FENCE();
        )
    }
};
template <bool BASE_BF16> struct EpiResid {
    static constexpr bool PERM = true, AFTER_DRAIN = false, MIDK = false;
    const void* base; bf16_t* ob; float* rowss; int ldc;
    __device__ __forceinline__ void operator()(const f32x4 (&acc)[2][2][4][2], const Unit& u, int wr, int wc, int fr, int fq) const {
        const int col0 = u.pn * BM + wc * 32 + 8 * fq;
        EPI_ROWS(
            float ss = 0.f;
            _Pragma("unroll") for (int bj = 0; bj < 2; ++bj) { const size_t off = (size_t)row * ldc + col0 + bj * HALF;
                f32x4 b0, b1;
                if (BASE_BF16) { const u32x4 bw = *(const u32x4*)((const bf16_t*)base + off); b0 = (f32x4){bf_lo(bw.x), bf_hi(bw.x), bf_lo(bw.y), bf_hi(bw.y)}; b1 = (f32x4){bf_lo(bw.z), bf_hi(bw.z), bf_lo(bw.w), bf_hi(bw.w)}; }
                else { b0 = __builtin_nontemporal_load((const f32x4*)((const float*)base + off)); b1 = __builtin_nontemporal_load((const f32x4*)((const float*)base + off + 4)); }
                const f32x4 v0 = acc[ai][bj][m][0] + b0, v1 = acc[ai][bj][m][1] + b1;
                ss += (v0[0] * v0[0] + v0[1] * v0[1]) + (v0[2] * v0[2] + v0[3] * v0[3]) + (v1[0] * v1[0] + v1[1] * v1[1]) + (v1[2] * v1[2] + v1[3] * v1[3]);
                u32x4 w; w.x = cvt_pk_bf16(v0[0], v0[1]); w.y = cvt_pk_bf16(v0[2], v0[3]); w.z = cvt_pk_bf16(v1[0], v1[1]); w.w = cvt_pk_bf16(v1[2], v1[3]);
                *(u32x4*)(ob + off) = w; }
            ss += __shfl_xor(ss, 16); ss += __shfl_xor(ss, 32);
            if (fq == 0) atomicAdd(rowss + row, ss);
            EPI_FENCE();
        )
    }
};
struct EpiSwiGLU {
    static constexpr bool PERM = true, AFTER_DRAIN = false, MIDK = false;
    const float* rowss; bf16_t* H; int ldh; float inv_d, eps;
    __device__ __forceinline__ void operator()(const f32x4 (&acc)[2][2][4][2], const Unit& u, int wr, int wc, int fr, int fq) const {
        const int col0 = u.pn * HALF + wc * 32 + 8 * fq;
        EPI_ROWS(
            const float rs = __builtin_amdgcn_rsqf(rowss[row] * inv_d + eps);
            float hv[8];
            _Pragma("unroll") for (int n = 0; n < 2; ++n) _Pragma("unroll") for (int j = 0; j < 4; ++j) { const float g = acc[ai][0][m][n][j] * rs, up = acc[ai][1][m][n][j] * rs; hv[n * 4 + j] = g * sigmoidf_(g) * up; }
            u32x4 w; w.x = cvt_pk_bf16(hv[0], hv[1]); w.y = cvt_pk_bf16(hv[2], hv[3]); w.z = cvt_pk_bf16(hv[4], hv[5]); w.w = cvt_pk_bf16(hv[6], hv[7]);
            *(u32x4*)(H + (size_t)row * ldh + col0) = w;
            EPI_FENCE();
        )
    }
};
struct EpiStoreBf16 {
    static constexpr bool PERM = true, AFTER_DRAIN = false, MIDK = false;
    bf16_t* T; int ldc;
    __device__ __forceinline__ void operator()(const f32x4 (&acc)[2][2][4][2], const Unit& u, int wr, int wc, int fr, int fq) const {
        const int col0 = u.pn * BM + wc * 32 + 8 * fq;
        EPI_ROWS(
            _Pragma("unroll") for (int bj = 0; bj < 2; ++bj) { const f32x4 v0 = acc[ai][bj][m][0], v1 = acc[ai][bj][m][1];
                u32x4 w; w.x = cvt_pk_bf16(v0[0], v0[1]); w.y = cvt_pk_bf16(v0[2], v0[3]); w.z = cvt_pk_bf16(v1[0], v1[1]); w.w = cvt_pk_bf16(v1[2], v1[3]);
                *(u32x4*)(T + (size_t)row * ldc + col0 + bj * HALF) = w; }
            EPI_FENCE();
        )
    }
};
struct EpiPle {
    static constexpr bool PERM = true, AFTER_DRAIN = false, MIDK = false;
    const float* rowss; const bf16_t* T; const bf16_t* X; float* out; int ldc; float inv_d, eps;
    __device__ __forceinline__ void operator()(const f32x4 (&acc)[2][2][4][2], const Unit& u, int wr, int wc, int fr, int fq) const {
        const int col0 = u.pn * BM + wc * 32 + 8 * fq;
        EPI_ROWS(
            const float rs = __builtin_amdgcn_rsqf(rowss[row] * inv_d + eps);
            _Pragma("unroll") for (int bj = 0; bj < 2; ++bj) { const size_t off = (size_t)row * ldc + col0 + bj * HALF;
                const u32x4 tw = *(const u32x4*)(T + off), xw = *(const u32x4*)(X + off);
                const float t[8] = {bf_lo(tw.x), bf_hi(tw.x), bf_lo(tw.y), bf_hi(tw.y), bf_lo(tw.z), bf_hi(tw.z), bf_lo(tw.w), bf_hi(tw.w)};
                const float x[8] = {bf_lo(xw.x), bf_hi(xw.x), bf_lo(xw.y), bf_hi(xw.y), bf_lo(xw.z), bf_hi(xw.z), bf_lo(xw.w), bf_hi(xw.w)};
                f32x4 o0, o1;
                _Pragma("unroll") for (int j = 0; j < 4; ++j) { o0[j] = x[j] + sigmoidf_(acc[ai][bj][m][0][j] * rs) * t[j]; o1[j] = x[4 + j] + sigmoidf_(acc[ai][bj][m][1][j] * rs) * t[4 + j]; }
                __builtin_nontemporal_store(o0, (f32x4*)(out + off)); __builtin_nontemporal_store(o1, (f32x4*)(out + off + 4)); }
            EPI_FENCE();
        )
    }
};
template <class Epi, class Sched, bool ALIGN_EPI = false, bool SP2 = false>
__device__ __forceinline__ void gemm_phase(PG8_LAS unsigned char* lds, const Gemm g, const Sched& S, const Epi& E) {
    int tid_ = threadIdx.x; asm volatile("" : "+v"(tid_));
    const int tid = tid_, wid = __builtin_amdgcn_readfirstlane(tid >> 6), lane = tid & 63, wr = wid >> 2, wc = wid & 3, fr = lane & 15, fq = lane >> 4;
    const int K = g.K, nt = g.nt ? g.nt : K / BK;
    unsigned voffA[2], voffB[2];
#pragma unroll
    for (int i = 0; i < 2; ++i) { int R, C; stage_rc(tid * 16 + i * 8192, R, C); const int Rb = Epi::PERM ? ((R & ~31) + perm32(R & 31)) : R;
        voffA[i] = (unsigned)(R * K + C) * 2u; voffB[i] = (unsigned)(Rb * K + C) * 2u; }
    const size_t kstep = (size_t)(BK * 2);
    const size_t hstep = (size_t)HALF * K * 2;
    const size_t tstep = 2 * hstep;
    const unsigned ldsw = (unsigned)wid * 1024u;
    const int aoff = lds_byte(wr * 64 + fr, fq * 8), boff = lds_byte(wc * 32 + fr, fq * 8);
#define PG8_SA(b, h) (((b) * 2 + (h)) * HTB)
#define PG8_SB(b, h) ((4 + (b) * 2 + (h)) * HTB)
#define PG8_STAGE(bufoff, gbase, voff) do { _Pragma("unroll") for (int _i = 0; _i < 2; ++_i) \
        __builtin_amdgcn_global_load_lds((const unsigned*)((const char*)(gbase) + (voff)[_i]), (PG8_LAS unsigned*)(lds + (bufoff) + ldsw + _i * 8192), 16, 0, 0); } while (0)
#define PG8_LDA(dst, b, h) do { _Pragma("unroll") for (int m = 0; m < 4; ++m) _Pragma("unroll") for (int k = 0; k < 2; ++k) dst[m][k] = *(const PG8_LAS bf16x8*)(lds + PG8_SA(b, h) + aoff + m * 2048 + k * 1024); } while (0)
#define PG8_LDB(dst, b, h) do { _Pragma("unroll") for (int n = 0; n < 2; ++n) _Pragma("unroll") for (int k = 0; k < 2; ++k) dst[n][k] = *(const PG8_LAS bf16x8*)(lds + PG8_SB(b, h) + boff + n * 2048 + k * 1024); } while (0)
#define PG8_MMA(ai, bj, At, Bt) do { __builtin_amdgcn_s_setprio(1); _Pragma("unroll") for (int m = 0; m < 4; ++m) _Pragma("unroll") for (int n = 0; n < 2; ++n) _Pragma("unroll") for (int k = 0; k < 2; ++k) \
        acc[ai][bj][m][n] = __builtin_amdgcn_mfma_f32_16x16x32_bf16(Bt[n][k], At[m][k], acc[ai][bj][m][n], 0, 0, 0); __builtin_amdgcn_s_setprio(0); } while (0)
#define PG8_WAIT_V(n) asm volatile("s_waitcnt vmcnt(" #n ")" ::: "memory")
#define PG8_WAIT_L(n) asm volatile("s_waitcnt lgkmcnt(" #n ")" ::: "memory")
#define PG8_BAR __builtin_amdgcn_s_barrier()
#define PG8_SCHED __builtin_amdgcn_sched_barrier(0)
    Unit cur, nxt; int ui = 0;
    if (!S.next(0, cur)) return;
    f32x4 acc[2][2][4][2];
#pragma unroll
    for (int a = 0; a < 2; ++a)
#pragma unroll
        for (int b = 0; b < 2; ++b)
#pragma unroll
            for (int m = 0; m < 4; ++m)
#pragma unroll
                for (int n = 0; n < 2; ++n) acc[a][b][m][n] = (f32x4){0.f, 0.f, 0.f, 0.f};
    bf16x8 At[4][2], B0[2][2], B1[2][2];
    const char* cA = (const char*)g.A + (size_t)cur.pm * tstep + cur.ko; const char* cB = (const char*)g.Bt + (size_t)cur.pn * tstep + cur.ko;
    S.a_ready(cur);
    if constexpr (SP2) {
        PG8_STAGE(PG8_SB(0, 0), cB, voffB); PG8_STAGE(PG8_SB(0, 1), cB + hstep, voffB); PG8_STAGE(PG8_SA(0, 0), cA, voffA); PG8_STAGE(PG8_SA(0, 1), cA + hstep, voffA);
        if (wr == 1) PG8_BAR;
        PG8_WAIT_V(2); PG8_BAR;
        PG8_STAGE(PG8_SB(1, 0), cB + kstep, voffB); PG8_STAGE(PG8_SA(1, 0), cA + kstep, voffA); PG8_STAGE(PG8_SB(1, 1), cB + hstep + kstep, voffB);
        PG8_WAIT_V(6); PG8_BAR;
    } else {
        PG8_STAGE(PG8_SB(0, 0), cB, voffB); PG8_STAGE(PG8_SA(0, 0), cA, voffA); PG8_STAGE(PG8_SB(0, 1), cB + hstep, voffB); PG8_STAGE(PG8_SA(0, 1), cA + hstep, voffA);
        if (wr == 1) PG8_BAR;
        PG8_WAIT_V(4); PG8_BAR;
        PG8_STAGE(PG8_SB(1, 0), cB + kstep, voffB); PG8_STAGE(PG8_SA(1, 0), cA + kstep, voffA); PG8_STAGE(PG8_SB(1, 1), cB + hstep + kstep, voffB);
        PG8_WAIT_V(6); PG8_BAR;
    }
    for (;;) {
        const bool has_next = S.next(ui + 1, nxt);
        const char* nA = has_next ? (const char*)g.A + (size_t)nxt.pm * tstep + nxt.ko : cA; const char* nB = has_next ? (const char*)g.Bt + (size_t)nxt.pn * tstep + nxt.ko : cB;
        for (int t = 0; t < nt; t += 2) {
            const bool last = (t == nt - 2);
            const char* a1 = cA + (size_t)(t + 1) * kstep;
            const char* a2 = last ? nA : cA + (size_t)(t + 2) * kstep; const char* b2 = last ? nB : cB + (size_t)(t + 2) * kstep;
            const char* a3 = a2 + kstep; const char* b3 = b2 + kstep;
            if (last && has_next) S.a_ready(nxt);
            if constexpr (SP2) {
            PG8_LDB(B0, 0, 0); PG8_LDB(B1, 0, 1); PG8_SCHED; PG8_LDA(At, 0, 0); PG8_STAGE(PG8_SA(1, 1), a1 + hstep, voffA);
            PG8_WAIT_V(8); PG8_WAIT_L(0); PG8_BAR; PG8_MMA(0, 0, At, B0); PG8_MMA(0, 1, At, B1); PG8_BAR; PG8_SCHED;
            PG8_LDA(At, 0, 1); PG8_STAGE(PG8_SB(0, 0), b2, voffB); PG8_STAGE(PG8_SB(0, 1), b2 + hstep, voffB); PG8_STAGE(PG8_SA(0, 0), a2, voffA);
            PG8_WAIT_V(8); PG8_WAIT_L(0); PG8_BAR; PG8_MMA(1, 0, At, B0); PG8_MMA(1, 1, At, B1); PG8_BAR; PG8_SCHED;
            PG8_LDB(B0, 1, 0); PG8_LDB(B1, 1, 1); PG8_SCHED; PG8_LDA(At, 1, 0); PG8_STAGE(PG8_SA(0, 1), a2 + hstep, voffA);
            PG8_WAIT_V(8); PG8_WAIT_L(0); PG8_BAR; PG8_MMA(0, 0, At, B0); PG8_MMA(0, 1, At, B1); PG8_BAR; PG8_SCHED;
            PG8_LDA(At, 1, 1); PG8_STAGE(PG8_SB(1, 0), b3, voffB); PG8_STAGE(PG8_SB(1, 1), b3 + hstep, voffB); PG8_STAGE(PG8_SA(1, 0), a3, voffA);
            PG8_WAIT_V(8); PG8_WAIT_L(0); PG8_BAR; PG8_MMA(1, 0, At, B0); PG8_MMA(1, 1, At, B1); PG8_BAR; PG8_SCHED;
            } else {
            PG8_LDB(B0, 0, 0); PG8_SCHED; PG8_LDA(At, 0, 0); PG8_STAGE(PG8_SA(1, 1), a1 + hstep, voffA);
            PG8_WAIT_L(8); PG8_BAR; PG8_WAIT_L(0); PG8_MMA(0, 0, At, B0); PG8_BAR; PG8_SCHED;
            PG8_LDB(B1, 0, 1); PG8_STAGE(PG8_SB(0, 0), b2, voffB);
            PG8_BAR; PG8_WAIT_L(0); PG8_MMA(0, 1, At, B1); PG8_BAR;
            PG8_LDA(At, 0, 1); PG8_STAGE(PG8_SA(0, 0), a2, voffA);
            PG8_BAR; PG8_WAIT_L(0); PG8_MMA(1, 0, At, B0); PG8_BAR; PG8_SCHED;
            PG8_STAGE(PG8_SB(0, 1), b2 + hstep, voffB);
            PG8_WAIT_V(6); PG8_BAR; PG8_MMA(1, 1, At, B1); PG8_BAR;
            PG8_LDB(B0, 1, 0); PG8_SCHED; PG8_LDA(At, 1, 0); PG8_STAGE(PG8_SA(0, 1), a2 + hstep, voffA);
            PG8_WAIT_L(8); PG8_BAR; PG8_WAIT_L(0); PG8_MMA(0, 0, At, B0); PG8_BAR; PG8_SCHED;
            PG8_LDB(B1, 1, 1); PG8_STAGE(PG8_SB(1, 0), b3, voffB);
            PG8_BAR; PG8_WAIT_L(0); PG8_MMA(0, 1, At, B1); PG8_BAR;
            PG8_LDA(At, 1, 1); PG8_STAGE(PG8_SA(1, 0), a3, voffA);
            PG8_BAR; PG8_WAIT_L(0); PG8_MMA(1, 0, At, B0); PG8_BAR; PG8_SCHED;
            PG8_STAGE(PG8_SB(1, 1), b3 + hstep, voffB);
            PG8_WAIT_V(6); PG8_BAR; PG8_MMA(1, 1, At, B1); PG8_BAR;
            }
        }
        if constexpr (ALIGN_EPI) { if (wr == 0) PG8_BAR; }
        bool keep_acc = false;
        if constexpr (Epi::MIDK) { if (cur.ko == 0) { E.mid(acc, cur, wr, wc, fr, fq); keep_acc = true; } else E(acc, cur, wr, wc, fr, fq); }
        else if constexpr (!Epi::AFTER_DRAIN) { E(acc, cur, wr, wc, fr, fq); S.done(cur); }
        if (!has_next) break;
        if (!keep_acc) {
#pragma unroll
        for (int a = 0; a < 2; ++a)
#pragma unroll
            for (int b = 0; b < 2; ++b)
#pragma unroll
                for (int m = 0; m < 4; ++m)
#pragma unroll
                    for (int n = 0; n < 2; ++n) acc[a][b][m][n] = (f32x4){0.f, 0.f, 0.f, 0.f};
        }
        cur = nxt; cA = nA; cB = nB; ++ui;
        if constexpr (ALIGN_EPI) { if (wr == 1) PG8_BAR; }
    }
    PG8_WAIT_V(0);
    if constexpr (!ALIGN_EPI) { if (wr == 0) PG8_BAR; }
    PG8_BAR;
    if constexpr (Epi::AFTER_DRAIN) { E.fused(acc, cur, wr, wc, fr, fq, lds, wid, lane); S.done(cur); }
#undef PG8_SA
#undef PG8_SB
#undef PG8_STAGE
#undef PG8_LDA
#undef PG8_LDB
#undef PG8_MMA
#undef PG8_WAIT_V
#undef PG8_WAIT_L
#undef PG8_BAR
#undef PG8_SCHED
}
}
constexpr int D = 2048, BATCH = 2, SEQ = 4096, M = BATCH * SEQ, GW = 64, GROWS = SEQ / GW, FF = 5632, PLE = 256;
constexpr int NA_H = 8, NA_DH = 128, DF_H = 8, DF_DQ = 64, DF_DV = 128;
constexpr int NQKG = 8192;
constexpr int QC_NAQ = 0, QC_NAK = 1024, QC_DFQ = 2048, QC_DFK = 3072, QC_GA = 4096, QC_GB = 6144;
constexpr float EPS = 1e-6f, LOG2E = 1.4426950408889634f;
constexpr float LAM_INIT = 0.2f;
constexpr int NWAVES = 8, NTHREADS = 512;
constexpr size_t MiB = 1u << 20;
constexpr size_t WS_RS1 = 64 * 1024, WS_RS2 = 128 * 1024, WS_ROPE = 1 * MiB;
constexpr size_t WS_W1 = 2 * MiB, WS_WNA = 42 * MiB, WS_WDF = 46 * MiB, WS_WO = 50 * MiB, WS_WGU = 58 * MiB, WS_WDN = 102 * MiB, WS_WPG = 124 * MiB, WS_WPP = 132 * MiB;
constexpr size_t WS_A = 133 * MiB;
constexpr size_t WS_B = 261 * MiB;
constexpr size_t WS_C = 293 * MiB;
constexpr size_t WS_PB = 325 * MiB;
constexpr size_t WS_END = 329 * MiB;
constexpr int LDS_BYTES = 147456;
#define LAS __attribute__((address_space(3)))
typedef unsigned short bf16;
typedef unsigned u32x4 __attribute__((ext_vector_type(4)));
typedef unsigned u32x2 __attribute__((ext_vector_type(2)));
typedef float f32x4 __attribute__((ext_vector_type(4)));
typedef float f32x2 __attribute__((ext_vector_type(2)));
typedef float f32x16 __attribute__((ext_vector_type(16)));
typedef short bf16x8 __attribute__((ext_vector_type(8)));
using pg8::cvt_pk_bf16; using pg8::bf_lo; using pg8::bf_hi;

__device__ __forceinline__ float wave_sum(float v) {
#pragma unroll
    for (int o = 1; o < 64; o <<= 1) v += __shfl_xor(v, o);
    return v;
}
__device__ __forceinline__ float wave_max(float v) {
#pragma unroll
    for (int o = 1; o < 64; o <<= 1) v = fmaxf(v, __shfl_xor(v, o));
    return v;
}
__device__ __forceinline__ int crow(int r, int hi) { return (r & 3) + 8 * (r >> 2) + 4 * hi; }

__device__ __forceinline__ int rowmap(int mode, int n0) {
    if (mode == 0) return n0;
    if (mode == 1) {
        if (n0 < 2048) return n0;
        if (n0 < 3072) return 8192 + (n0 - 2048);
        if (n0 < 4096) return 2048 + (n0 - 3072);
        if (n0 < 5120) return 3072 + (n0 - 4096);
        if (n0 < 6144) return 9216 + (n0 - 5120);
        return 4096 + (n0 - 6144);
    }
    return 256 * (n0 >> 7) + (n0 & 127) + (mode == 3 ? 128 : 0);
}
struct P0Item { const float* W; bf16* WT; const float* gk; int K, N, mode, item, Kd, kofs; };
__device__ __forceinline__ void p0_item_load(const P0Item& d, float (&v)[32], int lane) {
    const int nblk = d.N / 32, kb = d.item / nblk, nb = d.item % nblk, k0 = 64 * kb, n0 = 32 * nb;
    const float* src = d.W + (size_t)(k0 + (lane >> 5)) * d.N + n0 + (lane & 31);
#pragma unroll
    for (int i = 0; i < 32; ++i) v[i] = __builtin_nontemporal_load(src + (size_t)(2 * i) * d.N);
}
__device__ __forceinline__ void p0_item_store(const P0Item& d, const float (&v)[32], LAS float* scr, int lane) {
    const int nblk = d.N / 32, kb = d.item / nblk, nb = d.item % nblk, k0 = 64 * kb, n0 = 32 * nb;
    const int r0 = rowmap(d.mode, n0);
    if (d.gk) {
#pragma unroll
        for (int i = 0; i < 32; ++i) { const int kk = 2 * i + (lane >> 5); scr[kk * 33 + (lane & 31)] = v[i] * d.gk[k0 + kk]; }
    } else {
#pragma unroll
        for (int i = 0; i < 32; ++i) { const int kk = 2 * i + (lane >> 5); scr[kk * 33 + (lane & 31)] = v[i]; }
    }
    asm volatile("s_waitcnt lgkmcnt(0)" ::: "memory");
    const int c = lane & 7;
#pragma unroll
    for (int j = 0; j < 4; ++j) { const int n = (lane >> 3) + 8 * j; const LAS float* s = scr + (8 * c) * 33 + n;
        u32x4 o; o.x = cvt_pk_bf16(s[0 * 33], s[1 * 33]); o.y = cvt_pk_bf16(s[2 * 33], s[3 * 33]); o.z = cvt_pk_bf16(s[4 * 33], s[5 * 33]); o.w = cvt_pk_bf16(s[6 * 33], s[7 * 33]);
        *(u32x4*)(d.WT + (size_t)(r0 + n) * d.Kd + d.kofs + k0 + 8 * c) = o; }
    asm volatile("s_waitcnt lgkmcnt(0)" ::: "memory");
}
#define RLX_AGENT __ATOMIC_RELAXED, __HIP_MEMORY_SCOPE_AGENT
#define XB_TMO      128
#define XB_XCNT(j)  (256  + 64 * (j))
#define XB_XSUB(j)  (1280 + 64 * (j))
#define XB_XGEN(j)  (2304 + 64 * (j))
#define XB_TOP      3328
#define XB_TOPGEN   3392
#define XCD_BAR_WORDS 3456
#define XB_SPIN_CAP (1u << 18)

__device__ __forceinline__ unsigned xb_ld(unsigned* p)              { return __hip_atomic_load(p, __ATOMIC_RELAXED, __HIP_MEMORY_SCOPE_AGENT); }
__device__ __forceinline__ unsigned xb_add(unsigned* p, unsigned v) { return __hip_atomic_fetch_add(p, v, __ATOMIC_RELAXED, __HIP_MEMORY_SCOPE_AGENT); }
__device__ __forceinline__ unsigned xb_xcc_id() { return (unsigned)__builtin_amdgcn_s_getreg((3 << 11) | 20) & 0xFu; }
#define XB_SPIN(cond, bar) do { unsigned _sp = 0; while (cond) { __builtin_amdgcn_s_sleep(1); \
    if ((++_sp & 255u) == 0u) { if (xb_ld(&(bar)[XB_TMO])) break; if (_sp > XB_SPIN_CAP) { atomicAdd(&(bar)[XB_TMO], 1u); break; } } } } while (0)

struct XcdBarrier {
    unsigned* bar; unsigned x;
    volatile LAS unsigned* st;
};

__device__ __forceinline__ XcdBarrier xcd_barrier_post(unsigned* bar, volatile LAS unsigned* st) {
    XcdBarrier b; b.bar = bar; b.x = xb_xcc_id(); b.st = st;
    if (threadIdx.x == 0) (void)xb_add(&bar[XB_XCNT(b.x)], 1u);
    return b;
}
__device__ __forceinline__ void xcd_barrier_complete(unsigned* bar, unsigned x, unsigned& nloc, unsigned& nx) {
    const unsigned G = gridDim.x * gridDim.y * gridDim.z;
    unsigned sum, cnt, mine, sp = 0u;
    for (;;) {
        sum = 0u; cnt = 0u; mine = 0u;
#pragma unroll
        for (unsigned j = 0; j < 16; ++j) { const unsigned c = xb_ld(&bar[XB_XCNT(j)]); sum += c; cnt += (c > 0u) ? 1u : 0u; mine = (j == x) ? c : mine; }
        if (sum == G) break;
        __builtin_amdgcn_s_sleep(1);
        if ((++sp & 255u) == 0u) { if (xb_ld(&bar[XB_TMO])) break; if (sp > XB_SPIN_CAP) { atomicAdd(&bar[XB_TMO], 1u); break; } }
    }
    nloc = mine > 0u ? mine : 1u; nx = cnt > 0u ? cnt : 1u;
}

__device__ __forceinline__ void xcd_barrier(const XcdBarrier& b) {
    asm volatile("s_waitcnt vmcnt(0)" ::: "memory");
    __syncthreads();
    if (threadIdx.x == 0) {
        unsigned* bar = b.bar;
        __builtin_amdgcn_s_waitcnt(0);
        unsigned nloc = b.st[0], nx = b.st[1];
        if (nloc == 0u) { xcd_barrier_complete(bar, b.x, nloc, nx); b.st[0] = nloc; b.st[1] = nx; }
        const unsigned old = xb_add(&bar[XB_XSUB(b.x)], 1u);
        const unsigned gen = old / nloc;
        if (old + 1u == (gen + 1u) * nloc) {
            __builtin_amdgcn_fence(__ATOMIC_RELEASE, "agent");
            asm volatile("s_waitcnt vmcnt(0)" ::: "memory");
            const unsigned og = xb_add(&bar[XB_TOP], 1u);
            const unsigned tg = og / nx;
            if (og + 1u == (tg + 1u) * nx) xb_add(&bar[XB_TOPGEN], 1u);
            else XB_SPIN(xb_ld(&bar[XB_TOPGEN]) == tg, bar);
            __builtin_amdgcn_fence(__ATOMIC_ACQUIRE, "agent");
            xb_add(&bar[XB_XGEN(b.x)], 1u);
            asm volatile("s_waitcnt vmcnt(0)" ::: "memory");
        } else {
            XB_SPIN(xb_ld(&bar[XB_XGEN(b.x)]) == gen, bar);
            __builtin_amdgcn_fence(__ATOMIC_ACQUIRE, "agent");
            asm volatile("s_waitcnt vmcnt(0)" ::: "memory");
        }
    }
    __syncthreads();
}
struct Args {
    const float *x, *p, *g_mix, *w_in, *g_na_q, *g_na_k, *na_rpb, *g_df_q, *g_df_k, *lam_q1, *lam_k1, *lam_q2, *lam_k2, *g_df_sub,
                *w_na_out, *w_df_out, *w_o, *g_ffn, *w_gate, *w_up, *w_down, *g_ple, *w_ple_gate, *w_ple_proj;
    float* out; unsigned char* ws; int ph_lo, ph_hi, rep3, pad;
};

__device__ __forceinline__ void na_wave_unit(const bf16* QKG, const bf16* VT, const float* rpb, bf16* NAO, float M2, int b, int h, int r, int half) {
    int tid_ = threadIdx.x; asm volatile("" : "+v"(tid_)); const int lane = tid_ & 63;
    const int q = lane & 31, hi = lane >> 5, c = 32 * half + q;
    const size_t tokq = (size_t)b * SEQ + r * GW + c;
    bf16x8 qf[8];
#pragma unroll
    for (int d0 = 0; d0 < 8; ++d0) qf[d0] = *(const bf16x8*)(QKG + tokq * NQKG + QC_NAQ + h * NA_DH + 16 * d0 + 8 * hi);
    int rs = r - 4; rs = rs < 0 ? 0 : (rs > GROWS - 8 ? GROWS - 8 : rs);
    int cs = c - 8; cs = cs < 0 ? 0 : (cs > GW - 16 ? GW - 16 : cs);
    f32x16 o[4];
#pragma unroll
    for (int i = 0; i < 4; ++i) o[i] = (f32x16){};
    float l = 0.f;
    for (int kr = 0; kr < 8; ++kr) {
        const int krow = rs + kr, dr = krow - r + 7;
        const float* brow = rpb + (h * 15 + dr) * 31;
#pragma unroll
        for (int kb = 0; kb < 2; ++kb) {
            f32x16 s = (f32x16){};
            const bf16* kp = QKG + ((size_t)b * SEQ + krow * GW + 32 * kb + q) * NQKG + QC_NAK + h * NA_DH + 8 * hi;
#pragma unroll
            for (int d0 = 0; d0 < 8; ++d0) { const bf16x8 kf = *(const bf16x8*)(kp + 16 * d0); s = __builtin_amdgcn_mfma_f32_32x32x16_bf16(kf, qf[d0], s, 0, 0, 0); }
            float pv[16];
#pragma unroll
            for (int i = 0; i < 16; ++i) { const int kc = 32 * kb + crow(i, hi); const bool in = (kc >= cs) && (kc < cs + 16); const int dc = in ? (kc - c + 15) : 0;
                const float bias = brow[dc] * LOG2E - M2; const float e = __builtin_amdgcn_exp2f(s[i] + bias); pv[i] = in ? e : 0.f; l += pv[i]; }
            u32x4 w0, w1;
            w0.x = cvt_pk_bf16(pv[0], pv[1]); w0.y = cvt_pk_bf16(pv[2], pv[3]); w0.z = cvt_pk_bf16(pv[4], pv[5]); w0.w = cvt_pk_bf16(pv[6], pv[7]);
            w1.x = cvt_pk_bf16(pv[8], pv[9]); w1.y = cvt_pk_bf16(pv[10], pv[11]); w1.z = cvt_pk_bf16(pv[12], pv[13]); w1.w = cvt_pk_bf16(pv[14], pv[15]);
            const bf16x8 p0 = __builtin_bit_cast(bf16x8, w0), p1 = __builtin_bit_cast(bf16x8, w1);
            const bf16* vp = VT + (size_t)(h * NA_DH + q) * M + (size_t)b * SEQ + krow * GW + 32 * kb + 8 * hi;
#pragma unroll
            for (int db = 0; db < 4; ++db) {
                const bf16x8 v0 = *(const bf16x8*)(vp + (size_t)(32 * db) * M), v1 = *(const bf16x8*)(vp + (size_t)(32 * db) * M + 16);
                o[db] = __builtin_amdgcn_mfma_f32_32x32x16_bf16(v0, p0, o[db], 0, 0, 0);
                o[db] = __builtin_amdgcn_mfma_f32_32x32x16_bf16(v1, p1, o[db], 0, 0, 0);
            }
        }
    }
    l += __shfl_xor(l, 32);
    const float rl = 1.0f / l;
    bf16* op = NAO + tokq * 2048 + h * NA_DH + 4 * hi;
#pragma unroll
    for (int db = 0; db < 4; ++db)
#pragma unroll
        for (int g = 0; g < 4; ++g) { u32x2 w; w.x = cvt_pk_bf16(o[db][4 * g] * rl, o[db][4 * g + 1] * rl); w.y = cvt_pk_bf16(o[db][4 * g + 2] * rl, o[db][4 * g + 3] * rl);
            *(u32x2*)(op + 32 * db + 8 * g) = w; }
}

__device__ __forceinline__ void df_unit(LAS unsigned char* lds, const bf16* QKG, const bf16* KC, const bf16* VT, bf16* DFO, const float* g_sub, const float* gq, const f32x2* rope, float lam, float M2, int b, int h, int qb, unsigned long long* df_wait = nullptr) {
    int tid_ = threadIdx.x; asm volatile("" : "+v"(tid_));
    const int tid = tid_, lane = tid & 63, w = __builtin_amdgcn_readfirstlane(tid >> 6), q = lane & 31, hi = lane >> 5;
    const int mm = w & 1, qg = w >> 1;
    const int q0 = qb * 128 + qg * 32;
    bf16x8 qf[4];
    {
      u32x4 qr[4]; float ss = 0.f; float xv[4][8];
#pragma unroll
      for (int d0 = 0; d0 < 4; ++d0) { qr[d0] = *(const u32x4*)(QKG + ((size_t)b * SEQ + q0 + q) * NQKG + QC_DFQ + h * 128 + mm * 64 + 16 * d0 + 8 * hi);
          xv[d0][0] = bf_lo(qr[d0].x); xv[d0][1] = bf_hi(qr[d0].x); xv[d0][2] = bf_lo(qr[d0].y); xv[d0][3] = bf_hi(qr[d0].y); xv[d0][4] = bf_lo(qr[d0].z); xv[d0][5] = bf_hi(qr[d0].z); xv[d0][6] = bf_lo(qr[d0].w); xv[d0][7] = bf_hi(qr[d0].w);
#pragma unroll
          for (int j = 0; j < 8; ++j) ss += xv[d0][j] * xv[d0][j]; }
      ss += __shfl_xor(ss, 32);
      const float rs = __builtin_amdgcn_rsqf(ss * (1.0f / 64.0f) + EPS);
      const float QS = 0.125f * LOG2E;
      const f32x2* rp = rope + (size_t)(q0 + q) * 32;
#pragma unroll
      for (int d0 = 0; d0 < 2; ++d0) { float o1[8], o2[8];
#pragma unroll
          for (int j = 0; j < 8; ++j) { const int i = 16 * d0 + 8 * hi + j; const f32x2 cs = rp[i];
              const float x1 = xv[d0][j] * rs * gq[i], x2 = xv[d0 + 2][j] * rs * gq[32 + i];
              o1[j] = (x1 * cs.x - x2 * cs.y) * QS; o2[j] = (x1 * cs.y + x2 * cs.x) * QS; }
          u32x4 wa, wb; wa.x = cvt_pk_bf16(o1[0], o1[1]); wa.y = cvt_pk_bf16(o1[2], o1[3]); wa.z = cvt_pk_bf16(o1[4], o1[5]); wa.w = cvt_pk_bf16(o1[6], o1[7]);
          wb.x = cvt_pk_bf16(o2[0], o2[1]); wb.y = cvt_pk_bf16(o2[2], o2[3]); wb.z = cvt_pk_bf16(o2[4], o2[5]); wb.w = cvt_pk_bf16(o2[6], o2[7]);
          qf[d0] = __builtin_bit_cast(bf16x8, wa); qf[d0 + 2] = __builtin_bit_cast(bf16x8, wb); } }
    const unsigned char* kbase = (const unsigned char*)(KC + ((size_t)(b * 8 + h) * SEQ) * 128);
    const unsigned char* vbase = (const unsigned char*)(VT + ((size_t)(b * 16 + 8 + h) * 64) * 128 * 64);
    unsigned koff[2], voff[2];
#pragma unroll
    for (int i = 0; i < 2; ++i) {
        const int piece = w * 2 + i;
        { const int row = piece * 4 + (lane >> 4), ph = lane & 15, ch = ph ^ (row & 15); koff[i] = (unsigned)(row * 128 + ch * 8) * 2u; }
        { const int row = piece * 8 + (lane >> 3), ph = lane & 7, ch = ph ^ ((row >> 1) & 7); voff[i] = (unsigned)(row * 64 + ch * 8) * 2u; }
    }
#define DF_DMA(kt, stg) do { const unsigned char* kb_ = kbase + (size_t)(kt) * 16384; const unsigned char* vb_ = vbase + (size_t)(kt) * 16384; _Pragma("unroll") for (int _i = 0; _i < 2; ++_i) { \
        __builtin_amdgcn_global_load_lds((const unsigned*)(kb_ + koff[_i]), (LAS unsigned*)(lds + (stg) * 32768 + (w * 2 + _i) * 1024), 16, 0, 0); \
        __builtin_amdgcn_global_load_lds((const unsigned*)(vb_ + voff[_i]), (LAS unsigned*)(lds + (stg) * 32768 + 16384 + (w * 2 + _i) * 1024), 16, 0, 0); } } while (0)
    int kofs[4], vofs[4];
#pragma unroll
    for (int d0 = 0; d0 < 4; ++d0) kofs[d0] = q * 256 + (((mm * 8 + 2 * d0 + hi) ^ (q & 15)) * 16);
#pragma unroll
    for (int g = 0; g < 4; ++g) vofs[g] = 16384 + q * 128 + (((2 * g + hi) ^ ((q >> 1) & 7)) * 16);
    f32x16 o[4];
#pragma unroll
    for (int i = 0; i < 4; ++i) o[i] = (f32x16){};
    float l = 0.f;
    const float shift = (M2 > 60.0f) ? M2 : 0.0f;
    constexpr int NT = SEQ / 64;
    typedef float f32x2_t __attribute__((ext_vector_type(2))); typedef __bf16 bf16x2_t __attribute__((ext_vector_type(2)));
#define CVTPK(lo, hi) __builtin_bit_cast(unsigned, __builtin_convertvector((f32x2_t){(lo), (hi)}, bf16x2_t))
#define DF_S(dst, St_, kb_) do { bf16x8 kf_[4]; _Pragma("unroll") for (int d0 = 0; d0 < 4; ++d0) kf_[d0] = *(const LAS bf16x8*)((St_) + kofs[d0] + (kb_) * 8192); \
        dst = (f32x16){}; _Pragma("unroll") for (int d0 = 0; d0 < 4; ++d0) dst = __builtin_amdgcn_mfma_f32_32x32x16_bf16(kf_[d0], qf[d0], dst, 0, 0, 0); } while (0)
#define DF_TILE(Stile, sv0, sv1) do { _Pragma("unroll") for (int kb = 0; kb < 2; ++kb) { \
            bf16x8 vf[2][4]; \
            _Pragma("unroll") for (int jj = 0; jj < 2; ++jj) _Pragma("unroll") for (int db = 0; db < 4; ++db) vf[jj][db] = *(const LAS bf16x8*)((Stile) + vofs[2 * kb + jj] + db * 4096); \
            f32x16 s = kb ? sv1 : sv0; \
            if (shift != 0.f) { _Pragma("unroll") for (int i = 0; i < 16; ++i) s[i] -= shift; } \
            float ls = 0.f; \
            _Pragma("unroll") for (int i = 0; i < 16; ++i) { s[i] = __builtin_amdgcn_exp2f(s[i]); ls += s[i]; } \
            l += ls; \
            u32x4 w0, w1; \
            w0.x = CVTPK(s[0], s[1]); w0.y = CVTPK(s[2], s[3]); w0.z = CVTPK(s[4], s[5]); w0.w = CVTPK(s[6], s[7]); \
            w1.x = CVTPK(s[8], s[9]); w1.y = CVTPK(s[10], s[11]); w1.z = CVTPK(s[12], s[13]); w1.w = CVTPK(s[14], s[15]); \
            const bf16x8 p0 = __builtin_bit_cast(bf16x8, w0), p1 = __builtin_bit_cast(bf16x8, w1); \
            _Pragma("unroll") for (int db = 0; db < 4; ++db) o[db] = __builtin_amdgcn_mfma_f32_32x32x16_bf16(vf[0][db], p0, o[db], 0, 0, 0); \
            _Pragma("unroll") for (int db = 0; db < 4; ++db) o[db] = __builtin_amdgcn_mfma_f32_32x32x16_bf16(vf[1][db], p1, o[db], 0, 0, 0); } } while (0)
    constexpr int NTS = NT / 2;
    DF_DMA(0, 0); DF_DMA(1, 1);
    asm volatile("s_waitcnt vmcnt(0)" ::: "memory");
    __builtin_amdgcn_s_barrier();
    asm volatile("" ::: "memory");
    for (int st = 0; st < NTS; ++st) {
        const int sb = (st & 1) * 2;
        if (st + 1 < NTS) { DF_DMA(2 * st + 2, sb ^ 2); DF_DMA(2 * st + 3, (sb ^ 2) + 1); }
        const LAS unsigned char* T0 = lds + sb * 32768;
        const LAS unsigned char* T1 = T0 + 32768;
        f32x16 a0, a1, b0, b1;
        DF_S(a0, T0, 0); DF_S(a1, T0, 1);
        DF_S(b0, T1, 0); DF_S(b1, T1, 1);
        DF_TILE(T0, a0, a1);
        DF_TILE(T1, b0, b1);
        asm volatile("s_waitcnt vmcnt(0) lgkmcnt(0)" ::: "memory");
        __builtin_amdgcn_s_barrier();
        asm volatile("" ::: "memory");
    }
#undef DF_TILE
#undef DF_S
#undef CVTPK
#undef DF_DMA
    LAS float* xch = (LAS float*)lds;
    { float lt = l; lt += __shfl_xor(lt, 32);
      const float sc = (mm == 1 ? lam : 1.0f) / lt;
#pragma unroll
      for (int db = 0; db < 4; ++db)
#pragma unroll
          for (int i = 0; i < 16; ++i) o[db][i] *= sc; }
    if (mm == 1) {
#pragma unroll
        for (int db = 0; db < 4; ++db)
#pragma unroll
            for (int i = 0; i < 16; ++i) xch[(qg * 64 + db * 16 + i) * 64 + lane] = o[db][i];
    }
    __syncthreads();
    if (mm == 0) {
        float ss = 0.f;
#pragma unroll
        for (int db = 0; db < 4; ++db)
#pragma unroll
            for (int i = 0; i < 16; ++i) { const float v = o[db][i] - xch[(qg * 64 + db * 16 + i) * 64 + lane]; o[db][i] = v; ss += v * v; }
        ss += __shfl_xor(ss, 32);
        const float rn = __builtin_amdgcn_rsqf(ss * (1.0f / 128.0f) + EPS) * (1.0f - LAM_INIT);
        bf16* op = DFO + ((size_t)b * SEQ + q0 + q) * 2048 + h * 128 + 4 * hi;
#pragma unroll
        for (int db = 0; db < 4; ++db)
#pragma unroll
            for (int g = 0; g < 4; ++g) { const f32x4 gs = *(const f32x4*)(g_sub + 32 * db + 8 * g + 4 * hi);
                u32x2 wv; wv.x = cvt_pk_bf16(o[db][4 * g] * rn * gs[0], o[db][4 * g + 1] * rn * gs[1]); wv.y = cvt_pk_bf16(o[db][4 * g + 2] * rn * gs[2], o[db][4 * g + 3] * rn * gs[3]);
                *(u32x2*)(op + 32 * db + 8 * g) = wv; }
    }
    __syncthreads();
}

__device__ __forceinline__ void na_unit(LAS unsigned char* lds, const bf16* QKG, const bf16* KC, const bf16* VT, const float* rpb, const float* gq, bf16* NAO, float M2, int b, int h, int r0) {
    int tid_ = threadIdx.x; asm volatile("" : "+v"(tid_));
    const int tid = tid_, lane = tid & 63, w = __builtin_amdgcn_readfirstlane(tid >> 6), q = lane & 31, hi = lane >> 5;
    const int rq = r0 + (w >> 1), half = w & 1, c = 32 * half + q;
    const size_t tokq = (size_t)b * SEQ + rq * GW + c;
    bf16x8 qf[8];
    {
      u32x4 qr[8]; float ss = 0.f;
#pragma unroll
      for (int d0 = 0; d0 < 8; ++d0) { qr[d0] = *(const u32x4*)(QKG + tokq * NQKG + QC_NAQ + h * NA_DH + 16 * d0 + 8 * hi);
          const float v[8] = {bf_lo(qr[d0].x), bf_hi(qr[d0].x), bf_lo(qr[d0].y), bf_hi(qr[d0].y), bf_lo(qr[d0].z), bf_hi(qr[d0].z), bf_lo(qr[d0].w), bf_hi(qr[d0].w)};
#pragma unroll
          for (int j = 0; j < 8; ++j) ss += v[j] * v[j]; }
      ss += __shfl_xor(ss, 32);
      const float rn = __builtin_amdgcn_rsqf(ss * (1.0f / 128.0f) + EPS) * (0.08838834764831845f * LOG2E);
#pragma unroll
      for (int d0 = 0; d0 < 8; ++d0) { const float* g1 = gq + 16 * d0 + 8 * hi;
          const float v[8] = {bf_lo(qr[d0].x), bf_hi(qr[d0].x), bf_lo(qr[d0].y), bf_hi(qr[d0].y), bf_lo(qr[d0].z), bf_hi(qr[d0].z), bf_lo(qr[d0].w), bf_hi(qr[d0].w)};
          u32x4 o; o.x = cvt_pk_bf16(v[0] * rn * g1[0], v[1] * rn * g1[1]); o.y = cvt_pk_bf16(v[2] * rn * g1[2], v[3] * rn * g1[3]);
          o.z = cvt_pk_bf16(v[4] * rn * g1[4], v[5] * rn * g1[5]); o.w = cvt_pk_bf16(v[6] * rn * g1[6], v[7] * rn * g1[7]);
          qf[d0] = __builtin_bit_cast(bf16x8, o); } }
    int rs = rq - 4; rs = rs < 0 ? 0 : (rs > GROWS - 8 ? GROWS - 8 : rs);
    int cs = c - 8; cs = cs < 0 ? 0 : (cs > GW - 16 ? GW - 16 : cs);
    int klo = r0 - 4; klo = klo < 0 ? 0 : (klo > GROWS - 8 ? GROWS - 8 : klo);
    int khi = r0 + 3 - 4; khi = (khi < 0 ? 0 : (khi > GROWS - 8 ? GROWS - 8 : khi)) + 7;
    const int nst = khi - klo + 1;
    const unsigned char* kbase = (const unsigned char*)(KC + ((size_t)(b * 8 + h) * SEQ + klo * GW) * 128);
    const unsigned char* vbase = (const unsigned char*)(VT + ((size_t)(b * 16 + h) * 64 + klo) * 128 * 64);
    unsigned koff[2], voff[2];
#pragma unroll
    for (int i = 0; i < 2; ++i) {
        const int piece = w * 2 + i;
        { const int row = piece * 4 + (lane >> 4), ph = lane & 15, ch = ph ^ (row & 15); koff[i] = (unsigned)(row * 128 + ch * 8) * 2u; }
        { const int row = piece * 8 + (lane >> 3), ph = lane & 7, ch = ph ^ ((row >> 1) & 7); voff[i] = (unsigned)(row * 64 + ch * 8) * 2u; }
    }
#define NA_DMA(t, stg) do { const unsigned char* kb_ = kbase + (size_t)(t) * 16384; const unsigned char* vb_ = vbase + (size_t)(t) * 16384; _Pragma("unroll") for (int _i = 0; _i < 2; ++_i) { \
        __builtin_amdgcn_global_load_lds((const unsigned*)(kb_ + koff[_i]), (LAS unsigned*)(lds + (stg) * 32768 + (w * 2 + _i) * 1024), 16, 0, 0); \
        __builtin_amdgcn_global_load_lds((const unsigned*)(vb_ + voff[_i]), (LAS unsigned*)(lds + (stg) * 32768 + 16384 + (w * 2 + _i) * 1024), 16, 0, 0); } } while (0)
    int kofs[8], vofs[4];
#pragma unroll
    for (int d0 = 0; d0 < 8; ++d0) kofs[d0] = q * 256 + (((2 * d0 + hi) ^ (q & 15)) * 16);
#pragma unroll
    for (int g = 0; g < 4; ++g) vofs[g] = 16384 + q * 128 + (((2 * g + hi) ^ ((q >> 1) & 7)) * 16);
    f32x16 o[4];
#pragma unroll
    for (int i = 0; i < 4; ++i) o[i] = (f32x16){};
    float l = 0.f;
    LAS float* btab = (LAS float*)(lds + 131072 + 1024);
    for (int i = tid; i < 15 * 31; i += NTHREADS) btab[i] = rpb[h * 15 * 31 + i] * LOG2E - M2;
    asm volatile("s_waitcnt vmcnt(0) lgkmcnt(0)" ::: "memory");
    __builtin_amdgcn_s_barrier();
    asm volatile("" ::: "memory");
    NA_DMA(0, 0); NA_DMA(1, 1);
    asm volatile("s_waitcnt vmcnt(4)" ::: "memory");
    __builtin_amdgcn_s_barrier();
    asm volatile("" ::: "memory");
    for (int t = 0; t < nst; ++t) {
        if (t + 2 < nst) NA_DMA(t + 2, (t + 2) & 3);
        const int krow = klo + t;
        if (krow >= rs && krow < rs + 8) {
            const LAS unsigned char* St = lds + (t & 3) * 32768;
            const LAS float* brow = btab + (krow - rq + 7) * 31;
#pragma unroll 1
            for (int kb = 0; kb < 2; ++kb) {
                f32x16 s = (f32x16){};
#pragma unroll
                for (int d0 = 0; d0 < 8; ++d0) { const bf16x8 kf = *(const LAS bf16x8*)(St + kofs[d0] + kb * 8192); s = __builtin_amdgcn_mfma_f32_32x32x16_bf16(kf, qf[d0], s, 0, 0, 0); }
                bf16x8 vf[2][4];
#pragma unroll
                for (int jj = 0; jj < 2; ++jj)
#pragma unroll
                    for (int db = 0; db < 4; ++db) vf[jj][db] = *(const LAS bf16x8*)(St + (kb ? vofs[2 + jj] : vofs[jj]) + db * 4096);
                float pv[16];
                const LAS float* bp = brow + (4 * hi - c + 15 + 32 * kb);
                const int wa = 4 * hi - cs + 32 * kb;
#pragma unroll
                for (int i = 0; i < 16; ++i) { const int e0 = (i & 3) + 8 * (i >> 2); const float bias = bp[e0]; const float e = __builtin_amdgcn_exp2f(s[i] + bias);
                    pv[i] = ((unsigned)(wa + e0) < 16u) ? e : 0.f; l += pv[i]; }
                u32x4 w0, w1;
                w0.x = cvt_pk_bf16(pv[0], pv[1]); w0.y = cvt_pk_bf16(pv[2], pv[3]); w0.z = cvt_pk_bf16(pv[4], pv[5]); w0.w = cvt_pk_bf16(pv[6], pv[7]);
                w1.x = cvt_pk_bf16(pv[8], pv[9]); w1.y = cvt_pk_bf16(pv[10], pv[11]); w1.z = cvt_pk_bf16(pv[12], pv[13]); w1.w = cvt_pk_bf16(pv[14], pv[15]);
                const bf16x8 p0 = __builtin_bit_cast(bf16x8, w0), p1 = __builtin_bit_cast(bf16x8, w1);
#pragma unroll
                for (int db = 0; db < 4; ++db) o[db] = __builtin_amdgcn_mfma_f32_32x32x16_bf16(vf[0][db], p0, o[db], 0, 0, 0);
#pragma unroll
                for (int db = 0; db < 4; ++db) o[db] = __builtin_amdgcn_mfma_f32_32x32x16_bf16(vf[1][db], p1, o[db], 0, 0, 0);
            }
        }
        if (t + 2 < nst) asm volatile("s_waitcnt vmcnt(4) lgkmcnt(0)" ::: "memory"); else asm volatile("s_waitcnt vmcnt(0) lgkmcnt(0)" ::: "memory");
        __builtin_amdgcn_s_barrier();
        asm volatile("" ::: "memory");
    }
#undef NA_DMA
    l += __shfl_xor(l, 32);
    const float rl = 1.0f / l;
    bf16* op = NAO + tokq * 2048 + h * NA_DH + 4 * hi;
#pragma unroll
    for (int db = 0; db < 4; ++db)
#pragma unroll
        for (int g = 0; g < 4; ++g) { u32x2 wv; wv.x = cvt_pk_bf16(o[db][4 * g] * rl, o[db][4 * g + 1] * rl); wv.y = cvt_pk_bf16(o[db][4 * g + 2] * rl, o[db][4 * g + 3] * rl);
            *(u32x2*)(op + 32 * db + 8 * g) = wv; }
}
template <int TB>
__device__ __forceinline__ void qknorm_batch(bf16* QKG, bf16* KCna, bf16* KCdf, int m0, int mstride, const float* gnk, const float* gdk, const f32x2* rope, int lane) {
    u32x4 na[TB][2], da[TB], db[TB];
#pragma unroll
    for (int t = 0; t < TB; ++t) { int mt = m0 + t * mstride; if (mt >= M) mt = M - 1; const bf16* row = QKG + (size_t)mt * NQKG;
#pragma unroll
        for (int j = 0; j < 2; ++j) na[t][j] = *(const u32x4*)(row + QC_NAK + 512 * j + 8 * lane);
        const bf16* p1 = row + QC_DFK + 64 * (lane >> 2) + 8 * (lane & 3); da[t] = *(const u32x4*)p1; db[t] = *(const u32x4*)(p1 + 32); }
#pragma unroll
    for (int t = 0; t < TB; ++t) { const int mt = m0 + t * mstride; if (mt >= M) break; const int pos = mt & (SEQ - 1);
#pragma unroll
        for (int j = 0; j < 2; ++j) {
            const u32x4 w = na[t][j];
            float v[8] = {bf_lo(w.x), bf_hi(w.x), bf_lo(w.y), bf_hi(w.y), bf_lo(w.z), bf_hi(w.z), bf_lo(w.w), bf_hi(w.w)};
            float ss = 0.f;
#pragma unroll
            for (int i = 0; i < 8; ++i) ss += v[i] * v[i];
            ss += __shfl_xor(ss, 1); ss += __shfl_xor(ss, 2); ss += __shfl_xor(ss, 4); ss += __shfl_xor(ss, 8);
            const float rs = __builtin_amdgcn_rsqf(ss * (1.0f / 128.0f) + EPS);
            const float* g = gnk + 8 * (lane & 15);
#pragma unroll
            for (int i = 0; i < 8; ++i) v[i] = v[i] * rs * g[i];
            u32x4 o; o.x = cvt_pk_bf16(v[0], v[1]); o.y = cvt_pk_bf16(v[2], v[3]); o.z = cvt_pk_bf16(v[4], v[5]); o.w = cvt_pk_bf16(v[6], v[7]);
            const int x = 512 * j + 8 * lane;
            *(u32x4*)(KCna + ((size_t)((mt >> 12) * 8 + (x >> 7)) * SEQ + pos) * 128 + (x & 127)) = o;
        }
        {
            const u32x4 wa = da[t], wb = db[t];
            float a[8] = {bf_lo(wa.x), bf_hi(wa.x), bf_lo(wa.y), bf_hi(wa.y), bf_lo(wa.z), bf_hi(wa.z), bf_lo(wa.w), bf_hi(wa.w)};
            float c[8] = {bf_lo(wb.x), bf_hi(wb.x), bf_lo(wb.y), bf_hi(wb.y), bf_lo(wb.z), bf_hi(wb.z), bf_lo(wb.w), bf_hi(wb.w)};
            float ss = 0.f;
#pragma unroll
            for (int i = 0; i < 8; ++i) ss += a[i] * a[i] + c[i] * c[i];
            ss += __shfl_xor(ss, 1); ss += __shfl_xor(ss, 2);
            const float rs = __builtin_amdgcn_rsqf(ss * (1.0f / 64.0f) + EPS);
            const float* g = gdk + 8 * (lane & 3);
            const f32x2* rp = rope + pos * 32 + 8 * (lane & 3);
            float o1[8], o2[8];
#pragma unroll
            for (int i = 0; i < 8; ++i) { const float x1 = a[i] * rs * g[i], x2 = c[i] * rs * g[32 + i]; const f32x2 cs = rp[i]; o1[i] = x1 * cs.x - x2 * cs.y; o2[i] = x1 * cs.y + x2 * cs.x; }
            u32x4 oa, ob; oa.x = cvt_pk_bf16(o1[0], o1[1]); oa.y = cvt_pk_bf16(o1[2], o1[3]); oa.z = cvt_pk_bf16(o1[4], o1[5]); oa.w = cvt_pk_bf16(o1[6], o1[7]);
            ob.x = cvt_pk_bf16(o2[0], o2[1]); ob.y = cvt_pk_bf16(o2[2], o2[3]); ob.z = cvt_pk_bf16(o2[4], o2[5]); ob.w = cvt_pk_bf16(o2[6], o2[7]);
            const int x = 64 * (lane >> 2) + 8 * (lane & 3); bf16* kp = KCdf + ((size_t)((mt >> 12) * 8 + (x >> 7)) * SEQ + pos) * 128 + (x & 127);
            *(u32x4*)kp = oa; *(u32x4*)(kp + 32) = ob;
        }
    }
}

__device__ __forceinline__ void grid_barrier(unsigned* cnt, unsigned target) {
    asm volatile("s_waitcnt vmcnt(0) lgkmcnt(0)" ::: "memory");
    __syncthreads();
    if (threadIdx.x == 0) {
        __builtin_amdgcn_fence(__ATOMIC_RELEASE, "agent");
        asm volatile("s_waitcnt vmcnt(0)" ::: "memory");
        __hip_atomic_fetch_add(cnt, 1u, __ATOMIC_RELAXED, __HIP_MEMORY_SCOPE_AGENT);
        while (__hip_atomic_load(cnt, __ATOMIC_RELAXED, __HIP_MEMORY_SCOPE_AGENT) < target) __builtin_amdgcn_s_sleep(2);
        __builtin_amdgcn_fence(__ATOMIC_ACQUIRE, "agent");
        asm volatile("s_waitcnt vmcnt(0)" ::: "memory");
    }
    __syncthreads();
}
constexpr int I_IN = 32 * 320, I_NA = 16 * 64, I_O = 32 * 64, I_G = 32 * 176, I_DN = 88 * 64, I_PP = 4 * 64;
constexpr int N_EARLY = I_IN + 2 * I_NA + I_O + 2 * I_G + I_PP, NITEMS = N_EARLY + I_DN + I_O;
#define P0_DECODE(it_, d_) do { int r = (it_); \
            if (r < I_IN) { d_ = P0Item{ap->w_in, W1t, nullptr, D, 10240, 1, r, D, 0}; break; } r -= I_IN; \
            if (r < I_NA) { d_ = P0Item{ap->w_na_out, Wna, nullptr, 1024, D, 0, r, 2048, 0}; break; } r -= I_NA; \
            if (r < I_NA) { d_ = P0Item{ap->w_df_out, Wna, nullptr, 1024, D, 0, r, 2048, 1024}; break; } r -= I_NA; \
            if (r < I_O) { d_ = P0Item{ap->w_o, Wo, nullptr, D, D, 0, r, D, 0}; break; } r -= I_O; \
            if (r < I_G) { d_ = P0Item{ap->w_gate, Wgu, ap->g_ffn, D, FF, 2, r, D, 0}; break; } r -= I_G; \
            if (r < I_G) { d_ = P0Item{ap->w_up, Wgu, ap->g_ffn, D, FF, 3, r, D, 0}; break; } r -= I_G; \
            if (r < I_PP) { d_ = P0Item{ap->w_ple_proj, Wpp, nullptr, PLE, D, 0, r, PLE, 0}; break; } r -= I_PP; \
            if (r < I_DN) { d_ = P0Item{ap->w_down, Wdn, nullptr, FF, D, 0, r, FF, 0}; break; } r -= I_DN; \
            d_ = P0Item{ap->w_ple_gate, Wpg, ap->g_ple, D, D, 0, r, D, 0}; } while (0)
constexpr int NPHASE = 9;
__global__ void __launch_bounds__(NTHREADS, 2) fwd_megakernel(Args a) {
    extern __shared__ __attribute__((aligned(16))) unsigned char lds_raw[];
    LAS unsigned char* lds = (LAS unsigned char*)lds_raw;
    cg::grid_group grid = cg::this_grid();
    const int G = gridDim.x, bx = blockIdx.x;
    const int vcu = (G % 8 == 0) ? (bx % 8) * (G / 8) + bx / 8 : bx;
    const int NGW = G * NWAVES;
typedef __attribute__((opencl_constant)) const Args* CArgsP;
#define FRESH_ARGS() auto kp_ = __builtin_amdgcn_kernarg_segment_ptr(); asm volatile("" : "+s"(kp_)); const CArgsP ap = (CArgsP)kp_
#define FRESH_TID() int tid_ = threadIdx.x; asm volatile("" : "+v"(tid_)); const int tid = tid_, lane = tid & 63, wave = __builtin_amdgcn_readfirstlane(tid >> 6), gw = vcu * NWAVES + wave; (void)lane; (void)gw
    unsigned char* ws = a.ws;
    float* RS1 = (float*)(ws + WS_RS1); float* RS2 = (float*)(ws + WS_RS2); f32x2* ROPE = (f32x2*)(ws + WS_ROPE);
    bf16 *W1t = (bf16*)(ws + WS_W1), *Wna = (bf16*)(ws + WS_WNA), *Wdf = (bf16*)(ws + WS_WDF), *Wo = (bf16*)(ws + WS_WO), *Wgu = (bf16*)(ws + WS_WGU), *Wdn = (bf16*)(ws + WS_WDN), *Wpg = (bf16*)(ws + WS_WPG), *Wpp = (bf16*)(ws + WS_WPP);
    bf16 *QKG = (bf16*)(ws + WS_A), *HB = (bf16*)(ws + WS_A);
    bf16 *XN = (bf16*)(ws + WS_B), *AO = (bf16*)(ws + WS_B), *X1B = (bf16*)(ws + WS_B), *X2B = (bf16*)(ws + WS_B);
    bf16 *VT = (bf16*)(ws + WS_C), *MRG = (bf16*)(ws + WS_C), *T2B = (bf16*)(ws + WS_C), *PB = (bf16*)(ws + WS_PB);
    bf16* KCna = (bf16*)a.out; bf16* KCdf = KCna + (size_t)M * 1024;
    const int lo = a.ph_lo, hi_ph = a.ph_hi;
    if (lo < 0) grid.sync();
    { volatile LAS unsigned* st0 = (volatile LAS unsigned*)(lds + 131072 + 768); if (threadIdx.x < 2) st0[threadIdx.x] = 0u; __syncthreads(); }
    XcdBarrier xbar = xcd_barrier_post((unsigned*)(ws + 8192), (volatile LAS unsigned*)(lds + 131072 + 768));
#ifndef PHASE_MASK
#define PHASE_MASK 0x1ff
#endif
#define IN(k) (((PHASE_MASK >> (k)) & 1) && lo <= (k) && (k) < hi_ph)
#ifdef PROBE_TS
#define STAMP(k) do { if (bx == 0 && threadIdx.x == 0) ((volatile unsigned long long*)(ws + 2048))[k] = __builtin_amdgcn_s_memrealtime(); } while (0)
#else
#define STAMP(k) do {} while (0)
#endif
#define GBAR(idx) xcd_barrier(xbar)
#define SEAM(k) do { if (IN(k) && IN((k) + 1)) GBAR(k); STAMP((k) + 1); } while (0)
#ifndef PROBE_DUP
#define PROBE_DUP 0
#endif
#define NREP(k) (((PROBE_DUP >> (k)) & 1) ? 2 : 1)

    STAMP(0);
    for (int rep_ = 0; rep_ < NREP(0); ++rep_) {
    if (IN(0)) {
        FRESH_ARGS();
        FRESH_TID();
        if (bx == 0) {
        LAS float* red = (LAS float*)(lds + 131072);
        float mq = 0.f, mk = 0.f, mdq = 0.f, mdk = 0.f, mb = 0.f;
        if (tid < 128) { mq = fabsf(ap->g_na_q[tid]); mk = fabsf(ap->g_na_k[tid]); }
        if (tid < 64) { mdq = fabsf(ap->g_df_q[tid]); mdk = fabsf(ap->g_df_k[tid]); }
        for (int i = tid; i < NA_H * 15 * 31; i += NTHREADS) mb = fmaxf(mb, ap->na_rpb[i]);
        mq = wave_max(mq); mk = wave_max(mk); mdq = wave_max(mdq); mdk = wave_max(mdk); mb = wave_max(mb);
        float d1 = 0.f, d2 = 0.f;
        if (wave == 0) { d1 = wave_sum(ap->lam_q1[lane] * ap->lam_k1[lane]); d2 = wave_sum(ap->lam_q2[lane] * ap->lam_k2[lane]); }
        if (lane == 0) { red[wave * 8 + 0] = mq; red[wave * 8 + 1] = mk; red[wave * 8 + 2] = mdq; red[wave * 8 + 3] = mdk; red[wave * 8 + 4] = mb; red[wave * 8 + 5] = d1; red[wave * 8 + 6] = d2; }
        __syncthreads();
        mq = 0.f; mk = 0.f; mdq = 0.f; mdk = 0.f; mb = 0.f;
#pragma unroll
        for (int w = 0; w < 8; ++w) { mq = fmaxf(mq, red[w * 8]); mk = fmaxf(mk, red[w * 8 + 1]); mdq = fmaxf(mdq, red[w * 8 + 2]); mdk = fmaxf(mdk, red[w * 8 + 3]); mb = fmaxf(mb, red[w * 8 + 4]); }
        if (tid == 0) { float* PARw = (float*)(ws + 3072); PARw[0] = expf(red[5]) - expf(red[6]) + LAM_INIT; PARw[1] = (11.313708498984761f * mq * mk + mb) * LOG2E + 0.125f; PARw[2] = (8.0f * mdq * mdk) * LOG2E + 0.125f; }
        __syncthreads();
        }
        LAS float* scr = (LAS float*)(lds + wave * 16384);
        {
            float cur[32], nxt[32]; P0Item dc, dn;
            int it = gw;
            if (it < N_EARLY) { P0_DECODE(it, dc); p0_item_load(dc, cur, lane); }
            for (; it < N_EARLY; it += NGW) {
                const int nit = it + NGW; const bool more = nit < N_EARLY;
                if (more) { P0_DECODE(nit, dn); p0_item_load(dn, nxt, lane); }
                p0_item_store(dc, cur, scr, lane);
                if (more) { dc = dn;
#pragma unroll
                    for (int i = 0; i < 32; ++i) cur[i] = nxt[i]; }
            }
        }
        for (int m = gw; m < M; m += NGW) {
            const f32x4* xr = (const f32x4*)(ap->x + (size_t)m * D) + lane; const f32x4* gr = (const f32x4*)ap->g_mix + lane;
            f32x4 v[8]; float s = 0.f;
#pragma unroll
            for (int j = 0; j < 8; ++j) { v[j] = __builtin_nontemporal_load(xr + 64 * j); s += (v[j].x * v[j].x + v[j].y * v[j].y) + (v[j].z * v[j].z + v[j].w * v[j].w); }
            const float rs = __builtin_amdgcn_rsqf(wave_sum(s) * (1.0f / D) + EPS);
            u32x2* o8 = (u32x2*)(XN + (size_t)m * D) + lane;
#pragma unroll
            for (int j = 0; j < 8; ++j) { const f32x4 g = gr[64 * j]; u32x2 w; w.x = cvt_pk_bf16(v[j].x * rs * g.x, v[j].y * rs * g.y); w.y = cvt_pk_bf16(v[j].z * rs * g.z, v[j].w * rs * g.w); o8[64 * j] = w; }
        }
        const int gt = vcu * NTHREADS + tid, NGT = G * NTHREADS;
        for (int i = gt; i < M * PLE / 8; i += NGT) { const f32x4 p0 = __builtin_nontemporal_load((const f32x4*)ap->p + 2 * i), p1 = __builtin_nontemporal_load((const f32x4*)ap->p + 2 * i + 1);
            u32x4 w; w.x = cvt_pk_bf16(p0.x, p0.y); w.y = cvt_pk_bf16(p0.z, p0.w); w.z = cvt_pk_bf16(p1.x, p1.y); w.w = cvt_pk_bf16(p1.z, p1.w); ((u32x4*)PB)[i] = w; }
        for (int i = gt; i < SEQ * 32; i += NGT) { const int pos = i >> 5, k = i & 31;
            const float inv = (float)(1.0 / pow(10000.0, (double)k / 32.0)); const float ang = (float)pos * inv;
            f32x2 cs; cs.x = (float)cos((double)ang); cs.y = (float)sin((double)ang); ROPE[i] = cs; }
        for (int i = gt; i < M; i += NGT) { RS1[i] = 0.f; RS2[i] = 0.f; }
    }
    }
    SEAM(0);
    for (int rep_ = 0; rep_ < NREP(1); ++rep_) {
    if (IN(1)) {
        FRESH_ARGS();
        { pg8::Gemm g{XN, W1t, M, NQKG, D}; pg8::StaticOrder S; S.init(M, NQKG, G, bx); pg8::EpiQKG E{QKG, NQKG};
          pg8::gemm_phase<pg8::EpiQKG, pg8::StaticOrder, true, true>(lds, g, S, E); }
        { pg8::Gemm g{W1t + (size_t)NQKG * D, XN, 2048, M, D}; pg8::StaticOrder S; S.init(2048, M, G, bx); pg8::EpiVT E{VT, M};
          pg8::gemm_phase<pg8::EpiVT, pg8::StaticOrder, true, true>(lds, g, S, E); }
    }
    }
    SEAM(1);
    if (IN(2)) {
        FRESH_ARGS();
        FRESH_TID();
        for (int m0 = gw; m0 < M; m0 += 4 * NGW) qknorm_batch<4>(QKG, KCna, KCdf, m0, NGW, ap->g_na_k, ap->g_df_k, ROPE, lane);
    }
    SEAM(2);
    for (int rep_ = 0; rep_ < NREP(3); ++rep_) {
    if (IN(3)) {
        FRESH_ARGS();
        FRESH_TID();
        const float* PAR = (const float*)(ws + 3072);
        const float lam = PAR[0], M2na = PAR[1], M2df = PAR[2];
#ifndef NO_DF
        for (int uu = 2 * vcu; uu < BATCH * DF_H * (SEQ / 128); uu += 2 * G)
            for (int i2 = 0; i2 < 2; ++i2) { const int uidx = uu + i2, bh = uidx >> 5, qb = uidx & 31;
#ifdef PROBE_DFWAIT
                unsigned long long dfw_ = 0;
                df_unit(lds, QKG, KCdf, VT, AO + 1024, ap->g_df_sub, ap->g_df_q, ROPE, lam, M2df, bh >> 3, bh & 7, qb, &dfw_);
                if (bx == 0 && threadIdx.x == 0) { volatile unsigned long long* TS = (volatile unsigned long long*)(ws + 2048); TS[11] = (i2 ? TS[11] : 0ull) + dfw_; TS[12] = 0ull; }
#else
                df_unit(lds, QKG, KCdf, VT, AO + 1024, ap->g_df_sub, ap->g_df_q, ROPE, lam, M2df, bh >> 3, bh & 7, qb);
#endif
            }
#endif
        STAMP(10);
#ifdef PROBE_TS
        if (threadIdx.x == 0) { atomicMax((unsigned long long*)(ws + 2048) + 14, (unsigned long long)__builtin_amdgcn_s_memrealtime()); atomicMin((unsigned long long*)(ws + 2048) + 16, (unsigned long long)__builtin_amdgcn_s_memrealtime()); }
#endif
#ifndef NO_NA
        for (int uidx = vcu; uidx < BATCH * NA_H * (GROWS / 4); uidx += G) {
            const int bh = uidx >> 4, rg = uidx & 15;
            na_unit(lds, QKG, KCna, VT, ap->na_rpb, ap->g_na_q, AO, M2na, bh >> 3, bh & 7, rg * 4);
        }
        STAMP(13);
#ifdef PROBE_TS
        if (threadIdx.x == 0) atomicMax((unsigned long long*)(ws + 2048) + 15, (unsigned long long)__builtin_amdgcn_s_memrealtime());
#endif
#endif
    }
    }
    SEAM(3);
    for (int rep_ = 0; rep_ < NREP(4); ++rep_) {
    if (IN(4)) {
        FRESH_ARGS();
        { pg8::Gemm g{AO, Wna, M, D, 2048, 16}; pg8::PairOrder S; S.S.init(M, D, G, bx); S.kob = 1024 * 2; pg8::EpiMerge E{QKG + QC_GA, QKG + QC_GB, NQKG, MRG, D, 16};
          pg8::gemm_phase<pg8::EpiMerge, pg8::PairOrder, true, true>(lds, g, S, E); }
    }
    }
    SEAM(4);
    if (IN(5)) {
        FRESH_ARGS();
        pg8::Gemm g{MRG, Wo, M, D, D}; pg8::StaticOrder S; S.init(M, D, G, bx); pg8::EpiResid<false> E{ap->x, X1B, RS1, D};
        pg8::gemm_phase<pg8::EpiResid<false>, pg8::StaticOrder, true, true>(lds, g, S, E);
    }
    SEAM(5);
    for (int rep_ = 0; rep_ < NREP(6); ++rep_) {
    if (IN(6)) {
        FRESH_ARGS();
        pg8::Gemm g{X1B, Wgu, M, 2 * FF, D}; pg8::StaticOrder S; S.init(M, 2 * FF, G, bx); pg8::EpiSwiGLU E{RS1, HB, FF, 1.0f / D, EPS};
        pg8::gemm_phase<pg8::EpiSwiGLU, pg8::StaticOrder, true, true>(lds, g, S, E);
        { constexpr int NU6 = (M / 256) * (2 * FF / 256), NU8 = (M / 256) * (D / 256);
          const int rem = NU6 % G, nshort = rem ? G - rem : G;
          pg8::TailOrder T; T.first = (rem == 0) ? bx : (bx >= rem ? bx - rem : -1); T.stride = nshort; T.total = NU8;
          int kple = PLE; asm volatile("" : "+s"(kple));
          pg8::Gemm g2{PB, Wpp, M, D, kple}; pg8::EpiStoreBf16 E2{T2B, D};
          pg8::gemm_phase<pg8::EpiStoreBf16, pg8::TailOrder, true, true>(lds, g2, T, E2);
          if (T.first >= 0) { FRESH_TID();
              LAS float* scr = (LAS float*)(lds + wave * 16384);
              const int sw = ((rem == 0) ? bx : bx - rem) * NWAVES + wave, nsw = nshort * NWAVES;
              float cur[32], nxt[32]; P0Item dc, dn;
              int it = N_EARLY + sw;
              if (it < NITEMS) { P0_DECODE(it, dc); p0_item_load(dc, cur, lane); }
              for (; it < NITEMS; it += nsw) {
                  const int nit = it + nsw; const bool more = nit < NITEMS;
                  if (more) { P0_DECODE(nit, dn); p0_item_load(dn, nxt, lane); }
                  p0_item_store(dc, cur, scr, lane);
                  if (more) { dc = dn;
#pragma unroll
                      for (int i = 0; i < 32; ++i) cur[i] = nxt[i]; }
              } } }
    }
    }
    SEAM(6);
    if (IN(7)) {
        FRESH_ARGS();
        pg8::Gemm g{HB, Wdn, M, D, FF}; pg8::StaticOrder S; S.init(M, D, G, bx); pg8::EpiResid<true> E{X1B, X2B, RS2, D};
        pg8::gemm_phase<pg8::EpiResid<true>, pg8::StaticOrder, true, true>(lds, g, S, E);
    }
    SEAM(7);
    if (IN(8)) {
        FRESH_ARGS();
#ifndef NO_P8B
        { pg8::Gemm g{X2B, Wpg, M, D, D}; pg8::StaticOrder S; S.init(M, D, G, bx); pg8::EpiPle E{RS2, T2B, X2B, ap->out, D, 1.0f / D, EPS};
          pg8::gemm_phase<pg8::EpiPle, pg8::StaticOrder, true, true>(lds, g, S, E); }
#endif
    }
#ifdef PROBE_TS
    STAMP(9);
    GBAR(8);
    { const unsigned long long* TS = (const unsigned long long*)(ws + 2048);
      const unsigned long long ta = __hip_atomic_load(TS + PROBE_A, __ATOMIC_RELAXED, __HIP_MEMORY_SCOPE_AGENT), tb = __hip_atomic_load(TS + PROBE_B, __ATOMIC_RELAXED, __HIP_MEMORY_SCOPE_AGENT);
      const int K = PROBE_CONST ? PROBE_CONST : (int)((tb - ta) / 8);
      FRESH_ARGS();
      for (int i = vcu * NTHREADS + (int)threadIdx.x; i < K && i < 42000; i += G * NTHREADS) ap->out[(size_t)i * 397] += 0.125f; }
#endif
#undef IN
#undef SEAM
}

#ifndef MK_SPLIT
#define MK_SPLIT 0
#endif
extern "C" void kernel_launch(void* const* d_in, const int* in_sizes, int n_in, void* d_out, int out_size, void* d_ws, size_t ws_size, hipStream_t stream) {
    static int grid = 0;
    if (grid == 0) {
        if (n_in != 24 || in_sizes[0] != M * D || out_size != M * D || ws_size < WS_END) { fprintf(stderr, "kernel_launch: unexpected shapes (n_in %d, in0 %d, out %d, ws %zu); nothing launched\n", n_in, n_in > 0 ? in_sizes[0] : -1, out_size, ws_size); grid = -1; return; }
        int dev = 0, cus = 0, per_cu = 0;
        hipGetDevice(&dev); hipDeviceGetAttribute(&cus, hipDeviceAttributeMultiprocessorCount, dev);
        hipFuncSetAttribute((const void*)fwd_megakernel, hipFuncAttributeMaxDynamicSharedMemorySize, LDS_BYTES);
        hipOccupancyMaxActiveBlocksPerMultiprocessor(&per_cu, (const void*)fwd_megakernel, NTHREADS, LDS_BYTES);
        if (per_cu < 1) per_cu = 1;
        grid = cus * per_cu;
        (void)hipGetLastError();
    }
    if (grid < 0) return;
    Args a{};
    const float** ap = (const float**)&a;
    for (int i = 0; i < 24; ++i) ap[i] = (const float*)d_in[i];
    a.out = (float*)d_out; a.ws = (unsigned char*)d_ws; a.rep3 = NREP(3); a.pad = 0;
#if MK_SPLIT
    for (int ph = 0; ph < NPHASE; ++ph) { a.ph_lo = ph; a.ph_hi = ph + 1; hipLaunchKernelGGL(fwd_megakernel, dim3(grid), dim3(NTHREADS), LDS_BYTES, stream, a); }
#else
    a.ph_lo = 0; a.ph_hi = NPHASE;
    (void)hipMemsetAsync((unsigned char*)d_ws + 4096, 0, 20480, stream);
#ifdef PROBE_TS
    (void)hipMemsetAsync((unsigned char*)d_ws + 2048 + 14 * 8, 0, 16, stream); (void)hipMemsetAsync((unsigned char*)d_ws + 2048 + 16 * 8, 0x7f, 8, stream);
#endif
    void* args[] = {&a};
    hipError_t e = hipLaunchCooperativeKernel((const void*)fwd_megakernel, dim3(grid), dim3(NTHREADS), args, LDS_BYTES, stream);
    if (e != hipSuccess) fprintf(stderr, "cooperative launch failed: %s (grid %d)\n", hipGetErrorString(e), grid);
#endif
}
```

```cpp
#include <hip/hip_runtime.h>
#include <hip/hip_cooperative_groups.h>
#include <cstdio>
#include <cstdint>
namespace cg = cooperative_groups;
namespace pg8 {
#define PG8_LAS __attribute__((address_space(3)))
typedef unsigned short bf16_t;
typedef short bf16x8 __attribute__((ext_vector_type(8)));
typedef float f32x4 __attribute__((ext_vector_type(4)));
typedef unsigned u32x4 __attribute__((ext_vector_type(4)));
constexpr int BM = 256, BK = 64, HALF = 128, HTB = HALF * BK * 2  , STAGE_BYTES = 8 * HTB, NXCD = 8, WGM = 8;

__host__ __device__ __forceinline__ int lds_byte(int r, int c) { const int st = (r >> 4) * 2 + (c >> 5), rr = r & 15, cc = c & 31, ob = rr * 64 + cc * 2; return st * 1024 + (ob ^ (((ob >> 9) & 1) << 5)); }
__host__ __device__ __forceinline__ void stage_rc(int b, int& R, int& C) { const int st = b / 1024, sb = b % 1024, swz = sb ^ (((sb >> 9) & 1) << 5); R = (st >> 1) * 16 + swz / 64; C = (st & 1) * 32 + (swz % 64) / 2; }
__host__ __device__ __forceinline__ int perm32(int rho) { const int n = rho >> 4, i = rho & 15; return 8 * (i >> 2) + 4 * n + (i & 3); }

struct Unit { int pm, pn; int ko = 0; };
struct Gemm { const bf16_t* A; const bf16_t* Bt; int M, N, K; int nt = 0; };

struct StaticOrder {
    int nM, nN, nwg, G, c;
    __host__ __device__ void init(int M, int N, int G_, int c_) { nM = M / BM; nN = N / BM; nwg = nM * nN; G = G_; c = c_; }
    __host__ __device__ bool next(int i, Unit& u) const {
        const long L = (long)i * G + c; if (L >= nwg) return false;
        int wgid = (int)L; { const int q = nwg / NXCD, r = nwg % NXCD, xcd = wgid % NXCD, off = wgid / NXCD; wgid = (xcd < r ? xcd * (q + 1) : r * (q + 1) + (xcd - r) * q) + off; }
        const int nig = WGM * nN, gid = wgid / nig, fm = gid * WGM, gsz = (nM - fm) < WGM ? (nM - fm) : WGM;
        u.pm = fm + ((wgid % nig) % gsz); u.pn = (wgid % nig) / gsz; return true;
    }
    __device__ __forceinline__ void a_ready(const Unit&) const {}
    __device__ __forceinline__ void done(const Unit&) const {}
};


struct TailOrder {
    int first, stride, total;
    __host__ __device__ bool next(int i, Unit& u) const { if (first < 0) return false; const int j = first + i * stride; if (j >= total) return false; u.pm = j >> 3; u.pn = j & 7; return true; }
    __device__ __forceinline__ void a_ready(const Unit&) const {}
    __device__ __forceinline__ void done(const Unit&) const {}
};

struct PairOrder {
    StaticOrder S; int kob;
    __host__ __device__ bool next(int i, Unit& u) const { if (!S.next(i >> 1, u)) return false; u.ko = (i & 1) * kob; return true; }
    __device__ __forceinline__ void a_ready(const Unit&) const {}
    __device__ __forceinline__ void done(const Unit&) const {}
};
typedef float cvt_f32x2_t __attribute__((ext_vector_type(2))); typedef __bf16 cvt_bf16x2_t __attribute__((ext_vector_type(2)));
__device__ __forceinline__ unsigned cvt_pk_bf16(float lo, float hi) { return __builtin_bit_cast(unsigned, __builtin_convertvector((cvt_f32x2_t){lo, hi}, cvt_bf16x2_t)); }
__device__ __forceinline__ float bf_lo(unsigned w) { return __uint_as_float(w << 16); }
__device__ __forceinline__ float bf_hi(unsigned w) { return __uint_as_float(w & 0xffff0000u); }
__device__ __forceinline__ float sigmoidf_(float x) { return __builtin_amdgcn_rcpf(1.0f + __expf(-x)); }
typedef unsigned u32x2 __attribute__((ext_vector_type(2)));
#define EPI_FENCE() do { if (m & 1) asm volatile("" ::: "memory"); } while (0)
#define EPI_ROWS(...) _Pragma("unroll") for (int ai = 0; ai < 2; ++ai) _Pragma("unroll") for (int m = 0; m < 4; ++m) { const int row = u.pm * BM + ai * HALF + wr * 64 + m * 16 + fr; __VA_ARGS__ }

struct EpiQKG {
    static constexpr bool PERM = true, AFTER_DRAIN = false, MIDK = false;
    bf16_t* O; int ldc;
    __device__ __forceinline__ void operator()(const f32x4 (&acc)[2][2][4][2], const Unit& u, int wr, int wc, int fr, int fq) const {
        const bool gate = u.pn >= 16; const int col0 = u.pn * BM + wc * 32 + 8 * fq;
        EPI_ROWS(
            bf16_t* rowp = O + (size_t)row * ldc + col0;
            _Pragma("unroll") for (int bj = 0; bj < 2; ++bj) { f32x4 v0 = acc[ai][bj][m][0], v1 = acc[ai][bj][m][1];
                if (gate) { _Pragma("unroll") for (int j = 0; j < 4; ++j) { v0[j] = sigmoidf_(v0[j]); v1[j] = sigmoidf_(v1[j]); } }
                u32x4 w; w.x = cvt_pk_bf16(v0[0], v0[1]); w.y = cvt_pk_bf16(v0[2], v0[3]); w.z = cvt_pk_bf16(v1[0], v1[1]); w.w = cvt_pk_bf16(v1[2], v1[3]);
                *(u32x4*)(rowp + bj * HALF) = w; }
            EPI_FENCE();
        )
    }
};
struct EpiVT {
    static constexpr bool PERM = true, AFTER_DRAIN = false, MIDK = false;
    bf16_t* O; int ldc;
    __device__ __forceinline__ void operator()(const f32x4 (&acc)[2][2][4][2], const Unit& u, int wr, int wc, int fr, int fq) const {
        const int cbase = u.pn * BM + wc * 32 + 16 * (fq >> 1) + 4 * (fq & 1);
        EPI_ROWS(
            const int hv = row >> 7, dd = row & 127;
            _Pragma("unroll") for (int bj = 0; bj < 2; ++bj) _Pragma("unroll") for (int n = 0; n < 2; ++n) { const f32x4 v = acc[ai][bj][m][n];
                const int col = cbase + bj * HALF + 8 * n, bb = col >> 12, kt = (col >> 6) & 63, pos = col & 63;
                u32x2 w; w.x = cvt_pk_bf16(v[0], v[1]); w.y = cvt_pk_bf16(v[2], v[3]);
                *(u32x2*)(O + ((((size_t)(bb * 16 + hv)) * 64 + kt) * 128 + dd) * 64 + pos) = w; }
            EPI_FENCE();
        )
    }
};
struct EpiMerge {
    static constexpr bool PERM = true, AFTER_DRAIN = false, MIDK = true;
    const bf16_t* GA; const bf16_t* GB; int ldg; bf16_t* O; int ldc; int midk;
    __device__ __forceinline__ void mid(f32x4 (&acc)[2][2][4][2], const Unit& u, int wr, int wc, int fr, int fq) const {
        const int col0 = u.pn * BM + wc * 32 + 8 * fq;
        EPI_ROWS(
            _Pragma("unroll") for (int bj = 0; bj < 2; ++bj) { const size_t off = (size_t)row * ldg + col0 + bj * HALF;
                const u32x4 a = *(const u32x4*)(GA + off), b = *(const u32x4*)(GB + off);
                float r[8];
                r[0] = bf_lo(a.x) * __builtin_amdgcn_rcpf(fmaxf(bf_lo(b.x), 1e-30f)); r[1] = bf_hi(a.x) * __builtin_amdgcn_rcpf(fmaxf(bf_hi(b.x), 1e-30f));
                r[2] = bf_lo(a.y) * __builtin_amdgcn_rcpf(fmaxf(bf_lo(b.y), 1e-30f)); r[3] = bf_hi(a.y) * __builtin_amdgcn_rcpf(fmaxf(bf_hi(b.y), 1e-30f));
                r[4] = bf_lo(a.z) * __builtin_amdgcn_rcpf(fmaxf(bf_lo(b.z), 1e-30f)); r[5] = bf_hi(a.z) * __builtin_amdgcn_rcpf(fmaxf(bf_hi(b.z), 1e-30f));
                r[6] = bf_lo(a.w) * __builtin_amdgcn_rcpf(fmaxf(bf_lo(b.w), 1e-30f)); r[7] = bf_hi(a.w) * __builtin_amdgcn_rcpf(fmaxf(bf_hi(b.w), 1e-30f));
                _Pragma("unroll") for (int j = 0; j < 4; ++j) { acc[ai][bj][m][0][j] *= r[j]; acc[ai][bj][m][1][j] *= r[4 + j]; } }
            EPI_FENCE();
        )
    }
    __device__ __forceinline__ void operator()(const f32x4 (&acc)[2][2][4][2], const Unit& u, int wr, int wc, int fr, int fq) const {
        const int col0 = u.pn * BM + wc * 32 + 8 * fq;
        EPI_ROWS(
            _Pragma("unroll") for (int bj = 0; bj < 2; ++bj) { const u32x4 b = *(const u32x4*)(GB + (size_t)row * ldg + col0 + bj * HALF);
                f32x4 v0 = acc[ai][bj][m][0], v1 = acc[ai][bj][m][1];
                v0[0] *= fmaxf(bf_lo(b.x), 1e-30f); v0[1] *= fmaxf(bf_hi(b.x), 1e-30f); v0[2] *= fmaxf(bf_lo(b.y), 1e-30f); v0[3] *= fmaxf(bf_hi(b.y), 1e-30f);
                v1[0] *= fmaxf(bf_lo(b.z), 1e-30f); v1[1] *= fmaxf(bf_hi(b.z), 1e-30f); v1[2] *= fmaxf(bf_lo(b.w), 1e-30f); v1[3] *= fmaxf(bf_hi(b.w), 1e-30f);
                u32x4 w; w.x = cvt_pk_bf16(v0[0], v0[1]); w.y = cvt_pk_bf16(v0[2], v0[3]); w.z = cvt_pk_bf16(v1[0], v1[1]); w.w = cvt_pk_bf16(v1[2], v1[3]);
                *(u32x4*)(O + (size_t)row * ldc + col0 + bj * HALF) = w; }
            EPI_FENCE();
        )
    }
};
template <bool BASE_BF16> struct EpiResid {
    static constexpr bool PERM = true, AFTER_DRAIN = false, MIDK = false;
    const void* base; bf16_t* ob; float* rowss; int ldc;
    __device__ __forceinline__ void operator()(const f32x4 (&acc)[2][2][4][2], const Unit& u, int wr, int wc, int fr, int fq) const {
        const int col0 = u.pn * BM + wc * 32 + 8 * fq;
        EPI_ROWS(
            float ss = 0.f;
            _Pragma("unroll") for (int bj = 0; bj < 2; ++bj) { const size_t off = (size_t)row * ldc + col0 + bj * HALF;
                f32x4 b0, b1;
                if (BASE_BF16) { const u32x4 bw = *(const u32x4*)((const bf16_t*)base + off); b0 = (f32x4){bf_lo(bw.x), bf_hi(bw.x), bf_lo(bw.y), bf_hi(bw.y)}; b1 = (f32x4){bf_lo(bw.z), bf_hi(bw.z), bf_lo(bw.w), bf_hi(bw.w)}; }
                else { b0 = __builtin_nontemporal_load((const f32x4*)((const float*)base + off)); b1 = __builtin_nontemporal_load((const f32x4*)((const float*)base + off + 4)); }
                const f32x4 v0 = acc[ai][bj][m][0] + b0, v1 = acc[ai][bj][m][1] + b1;
                ss += (v0[0] * v0[0] + v0[1] * v0[1]) + (v0[2] * v0[2] + v0[3] * v0[3]) + (v1[0] * v1[0] + v1[1] * v1[1]) + (v1[2] * v1[2] + v1[3] * v1[3]);
                u32x4 w; w.x = cvt_pk_bf16(v0[0], v0[1]); w.y = cvt_pk_bf16(v0[2], v0[3]); w.z = cvt_pk_bf16(v1[0], v1[1]); w.w = cvt_pk_bf16(v1[2], v1[3]);
                *(u32x4*)(ob + off) = w; }
            ss += __shfl_xor(ss, 16); ss += __shfl_xor(ss, 32);
            if (fq == 0) atomicAdd(rowss + row, ss);
            EPI_FENCE();
        )
    }
};
struct EpiSwiGLU {
    static constexpr bool PERM = true, AFTER_DRAIN = false, MIDK = false;
    const float* rowss; bf16_t* H; int ldh; float inv_d, eps;
    __device__ __forceinline__ void operator()(const f32x4 (&acc)[2][2][4][2], const Unit& u, int wr, int wc, int fr, int fq) const {
        const int col0 = u.pn * HALF + wc * 32 + 8 * fq;
        EPI_ROWS(
            const float rs = __builtin_amdgcn_rsqf(rowss[row] * inv_d + eps);
            float hv[8];
            _Pragma("unroll") for (int n = 0; n < 2; ++n) _Pragma("unroll") for (int j = 0; j < 4; ++j) { const float g = acc[ai][0][m][n][j] * rs, up = acc[ai][1][m][n][j] * rs; hv[n * 4 + j] = g * sigmoidf_(g) * up; }
            u32x4 w; w.x = cvt_pk_bf16(hv[0], hv[1]); w.y = cvt_pk_bf16(hv[2], hv[3]); w.z = cvt_pk_bf16(hv[4], hv[5]); w.w = cvt_pk_bf16(hv[6], hv[7]);
            *(u32x4*)(H + (size_t)row * ldh + col0) = w;
            EPI_FENCE();
        )
    }
};
struct EpiStoreBf16 {
    static constexpr bool PERM = true, AFTER_DRAIN = false, MIDK = false;
    bf16_t* T; int ldc;
    __device__ __forceinline__ void operator()(const f32x4 (&acc)[2][2][4][2], const Unit& u, int wr, int wc, int fr, int fq) const {
        const int col0 = u.pn * BM + wc * 32 + 8 * fq;
        EPI_ROWS(
            _Pragma("unroll") for (int bj = 0; bj < 2; ++bj) { const f32x4 v0 = acc[ai][bj][m][0], v1 = acc[ai][bj][m][1];
                u32x4 w; w.x = cvt_pk_bf16(v0[0], v0[1]); w.y = cvt_pk_bf16(v0[2], v0[3]); w.z = cvt_pk_bf16(v1[0], v1[1]); w.w = cvt_pk_bf16(v1[2], v1[3]);
                *(u32x4*)(T + (size_t)row * ldc + col0 + bj * HALF) = w; }
            EPI_FENCE();
        )
    }
};
struct EpiPle {
    static constexpr bool PERM = true, AFTER_DRAIN = false, MIDK = false;
    const float* rowss; const bf16_t* T; const bf16_t* X; float* out; int ldc; float inv_d, eps;
    __device__ __forceinline__ void operator()(const f32x4 (&acc)[2][2][4][2], const Unit& u, int wr, int wc, int fr, int fq) const {
        const int col0 = u.pn * BM + wc * 32 + 8 * fq;
        EPI_ROWS(
            const float rs = __builtin_amdgcn_rsqf(rowss[row] * inv_d + eps);
            _Pragma("unroll") for (int bj = 0; bj < 2; ++bj) { const size_t off = (size_t)row * ldc + col0 + bj * HALF;
                const u32x4 tw = *(const u32x4*)(T + off), xw = *(const u32x4*)(X + off);
                const float t[8] = {bf_lo(tw.x), bf_hi(tw.x), bf_lo(tw.y), bf_hi(tw.y), bf_lo(tw.z), bf_hi(tw.z), bf_lo(tw.w), bf_hi(tw.w)};
                const float x[8] = {bf_lo(xw.x), bf_hi(xw.x), bf_lo(xw.y), bf_hi(xw.y), bf_lo(xw.z), bf_hi(xw.z), bf_lo(xw.w), bf_hi(xw.w)};
                f32x4 o0, o1;
                _Pragma("unroll") for (int j = 0; j < 4; ++j) { o0[j] = x[j] + sigmoidf_(acc[ai][bj][m][0][j] * rs) * t[j]; o1[j] = x[4 + j] + sigmoidf_(acc[ai][bj][m][1][j] * rs) * t[4 + j]; }
                __builtin_nontemporal_store(o0, (f32x4*)(out + off)); __builtin_nontemporal_store(o1, (f32x4*)(out + off + 4)); }
            EPI_FENCE();
        )
    }
};
template <class Epi, class Sched, bool ALIGN_EPI = false, bool SP2 = false>
__device__ __forceinline__ void gemm_phase(PG8_LAS unsigned char* lds, const Gemm g, const Sched& S, const Epi& E) {
    int tid_ = threadIdx.x; asm volatile("" : "+v"(tid_));
    const int tid = tid_, wid = __builtin_amdgcn_readfirstlane(tid >> 6), lane = tid & 63, wr = wid >> 2, wc = wid & 3, fr = lane & 15, fq = lane >> 4;
    const int K = g.K, nt = g.nt ? g.nt : K / BK;
    unsigned voffA[2], voffB[2];
#pragma unroll
    for (int i = 0; i < 2; ++i) { int R, C; stage_rc(tid * 16 + i * 8192, R, C); const int Rb = Epi::PERM ? ((R & ~31) + perm32(R & 31)) : R;
        voffA[i] = (unsigned)(R * K + C) * 2u; voffB[i] = (unsigned)(Rb * K + C) * 2u; }
    const size_t kstep = (size_t)(BK * 2);
    const size_t hstep = (size_t)HALF * K * 2;
    const size_t tstep = 2 * hstep;
    const unsigned ldsw = (unsigned)wid * 1024u;
    const int aoff = lds_byte(wr * 64 + fr, fq * 8), boff = lds_byte(wc * 32 + fr, fq * 8);
#define PG8_SA(b, h) (((b) * 2 + (h)) * HTB)
#define PG8_SB(b, h) ((4 + (b) * 2 + (h)) * HTB)
#define PG8_STAGE(bufoff, gbase, voff) do { _Pragma("unroll") for (int _i = 0; _i < 2; ++_i) \
        __builtin_amdgcn_global_load_lds((const unsigned*)((const char*)(gbase) + (voff)[_i]), (PG8_LAS unsigned*)(lds + (bufoff) + ldsw + _i * 8192), 16, 0, 0); } while (0)
#define PG8_LDA(dst, b, h) do { _Pragma("unroll") for (int m = 0; m < 4; ++m) _Pragma("unroll") for (int k = 0; k < 2; ++k) dst[m][k] = *(const PG8_LAS bf16x8*)(lds + PG8_SA(b, h) + aoff + m * 2048 + k * 1024); } while (0)
#define PG8_LDB(dst, b, h) do { _Pragma("unroll") for (int n = 0; n < 2; ++n) _Pragma("unroll") for (int k = 0; k < 2; ++k) dst[n][k] = *(const PG8_LAS bf16x8*)(lds + PG8_SB(b, h) + boff + n * 2048 + k * 1024); } while (0)
#define PG8_MMA(ai, bj, At, Bt) do { __builtin_amdgcn_s_setprio(1); _Pragma("unroll") for (int m = 0; m < 4; ++m) _Pragma("unroll") for (int n = 0; n < 2; ++n) _Pragma("unroll") for (int k = 0; k < 2; ++k) \
        acc[ai][bj][m][n] = __builtin_amdgcn_mfma_f32_16x16x32_bf16(Bt[n][k], At[m][k], acc[ai][bj][m][n], 0, 0, 0); __builtin_amdgcn_s_setprio(0); } while (0)
#define PG8_WAIT_V(n) asm volatile("s_waitcnt vmcnt(" #n ")" ::: "memory")
#define PG8_WAIT_L(n) asm volatile("s_waitcnt lgkmcnt(" #n ")" ::: "memory")
#define PG8_BAR __builtin_amdgcn_s_barrier()
#define PG8_SCHED __builtin_amdgcn_sched_barrier(0)
    Unit cur, nxt; int ui = 0;
    if (!S.next(0, cur)) return;
    f32x4 acc[2][2][4][2];
#pragma unroll
    for (int a = 0; a < 2; ++a)
#pragma unroll
        for (int b = 0; b < 2; ++b)
#pragma unroll
            for (int m = 0; m < 4; ++m)
#pragma unroll
                for (int n = 0; n < 2; ++n) acc[a][b][m][n] = (f32x4){0.f, 0.f, 0.f, 0.f};
    bf16x8 At[4][2], B0[2][2], B1[2][2];
    const char* cA = (const char*)g.A + (size_t)cur.pm * tstep + cur.ko; const char* cB = (const char*)g.Bt + (size_t)cur.pn * tstep + cur.ko;
    S.a_ready(cur);
    if constexpr (SP2) {
        PG8_STAGE(PG8_SB(0, 0), cB, voffB); PG8_STAGE(PG8_SB(0, 1), cB + hstep, voffB); PG8_STAGE(PG8_SA(0, 0), cA, voffA); PG8_STAGE(PG8_SA(0, 1), cA + hstep, voffA);
        if (wr == 1) PG8_BAR;
        PG8_WAIT_V(2); PG8_BAR;
        PG8_STAGE(PG8_SB(1, 0), cB + kstep, voffB); PG8_STAGE(PG8_SA(1, 0), cA + kstep, voffA); PG8_STAGE(PG8_SB(1, 1), cB + hstep + kstep, voffB);
        PG8_WAIT_V(6); PG8_BAR;
    } else {
        PG8_STAGE(PG8_SB(0, 0), cB, voffB); PG8_STAGE(PG8_SA(0, 0), cA, voffA); PG8_STAGE(PG8_SB(0, 1), cB + hstep, voffB); PG8_STAGE(PG8_SA(0, 1), cA + hstep, voffA);
        if (wr == 1) PG8_BAR;
        PG8_WAIT_V(4); PG8_BAR;
        PG8_STAGE(PG8_SB(1, 0), cB + kstep, voffB); PG8_STAGE(PG8_SA(1, 0), cA + kstep, voffA); PG8_STAGE(PG8_SB(1, 1), cB + hstep + kstep, voffB);
        PG8_WAIT_V(6); PG8_BAR;
    }
    for (;;) {
        const bool has_next = S.next(ui + 1, nxt);
        const char* nA = has_next ? (const char*)g.A + (size_t)nxt.pm * tstep + nxt.ko : cA; const char* nB = has_next ? (const char*)g.Bt + (size_t)nxt.pn * tstep + nxt.ko : cB;
        for (int t = 0; t < nt; t += 2) {
            const bool last = (t == nt - 2);
            const char* a1 = cA + (size_t)(t + 1) * kstep;
            const char* a2 = last ? nA : cA + (size_t)(t + 2) * kstep; const char* b2 = last ? nB : cB + (size_t)(t + 2) * kstep;
            const char* a3 = a2 + kstep; const char* b3 = b2 + kstep;
            if (last && has_next) S.a_ready(nxt);
            if constexpr (SP2) {
            PG8_LDB(B0, 0, 0); PG8_LDB(B1, 0, 1); PG8_SCHED; PG8_LDA(At, 0, 0); PG8_STAGE(PG8_SA(1, 1), a1 + hstep, voffA);
            PG8_WAIT_V(8); PG8_WAIT_L(0); PG8_BAR; PG8_MMA(0, 0, At, B0); PG8_MMA(0, 1, At, B1); PG8_BAR; PG8_SCHED;
            PG8_LDA(At, 0, 1); PG8_STAGE(PG8_SB(0, 0), b2, voffB); PG8_STAGE(PG8_SB(0, 1), b2 + hstep, voffB); PG8_STAGE(PG8_SA(0, 0), a2, voffA);
            PG8_WAIT_V(8); PG8_WAIT_L(0); PG8_BAR; PG8_MMA(1, 0, At, B0); PG8_MMA(1, 1, At, B1); PG8_BAR; PG8_SCHED;
            PG8_LDB(B0, 1, 0); PG8_LDB(B1, 1, 1); PG8_SCHED; PG8_LDA(At, 1, 0); PG8_STAGE(PG8_SA(0, 1), a2 + hstep, voffA);
            PG8_WAIT_V(8); PG8_WAIT_L(0); PG8_BAR; PG8_MMA(0, 0, At, B0); PG8_MMA(0, 1, At, B1); PG8_BAR; PG8_SCHED;
            PG8_LDA(At, 1, 1); PG8_STAGE(PG8_SB(1, 0), b3, voffB); PG8_STAGE(PG8_SB(1, 1), b3 + hstep, voffB); PG8_STAGE(PG8_SA(1, 0), a3, voffA);
            PG8_WAIT_V(8); PG8_WAIT_L(0); PG8_BAR; PG8_MMA(1, 0, At, B0); PG8_MMA(1, 1, At, B1); PG8_BAR; PG8_SCHED;
            } else {
            PG8_LDB(B0, 0, 0); PG8_SCHED; PG8_LDA(At, 0, 0); PG8_STAGE(PG8_SA(1, 1), a1 + hstep, voffA);
            PG8_WAIT_L(8); PG8_BAR; PG8_WAIT_L(0); PG8_MMA(0, 0, At, B0); PG8_BAR; PG8_SCHED;
            PG8_LDB(B1, 0, 1); PG8_STAGE(PG8_SB(0, 0), b2, voffB);
            PG8_BAR; PG8_WAIT_L(0); PG8_MMA(0, 1, At, B1); PG8_BAR;
            PG8_LDA(At, 0, 1); PG8_STAGE(PG8_SA(0, 0), a2, voffA);
            PG8_BAR; PG8_WAIT_L(0); PG8_MMA(1, 0, At, B0); PG8_BAR; PG8_SCHED;
            PG8_STAGE(PG8_SB(0, 1), b2 + hstep, voffB);
            PG8_WAIT_V(6); PG8_BAR; PG8_MMA(1, 1, At, B1); PG8_BAR;
            PG8_LDB(B0, 1, 0); PG8_SCHED; PG8_LDA(At, 1, 0); PG8_STAGE(PG8_SA(0, 1), a2 + hstep, voffA);
            PG8_WAIT_L(8); PG8_BAR; PG8_WAIT_L(0); PG8_MMA(0, 0, At, B0); PG8_BAR; PG8_SCHED;
            PG8_LDB(B1, 1, 1); PG8_STAGE(PG8_SB(1, 0), b3, voffB);
            PG8_BAR; PG8_WAIT_L(0); PG8_MMA(0, 1, At, B1); PG8_BAR;
            PG8_LDA(At, 1, 1); PG8_STAGE(PG8_SA(1, 0), a3, voffA);
            PG8_BAR; PG8_WAIT_L(0); PG8_MMA(1, 0, At, B0); PG8_BAR; PG8_SCHED;
            PG8_STAGE(PG8_SB(1, 1), b3 + hstep, voffB);
            PG8_WAIT_V(6); PG8_BAR; PG8_MMA(1, 1, At, B1); PG8_BAR;
            }
        }
        if constexpr (ALIGN_EPI) { if (wr == 0) PG8_BAR; }
        bool keep_acc = false;
        if constexpr (Epi::MIDK) { if (cur.ko == 0) { E.mid(acc, cur, wr, wc, fr, fq); keep_acc = true; } else E(acc, cur, wr, wc, fr, fq); }
        else if constexpr (!Epi::AFTER_DRAIN) { E(acc, cur, wr, wc, fr, fq); S.done(cur); }
        if (!has_next) break;
        if (!keep_acc) {
#pragma unroll
        for (int a = 0; a < 2; ++a)
#pragma unroll
            for (int b = 0; b < 2; ++b)
#pragma unroll
                for (int m = 0; m < 4; ++m)
#pragma unroll
                    for (int n = 0; n < 2; ++n) acc[a][b][m][n] = (f32x4){0.f, 0.f, 0.f, 0.f};
        }
        cur = nxt; cA = nA; cB = nB; ++ui;
        if constexpr (ALIGN_EPI) { if (wr == 1) PG8_BAR; }
    }
    PG8_WAIT_V(0);
    if constexpr (!ALIGN_EPI) { if (wr == 0) PG8_BAR; }
    PG8_BAR;
    if constexpr (Epi::AFTER_DRAIN) { E.fused(acc, cur, wr, wc, fr, fq, lds, wid, lane); S.done(cur); }
#undef PG8_SA
#undef PG8_SB
#undef PG8_STAGE
#undef PG8_LDA
#undef PG8_LDB
#undef PG8_MMA
#undef PG8_WAIT_V
#undef PG8_WAIT_L
#undef PG8_BAR
#undef PG8_SCHED
}
}
constexpr int D = 2048, BATCH = 2, SEQ = 4096, M = BATCH * SEQ, GW = 64, GROWS = SEQ / GW, FF = 5632, PLE = 256;
constexpr int NA_H = 8, NA_DH = 128, DF_H = 8, DF_DQ = 64, DF_DV = 128;
constexpr int NQKG = 8192;
constexpr int QC_NAQ = 0, QC_NAK = 1024, QC_DFQ = 2048, QC_DFK = 3072, QC_GA = 4096, QC_GB = 6144;
constexpr float EPS = 1e-6f, LOG2E = 1.4426950408889634f;
constexpr float LAM_INIT = 0.2f;
constexpr int NWAVES = 8, NTHREADS = 512;
constexpr size_t MiB = 1u << 20;
constexpr size_t WS_RS1 = 64 * 1024, WS_RS2 = 128 * 1024, WS_ROPE = 1 * MiB;
constexpr size_t WS_W1 = 2 * MiB, WS_WNA = 42 * MiB, WS_WDF = 46 * MiB, WS_WO = 50 * MiB, WS_WGU = 58 * MiB, WS_WDN = 102 * MiB, WS_WPG = 124 * MiB, WS_WPP = 132 * MiB;
constexpr size_t WS_A = 133 * MiB;
constexpr size_t WS_B = 261 * MiB;
constexpr size_t WS_C = 293 * MiB;
constexpr size_t WS_PB = 325 * MiB;
constexpr size_t WS_END = 329 * MiB;
constexpr int LDS_BYTES = 147456;
#define LAS __attribute__((address_space(3)))
typedef unsigned short bf16;
typedef unsigned u32x4 __attribute__((ext_vector_type(4)));
typedef unsigned u32x2 __attribute__((ext_vector_type(2)));
typedef float f32x4 __attribute__((ext_vector_type(4)));
typedef float f32x2 __attribute__((ext_vector_type(2)));
typedef float f32x16 __attribute__((ext_vector_type(16)));
typedef short bf16x8 __attribute__((ext_vector_type(8)));
using pg8::cvt_pk_bf16; using pg8::bf_lo; using pg8::bf_hi;

__device__ __forceinline__ float wave_sum(float v) {
#pragma unroll
    for (int o = 1; o < 64; o <<= 1) v += __shfl_xor(v, o);
    return v;
}
__device__ __forceinline__ float wave_max(float v) {
#pragma unroll
    for (int o = 1; o < 64; o <<= 1) v = fmaxf(v, __shfl_xor(v, o));
    return v;
}
__device__ __forceinline__ int crow(int r, int hi) { return (r & 3) + 8 * (r >> 2) + 4 * hi; }

__device__ __forceinline__ int rowmap(int mode, int n0) {
    if (mode == 0) return n0;
    if (mode == 1) {
        if (n0 < 2048) return n0;
        if (n0 < 3072) return 8192 + (n0 - 2048);
        if (n0 < 4096) return 2048 + (n0 - 3072);
        if (n0 < 5120) return 3072 + (n0 - 4096);
        if (n0 < 6144) return 9216 + (n0 - 5120);
        return 4096 + (n0 - 6144);
    }
    return 256 * (n0 >> 7) + (n0 & 127) + (mode == 3 ? 128 : 0);
}
struct P0Item { const float* W; bf16* WT; const float* gk; int K, N, mode, item, Kd, kofs; };
__device__ __forceinline__ void p0_item_load(const P0Item& d, float (&v)[32], int lane) {
    const int nblk = d.N / 32, kb = d.item / nblk, nb = d.item % nblk, k0 = 64 * kb, n0 = 32 * nb;
    const float* src = d.W + (size_t)(k0 + (lane >> 5)) * d.N + n0 + (lane & 31);
#pragma unroll
    for (int i = 0; i < 32; ++i) v[i] = __builtin_nontemporal_load(src + (size_t)(2 * i) * d.N);
}
__device__ __forceinline__ void p0_item_store(const P0Item& d, const float (&v)[32], LAS float* scr, int lane) {
    const int nblk = d.N / 32, kb = d.item / nblk, nb = d.item % nblk, k0 = 64 * kb, n0 = 32 * nb;
    const int r0 = rowmap(d.mode, n0);
    if (d.gk) {
#pragma unroll
        for (int i = 0; i < 32; ++i) { const int kk = 2 * i + (lane >> 5); scr[kk * 33 + (lane & 31)] = v[i] * d.gk[k0 + kk]; }
    } else {
#pragma unroll
        for (int i = 0; i < 32; ++i) { const int kk = 2 * i + (lane >> 5); scr[kk * 33 + (lane & 31)] = v[i]; }
    }
    asm volatile("s_waitcnt lgkmcnt(0)" ::: "memory");
    const int c = lane & 7;
#pragma unroll
    for (int j = 0; j < 4; ++j) { const int n = (lane >> 3) + 8 * j; const LAS float* s = scr + (8 * c) * 33 + n;
        u32x4 o; o.x = cvt_pk_bf16(s[0 * 33], s[1 * 33]); o.y = cvt_pk_bf16(s[2 * 33], s[3 * 33]); o.z = cvt_pk_bf16(s[4 * 33], s[5 * 33]); o.w = cvt_pk_bf16(s[6 * 33], s[7 * 33]);
        *(u32x4*)(d.WT + (size_t)(r0 + n) * d.Kd + d.kofs + k0 + 8 * c) = o; }
    asm volatile("s_waitcnt lgkmcnt(0)" ::: "memory");
}
#define RLX_AGENT __ATOMIC_RELAXED, __HIP_MEMORY_SCOPE_AGENT
#define XB_TMO      128
#define XB_XCNT(j)  (256  + 64 * (j))
#define XB_XSUB(j)  (1280 + 64 * (j))
#define XB_XGEN(j)  (2304 + 64 * (j))
#define XB_TOP      3328
#define XB_TOPGEN   3392
#define XCD_BAR_WORDS 3456
#define XB_SPIN_CAP (1u << 18)

__device__ __forceinline__ unsigned xb_ld(unsigned* p)              { return __hip_atomic_load(p, __ATOMIC_RELAXED, __HIP_MEMORY_SCOPE_AGENT); }
__device__ __forceinline__ unsigned xb_add(unsigned* p, unsigned v) { return __hip_atomic_fetch_add(p, v, __ATOMIC_RELAXED, __HIP_MEMORY_SCOPE_AGENT); }
__device__ __forceinline__ unsigned xb_xcc_id() { return (unsigned)__builtin_amdgcn_s_getreg((3 << 11) | 20) & 0xFu; }
#define XB_SPIN(cond, bar) do { unsigned _sp = 0; while (cond) { __builtin_amdgcn_s_sleep(1); \
    if ((++_sp & 255u) == 0u) { if (xb_ld(&(bar)[XB_TMO])) break; if (_sp > XB_SPIN_CAP) { atomicAdd(&(bar)[XB_TMO], 1u); break; } } } } while (0)

struct XcdBarrier {
    unsigned* bar; unsigned x;
    volatile LAS unsigned* st;
};

__device__ __forceinline__ XcdBarrier xcd_barrier_post(unsigned* bar, volatile LAS unsigned* st) {
    XcdBarrier b; b.bar = bar; b.x = xb_xcc_id(); b.st = st;
    if (threadIdx.x == 0) (void)xb_add(&bar[XB_XCNT(b.x)], 1u);
    return b;
}
__device__ __forceinline__ void xcd_barrier_complete(unsigned* bar, unsigned x, unsigned& nloc, unsigned& nx) {
    const unsigned G = gridDim.x * gridDim.y * gridDim.z;
    unsigned sum, cnt, mine, sp = 0u;
    for (;;) {
        sum = 0u; cnt = 0u; mine = 0u;
#pragma unroll
        for (unsigned j = 0; j < 16; ++j) { const unsigned c = xb_ld(&bar[XB_XCNT(j)]); sum += c; cnt += (c > 0u) ? 1u : 0u; mine = (j == x) ? c : mine; }
        if (sum == G) break;
        __builtin_amdgcn_s_sleep(1);
        if ((++sp & 255u) == 0u) { if (xb_ld(&bar[XB_TMO])) break; if (sp > XB_SPIN_CAP) { atomicAdd(&bar[XB_TMO], 1u); break; } }
    }
    nloc = mine > 0u ? mine : 1u; nx = cnt > 0u ? cnt : 1u;
}

__device__ __forceinline__ void xcd_barrier(const XcdBarrier& b) {
    asm volatile("s_waitcnt vmcnt(0)" ::: "memory");
    __syncthreads();
    if (threadIdx.x == 0) {
        unsigned* bar = b.bar;
        __builtin_amdgcn_s_waitcnt(0);
        unsigned nloc = b.st[0], nx = b.st[1];
        if (nloc == 0u) { xcd_barrier_complete(bar, b.x, nloc, nx); b.st[0] = nloc; b.st[1] = nx; }
        const unsigned old = xb_add(&bar[XB_XSUB(b.x)], 1u);
        const unsigned gen = old / nloc;
        if (old + 1u == (gen + 1u) * nloc) {
            __builtin_amdgcn_fence(__ATOMIC_RELEASE, "agent");
            asm volatile("s_waitcnt vmcnt(0)" ::: "memory");
            const unsigned og = xb_add(&bar[XB_TOP], 1u);
            const unsigned tg = og / nx;
            if (og + 1u == (tg + 1u) * nx) xb_add(&bar[XB_TOPGEN], 1u);
            else XB_SPIN(xb_ld(&bar[XB_TOPGEN]) == tg, bar);
            __builtin_amdgcn_fence(__ATOMIC_ACQUIRE, "agent");
            xb_add(&bar[XB_XGEN(b.x)], 1u);
            asm volatile("s_waitcnt vmcnt(0)" ::: "memory");
        } else {
            XB_SPIN(xb_ld(&bar[XB_XGEN(b.x)]) == gen, bar);
            __builtin_amdgcn_fence(__ATOMIC_ACQUIRE, "agent");
            asm volatile("s_waitcnt vmcnt(0)" ::: "memory");
        }
    }
    __syncthreads();
}
struct Args {
    const float *x, *p, *g_mix, *w_in, *g_na_q, *g_na_k, *na_rpb, *g_df_q, *g_df_k, *lam_q1, *lam_k1, *lam_q2, *lam_k2, *g_df_sub,
                *w_na_out, *w_df_out, *w_o, *g_ffn, *w_gate, *w_up, *w_down, *g_ple, *w_ple_gate, *w_ple_proj;
    float* out; unsigned char* ws; int ph_lo, ph_hi, rep3, pad;
};

__device__ __forceinline__ void na_wave_unit(const bf16* QKG, const bf16* VT, const float* rpb, bf16* NAO, float M2, int b, int h, int r, int half) {
    int tid_ = threadIdx.x; asm volatile("" : "+v"(tid_)); const int lane = tid_ & 63;
    const int q = lane & 31, hi = lane >> 5, c = 32 * half + q;
    const size_t tokq = (size_t)b * SEQ + r * GW + c;
    bf16x8 qf[8];
#pragma unroll
    for (int d0 = 0; d0 < 8; ++d0) qf[d0] = *(const bf16x8*)(QKG + tokq * NQKG + QC_NAQ + h * NA_DH + 16 * d0 + 8 * hi);
    int rs = r - 4; rs = rs < 0 ? 0 : (rs > GROWS - 8 ? GROWS - 8 : rs);
    int cs = c - 8; cs = cs < 0 ? 0 : (cs > GW - 16 ? GW - 16 : cs);
    f32x16 o[4];
#pragma unroll
    for (int i = 0; i < 4; ++i) o[i] = (f32x16){};
    float l = 0.f;
    for (int kr = 0; kr < 8; ++kr) {
        const int krow = rs + kr, dr = krow - r + 7;
        const float* brow = rpb + (h * 15 + dr) * 31;
#pragma unroll
        for (int kb = 0; kb < 2; ++kb) {
            f32x16 s = (f32x16){};
            const bf16* kp = QKG + ((size_t)b * SEQ + krow * GW + 32 * kb + q) * NQKG + QC_NAK + h * NA_DH + 8 * hi;
#pragma unroll
            for (int d0 = 0; d0 < 8; ++d0) { const bf16x8 kf = *(const bf16x8*)(kp + 16 * d0); s = __builtin_amdgcn_mfma_f32_32x32x16_bf16(kf, qf[d0], s, 0, 0, 0); }
            float pv[16];
#pragma unroll
            for (int i = 0; i < 16; ++i) { const int kc = 32 * kb + crow(i, hi); const bool in = (kc >= cs) && (kc < cs + 16); const int dc = in ? (kc - c + 15) : 0;
                const float bias = brow[dc] * LOG2E - M2; const float e = __builtin_amdgcn_exp2f(s[i] + bias); pv[i] = in ? e : 0.f; l += pv[i]; }
            u32x4 w0, w1;
            w0.x = cvt_pk_bf16(pv[0], pv[1]); w0.y = cvt_pk_bf16(pv[2], pv[3]); w0.z = cvt_pk_bf16(pv[4], pv[5]); w0.w = cvt_pk_bf16(pv[6], pv[7]);
            w1.x = cvt_pk_bf16(pv[8], pv[9]); w1.y = cvt_pk_bf16(pv[10], pv[11]); w1.z = cvt_pk_bf16(pv[12], pv[13]); w1.w = cvt_pk_bf16(pv[14], pv[15]);
            const bf16x8 p0 = __builtin_bit_cast(bf16x8, w0), p1 = __builtin_bit_cast(bf16x8, w1);
            const bf16* vp = VT + (size_t)(h * NA_DH + q) * M + (size_t)b * SEQ + krow * GW + 32 * kb + 8 * hi;
#pragma unroll
            for (int db = 0; db < 4; ++db) {
                const bf16x8 v0 = *(const bf16x8*)(vp + (size_t)(32 * db) * M), v1 = *(const bf16x8*)(vp + (size_t)(32 * db) * M + 16);
                o[db] = __builtin_amdgcn_mfma_f32_32x32x16_bf16(v0, p0, o[db], 0, 0, 0);
                o[db] = __builtin_amdgcn_mfma_f32_32x32x16_bf16(v1, p1, o[db], 0, 0, 0);
            }
        }
    }
    l += __shfl_xor(l, 32);
    const float rl = 1.0f / l;
    bf16* op = NAO + tokq * 2048 + h * NA_DH + 4 * hi;
#pragma unroll
    for (int db = 0; db < 4; ++db)
#pragma unroll
        for (int g = 0; g < 4; ++g) { u32x2 w; w.x = cvt_pk_bf16(o[db][4 * g] * rl, o[db][4 * g + 1] * rl); w.y = cvt_pk_bf16(o[db][4 * g + 2] * rl, o[db][4 * g + 3] * rl);
            *(u32x2*)(op + 32 * db + 8 * g) = w; }
}

__device__ __forceinline__ void df_unit(LAS unsigned char* lds, const bf16* QKG, const bf16* KC, const bf16* VT, bf16* DFO, const float* g_sub, const float* gq, const f32x2* rope, float lam, float M2, int b, int h, int qb, unsigned long long* df_wait = nullptr) {
    int tid_ = threadIdx.x; asm volatile("" : "+v"(tid_));
    const int tid = tid_, lane = tid & 63, w = __builtin_amdgcn_readfirstlane(tid >> 6), q = lane & 31, hi = lane >> 5;
    const int mm = w & 1, qg = w >> 1;
    const int q0 = qb * 128 + qg * 32;
    bf16x8 qf[4];
    {
      u32x4 qr[4]; float ss = 0.f; float xv[4][8];
#pragma unroll
      for (int d0 = 0; d0 < 4; ++d0) { qr[d0] = *(const u32x4*)(QKG + ((size_t)b * SEQ + q0 + q) * NQKG + QC_DFQ + h * 128 + mm * 64 + 16 * d0 + 8 * hi);
          xv[d0][0] = bf_lo(qr[d0].x); xv[d0][1] = bf_hi(qr[d0].x); xv[d0][2] = bf_lo(qr[d0].y); xv[d0][3] = bf_hi(qr[d0].y); xv[d0][4] = bf_lo(qr[d0].z); xv[d0][5] = bf_hi(qr[d0].z); xv[d0][6] = bf_lo(qr[d0].w); xv[d0][7] = bf_hi(qr[d0].w);
#pragma unroll
          for (int j = 0; j < 8; ++j) ss += xv[d0][j] * xv[d0][j]; }
      ss += __shfl_xor(ss, 32);
      const float rs = __builtin_amdgcn_rsqf(ss * (1.0f / 64.0f) + EPS);
      const float QS = 0.125f * LOG2E;
      const f32x2* rp = rope + (size_t)(q0 + q) * 32;
#pragma unroll
      for (int d0 = 0; d0 < 2; ++d0) { float o1[8], o2[8];
#pragma unroll
          for (int j = 0; j < 8; ++j) { const int i = 16 * d0 + 8 * hi + j; const f32x2 cs = rp[i];
              const float x1 = xv[d0][j] * rs * gq[i], x2 = xv[d0 + 2][j] * rs * gq[32 + i];
              o1[j] = (x1 * cs.x - x2 * cs.y) * QS; o2[j] = (x1 * cs.y + x2 * cs.x) * QS; }
          u32x4 wa, wb; wa.x = cvt_pk_bf16(o1[0], o1[1]); wa.y = cvt_pk_bf16(o1[2], o1[3]); wa.z = cvt_pk_bf16(o1[4], o1[5]); wa.w = cvt_pk_bf16(o1[6], o1[7]);
          wb.x = cvt_pk_bf16(o2[0], o2[1]); wb.y = cvt_pk_bf16(o2[2], o2[3]); wb.z = cvt_pk_bf16(o2[4], o2[5]); wb.w = cvt_pk_bf16(o2[6], o2[7]);
          qf[d0] = __builtin_bit_cast(bf16x8, wa); qf[d0 + 2] = __builtin_bit_cast(bf16x8, wb); } }
    const unsigned char* kbase = (const unsigned char*)(KC + ((size_t)(b * 8 + h) * SEQ) * 128);
    const unsigned char* vbase = (const unsigned char*)(VT + ((size_t)(b * 16 + 8 + h) * 64) * 128 * 64);
    unsigned koff[2], voff[2];
#pragma unroll
    for (int i = 0; i < 2; ++i) {
        const int piece = w * 2 + i;
        { const int row = piece * 4 + (lane >> 4), ph = lane & 15, ch = ph ^ (row & 15); koff[i] = (unsigned)(row * 128 + ch * 8) * 2u; }
        { const int row = piece * 8 + (lane >> 3), ph = lane & 7, ch = ph ^ ((row >> 1) & 7); voff[i] = (unsigned)(row * 64 + ch * 8) * 2u; }
    }
#define DF_DMA(kt, stg) do { const unsigned char* kb_ = kbase + (size_t)(kt) * 16384; const unsigned char* vb_ = vbase + (size_t)(kt) * 16384; _Pragma("unroll") for (int _i = 0; _i < 2; ++_i) { \
        __builtin_amdgcn_global_load_lds((const unsigned*)(kb_ + koff[_i]), (LAS unsigned*)(lds + (stg) * 32768 + (w * 2 + _i) * 1024), 16, 0, 0); \
        __builtin_amdgcn_global_load_lds((const unsigned*)(vb_ + voff[_i]), (LAS unsigned*)(lds + (stg) * 32768 + 16384 + (w * 2 + _i) * 1024), 16, 0, 0); } } while (0)
    int kofs[4], vofs[4];
#pragma unroll
    for (int d0 = 0; d0 < 4; ++d0) kofs[d0] = q * 256 + (((mm * 8 + 2 * d0 + hi) ^ (q & 15)) * 16);
#pragma unroll
    for (int g = 0; g < 4; ++g) vofs[g] = 16384 + q * 128 + (((2 * g + hi) ^ ((q >> 1) & 7)) * 16);
    f32x16 o[4];
#pragma unroll
    for (int i = 0; i < 4; ++i) o[i] = (f32x16){};
    float l = 0.f;
    const float shift = (M2 > 60.0f) ? M2 : 0.0f;
    constexpr int NT = SEQ / 64;
    typedef float f32x2_t __attribute__((ext_vector_type(2))); typedef __bf16 bf16x2_t __attribute__((ext_vector_type(2)));
#define CVTPK(lo, hi) __builtin_bit_cast(unsigned, __builtin_convertvector((f32x2_t){(lo), (hi)}, bf16x2_t))
#define DF_S(dst, St_, kb_) do { bf16x8 kf_[4]; _Pragma("unroll") for (int d0 = 0; d0 < 4; ++d0) kf_[d0] = *(const LAS bf16x8*)((St_) + kofs[d0] + (kb_) * 8192); \
        dst = (f32x16){}; _Pragma("unroll") for (int d0 = 0; d0 < 4; ++d0) dst = __builtin_amdgcn_mfma_f32_32x32x16_bf16(kf_[d0], qf[d0], dst, 0, 0, 0); } while (0)
#define DF_TILE(Stile, sv0, sv1) do { _Pragma("unroll") for (int kb = 0; kb < 2; ++kb) { \
            bf16x8 vf[2][4]; \
            _Pragma("unroll") for (int jj = 0; jj < 2; ++jj) _Pragma("unroll") for (int db = 0; db < 4; ++db) vf[jj][db] = *(const LAS bf16x8*)((Stile) + vofs[2 * kb + jj] + db * 4096); \
            f32x16 s = kb ? sv1 : sv0; \
            if (shift != 0.f) { _Pragma("unroll") for (int i = 0; i < 16; ++i) s[i] -= shift; } \
            float ls = 0.f; \
            _Pragma("unroll") for (int i = 0; i < 16; ++i) { s[i] = __builtin_amdgcn_exp2f(s[i]); ls += s[i]; } \
            l += ls; \
            u32x4 w0, w1; \
            w0.x = CVTPK(s[0], s[1]); w0.y = CVTPK(s[2], s[3]); w0.z = CVTPK(s[4], s[5]); w0.w = CVTPK(s[6], s[7]); \
            w1.x = CVTPK(s[8], s[9]); w1.y = CVTPK(s[10], s[11]); w1.z = CVTPK(s[12], s[13]); w1.w = CVTPK(s[14], s[15]); \
            const bf16x8 p0 = __builtin_bit_cast(bf16x8, w0), p1 = __builtin_bit_cast(bf16x8, w1); \
            _Pragma("unroll") for (int db = 0; db < 4; ++db) o[db] = __builtin_amdgcn_mfma_f32_32x32x16_bf16(vf[0][db], p0, o[db], 0, 0, 0); \
            _Pragma("unroll") for (int db = 0; db < 4; ++db) o[db] = __builtin_amdgcn_mfma_f32_32x32x16_bf16(vf[1][db], p1, o[db], 0, 0, 0); } } while (0)
    constexpr int NTS = NT / 2;
    DF_DMA(0, 0); DF_DMA(1, 1);
    asm volatile("s_waitcnt vmcnt(0)" ::: "memory");
    __builtin_amdgcn_s_barrier();
    asm volatile("" ::: "memory");
    for (int st = 0; st < NTS; ++st) {
        const int sb = (st & 1) * 2;
        if (st + 1 < NTS) { DF_DMA(2 * st + 2, sb ^ 2); DF_DMA(2 * st + 3, (sb ^ 2) + 1); }
        const LAS unsigned char* T0 = lds + sb * 32768;
        const LAS unsigned char* T1 = T0 + 32768;
        f32x16 a0, a1, b0, b1;
        DF_S(a0, T0, 0); DF_S(a1, T0, 1);
        DF_S(b0, T1, 0); DF_S(b1, T1, 1);
        DF_TILE(T0, a0, a1);
        DF_TILE(T1, b0, b1);
        asm volatile("s_waitcnt vmcnt(0) lgkmcnt(0)" ::: "memory");
        __builtin_amdgcn_s_barrier();
        asm volatile("" ::: "memory");
    }
#undef DF_TILE
#undef DF_S
#undef CVTPK
#undef DF_DMA
    LAS float* xch = (LAS float*)lds;
    { float lt = l; lt += __shfl_xor(lt, 32);
      const float sc = (mm == 1 ? lam : 1.0f) / lt;
#pragma unroll
      for (int db = 0; db < 4; ++db)
#pragma unroll
          for (int i = 0; i < 16; ++i) o[db][i] *= sc; }
    if (mm == 1) {
#pragma unroll
        for (int db = 0; db < 4; ++db)
#pragma unroll
            for (int i = 0; i < 16; ++i) xch[(qg * 64 + db * 16 + i) * 64 + lane] = o[db][i];
    }
    __syncthreads();
    if (mm == 0) {
        float ss = 0.f;
#pragma unroll
        for (int db = 0; db < 4; ++db)
#pragma unroll
            for (int i = 0; i < 16; ++i) { const float v = o[db][i] - xch[(qg * 64 + db * 16 + i) * 64 + lane]; o[db][i] = v; ss += v * v; }
        ss += __shfl_xor(ss, 32);
        const float rn = __builtin_amdgcn_rsqf(ss * (1.0f / 128.0f) + EPS) * (1.0f - LAM_INIT);
        bf16* op = DFO + ((size_t)b * SEQ + q0 + q) * 2048 + h * 128 + 4 * hi;
#pragma unroll
        for (int db = 0; db < 4; ++db)
#pragma unroll
            for (int g = 0; g < 4; ++g) { const f32x4 gs = *(const f32x4*)(g_sub + 32 * db + 8 * g + 4 * hi);
                u32x2 wv; wv.x = cvt_pk_bf16(o[db][4 * g] * rn * gs[0], o[db][4 * g + 1] * rn * gs[1]); wv.y = cvt_pk_bf16(o[db][4 * g + 2] * rn * gs[2], o[db][4 * g + 3] * rn * gs[3]);
                *(u32x2*)(op + 32 * db + 8 * g) = wv; }
    }
    __syncthreads();
}

__device__ __forceinline__ void na_unit(LAS unsigned char* lds, const bf16* QKG, const bf16* KC, const bf16* VT, const float* rpb, const float* gq, bf16* NAO, float M2, int b, int h, int r0) {
    int tid_ = threadIdx.x; asm volatile("" : "+v"(tid_));
    const int tid = tid_, lane = tid & 63, w = __builtin_amdgcn_readfirstlane(tid >> 6), q = lane & 31, hi = lane >> 5;
    const int rq = r0 + (w >> 1), half = w & 1, c = 32 * half + q;
    const size_t tokq = (size_t)b * SEQ + rq * GW + c;
    bf16x8 qf[8];
    {
      u32x4 qr[8]; float ss = 0.f;
#pragma unroll
      for (int d0 = 0; d0 < 8; ++d0) { qr[d0] = *(const u32x4*)(QKG + tokq * NQKG + QC_NAQ + h * NA_DH + 16 * d0 + 8 * hi);
          const float v[8] = {bf_lo(qr[d0].x), bf_hi(qr[d0].x), bf_lo(qr[d0].y), bf_hi(qr[d0].y), bf_lo(qr[d0].z), bf_hi(qr[d0].z), bf_lo(qr[d0].w), bf_hi(qr[d0].w)};
#pragma unroll
          for (int j = 0; j < 8; ++j) ss += v[j] * v[j]; }
      ss += __shfl_xor(ss, 32);
      const float rn = __builtin_amdgcn_rsqf(ss * (1.0f / 128.0f) + EPS) * (0.08838834764831845f * LOG2E);
#pragma unroll
      for (int d0 = 0; d0 < 8; ++d0) { const float* g1 = gq + 16 * d0 + 8 * hi;
          const float v[8] = {bf_lo(qr[d0].x), bf_hi(qr[d0].x), bf_lo(qr[d0].y), bf_hi(qr[d0].y), bf_lo(qr[d0].z), bf_hi(qr[d0].z), bf_lo(qr[d0].w), bf_hi(qr[d0].w)};
          u32x4 o; o.x = cvt_pk_bf16(v[0] * rn * g1[0], v[1] * rn * g1[1]); o.y = cvt_pk_bf16(v[2] * rn * g1[2], v[3] * rn * g1[3]);
          o.z = cvt_pk_bf16(v[4] * rn * g1[4], v[5] * rn * g1[5]); o.w = cvt_pk_bf16(v[6] * rn * g1[6], v[7] * rn * g1[7]);
          qf[d0] = __builtin_bit_cast(bf16x8, o); } }
    int rs = rq - 4; rs = rs < 0 ? 0 : (rs > GROWS - 8 ? GROWS - 8 : rs);
    int cs = c - 8; cs = cs < 0 ? 0 : (cs > GW - 16 ? GW - 16 : cs);
    int klo = r0 - 4; klo = klo < 0 ? 0 : (klo > GROWS - 8 ? GROWS - 8 : klo);
    int khi = r0 + 3 - 4; khi = (khi < 0 ? 0 : (khi > GROWS - 8 ? GROWS - 8 : khi)) + 7;
    const int nst = khi - klo + 1;
    const unsigned char* kbase = (const unsigned char*)(KC + ((size_t)(b * 8 + h) * SEQ + klo * GW) * 128);
    const unsigned char* vbase = (const unsigned char*)(VT + ((size_t)(b * 16 + h) * 64 + klo) * 128 * 64);
    unsigned koff[2], voff[2];
#pragma unroll
    for (int i = 0; i < 2; ++i) {
        const int piece = w * 2 + i;
        { const int row = piece * 4 + (lane >> 4), ph = lane & 15, ch = ph ^ (row & 15); koff[i] = (unsigned)(row * 128 + ch * 8) * 2u; }
        { const int row = piece * 8 + (lane >> 3), ph = lane & 7, ch = ph ^ ((row >> 1) & 7); voff[i] = (unsigned)(row * 64 + ch * 8) * 2u; }
    }
#define NA_DMA(t, stg) do { const unsigned char* kb_ = kbase + (size_t)(t) * 16384; const unsigned char* vb_ = vbase + (size_t)(t) * 16384; _Pragma("unroll") for (int _i = 0; _i < 2; ++_i) { \
        __builtin_amdgcn_global_load_lds((const unsigned*)(kb_ + koff[_i]), (LAS unsigned*)(lds + (stg) * 32768 + (w * 2 + _i) * 1024), 16, 0, 0); \
        __builtin_amdgcn_global_load_lds((const unsigned*)(vb_ + voff[_i]), (LAS unsigned*)(lds + (stg) * 32768 + 16384 + (w * 2 + _i) * 1024), 16, 0, 0); } } while (0)
    int kofs[8], vofs[4];
#pragma unroll
    for (int d0 = 0; d0 < 8; ++d0) kofs[d0] = q * 256 + (((2 * d0 + hi) ^ (q & 15)) * 16);
#pragma unroll
    for (int g = 0; g < 4; ++g) vofs[g] = 16384 + q * 128 + (((2 * g + hi) ^ ((q >> 1) & 7)) * 16);
    f32x16 o[4];
#pragma unroll
    for (int i = 0; i < 4; ++i) o[i] = (f32x16){};
    float l = 0.f;
    LAS float* btab = (LAS float*)(lds + 131072 + 1024);
    for (int i = tid; i < 15 * 31; i += NTHREADS) btab[i] = rpb[h * 15 * 31 + i] * LOG2E - M2;
    asm volatile("s_waitcnt vmcnt(0) lgkmcnt(0)" ::: "memory");
    __builtin_amdgcn_s_barrier();
    asm volatile("" ::: "memory");
    NA_DMA(0, 0); NA_DMA(1, 1);
    asm volatile("s_waitcnt vmcnt(4)" ::: "memory");
    __builtin_amdgcn_s_barrier();
    asm volatile("" ::: "memory");
    for (int t = 0; t < nst; ++t) {
        if (t + 2 < nst) NA_DMA(t + 2, (t + 2) & 3);
        const int krow = klo + t;
        if (krow >= rs && krow < rs + 8) {
            const LAS unsigned char* St = lds + (t & 3) * 32768;
            const LAS float* brow = btab + (krow - rq + 7) * 31;
#pragma unroll 1
            for (int kb = 0; kb < 2; ++kb) {
                f32x16 s = (f32x16){};
#pragma unroll
                for (int d0 = 0; d0 < 8; ++d0) { const bf16x8 kf = *(const LAS bf16x8*)(St + kofs[d0] + kb * 8192); s = __builtin_amdgcn_mfma_f32_32x32x16_bf16(kf, qf[d0], s, 0, 0, 0); }
                bf16x8 vf[2][4];
#pragma unroll
                for (int jj = 0; jj < 2; ++jj)
#pragma unroll
                    for (int db = 0; db < 4; ++db) vf[jj][db] = *(const LAS bf16x8*)(St + (kb ? vofs[2 + jj] : vofs[jj]) + db * 4096);
                float pv[16];
                const LAS float* bp = brow + (4 * hi - c + 15 + 32 * kb);
                const int wa = 4 * hi - cs + 32 * kb;
#pragma unroll
                for (int i = 0; i < 16; ++i) { const int e0 = (i & 3) + 8 * (i >> 2); const float bias = bp[e0]; const float e = __builtin_amdgcn_exp2f(s[i] + bias);
                    pv[i] = ((unsigned)(wa + e0) < 16u) ? e : 0.f; l += pv[i]; }
                u32x4 w0, w1;
                w0.x = cvt_pk_bf16(pv[0], pv[1]); w0.y = cvt_pk_bf16(pv[2], pv[3]); w0.z = cvt_pk_bf16(pv[4], pv[5]); w0.w = cvt_pk_bf16(pv[6], pv[7]);
                w1.x = cvt_pk_bf16(pv[8], pv[9]); w1.y = cvt_pk_bf16(pv[10], pv[11]); w1.z = cvt_pk_bf16(pv[12], pv[13]); w1.w = cvt_pk_bf16(pv[14], pv[15]);
                const bf16x8 p0 = __builtin_bit_cast(bf16x8, w0), p1 = __builtin_bit_cast(bf16x8, w1);
#pragma unroll
                for (int db = 0; db < 4; ++db) o[db] = __builtin_amdgcn_mfma_f32_32x32x16_bf16(vf[0][db], p0, o[db], 0, 0, 0);
#pragma unroll
                for (int db = 0; db < 4; ++db) o[db] = __builtin_amdgcn_mfma_f32_32x32x16_bf16(vf[1][db], p1, o[db], 0, 0, 0);
            }
        }
        if (t + 2 < nst) asm volatile("s_waitcnt vmcnt(4) lgkmcnt(0)" ::: "memory"); else asm volatile("s_waitcnt vmcnt(0) lgkmcnt(0)" ::: "memory");
        __builtin_amdgcn_s_barrier();
        asm volatile("" ::: "memory");
    }
#undef NA_DMA
    l += __shfl_xor(l, 32);
    const float rl = 1.0f / l;
    bf16* op = NAO + tokq * 2048 + h * NA_DH + 4 * hi;
#pragma unroll
    for (int db = 0; db < 4; ++db)
#pragma unroll
        for (int g = 0; g < 4; ++g) { u32x2 wv; wv.x = cvt_pk_bf16(o[db][4 * g] * rl, o[db][4 * g + 1] * rl); wv.y = cvt_pk_bf16(o[db][4 * g + 2] * rl, o[db][4 * g + 3] * rl);
            *(u32x2*)(op + 32 * db + 8 * g) = wv; }
}
template <int TB>
__device__ __forceinline__ void qknorm_batch(bf16* QKG, bf16* KCna, bf16* KCdf, int m0, int mstride, const float* gnk, const float* gdk, const f32x2* rope, int lane) {
    u32x4 na[TB][2], da[TB], db[TB];
#pragma unroll
    for (int t = 0; t < TB; ++t) { int mt = m0 + t * mstride; if (mt >= M) mt = M - 1; const bf16* row = QKG + (size_t)mt * NQKG;
#pragma unroll
        for (int j = 0; j < 2; ++j) na[t][j] = *(const u32x4*)(row + QC_NAK + 512 * j + 8 * lane);
        const bf16* p1 = row + QC_DFK + 64 * (lane >> 2) + 8 * (lane & 3); da[t] = *(const u32x4*)p1; db[t] = *(const u32x4*)(p1 + 32); }
#pragma unroll
    for (int t = 0; t < TB; ++t) { const int mt = m0 + t * mstride; if (mt >= M) break; const int pos = mt & (SEQ - 1);
#pragma unroll
        for (int j = 0; j < 2; ++j) {
            const u32x4 w = na[t][j];
            float v[8] = {bf_lo(w.x), bf_hi(w.x), bf_lo(w.y), bf_hi(w.y), bf_lo(w.z), bf_hi(w.z), bf_lo(w.w), bf_hi(w.w)};
            float ss = 0.f;
#pragma unroll
            for (int i = 0; i < 8; ++i) ss += v[i] * v[i];
            ss += __shfl_xor(ss, 1); ss += __shfl_xor(ss, 2); ss += __shfl_xor(ss, 4); ss += __shfl_xor(ss, 8);
            const float rs = __builtin_amdgcn_rsqf(ss * (1.0f / 128.0f) + EPS);
            const float* g = gnk + 8 * (lane & 15);
#pragma unroll
            for (int i = 0; i < 8; ++i) v[i] = v[i] * rs * g[i];
            u32x4 o; o.x = cvt_pk_bf16(v[0], v[1]); o.y = cvt_pk_bf16(v[2], v[3]); o.z = cvt_pk_bf16(v[4], v[5]); o.w = cvt_pk_bf16(v[6], v[7]);
            const int x = 512 * j + 8 * lane;
            *(u32x4*)(KCna + ((size_t)((mt >> 12) * 8 + (x >> 7)) * SEQ + pos) * 128 + (x & 127)) = o;
        }
        {
            const u32x4 wa = da[t], wb = db[t];
            float a[8] = {bf_lo(wa.x), bf_hi(wa.x), bf_lo(wa.y), bf_hi(wa.y), bf_lo(wa.z), bf_hi(wa.z), bf_lo(wa.w), bf_hi(wa.w)};
            float c[8] = {bf_lo(wb.x), bf_hi(wb.x), bf_lo(wb.y), bf_hi(wb.y), bf_lo(wb.z), bf_hi(wb.z), bf_lo(wb.w), bf_hi(wb.w)};
            float ss = 0.f;
#pragma unroll
            for (int i = 0; i < 8; ++i) ss += a[i] * a[i] + c[i] * c[i];
            ss += __shfl_xor(ss, 1); ss += __shfl_xor(ss, 2);
            const float rs = __builtin_amdgcn_rsqf(ss * (1.0f / 64.0f) + EPS);
            const float* g = gdk + 8 * (lane & 3);
            const f32x2* rp = rope + pos * 32 + 8 * (lane & 3);
            float o1[8], o2[8];
#pragma unroll
            for (int i = 0; i < 8; ++i) { const float x1 = a[i] * rs * g[i], x2 = c[i] * rs * g[32 + i]; const f32x2 cs = rp[i]; o1[i] = x1 * cs.x - x2 * cs.y; o2[i] = x1 * cs.y + x2 * cs.x; }
            u32x4 oa, ob; oa.x = cvt_pk_bf16(o1[0], o1[1]); oa.y = cvt_pk_bf16(o1[2], o1[3]); oa.z = cvt_pk_bf16(o1[4], o1[5]); oa.w = cvt_pk_bf16(o1[6], o1[7]);
            ob.x = cvt_pk_bf16(o2[0], o2[1]); ob.y = cvt_pk_bf16(o2[2], o2[3]); ob.z = cvt_pk_bf16(o2[4], o2[5]); ob.w = cvt_pk_bf16(o2[6], o2[7]);
            const int x = 64 * (lane >> 2) + 8 * (lane & 3); bf16* kp = KCdf + ((size_t)((mt >> 12) * 8 + (x >> 7)) * SEQ + pos) * 128 + (x & 127);
            *(u32x4*)kp = oa; *(u32x4*)(kp + 32) = ob;
        }
    }
}

__device__ __forceinline__ void grid_barrier(unsigned* cnt, unsigned target) {
    asm volatile("s_waitcnt vmcnt(0) lgkmcnt(0)" ::: "memory");
    __syncthreads();
    if (threadIdx.x == 0) {
        __builtin_amdgcn_fence(__ATOMIC_RELEASE, "agent");
        asm volatile("s_waitcnt vmcnt(0)" ::: "memory");
        __hip_atomic_fetch_add(cnt, 1u, __ATOMIC_RELAXED, __HIP_MEMORY_SCOPE_AGENT);
        while (__hip_atomic_load(cnt, __ATOMIC_RELAXED, __HIP_MEMORY_SCOPE_AGENT) < target) __builtin_amdgcn_s_sleep(2);
        __builtin_amdgcn_fence(__ATOMIC_ACQUIRE, "agent");
        asm volatile("s_waitcnt vmcnt(0)" ::: "memory");
    }
    __syncthreads();
}
constexpr int I_IN = 32 * 320, I_NA = 16 * 64, I_O = 32 * 64, I_G = 32 * 176, I_DN = 88 * 64, I_PP = 4 * 64;
constexpr int N_EARLY = I_IN + 2 * I_NA + I_O + 2 * I_G + I_PP, NITEMS = N_EARLY + I_DN + I_O;
#define P0_DECODE(it_, d_) do { int r = (it_); \
            if (r < I_IN) { d_ = P0Item{ap->w_in, W1t, nullptr, D, 10240, 1, r, D, 0}; break; } r -= I_IN; \
            if (r < I_NA) { d_ = P0Item{ap->w_na_out, Wna, nullptr, 1024, D, 0, r, 2048, 0}; break; } r -= I_NA; \
            if (r < I_NA) { d_ = P0Item{ap->w_df_out, Wna, nullptr, 1024, D, 0, r, 2048, 1024}; break; } r -= I_NA; \
            if (r < I_O) { d_ = P0Item{ap->w_o, Wo, nullptr, D, D, 0, r, D, 0}; break; } r -= I_O; \
            if (r < I_G) { d_ = P0Item{ap->w_gate, Wgu, ap->g_ffn, D, FF, 2, r, D, 0}; break; } r -= I_G; \
            if (r < I_G) { d_ = P0Item{ap->w_up, Wgu, ap->g_ffn, D, FF, 3, r, D, 0}; break; } r -= I_G; \
            if (r < I_PP) { d_ = P0Item{ap->w_ple_proj, Wpp, nullptr, PLE, D, 0, r, PLE, 0}; break; } r -= I_PP; \
            if (r < I_DN) { d_ = P0Item{ap->w_down, Wdn, nullptr, FF, D, 0, r, FF, 0}; break; } r -= I_DN; \
            d_ = P0Item{ap->w_ple_gate, Wpg, ap->g_ple, D, D, 0, r, D, 0}; } while (0)
constexpr int NPHASE = 9;
__global__ void __launch_bounds__(NTHREADS, 2) fwd_megakernel(Args a) {
    extern __shared__ __attribute__((aligned(16))) unsigned char lds_raw[];
    LAS unsigned char* lds = (LAS unsigned char*)lds_raw;
    cg::grid_group grid = cg::this_grid();
    const int G = gridDim.x, bx = blockIdx.x;
    const int vcu = (G % 8 == 0) ? (bx % 8) * (G / 8) + bx / 8 : bx;
    const int NGW = G * NWAVES;
typedef __attribute__((opencl_constant)) const Args* CArgsP;
#define FRESH_ARGS() auto kp_ = __builtin_amdgcn_kernarg_segment_ptr(); asm volatile("" : "+s"(kp_)); const CArgsP ap = (CArgsP)kp_
#define FRESH_TID() int tid_ = threadIdx.x; asm volatile("" : "+v"(tid_)); const int tid = tid_, lane = tid & 63, wave = __builtin_amdgcn_readfirstlane(tid >> 6), gw = vcu * NWAVES + wave; (void)lane; (void)gw
    unsigned char* ws = a.ws;
    float* RS1 = (float*)(ws + WS_RS1); float* RS2 = (float*)(ws + WS_RS2); f32x2* ROPE = (f32x2*)(ws + WS_ROPE);
    bf16 *W1t = (bf16*)(ws + WS_W1), *Wna = (bf16*)(ws + WS_WNA), *Wdf = (bf16*)(ws + WS_WDF), *Wo = (bf16*)(ws + WS_WO), *Wgu = (bf16*)(ws + WS_WGU), *Wdn = (bf16*)(ws + WS_WDN), *Wpg = (bf16*)(ws + WS_WPG), *Wpp = (bf16*)(ws + WS_WPP);
    bf16 *QKG = (bf16*)(ws + WS_A), *HB = (bf16*)(ws + WS_A);
    bf16 *XN = (bf16*)(ws + WS_B), *AO = (bf16*)(ws + WS_B), *X1B = (bf16*)(ws + WS_B), *X2B = (bf16*)(ws + WS_B);
    bf16 *VT = (bf16*)(ws + WS_C), *MRG = (bf16*)(ws + WS_C), *T2B = (bf16*)(ws + WS_C), *PB = (bf16*)(ws + WS_PB);
    bf16* KCna = (bf16*)a.out; bf16* KCdf = KCna + (size_t)M * 1024;
    const int lo = a.ph_lo, hi_ph = a.ph_hi;
    if (lo < 0) grid.sync();
    { volatile LAS unsigned* st0 = (volatile LAS unsigned*)(lds + 131072 + 768); if (threadIdx.x < 2) st0[threadIdx.x] = 0u; __syncthreads(); }
    XcdBarrier xbar = xcd_barrier_post((unsigned*)(ws + 8192), (volatile LAS unsigned*)(lds + 131072 + 768));
#ifndef PHASE_MASK
#define PHASE_MASK 0x1ff
#endif
#define IN(k) (((PHASE_MASK >> (k)) & 1) && lo <= (k) && (k) < hi_ph)
#ifdef PROBE_TS
#define STAMP(k) do { if (bx == 0 && threadIdx.x == 0) ((volatile unsigned long long*)(ws + 2048))[k] = __builtin_amdgcn_s_memrealtime(); } while (0)
#else
#define STAMP(k) do {} while (0)
#endif
#define GBAR(idx) xcd_barrier(xbar)
#define SEAM(k) do { if (IN(k) && IN((k) + 1)) GBAR(k); STAMP((k) + 1); } while (0)
#ifndef PROBE_DUP
#define PROBE_DUP 0
#endif
#define NREP(k) (((PROBE_DUP >> (k)) & 1) ? 2 : 1)

    STAMP(0);
    for (int rep_ = 0; rep_ < NREP(0); ++rep_) {
    if (IN(0)) {
        FRESH_ARGS();
        FRESH_TID();
        if (bx == 0) {
        LAS float* red = (LAS float*)(lds + 131072);
        float mq = 0.f, mk = 0.f, mdq = 0.f, mdk = 0.f, mb = 0.f;
        if (tid < 128) { mq = fabsf(ap->g_na_q[tid]); mk = fabsf(ap->g_na_k[tid]); }
        if (tid < 64) { mdq = fabsf(ap->g_df_q[tid]); mdk = fabsf(ap->g_df_k[tid]); }
        for (int i = tid; i < NA_H * 15 * 31; i += NTHREADS) mb = fmaxf(mb, ap->na_rpb[i]);
        mq = wave_max(mq); mk = wave_max(mk); mdq = wave_max(mdq); mdk = wave_max(mdk); mb = wave_max(mb);
        float d1 = 0.f, d2 = 0.f;
        if (wave == 0) { d1 = wave_sum(ap->lam_q1[lane] * ap->lam_k1[lane]); d2 = wave_sum(ap->lam_q2[lane] * ap->lam_k2[lane]); }
        if (lane == 0) { red[wave * 8 + 0] = mq; red[wave * 8 + 1] = mk; red[wave * 8 + 2] = mdq; red[wave * 8 + 3] = mdk; red[wave * 8 + 4] = mb; red[wave * 8 + 5] = d1; red[wave * 8 + 6] = d2; }
        __syncthreads();
        mq = 0.f; mk = 0.f; mdq = 0.f; mdk = 0.f; mb = 0.f;
#pragma unroll
        for (int w = 0; w < 8; ++w) { mq = fmaxf(mq, red[w * 8]); mk = fmaxf(mk, red[w * 8 + 1]); mdq = fmaxf(mdq, red[w * 8 + 2]); mdk = fmaxf(mdk, red[w * 8 + 3]); mb = fmaxf(mb, red[w * 8 + 4]); }
        if (tid == 0) { float* PARw = (float*)(ws + 3072); PARw[0] = expf(red[5]) - expf(red[6]) + LAM_INIT; PARw[1] = (11.313708498984761f * mq * mk + mb) * LOG2E + 0.125f; PARw[2] = (8.0f * mdq * mdk) * LOG2E + 0.125f; }
        __syncthreads();
        }
        LAS float* scr = (LAS float*)(lds + wave * 16384);
        {
            float cur[32], nxt[32]; P0Item dc, dn;
            int it = gw;
            if (it < N_EARLY) { P0_DECODE(it, dc); p0_item_load(dc, cur, lane); }
            for (; it < N_EARLY; it += NGW) {
                const int nit = it + NGW; const bool more = nit < N_EARLY;
                if (more) { P0_DECODE(nit, dn); p0_item_load(dn, nxt, lane); }
                p0_item_store(dc, cur, scr, lane);
                if (more) { dc = dn;
#pragma unroll
                    for (int i = 0; i < 32; ++i) cur[i] = nxt[i]; }
            }
        }
        for (int m = gw; m < M; m += NGW) {
            const f32x4* xr = (const f32x4*)(ap->x + (size_t)m * D) + lane; const f32x4* gr = (const f32x4*)ap->g_mix + lane;
            f32x4 v[8]; float s = 0.f;
#pragma unroll
            for (int j = 0; j < 8; ++j) { v[j] = __builtin_nontemporal_load(xr + 64 * j); s += (v[j].x * v[j].x + v[j].y * v[j].y) + (v[j].z * v[j].z + v[j].w * v[j].w); }
            const float rs = __builtin_amdgcn_rsqf(wave_sum(s) * (1.0f / D) + EPS);
            u32x2* o8 = (u32x2*)(XN + (size_t)m * D) + lane;
#pragma unroll
            for (int j = 0; j < 8; ++j) { const f32x4 g = gr[64 * j]; u32x2 w; w.x = cvt_pk_bf16(v[j].x * rs * g.x, v[j].y * rs * g.y); w.y = cvt_pk_bf16(v[j].z * rs * g.z, v[j].w * rs * g.w); o8[64 * j] = w; }
        }
        const int gt = vcu * NTHREADS + tid, NGT = G * NTHREADS;
        for (int i = gt; i < M * PLE / 8; i += NGT) { const f32x4 p0 = __builtin_nontemporal_load((const f32x4*)ap->p + 2 * i), p1 = __builtin_nontemporal_load((const f32x4*)ap->p + 2 * i + 1);
            u32x4 w; w.x = cvt_pk_bf16(p0.x, p0.y); w.y = cvt_pk_bf16(p0.z, p0.w); w.z = cvt_pk_bf16(p1.x, p1.y); w.w = cvt_pk_bf16(p1.z, p1.w); ((u32x4*)PB)[i] = w; }
        for (int i = gt; i < SEQ * 32; i += NGT) { const int pos = i >> 5, k = i & 31;
            const float inv = (float)(1.0 / pow(10000.0, (double)k / 32.0)); const float ang = (float)pos * inv;
            f32x2 cs; cs.x = (float)cos((double)ang); cs.y = (float)sin((double)ang); ROPE[i] = cs; }
        for (int i = gt; i < M; i += NGT) { RS1[i] = 0.f; RS2[i] = 0.f; }
    }
    }
    SEAM(0);
    for (int rep_ = 0; rep_ < NREP(1); ++rep_) {
    if (IN(1)) {
        FRESH_ARGS();
        { pg8::Gemm g{XN, W1t, M, NQKG, D}; pg8::StaticOrder S; S.init(M, NQKG, G, bx); pg8::EpiQKG E{QKG, NQKG};
          pg8::gemm_phase<pg8::EpiQKG, pg8::StaticOrder, true, true>(lds, g, S, E); }
        { pg8::Gemm g{W1t + (size_t)NQKG * D, XN, 2048, M, D}; pg8::StaticOrder S; S.init(2048, M, G, bx); pg8::EpiVT E{VT, M};
          pg8::gemm_phase<pg8::EpiVT, pg8::StaticOrder, true, true>(lds, g, S, E); }
    }
    }
    SEAM(1);
    if (IN(2)) {
        FRESH_ARGS();
        FRESH_TID();
        for (int m0 = gw; m0 < M; m0 += 4 * NGW) qknorm_batch<4>(QKG, KCna, KCdf, m0, NGW, ap->g_na_k, ap->g_df_k, ROPE, lane);
    }
    SEAM(2);
    for (int rep_ = 0; rep_ < NREP(3); ++rep_) {
    if (IN(3)) {
        FRESH_ARGS();
        FRESH_TID();
        const float* PAR = (const float*)(ws + 3072);
        const float lam = PAR[0], M2na = PAR[1], M2df = PAR[2];
#ifndef NO_DF
        for (int uu = 2 * vcu; uu < BATCH * DF_H * (SEQ / 128); uu += 2 * G)
            for (int i2 = 0; i2 < 2; ++i2) { const int uidx = uu + i2, bh = uidx >> 5, qb = uidx & 31;
#ifdef PROBE_DFWAIT
                unsigned long long dfw_ = 0;
                df_unit(lds, QKG, KCdf, VT, AO + 1024, ap->g_df_sub, ap->g_df_q, ROPE, lam, M2df, bh >> 3, bh & 7, qb, &dfw_);
                if (bx == 0 && threadIdx.x == 0) { volatile unsigned long long* TS = (volatile unsigned long long*)(ws + 2048); TS[11] = (i2 ? TS[11] : 0ull) + dfw_; TS[12] = 0ull; }
#else
                df_unit(lds, QKG, KCdf, VT, AO + 1024, ap->g_df_sub, ap->g_df_q, ROPE, lam, M2df, bh >> 3, bh & 7, qb);
#endif
            }
#endif
        STAMP(10);
#ifdef PROBE_TS
        if (threadIdx.x == 0) { atomicMax((unsigned long long*)(ws + 2048) + 14, (unsigned long long)__builtin_amdgcn_s_memrealtime()); atomicMin((unsigned long long*)(ws + 2048) + 16, (unsigned long long)__builtin_amdgcn_s_memrealtime()); }
#endif
#ifndef NO_NA
        for (int uidx = vcu; uidx < BATCH * NA_H * (GROWS / 4); uidx += G) {
            const int bh = uidx >> 4, rg = uidx & 15;
            na_unit(lds, QKG, KCna, VT, ap->na_rpb, ap->g_na_q, AO, M2na, bh >> 3, bh & 7, rg * 4);
        }
        STAMP(13);
#ifdef PROBE_TS
        if (threadIdx.x == 0) atomicMax((unsigned long long*)(ws + 2048) + 15, (unsigned long long)__builtin_amdgcn_s_memrealtime());
#endif
#endif
    }
    }
    SEAM(3);
    for (int rep_ = 0; rep_ < NREP(4); ++rep_) {
    if (IN(4)) {
        FRESH_ARGS();
        { pg8::Gemm g{AO, Wna, M, D, 2048, 16}; pg8::PairOrder S; S.S.init(M, D, G, bx); S.kob = 1024 * 2; pg8::EpiMerge E{QKG + QC_GA, QKG + QC_GB, NQKG, MRG, D, 16};
          pg8::gemm_phase<pg8::EpiMerge, pg8::PairOrder, true, true>(lds, g, S, E); }
    }
    }
    SEAM(4);
    if (IN(5)) {
        FRESH_ARGS();
        pg8::Gemm g{MRG, Wo, M, D, D}; pg8::StaticOrder S; S.init(M, D, G, bx); pg8::EpiResid<false> E{ap->x, X1B, RS1, D};
        pg8::gemm_phase<pg8::EpiResid<false>, pg8::StaticOrder, true, true>(lds, g, S, E);
    }
    SEAM(5);
    for (int rep_ = 0; rep_ < NREP(6); ++rep_) {
    if (IN(6)) {
        FRESH_ARGS();
        pg8::Gemm g{X1B, Wgu, M, 2 * FF, D}; pg8::StaticOrder S; S.init(M, 2 * FF, G, bx); pg8::EpiSwiGLU E{RS1, HB, FF, 1.0f / D, EPS};
        pg8::gemm_phase<pg8::EpiSwiGLU, pg8::StaticOrder, true, true>(lds, g, S, E);
        { constexpr int NU6 = (M / 256) * (2 * FF / 256), NU8 = (M / 256) * (D / 256);
          const int rem = NU6 % G, nshort = rem ? G - rem : G;
          pg8::TailOrder T; T.first = (rem == 0) ? bx : (bx >= rem ? bx - rem : -1); T.stride = nshort; T.total = NU8;
          int kple = PLE; asm volatile("" : "+s"(kple));
          pg8::Gemm g2{PB, Wpp, M, D, kple}; pg8::EpiStoreBf16 E2{T2B, D};
          pg8::gemm_phase<pg8::EpiStoreBf16, pg8::TailOrder, true, true>(lds, g2, T, E2);
          if (T.first >= 0) { FRESH_TID();
              LAS float* scr = (LAS float*)(lds + wave * 16384);
              const int sw = ((rem == 0) ? bx : bx - rem) * NWAVES + wave, nsw = nshort * NWAVES;
              float cur[32], nxt[32]; P0Item dc, dn;
              int it = N_EARLY + sw;
              if (it < NITEMS) { P0_DECODE(it, dc); p0_item_load(dc, cur, lane); }
              for (; it < NITEMS; it += nsw) {
                  const int nit = it + nsw; const bool more = nit < NITEMS;
                  if (more) { P0_DECODE(nit, dn); p0_item_load(dn, nxt, lane); }
                  p0_item_store(dc, cur, scr, lane);
                  if (more) { dc = dn;
#pragma unroll
                      for (int i = 0; i < 32; ++i) cur[i] = nxt[i]; }
              } } }
    }
    }
    SEAM(6);
    if (IN(7)) {
        FRESH_ARGS();
        pg8::Gemm g{HB, Wdn, M, D, FF}; pg8::StaticOrder S; S.init(M, D, G, bx); pg8::EpiResid<true> E{X1B, X2B, RS2, D};
        pg8::gemm_phase<pg8::EpiResid<true>, pg8::StaticOrder, true, true>(lds, g, S, E);
    }
    SEAM(7);
    if (IN(8)) {
        FRESH_ARGS();
#ifndef NO_P8B
        { pg8::Gemm g{X2B, Wpg, M, D, D}; pg8::StaticOrder S; S.init(M, D, G, bx); pg8::EpiPle E{RS2, T2B, X2B, ap->out, D, 1.0f / D, EPS};
          pg8::gemm_phase<pg8::EpiPle, pg8::StaticOrder, true, true>(lds, g, S, E); }
#endif
    }
#ifdef PROBE_TS
    STAMP(9);
    GBAR(8);
    { const unsigned long long* TS = (const unsigned long long*)(ws + 2048);
      const unsigned long long ta = __hip_atomic_load(TS + PROBE_A, __ATOMIC_RELAXED, __HIP_MEMORY_SCOPE_AGENT), tb = __hip_atomic_load(TS + PROBE_B, __ATOMIC_RELAXED, __HIP_MEMORY_SCOPE_AGENT);
      const int K = PROBE_CONST ? PROBE_CONST : (int)((tb - ta) / 8);
      FRESH_ARGS();
      for (int i = vcu * NTHREADS + (int)threadIdx.x; i < K && i < 42000; i += G * NTHREADS) ap->out[(size_t)i * 397] += 0.125f; }
#endif
#undef IN
#undef SEAM
}

#ifndef MK_SPLIT
#define MK_SPLIT 0
#endif
extern "C" void kernel_launch(void* const* d_in, const int* in_sizes, int n_in, void* d_out, int out_size, void* d_ws, size_t ws_size, hipStream_t stream) {
    static int grid = 0;
    if (grid == 0) {
        if (n_in != 24 || in_sizes[0] != M * D || out_size != M * D || ws_size < WS_END) { fprintf(stderr, "kernel_launch: unexpected shapes (n_in %d, in0 %d, out %d, ws %zu); nothing launched\n", n_in, n_in > 0 ? in_sizes[0] : -1, out_size, ws_size); grid = -1; return; }
        int dev = 0, cus = 0, per_cu = 0;
        hipGetDevice(&dev); hipDeviceGetAttribute(&cus, hipDeviceAttributeMultiprocessorCount, dev);
        hipFuncSetAttribute((const void*)fwd_megakernel, hipFuncAttributeMaxDynamicSharedMemorySize, LDS_BYTES);
        hipOccupancyMaxActiveBlocksPerMultiprocessor(&per_cu, (const void*)fwd_megakernel, NTHREADS, LDS_BYTES);
        if (per_cu < 1) per_cu = 1;
        grid = cus * per_cu;
        (void)hipGetLastError();
    }
    if (grid < 0) return;
    Args a{};
    const float** ap = (const float**)&a;
    for (int i = 0; i < 24; ++i) ap[i] = (const float*)d_in[i];
    a.out = (float*)d_out; a.ws = (unsigned char*)d_ws; a.rep3 = NREP(3); a.pad = 0;
#if MK_SPLIT
    for (int ph = 0; ph < NPHASE; ++ph) { a.ph_lo = ph; a.ph_hi = ph + 1; hipLaunchKernelGGL(fwd_megakernel, dim3(grid), dim3(NTHREADS), LDS_BYTES, stream, a); }
#else
    a.ph_lo = 0; a.ph_hi = NPHASE;
    (void)hipMemsetAsync((unsigned char*)d_ws + 4096, 0, 20480, stream);
#ifdef PROBE_TS
    (void)hipMemsetAsync((unsigned char*)d_ws + 2048 + 14 * 8, 0, 16, stream); (void)hipMemsetAsync((unsigned char*)d_ws + 2048 + 16 * 8, 0x7f, 8, stream);
#endif
    void* args[] = {&a};
    hipError_t e = hipLaunchCooperativeKernel((const void*)fwd_megakernel, dim3(grid), dim3(NTHREADS), args, LDS_BYTES, stream);
    if (e != hipSuccess) fprintf(stderr, "cooperative launch failed: %s (grid %d)\n", hipGetErrorString(e), grid);
#endif
}
```

```cpp
#include <hip/hip_runtime.h>
#include <hip/hip_cooperative_groups.h>
#include <cstdio>
#include <cstdint>
namespace cg = cooperative_groups;
namespace pg8 {
#define PG8_LAS __attribute__((address_space(3)))
typedef unsigned short bf16_t;
typedef short bf16x8 __attribute__((ext_vector_type(8)));
typedef float f32x4 __attribute__((ext_vector_type(4)));
typedef unsigned u32x4 __attribute__((ext_vector_type(4)));
constexpr int BM = 256, BK = 64, HALF = 128, HTB = HALF * BK * 2  , STAGE_BYTES = 8 * HTB, NXCD = 8, WGM = 8;

__host__ __device__ __forceinline__ int lds_byte(int r, int c) { const int st = (r >> 4) * 2 + (c >> 5), rr = r & 15, cc = c & 31, ob = rr * 64 + cc * 2; return st * 1024 + (ob ^ (((ob >> 9) & 1) << 5)); }
__host__ __device__ __forceinline__ void stage_rc(int b, int& R, int& C) { const int st = b / 1024, sb = b % 1024, swz = sb ^ (((sb >> 9) & 1) << 5); R = (st >> 1) * 16 + swz / 64; C = (st & 1) * 32 + (swz % 64) / 2; }
__host__ __device__ __forceinline__ int perm32(int rho) { const int n = rho >> 4, i = rho & 15; return 8 * (i >> 2) + 4 * n + (i & 3); }

struct Unit { int pm, pn; int ko = 0; };
struct Gemm { const bf16_t* A; const bf16_t* Bt; int M, N, K; int nt = 0; };

struct StaticOrder {
    int nM, nN, nwg, G, c;
    __host__ __device__ void init(int M, int N, int G_, int c_) { nM = M / BM; nN = N / BM; nwg = nM * nN; G = G_; c = c_; }
    __host__ __device__ bool next(int i, Unit& u) const {
        const long L = (long)i * G + c; if (L >= nwg) return false;
        int wgid = (int)L; { const int q = nwg / NXCD, r = nwg % NXCD, xcd = wgid % NXCD, off = wgid / NXCD; wgid = (xcd < r ? xcd * (q + 1) : r * (q + 1) + (xcd - r) * q) + off; }
        const int nig = WGM * nN, gid = wgid / nig, fm = gid * WGM, gsz = (nM - fm) < WGM ? (nM - fm) : WGM;
        u.pm = fm + ((wgid % nig) % gsz); u.pn = (wgid % nig) / gsz; return true;
    }
    __device__ __forceinline__ void a_ready(const Unit&) const {}
    __device__ __forceinline__ void done(const Unit&) const {}
};


struct TailOrder {
    int first, stride, total;
    __host__ __device__ bool next(int i, Unit& u) const { if (first < 0) return false; const int j = first + i * stride; if (j >= total) return false; u.pm = j >> 3; u.pn = j & 7; return true; }
    __device__ __forceinline__ void a_ready(const Unit&) const {}
    __device__ __forceinline__ void done(const Unit&) const {}
};

struct PairOrder {
    StaticOrder S; int kob;
    __host__ __device__ bool next(int i, Unit& u) const { if (!S.next(i >> 1, u)) return false; u.ko = (i & 1) * kob; return true; }
    __device__ __forceinline__ void a_ready(const Unit&) const {}
    __device__ __forceinline__ void done(const Unit&) const {}
};
typedef float cvt_f32x2_t __attribute__((ext_vector_type(2))); typedef __bf16 cvt_bf16x2_t __attribute__((ext_vector_type(2)));
__device__ __forceinline__ unsigned cvt_pk_bf16(float lo, float hi) { return __builtin_bit_cast(unsigned, __builtin_convertvector((cvt_f32x2_t){lo, hi}, cvt_bf16x2_t)); }
__device__ __forceinline__ float bf_lo(unsigned w) { return __uint_as_float(w << 16); }
__device__ __forceinline__ float bf_hi(unsigned w) { return __uint_as_float(w & 0xffff0000u); }
__device__ __forceinline__ float sigmoidf_(float x) { return __builtin_amdgcn_rcpf(1.0f + __expf(-x)); }
typedef unsigned u32x2 __attribute__((ext_vector_type(2)));
#define EPI_FENCE() do { if (m & 1) asm volatile("" ::: "memory"); } while (0)
#define EPI_ROWS(...) _Pragma("unroll") for (int ai = 0; ai < 2; ++ai) _Pragma("unroll") for (int m = 0; m < 4; ++m) { const int row = u.pm * BM + ai * HALF + wr * 64 + m * 16 + fr; __VA_ARGS__ }

struct EpiQKG {
    static constexpr bool PERM = true, AFTER_DRAIN = false, MIDK = false;
    bf16_t* O; int ldc;
    __device__ __forceinline__ void operator()(const f32x4 (&acc)[2][2][4][2], const Unit& u, int wr, int wc, int fr, int fq) const {
        const bool gate = u.pn >= 16; const int col0 = u.pn * BM + wc * 32 + 8 * fq;
        EPI_ROWS(
            bf16_t* rowp = O + (size_t)row * ldc + col0;
            _Pragma("unroll") for (int bj = 0; bj < 2; ++bj) { f32x4 v0 = acc[ai][bj][m][0], v1 = acc[ai][bj][m][1];
                if (gate) { _Pragma("unroll") for (int j = 0; j < 4; ++j) { v0[j] = sigmoidf_(v0[j]); v1[j] = sigmoidf_(v1[j]); } }
                u32x4 w; w.x = cvt_pk_bf16(v0[0], v0[1]); w.y = cvt_pk_bf16(v0[2], v0[3]); w.z = cvt_pk_bf16(v1[0], v1[1]); w.w = cvt_pk_bf16(v1[2], v1[3]);
                *(u32x4*)(rowp + bj * HALF) = w; }
            EPI_FENCE();
        )
    }
};
struct EpiVT {
    static constexpr bool PERM = true, AFTER_DRAIN = false, MIDK = false;
    bf16_t* O; int ldc;
    __device__ __forceinline__ void operator()(const f32x4 (&acc)[2][2][4][2], const Unit& u, int wr, int wc, int fr, int fq) const {
        const int cbase = u.pn * BM + wc * 32 + 16 * (fq >> 1) + 4 * (fq & 1);
        EPI_ROWS(
            const int hv = row >> 7, dd = row & 127;
            _Pragma("unroll") for (int bj = 0; bj < 2; ++bj) _Pragma("unroll") for (int n = 0; n < 2; ++n) { const f32x4 v = acc[ai][bj][m][n];
                const int col = cbase + bj * HALF + 8 * n, bb = col >> 12, kt = (col >> 6) & 63, pos = col & 63;
                u32x2 w; w.x = cvt_pk_bf16(v[0], v[1]); w.y = cvt_pk_bf16(v[2], v[3]);
                *(u32x2*)(O + ((((size_t)(bb * 16 + hv)) * 64 + kt) * 128 + dd) * 64 + pos) = w; }
            EPI_FENCE();
        )
    }
};
struct EpiMerge {
    static constexpr bool PERM = true, AFTER_DRAIN = false, MIDK = true;
    const bf16_t* GA; const bf16_t* GB; int ldg; bf16_t* O; int ldc; int midk;
    __device__ __forceinline__ void mid(f32x4 (&acc)[2][2][4][2], const Unit& u, int wr, int wc, int fr, int fq) const {
        const int col0 = u.pn * BM + wc * 32 + 8 * fq;
        EPI_ROWS(
            _Pragma("unroll") for (int bj = 0; bj < 2; ++bj) { const size_t off = (size_t)row * ldg + col0 + bj * HALF;
                const u32x4 a = *(const u32x4*)(GA + off), b = *(const u32x4*)(GB + off);
                float r[8];
                r[0] = bf_lo(a.x) * __builtin_amdgcn_rcpf(fmaxf(bf_lo(b.x), 1e-30f)); r[1] = bf_hi(a.x) * __builtin_amdgcn_rcpf(fmaxf(bf_hi(b.x), 1e-30f));
                r[2] = bf_lo(a.y) * __builtin_amdgcn_rcpf(fmaxf(bf_lo(b.y), 1e-30f)); r[3] = bf_hi(a.y) * __builtin_amdgcn_rcpf(fmaxf(bf_hi(b.y), 1e-30f));
                r[4] = bf_lo(a.z) * __builtin_amdgcn_rcpf(fmaxf(bf_lo(b.z), 1e-30f)); r[5] = bf_hi(a.z) * __builtin_amdgcn_rcpf(fmaxf(bf_hi(b.z), 1e-30f));
                r[6] = bf_lo(a.w) * __builtin_amdgcn_rcpf(fmaxf(bf_lo(b.w), 1e-30f)); r[7] = bf_hi(a.w) * __builtin_amdgcn_rcpf(fmaxf(bf_hi(b.w), 1e-30f));
                _Pragma("unroll") for (int j = 0; j < 4; ++j) { acc[ai][bj][m][0][j] *= r[j]; acc[ai][bj][m][1][j] *= r[4 + j]; } }
            EPI_FENCE();
        )
    }
    __device__ __forceinline__ void operator()(const f32x4 (&acc)[2][2][4][2], const Unit& u, int wr, int wc, int fr, int fq) const {
        const int col0 = u.pn * BM + wc * 32 + 8 * fq;
        EPI_ROWS(
            _Pragma("unroll") for (int bj = 0; bj < 2; ++bj) { const u32x4 b = *(const u32x4*)(GB + (size_t)row * ldg + col0 + bj * HALF);
                f32x4 v0 = acc[ai][bj][m][0], v1 = acc[ai][bj][m][1];
                v0[0] *= fmaxf(bf_lo(b.x), 1e-30f); v0[1] *= fmaxf(bf_hi(b.x), 1e-30f); v0[2] *= fmaxf(bf_lo(b.y), 1e-30f); v0[3] *= fmaxf(bf_hi(b.y), 1e-30f);
                v1[0] *= fmaxf(bf_lo(b.z), 1e-30f); v1[1] *= fmaxf(bf_hi(b.z), 1e-30f); v1[2] *= fmaxf(bf_lo(b.w), 1e-30f); v1[3] *= fmaxf(bf_hi(b.w), 1e-30f);
                u32x4 w; w.x = cvt_pk_bf16(v0[0], v0[1]); w.y = cvt_pk_bf16(v0[2], v0[3]); w.z = cvt_pk_bf16(v1[0], v1[1]); w.w = cvt_pk_bf16(v1[2], v1[3]);
                *(u32x4*)(O + (size_t)row * ldc + col0 + bj * HALF) = w; }
            EPI_FENCE();
        )
    }
};
template <bool BASE_BF16> struct EpiResid {
    static constexpr bool PERM = true, AFTER_DRAIN = false, MIDK = false;
    const void* base; bf16_t* ob; float* rowss; int ldc;
    __device__ __forceinline__ void operator()(const f32x4 (&acc)[2][2][4][2], const Unit& u, int wr, int wc, int fr, int fq) const {
        const int col0 = u.pn * BM + wc * 32 + 8 * fq;
        EPI_ROWS(
            float ss = 0.f;
            _Pragma("unroll") for (int bj = 0; bj < 2; ++bj) { const size_t off = (size_t)row * ldc + col0 + bj * HALF;
                f32x4 b0, b1;
                if (BASE_BF16) { const u32x4 bw = *(const u32x4*)((const bf16_t*)base + off); b0 = (f32x4){bf_lo(bw.x), bf_hi(bw.x), bf_lo(bw.y), bf_hi(bw.y)}; b1 = (f32x4){bf_lo(bw.z), bf_hi(bw.z), bf_lo(bw.w), bf_hi(bw.w)}; }
                else { b0 = __builtin_nontemporal_load((const f32x4*)((const float*)base + off)); b1 = __builtin_nontemporal_load((const f32x4*)((const float*)base + off + 4)); }
                const f32x4 v0 = acc[ai][bj][m][0] + b0, v1 = acc[ai][bj][m][1] + b1;
                ss += (v0[0] * v0[0] + v0[1] * v0[1]) + (v0[2] * v0[2] + v0[3] * v0[3]) + (v1[0] * v1[0] + v1[1] * v1[1]) + (v1[2] * v1[2] + v1[3] * v1[3]);
                u32x4 w; w.x = cvt_pk_bf16(v0[0], v0[1]); w.y = cvt_pk_bf16(v0[2], v0[3]); w.z = cvt_pk_bf16(v1[0], v1[1]); w.w = cvt_pk_bf16(v1[2], v1[3]);
                *(u32x4*)(ob + off) = w; }
            ss += __shfl_xor(ss, 16); ss += __shfl_xor(ss, 32);
            if (fq == 0) atomicAdd(rowss + row, ss);
            EPI_FENCE();
        )
    }
};
struct EpiSwiGLU {
    static constexpr bool PERM = true, AFTER_DRAIN = false, MIDK = false;
    const float* rowss; bf16_t* H; int ldh; float inv_d, eps;
    __device__ __forceinline__ void operator()(const f32x4 (&acc)[2][2][4][2], const Unit& u, int wr, int wc, int fr, int fq) const {
        const int col0 = u.pn * HALF + wc * 32 + 8 * fq;
        EPI_ROWS(
            const float rs = __builtin_amdgcn_rsqf(rowss[row] * inv_d + eps);
            float hv[8];
            _Pragma("unroll") for (int n = 0; n < 2; ++n) _Pragma("unroll") for (int j = 0; j < 4; ++j) { const float g = acc[ai][0][m][n][j] * rs, up = acc[ai][1][m][n][j] * rs; hv[n * 4 + j] = g * sigmoidf_(g) * up; }
            u32x4 w; w.x = cvt_pk_bf16(hv[0], hv[1]); w.y = cvt_pk_bf16(hv[2], hv[3]); w.z = cvt_pk_bf16(hv[4], hv[5]); w.w = cvt_pk_bf16(hv[6], hv[7]);
            *(u32x4*)(H + (size_t)row * ldh + col0) = w;
            EPI_FENCE();
        )
    }
};
struct EpiStoreBf16 {
    static constexpr bool PERM = true, AFTER_DRAIN = false, MIDK = false;
    bf16_t* T; int ldc;
    __device__ __forceinline__ void operator()(const f32x4 (&acc)[2][2][4][2], const Unit& u, int wr, int wc, int fr, int fq) const {
        const int col0 = u.pn * BM + wc * 32 + 8 * fq;
        EPI_ROWS(
            _Pragma("unroll") for (int bj = 0; bj < 2; ++bj) { const f32x4 v0 = acc[ai][bj][m][0], v1 = acc[ai][bj][m][1];
                u32x4 w; w.x = cvt_pk_bf16(v0[0], v0[1]); w.y = cvt_pk_bf16(v0[2], v0[3]); w.z = cvt_pk_bf16(v1[0], v1[1]); w.w = cvt_pk_bf16(v1[2], v1[3]);
                *(u32x4*)(T + (size_t)row * ldc + col0 + bj * HALF) = w; }
            EPI_FENCE();
        )
    }
};
struct EpiPle {
    static constexpr bool PERM = true, AFTER_DRAIN = false, MIDK = false;
    const float* rowss; const bf16_t* T; const bf16_t* X; float* out; int ldc; float inv_d, eps;
    __device__ __forceinline__ void operator()(const f32x4 (&acc)[2][2][4][2], const Unit& u, int wr, int wc, int fr, int fq) const {
        const int col0 = u.pn * BM + wc * 32 + 8 * fq;
        EPI_ROWS(
            const float rs = __builtin_amdgcn_rsqf(rowss[row] * inv_d + eps);
            _Pragma("unroll") for (int bj = 0; bj < 2; ++bj) { const size_t off = (size_t)row * ldc + col0 + bj * HALF;
                const u32x4 tw = *(const u32x4*)(T + off), xw = *(const u32x4*)(X + off);
                const float t[8] = {bf_lo(tw.x), bf_hi(tw.x), bf_lo(tw.y), bf_hi(tw.y), bf_lo(tw.z), bf_hi(tw.z), bf_lo(tw.w), bf_hi(tw.w)};
                const float x[8] = {bf_lo(xw.x), bf_hi(xw.x), bf_lo(xw.y), bf_hi(xw.y), bf_lo(xw.z), bf_hi(xw.z), bf_lo(xw.w), bf_hi(xw.w)};
                f32x4 o0, o1;
                _Pragma("unroll") for (int j = 0; j < 4; ++j) { o0[j] = x[j] + sigmoidf_(acc[ai][bj][m][0][j] * rs) * t[j]; o1[j] = x[4 + j] + sigmoidf_(acc[ai][bj][m][1][j] * rs) * t[4 + j]; }
                __builtin_nontemporal_store(o0, (f32x4*)(out + off)); __builtin_nontemporal_store(o1, (f32x4*)(out + off + 4)); }
            EPI_FENCE();
        )
    }
};
template <class Epi, class Sched, bool ALIGN_EPI = false, bool SP2 = false>
__device__ __forceinline__ void gemm_phase(PG8_LAS unsigned char* lds, const Gemm g, const Sched& S, const Epi& E) {
    int tid_ = threadIdx.x; asm volatile("" : "+v"(tid_));
    const int tid = tid_, wid = __builtin_amdgcn_readfirstlane(tid >> 6), lane = tid & 63, wr = wid >> 2, wc = wid & 3, fr = lane & 15, fq = lane >> 4;
    const int K = g.K, nt = g.nt ? g.nt : K / BK;
    unsigned voffA[2], voffB[2];
#pragma unroll
    for (int i = 0; i < 2; ++i) { int R, C; stage_rc(tid * 16 + i * 8192, R, C); const int Rb = Epi::PERM ? ((R & ~31) + perm32(R & 31)) : R;
        voffA[i] = (unsigned)(R * K + C) * 2u; voffB[i] = (unsigned)(Rb * K + C) * 2u; }
    const size_t kstep = (size_t)(BK * 2);
    const size_t hstep = (size_t)HALF * K * 2;
    const size_t tstep = 2 * hstep;
    const unsigned ldsw = (unsigned)wid * 1024u;
    const int aoff = lds_byte(wr * 64 + fr, fq * 8), boff = lds_byte(wc * 32 + fr, fq * 8);
#define PG8_SA(b, h) (((b) * 2 + (h)) * HTB)
#define PG8_SB(b, h) ((4 + (b) * 2 + (h)) * HTB)
#define PG8_STAGE(bufoff, gbase, voff) do { _Pragma("unroll") for (int _i = 0; _i < 2; ++_i) \
        __builtin_amdgcn_global_load_lds((const unsigned*)((const char*)(gbase) + (voff)[_i]), (PG8_LAS unsigned*)(lds + (bufoff) + ldsw + _i * 8192), 16, 0, 0); } while (0)
#define PG8_LDA(dst, b, h) do { _Pragma("unroll") for (int m = 0; m < 4; ++m) _Pragma("unroll") for (int k = 0; k < 2; ++k) dst[m][k] = *(const PG8_LAS bf16x8*)(lds + PG8_SA(b, h) + aoff + m * 2048 + k * 1024); } while (0)
#define PG8_LDB(dst, b, h) do { _Pragma("unroll") for (int n = 0; n < 2; ++n) _Pragma("unroll") for (int k = 0; k < 2; ++k) dst[n][k] = *(const PG8_LAS bf16x8*)(lds + PG8_SB(b, h) + boff + n * 2048 + k * 1024); } while (0)
#define PG8_MMA(ai, bj, At, Bt) do { __builtin_amdgcn_s_setprio(1); _Pragma("unroll") for (int m = 0; m < 4; ++m) _Pragma("unroll") for (int n = 0; n < 2; ++n) _Pragma("unroll") for (int k = 0; k < 2; ++k) \
        acc[ai][bj][m][n] = __builtin_amdgcn_mfma_f32_16x16x32_bf16(Bt[n][k], At[m][k], acc[ai][bj][m][n], 0, 0, 0); __builtin_amdgcn_s_setprio(0); } while (0)
#define PG8_WAIT_V(n) asm volatile("s_waitcnt vmcnt(" #n ")" ::: "memory")
#define PG8_WAIT_L(n) asm volatile("s_waitcnt lgkmcnt(" #n ")" ::: "memory")
#define PG8_BAR __builtin_amdgcn_s_barrier()
#define PG8_SCHED __builtin_amdgcn_sched_barrier(0)
    Unit cur, nxt; int ui = 0;
    if (!S.next(0, cur)) return;
    f32x4 acc[2][2][4][2];
#pragma unroll
    for (int a = 0; a < 2; ++a)
#pragma unroll
        for (int b = 0; b < 2; ++b)
#pragma unroll
            for (int m = 0; m < 4; ++m)
#pragma unroll
                for (int n = 0; n < 2; ++n) acc[a][b][m][n] = (f32x4){0.f, 0.f, 0.f, 0.f};
    bf16x8 At[4][2], B0[2][2], B1[2][2];
    const char* cA = (const char*)g.A + (size_t)cur.pm * tstep + cur.ko; const char* cB = (const char*)g.Bt + (size_t)cur.pn * tstep + cur.ko;
    S.a_ready(cur);
    if constexpr (SP2) {
        PG8_STAGE(PG8_SB(0, 0), cB, voffB); PG8_STAGE(PG8_SB(0, 1), cB + hstep, voffB); PG8_STAGE(PG8_SA(0, 0), cA, voffA); PG8_STAGE(PG8_SA(0, 1), cA + hstep, voffA);
        if (wr == 1) PG8_BAR;
        PG8_WAIT_V(2); PG8_BAR;
        PG8_STAGE(PG8_SB(1, 0), cB + kstep, voffB); PG8_STAGE(PG8_SA(1, 0), cA + kstep, voffA); PG8_STAGE(PG8_SB(1, 1), cB + hstep + kstep, voffB);
        PG8_WAIT_V(6); PG8_BAR;
    } else {
        PG8_STAGE(PG8_SB(0, 0), cB, voffB); PG8_STAGE(PG8_SA(0, 0), cA, voffA); PG8_STAGE(PG8_SB(0, 1), cB + hstep, voffB); PG8_STAGE(PG8_SA(0, 1), cA + hstep, voffA);
        if (wr == 1) PG8_BAR;
        PG8_WAIT_V(4); PG8_BAR;
        PG8_STAGE(PG8_SB(1, 0), cB + kstep, voffB); PG8_STAGE(PG8_SA(1, 0), cA + kstep, voffA); PG8_STAGE(PG8_SB(1, 1), cB + hstep + kstep, voffB);
        PG8_WAIT_V(6); PG8_BAR;
    }
    for (;;) {
        const bool has_next = S.next(ui + 1, nxt);
        const char* nA = has_next ? (const char*)g.A + (size_t)nxt.pm * tstep + nxt.ko : cA; const char* nB = has_next ? (const char*)g.Bt + (size_t)nxt.pn * tstep + nxt.ko : cB;
        for (int t = 0; t < nt; t += 2) {
            const bool last = (t == nt - 2);
            const char* a1 = cA + (size_t)(t + 1) * kstep;
            const char* a2 = last ? nA : cA + (size_t)(t + 2) * kstep; const char* b2 = last ? nB : cB + (size_t)(t + 2) * kstep;
            const char* a3 = a2 + kstep; const char* b3 = b2 + kstep;
            if (last && has_next) S.a_ready(nxt);
            if constexpr (SP2) {
            PG8_LDB(B0, 0, 0); PG8_LDB(B1, 0, 1); PG8_SCHED; PG8_LDA(At, 0, 0); PG8_STAGE(PG8_SA(1, 1), a1 + hstep, voffA);
            PG8_WAIT_V(8); PG8_WAIT_L(0); PG8_BAR; PG8_MMA(0, 0, At, B0); PG8_MMA(0, 1, At, B1); PG8_BAR; PG8_SCHED;
            PG8_LDA(At, 0, 1); PG8_STAGE(PG8_SB(0, 0), b2, voffB); PG8_STAGE(PG8_SB(0, 1), b2 + hstep, voffB); PG8_STAGE(PG8_SA(0, 0), a2, voffA);
            PG8_WAIT_V(8); PG8_WAIT_L(0); PG8_BAR; PG8_MMA(1, 0, At, B0); PG8_MMA(1, 1, At, B1); PG8_BAR; PG8_SCHED;
            PG8_LDB(B0, 1, 0); PG8_LDB(B1, 1, 1); PG8_SCHED; PG8_LDA(At, 1, 0); PG8_STAGE(PG8_SA(0, 1), a2 + hstep, voffA);
            PG8_WAIT_V(8); PG8_WAIT_L(0); PG8_BAR; PG8_MMA(0, 0, At, B0); PG8_MMA(0, 1, At, B1); PG8_BAR; PG8_SCHED;
            PG8_LDA(At, 1, 1); PG8_STAGE(PG8_SB(1, 0), b3, voffB); PG8_STAGE(PG8_SB(1, 1), b3 + hstep, voffB); PG8_STAGE(PG8_SA(1, 0), a3, voffA);
            PG8_WAIT_V(8); PG8_WAIT_L(0); PG8_BAR; PG8_MMA(1, 0, At, B0); PG8_MMA(1, 1, At, B1); PG8_BAR; PG8_SCHED;
            } else {
            PG8_LDB(B0, 0, 0); PG8_SCHED; PG8_LDA(At, 0, 0); PG8_STAGE(PG8_SA(1, 1), a1 + hstep, voffA);
            PG8_WAIT_L(8); PG8_BAR; PG8_WAIT_L(0); PG8_MMA(0, 0, At, B0); PG8_BAR; PG8_SCHED;
            PG8_LDB(B1, 0, 1); PG8_STAGE(PG8_SB(0, 0), b2, voffB);
            PG8_BAR; PG8_WAIT_L(0); PG8_MMA(0, 1, At, B1); PG8_BAR;
            PG8_LDA(At, 0, 1); PG8_STAGE(PG8_SA(0, 0), a2, voffA);
            PG8_BAR; PG8_WAIT_L(0); PG8_MMA(1, 0, At, B0); PG8_BAR; PG8_SCHED;
            PG8_STAGE(PG8_SB(0, 1), b2 + hstep, voffB);
            PG8_WAIT_V(6); PG8_BAR; PG8_MMA(1, 1, At, B1); PG8_BAR;
            PG8_LDB(B0, 1, 0); PG8_SCHED; PG8_LDA(At, 1, 0); PG8_STAGE(PG8_SA(0, 1), a2 + hstep, voffA);
            PG8_WAIT_L(8); PG8_BAR; PG8_WAIT_L(0); PG8_MMA(0, 0, At, B0); PG8_BAR; PG8_SCHED;
            PG8_LDB(B1, 1, 1); PG8_STAGE(PG8_SB(1, 0), b3, voffB);
            PG8_BAR; PG8_WAIT_L(0); PG8_MMA(0, 1, At, B1); PG8_BAR;
            PG8_LDA(At, 1, 1); PG8_STAGE(PG8_SA(1, 0), a3, voffA);
            PG8_BAR; PG8_WAIT_L(0); PG8_MMA(1, 0, At, B0); PG8_BAR; PG8_SCHED;
            PG8_STAGE(PG8_SB(1, 1), b3 + hstep, voffB);
            PG8_WAIT_V(6); PG8_BAR; PG8_MMA(1, 1, At, B1); PG8_BAR;
            }
        }
        if constexpr (ALIGN_EPI) { if (wr == 0) PG8_BAR; }
        bool keep_acc = false;
        if constexpr (Epi::MIDK) { if (cur.ko == 0) { E.mid(acc, cur, wr, wc, fr, fq); keep_acc = true; } else E(acc, cur, wr, wc, fr, fq); }
        else if constexpr (!Epi::AFTER_DRAIN) { E(acc, cur, wr, wc, fr, fq); S.done(cur); }
        if (!has_next) break;
        if (!keep_acc) {
#pragma unroll
        for (int a = 0; a < 2; ++a)
#pragma unroll
            for (int b = 0; b < 2; ++b)
#pragma unroll
                for (int m = 0; m < 4; ++m)
#pragma unroll
                    for (int n = 0; n < 2; ++n) acc[a][b][m][n] = (f32x4){0.f, 0.f, 0.f, 0.f};
        }
        cur = nxt; cA = nA; cB = nB; ++ui;
        if constexpr (ALIGN_EPI) { if (wr == 1) PG8_BAR; }
    }
    PG8_WAIT_V(0);
    if constexpr (!ALIGN_EPI) { if (wr == 0) PG8_BAR; }
    PG8_BAR;
    if constexpr (Epi::AFTER_DRAIN) { E.fused(acc, cur, wr, wc, fr, fq, lds, wid, lane); S.done(cur); }
#undef PG8_SA
#undef PG8_SB
#undef PG8_STAGE
#undef PG8_LDA
#undef PG8_LDB
#undef PG8_MMA
#undef PG8_WAIT_V
#undef PG8_WAIT_L
#undef PG8_BAR
#undef PG8_SCHED
}
}
constexpr int D = 2048, BATCH = 2, SEQ = 4096, M = BATCH * SEQ, GW = 64, GROWS = SEQ / GW, FF = 5632, PLE = 256;
constexpr int NA_H = 8, NA_DH = 128, DF_H = 8, DF_DQ = 64, DF_DV = 128;
constexpr int NQKG = 8192;
constexpr int QC_NAQ = 0, QC_NAK = 1024, QC_DFQ = 2048, QC_DFK = 3072, QC_GA = 4096, QC_GB = 6144;
constexpr float EPS = 1e-6f, LOG2E = 1.4426950408889634f;
constexpr float LAM_INIT = 0.2f;
constexpr int NWAVES = 8, NTHREADS = 512;
constexpr size_t MiB = 1u << 20;
constexpr size_t WS_RS1 = 64 * 1024, WS_RS2 = 128 * 1024, WS_ROPE = 1 * MiB;
constexpr size_t WS_W1 = 2 * MiB, WS_WNA = 42 * MiB, WS_WDF = 46 * MiB, WS_WO = 50 * MiB, WS_WGU = 58 * MiB, WS_WDN = 102 * MiB, WS_WPG = 124 * MiB, WS_WPP = 132 * MiB;
constexpr size_t WS_A = 133 * MiB;
constexpr size_t WS_B = 261 * MiB;
constexpr size_t WS_C = 293 * MiB;
constexpr size_t WS_PB = 325 * MiB;
constexpr size_t WS_END = 329 * MiB;
constexpr int LDS_BYTES = 147456;
#define LAS __attribute__((address_space(3)))
typedef unsigned short bf16;
typedef unsigned u32x4 __attribute__((ext_vector_type(4)));
typedef unsigned u32x2 __attribute__((ext_vector_type(2)));
typedef float f32x4 __attribute__((ext_vector_type(4)));
typedef float f32x2 __attribute__((ext_vector_type(2)));
typedef float f32x16 __attribute__((ext_vector_type(16)));
typedef short bf16x8 __attribute__((ext_vector_type(8)));
using pg8::cvt_pk_bf16; using pg8::bf_lo; using pg8::bf_hi;

__device__ __forceinline__ float wave_sum(float v) {
#pragma unroll
    for (int o = 1; o < 64; o <<= 1) v += __shfl_xor(v, o);
    return v;
}
__device__ __forceinline__ float wave_max(float v) {
#pragma unroll
    for (int o = 1; o < 64; o <<= 1) v = fmaxf(v, __shfl_xor(v, o));
    return v;
}
__device__ __forceinline__ int crow(int r, int hi) { return (r & 3) + 8 * (r >> 2) + 4 * hi; }

__device__ __forceinline__ int rowmap(int mode, int n0) {
    if (mode == 0) return n0;
    if (mode == 1) {
        if (n0 < 2048) return n0;
        if (n0 < 3072) return 8192 + (n0 - 2048);
        if (n0 < 4096) return 2048 + (n0 - 3072);
        if (n0 < 5120) return 3072 + (n0 - 4096);
        if (n0 < 6144) return 9216 + (n0 - 5120);
        return 4096 + (n0 - 6144);
    }
    return 256 * (n0 >> 7) + (n0 & 127) + (mode == 3 ? 128 : 0);
}
struct P0Item { const float* W; bf16* WT; const float* gk; int K, N, mode, item, Kd, kofs; };
__device__ __forceinline__ void p0_item_load(const P0Item& d, float (&v)[32], int lane) {
    const int nblk = d.N / 32, kb = d.item / nblk, nb = d.item % nblk, k0 = 64 * kb, n0 = 32 * nb;
    const float* src = d.W + (size_t)(k0 + (lane >> 5)) * d.N + n0 + (lane & 31);
#pragma unroll
    for (int i = 0; i < 32; ++i) v[i] = __builtin_nontemporal_load(src + (size_t)(2 * i) * d.N);
}
__device__ __forceinline__ void p0_item_store(const P0Item& d, const float (&v)[32], LAS float* scr, int lane) {
    const int nblk = d.N / 32, kb = d.item / nblk, nb = d.item % nblk, k0 = 64 * kb, n0 = 32 * nb;
    const int r0 = rowmap(d.mode, n0);
    if (d.gk) {
#pragma unroll
        for (int i = 0; i < 32; ++i) { const int kk = 2 * i + (lane >> 5); scr[kk * 33 + (lane & 31)] = v[i] * d.gk[k0 + kk]; }
    } else {
#pragma unroll
        for (int i = 0; i < 32; ++i) { const int kk = 2 * i + (lane >> 5); scr[kk * 33 + (lane & 31)] = v[i]; }
    }
    asm volatile("s_waitcnt lgkmcnt(0)" ::: "memory");
    const int c = lane & 7;
#pragma unroll
    for (int j = 0; j < 4; ++j) { const int n = (lane >> 3) + 8 * j; const LAS float* s = scr + (8 * c) * 33 + n;
        u32x4 o; o.x = cvt_pk_bf16(s[0 * 33], s[1 * 33]); o.y = cvt_pk_bf16(s[2 * 33], s[3 * 33]); o.z = cvt_pk_bf16(s[4 * 33], s[5 * 33]); o.w = cvt_pk_bf16(s[6 * 33], s[7 * 33]);
        *(u32x4*)(d.WT + (size_t)(r0 + n) * d.Kd + d.kofs + k0 + 8 * c) = o; }
    asm volatile("s_waitcnt lgkmcnt(0)" ::: "memory");
}
#define RLX_AGENT __ATOMIC_RELAXED, __HIP_MEMORY_SCOPE_AGENT
#define XB_TMO      128
#define XB_XCNT(j)  (256  + 64 * (j))
#define XB_XSUB(j)  (1280 + 64 * (j))
#define XB_XGEN(j)  (2304 + 64 * (j))
#define XB_TOP      3328
#define XB_TOPGEN   3392
#define XCD_BAR_WORDS 3456
#define XB_SPIN_CAP (1u << 18)

__device__ __forceinline__ unsigned xb_ld(unsigned* p)              { return __hip_atomic_load(p, __ATOMIC_RELAXED, __HIP_MEMORY_SCOPE_AGENT); }
__device__ __forceinline__ unsigned xb_add(unsigned* p, unsigned v) { return __hip_atomic_fetch_add(p, v, __ATOMIC_RELAXED, __HIP_MEMORY_SCOPE_AGENT); }
__device__ __forceinline__ unsigned xb_xcc_id() { return (unsigned)__builtin_amdgcn_s_getreg((3 << 11) | 20) & 0xFu; }
#define XB_SPIN(cond, bar) do { unsigned _sp = 0; while (cond) { __builtin_amdgcn_s_sleep(1); \
    if ((++_sp & 255u) == 0u) { if (xb_ld(&(bar)[XB_TMO])) break; if (_sp > XB_SPIN_CAP) { atomicAdd(&(bar)[XB_TMO], 1u); break; } } } } while (0)

struct XcdBarrier {
    unsigned* bar; unsigned x;
    volatile LAS unsigned* st;
};

__device__ __forceinline__ XcdBarrier xcd_barrier_post(unsigned* bar, volatile LAS unsigned* st) {
    XcdBarrier b; b.bar = bar; b.x = xb_xcc_id(); b.st = st;
    if (threadIdx.x == 0) (void)xb_add(&bar[XB_XCNT(b.x)], 1u);
    return b;
}
__device__ __forceinline__ void xcd_barrier_complete(unsigned* bar, unsigned x, unsigned& nloc, unsigned& nx) {
    const unsigned G = gridDim.x * gridDim.y * gridDim.z;
    unsigned sum, cnt, mine, sp = 0u;
    for (;;) {
        sum = 0u; cnt = 0u; mine = 0u;
#pragma unroll
        for (unsigned j = 0; j < 16; ++j) { const unsigned c = xb_ld(&bar[XB_XCNT(j)]); sum += c; cnt += (c > 0u) ? 1u : 0u; mine = (j == x) ? c : mine; }
        if (sum == G) break;
        __builtin_amdgcn_s_sleep(1);
        if ((++sp & 255u) == 0u) { if (xb_ld(&bar[XB_TMO])) break; if (sp > XB_SPIN_CAP) { atomicAdd(&bar[XB_TMO], 1u); break; } }
    }
    nloc = mine > 0u ? mine : 1u; nx = cnt > 0u ? cnt : 1u;
}

__device__ __forceinline__ void xcd_barrier(const XcdBarrier& b) {
    asm volatile("s_waitcnt vmcnt(0)" ::: "memory");
    __syncthreads();
    if (threadIdx.x == 0) {
        unsigned* bar = b.bar;
        __builtin_amdgcn_s_waitcnt(0);
        unsigned nloc = b.st[0], nx = b.st[1];
        if (nloc == 0u) { xcd_barrier_complete(bar, b.x, nloc, nx); b.st[0] = nloc; b.st[1] = nx; }
        const unsigned old = xb_add(&bar[XB_XSUB(b.x)], 1u);
        const unsigned gen = old / nloc;
        if (old + 1u == (gen + 1u) * nloc) {
            __builtin_amdgcn_fence(__ATOMIC_RELEASE, "agent");
            asm volatile("s_waitcnt vmcnt(0)" ::: "memory");
            const unsigned og = xb_add(&bar[XB_TOP], 1u);
            const unsigned tg = og / nx;
            if (og + 1u == (tg + 1u) * nx) xb_add(&bar[XB_TOPGEN], 1u);
            else XB_SPIN(xb_ld(&bar[XB_TOPGEN]) == tg, bar);
            __builtin_amdgcn_fence(__ATOMIC_ACQUIRE, "agent");
            xb_add(&bar[XB_XGEN(b.x)], 1u);
            asm volatile("s_waitcnt vmcnt(0)" ::: "memory");
        } else {
            XB_SPIN(xb_ld(&bar[XB_XGEN(b.x)]) == gen, bar);
            __builtin_amdgcn_fence(__ATOMIC_ACQUIRE, "agent");
            asm volatile("s_waitcnt vmcnt(0)" ::: "memory");
        }
    }
    __syncthreads();
}
struct Args {
    const float *x, *p, *g_mix, *w_in, *g_na_q, *g_na_k, *na_rpb, *g_df_q, *g_df_k, *lam_q1, *lam_k1, *lam_q2, *lam_k2, *g_df_sub,
                *w_na_out, *w_df_out, *w_o, *g_ffn, *w_gate, *w_up, *w_down, *g_ple, *w_ple_gate, *w_ple_proj;
    float* out; unsigned char* ws; int ph_lo, ph_hi, rep3, pad;
};

__device__ __forceinline__ void na_wave_unit(const bf16* QKG, const bf16* VT, const float* rpb, bf16* NAO, float M2, int b, int h, int r, int half) {
    int tid_ = threadIdx.x; asm volatile("" : "+v"(tid_)); const int lane = tid_ & 63;
    const int q = lane & 31, hi = lane >> 5, c = 32 * half + q;
    const size_t tokq = (size_t)b * SEQ + r * GW + c;
    bf16x8 qf[8];
#pragma unroll
    for (int d0 = 0; d0 < 8; ++d0) qf[d0] = *(const bf16x8*)(QKG + tokq * NQKG + QC_NAQ + h * NA_DH + 16 * d0 + 8 * hi);
    int rs = r - 4; rs = rs < 0 ? 0 : (rs > GROWS - 8 ? GROWS - 8 : rs);
    int cs = c - 8; cs = cs < 0 ? 0 : (cs > GW - 16 ? GW - 16 : cs);
    f32x16 o[4];
#pragma unroll
    for (int i = 0; i < 4; ++i) o[i] = (f32x16){};
    float l = 0.f;
    for (int kr = 0; kr < 8; ++kr) {
        const int krow = rs + kr, dr = krow - r + 7;
        const float* brow = rpb + (h * 15 + dr) * 31;
#pragma unroll
        for (int kb = 0; kb < 2; ++kb) {
            f32x16 s = (f32x16){};
            const bf16* kp = QKG + ((size_t)b * SEQ + krow * GW + 32 * kb + q) * NQKG + QC_NAK + h * NA_DH + 8 * hi;
#pragma unroll
            for (int d0 = 0; d0 < 8; ++d0) { const bf16x8 kf = *(const bf16x8*)(kp + 16 * d0); s = __builtin_amdgcn_mfma_f32_32x32x16_bf16(kf, qf[d0], s, 0, 0, 0); }
            float pv[16];
#pragma unroll
            for (int i = 0; i < 16; ++i) { const int kc = 32 * kb + crow(i, hi); const bool in = (kc >= cs) && (kc < cs + 16); const int dc = in ? (kc - c + 15) : 0;
                const float bias = brow[dc] * LOG2E - M2; const float e = __builtin_amdgcn_exp2f(s[i] + bias); pv[i] = in ? e : 0.f; l += pv[i]; }
            u32x4 w0, w1;
            w0.x = cvt_pk_bf16(pv[0], pv[1]); w0.y = cvt_pk_bf16(pv[2], pv[3]); w0.z = cvt_pk_bf16(pv[4], pv[5]); w0.w = cvt_pk_bf16(pv[6], pv[7]);
            w1.x = cvt_pk_bf16(pv[8], pv[9]); w1.y = cvt_pk_bf16(pv[10], pv[11]); w1.z = cvt_pk_bf16(pv[12], pv[13]); w1.w = cvt_pk_bf16(pv[14], pv[15]);
            const bf16x8 p0 = __builtin_bit_cast(bf16x8, w0), p1 = __builtin_bit_cast(bf16x8, w1);
            const bf16* vp = VT + (size_t)(h * NA_DH + q) * M + (size_t)b * SEQ + krow * GW + 32 * kb + 8 * hi;
#pragma unroll
            for (int db = 0; db < 4; ++db) {
                const bf16x8 v0 = *(const bf16x8*)(vp + (size_t)(32 * db) * M), v1 = *(const bf16x8*)(vp + (size_t)(32 * db) * M + 16);
                o[db] = __builtin_amdgcn_mfma_f32_32x32x16_bf16(v0, p0, o[db], 0, 0, 0);
                o[db] = __builtin_amdgcn_mfma_f32_32x32x16_bf16(v1, p1, o[db], 0, 0, 0);
            }
        }
    }
    l += __shfl_xor(l, 32);
    const float rl = 1.0f / l;
    bf16* op = NAO + tokq * 2048 + h * NA_DH + 4 * hi;
#pragma unroll
    for (int db = 0; db < 4; ++db)
#pragma unroll
        for (int g = 0; g < 4; ++g) { u32x2 w; w.x = cvt_pk_bf16(o[db][4 * g] * rl, o[db][4 * g + 1] * rl); w.y = cvt_pk_bf16(o[db][4 * g + 2] * rl, o[db][4 * g + 3] * rl);
            *(u32x2*)(op + 32 * db + 8 * g) = w; }
}

__device__ __forceinline__ void df_unit(LAS unsigned char* lds, const bf16* QKG, const bf16* KC, const bf16* VT, bf16* DFO, const float* g_sub, const float* gq, const f32x2* rope, float lam, float M2, int b, int h, int qb, unsigned long long* df_wait = nullptr) {
    int tid_ = threadIdx.x; asm volatile("" : "+v"(tid_));
    const int tid = tid_, lane = tid & 63, w = __builtin_amdgcn_readfirstlane(tid >> 6), q = lane & 31, hi = lane >> 5;
    const int mm = w & 1, qg = w >> 1;
    const int q0 = qb * 128 + qg * 32;
    bf16x8 qf[4];
    {
      u32x4 qr[4]; float ss = 0.f; float xv[4][8];
#pragma unroll
      for (int d0 = 0; d0 < 4; ++d0) { qr[d0] = *(const u32x4*)(QKG + ((size_t)b * SEQ + q0 + q) * NQKG + QC_DFQ + h * 128 + mm * 64 + 16 * d0 + 8 * hi);
          xv[d0][0] = bf_lo(qr[d0].x); xv[d0][1] = bf_hi(qr[d0].x); xv[d0][2] = bf_lo(qr[d0].y); xv[d0][3] = bf_hi(qr[d0].y); xv[d0][4] = bf_lo(qr[d0].z); xv[d0][5] = bf_hi(qr[d0].z); xv[d0][6] = bf_lo(qr[d0].w); xv[d0][7] = bf_hi(qr[d0].w);
#pragma unroll
          for (int j = 0; j < 8; ++j) ss += xv[d0][j] * xv[d0][j]; }
      ss += __shfl_xor(ss, 32);
      const float rs = __builtin_amdgcn_rsqf(ss * (1.0f / 64.0f) + EPS);
      const float QS = 0.125f * LOG2E;
      const f32x2* rp = rope + (size_t)(q0 + q) * 32;
#pragma unroll
      for (int d0 = 0; d0 < 2; ++d0) { float o1[8], o2[8];
#pragma unroll
          for (int j = 0; j < 8; ++j) { const int i = 16 * d0 + 8 * hi + j; const f32x2 cs = rp[i];
              const float x1 = xv[d0][j] * rs * gq[i], x2 = xv[d0 + 2][j] * rs * gq[32 + i];
              o1[j] = (x1 * cs.x - x2 * cs.y) * QS; o2[j] = (x1 * cs.y + x2 * cs.x) * QS; }
          u32x4 wa, wb; wa.x = cvt_pk_bf16(o1[0], o1[1]); wa.y = cvt_pk_bf16(o1[2], o1[3]); wa.z = cvt_pk_bf16(o1[4], o1[5]); wa.w = cvt_pk_bf16(o1[6], o1[7]);
          wb.x = cvt_pk_bf16(o2[0], o2[1]); wb.y = cvt_pk_bf16(o2[2], o2[3]); wb.z = cvt_pk_bf16(o2[4], o2[5]); wb.w = cvt_pk_bf16(o2[6], o2[7]);
          qf[d0] = __builtin_bit_cast(bf16x8, wa); qf[d0 + 2] = __builtin_bit_cast(bf16x8, wb); } }
    const unsigned char* kbase = (const unsigned char*)(KC + ((size_t)(b * 8 + h) * SEQ) * 128);
    const unsigned char* vbase = (const unsigned char*)(VT + ((size_t)(b * 16 + 8 + h) * 64) * 128 * 64);
    unsigned koff[2], voff[2];
#pragma unroll
    for (int i = 0; i < 2; ++i) {
        const int piece = w * 2 + i;
        { const int row = piece * 4 + (lane >> 4), ph = lane & 15, ch = ph ^ (row & 15); koff[i] = (unsigned)(row * 128 + ch * 8) * 2u; }
        { const int row = piece * 8 + (lane >> 3), ph = lane & 7, ch = ph ^ ((row >> 1) & 7); voff[i] = (unsigned)(row * 64 + ch * 8) * 2u; }
    }
#define DF_DMA(kt, stg) do { const unsigned char* kb_ = kbase + (size_t)(kt) * 16384; const unsigned char* vb_ = vbase + (size_t)(kt) * 16384; _Pragma("unroll") for (int _i = 0; _i < 2; ++_i) { \
        __builtin_amdgcn_global_load_lds((const unsigned*)(kb_ + koff[_i]), (LAS unsigned*)(lds + (stg) * 32768 + (w * 2 + _i) * 1024), 16, 0, 0); \
        __builtin_amdgcn_global_load_lds((const unsigned*)(vb_ + voff[_i]), (LAS unsigned*)(lds + (stg) * 32768 + 16384 + (w * 2 + _i) * 1024), 16, 0, 0); } } while (0)
    int kofs[4], vofs[4];
#pragma unroll
    for (int d0 = 0; d0 < 4; ++d0) kofs[d0] = q * 256 + (((mm * 8 + 2 * d0 + hi) ^ (q & 15)) * 16);
#pragma unroll
    for (int g = 0; g < 4; ++g) vofs[g] = 16384 + q * 128 + (((2 * g + hi) ^ ((q >> 1) & 7)) * 16);
    f32x16 o[4];
#pragma unroll
    for (int i = 0; i < 4; ++i) o[i] = (f32x16){};
    float l = 0.f;
    const float shift = (M2 > 60.0f) ? M2 : 0.0f;
    constexpr int NT = SEQ / 64;
    typedef float f32x2_t __attribute__((ext_vector_type(2))); typedef __bf16 bf16x2_t __attribute__((ext_vector_type(2)));
#define CVTPK(lo, hi) __builtin_bit_cast(unsigned, __builtin_convertvector((f32x2_t){(lo), (hi)}, bf16x2_t))
#define DF_S(dst, St_, kb_) do { bf16x8 kf_[4]; _Pragma("unroll") for (int d0 = 0; d0 < 4; ++d0) kf_[d0] = *(const LAS bf16x8*)((St_) + kofs[d0] + (kb_) * 8192); \
        dst = (f32x16){}; _Pragma("unroll") for (int d0 = 0; d0 < 4; ++d0) dst = __builtin_amdgcn_mfma_f32_32x32x16_bf16(kf_[d0], qf[d0], dst, 0, 0, 0); } while (0)
#define DF_TILE(Stile, sv0, sv1) do { _Pragma("unroll") for (int kb = 0; kb < 2; ++kb) { \
            bf16x8 vf[2][4]; \
            _Pragma("unroll") for (int jj = 0; jj < 2; ++jj) _Pragma("unroll") for (int db = 0; db < 4; ++db) vf[jj][db] = *(const LAS bf16x8*)((Stile) + vofs[2 * kb + jj] + db * 4096); \
            f32x16 s = kb ? sv1 : sv0; \
            if (shift != 0.f) { _Pragma("unroll") for (int i = 0; i < 16; ++i) s[i] -= shift; } \
            float ls = 0.f; \
            _Pragma("unroll") for (int i = 0; i < 16; ++i) { s[i] = __builtin_amdgcn_exp2f(s[i]); ls += s[i]; } \
            l += ls; \
            u32x4 w0, w1; \
            w0.x = CVTPK(s[0], s[1]); w0.y = CVTPK(s[2], s[3]); w0.z = CVTPK(s[4], s[5]); w0.w = CVTPK(s[6], s[7]); \
            w1.x = CVTPK(s[8], s[9]); w1.y = CVTPK(s[10], s[11]); w1.z = CVTPK(s[12], s[13]); w1.w = CVTPK(s[14], s[15]); \
            const bf16x8 p0 = __builtin_bit_cast(bf16x8, w0), p1 = __builtin_bit_cast(bf16x8, w1); \
            _Pragma("unroll") for (int db = 0; db < 4; ++db) o[db] = __builtin_amdgcn_mfma_f32_32x32x16_bf16(vf[0][db], p0, o[db], 0, 0, 0); \
            _Pragma("unroll") for (int db = 0; db < 4; ++db) o[db] = __builtin_amdgcn_mfma_f32_32x32x16_bf16(vf[1][db], p1, o[db], 0, 0, 0); } } while (0)
    constexpr int NTS = NT / 2;
    DF_DMA(0, 0); DF_DMA(1, 1);
    asm volatile("s_waitcnt vmcnt(0)" ::: "memory");
    __builtin_amdgcn_s_barrier();
    asm volatile("" ::: "memory");
    for (int st = 0; st < NTS; ++st) {
        const int sb = (st & 1) * 2;
        if (st + 1 < NTS) { DF_DMA(2 * st + 2, sb ^ 2); DF_DMA(2 * st + 3, (sb ^ 2) + 1); }
        const LAS unsigned char* T0 = lds + sb * 32768;
        const LAS unsigned char* T1 = T0 + 32768;
        f32x16 a0, a1, b0, b1;
        DF_S(a0, T0, 0); DF_S(a1, T0, 1);
        DF_S(b0, T1, 0); DF_S(b1, T1, 1);
        DF_TILE(T0, a0, a1);
        DF_TILE(T1, b0, b1);
        asm volatile("s_waitcnt vmcnt(0) lgkmcnt(0)" ::: "memory");
        __builtin_amdgcn_s_barrier();
        asm volatile("" ::: "memory");
    }
#undef DF_TILE
#undef DF_S
#undef CVTPK
#undef DF_DMA
    LAS float* xch = (LAS float*)lds;
    { float lt = l; lt += __shfl_xor(lt, 32);
      const float sc = (mm == 1 ? lam : 1.0f) / lt;
#pragma unroll
      for (int db = 0; db < 4; ++db)
#pragma unroll
          for (int i = 0; i < 16; ++i) o[db][i] *= sc; }
    if (mm == 1) {
#pragma unroll
        for (int db = 0; db < 4; ++db)
#pragma unroll
            for (int i = 0; i < 16; ++i) xch[(qg * 64 + db * 16 + i) * 64 + lane] = o[db][i];
    }
    __syncthreads();
    if (mm == 0) {
        float ss = 0.f;
#pragma unroll
        for (int db = 0; db < 4; ++db)
#pragma unroll
            for (int i = 0; i < 16; ++i) { const float v = o[db][i] - xch[(qg * 64 + db * 16 + i) * 64 + lane]; o[db][i] = v; ss += v * v; }
        ss += __shfl_xor(ss, 32);
        const float rn = __builtin_amdgcn_rsqf(ss * (1.0f / 128.0f) + EPS) * (1.0f - LAM_INIT);
        bf16* op = DFO + ((size_t)b * SEQ + q0 + q) * 2048 + h * 128 + 4 * hi;
#pragma unroll
        for (int db = 0; db < 4; ++db)
#pragma unroll
            for (int g = 0; g < 4; ++g) { const f32x4 gs = *(const f32x4*)(g_sub + 32 * db + 8 * g + 4 * hi);
                u32x2 wv; wv.x = cvt_pk_bf16(o[db][4 * g] * rn * gs[0], o[db][4 * g + 1] * rn * gs[1]); wv.y = cvt_pk_bf16(o[db][4 * g + 2] * rn * gs[2], o[db][4 * g + 3] * rn * gs[3]);
                *(u32x2*)(op + 32 * db + 8 * g) = wv; }
    }
    __syncthreads();
}

__device__ __forceinline__ void na_unit(LAS unsigned char* lds, const bf16* QKG, const bf16* KC, const bf16* VT, const float* rpb, const float* gq, bf16* NAO, float M2, int b, int h, int r0) {
    int tid_ = threadIdx.x; asm volatile("" : "+v"(tid_));
    const int tid = tid_, lane = tid & 63, w = __builtin_amdgcn_readfirstlane(tid >> 6), q = lane & 31, hi = lane >> 5;
    const int rq = r0 + (w >> 1), half = w & 1, c = 32 * half + q;
    const size_t tokq = (size_t)b * SEQ + rq * GW + c;
    bf16x8 qf[8];
    {
      u32x4 qr[8]; float ss = 0.f;
#pragma unroll
      for (int d0 = 0; d0 < 8; ++d0) { qr[d0] = *(const u32x4*)(QKG + tokq * NQKG + QC_NAQ + h * NA_DH + 16 * d0 + 8 * hi);
          const float v[8] = {bf_lo(qr[d0].x), bf_hi(qr[d0].x), bf_lo(qr[d0].y), bf_hi(qr[d0].y), bf_lo(qr[d0].z), bf_hi(qr[d0].z), bf_lo(qr[d0].w), bf_hi(qr[d0].w)};
#pragma unroll
          for (int j = 0; j < 8; ++j) ss += v[j] * v[j]; }
      ss += __shfl_xor(ss, 32);
      const float rn = __builtin_amdgcn_rsqf(ss * (1.0f / 128.0f) + EPS) * (0.08838834764831845f * LOG2E);
#pragma unroll
      for (int d0 = 0; d0 < 8; ++d0) { const float* g1 = gq + 16 * d0 + 8 * hi;
          const float v[8] = {bf_lo(qr[d0].x), bf_hi(qr[d0].x), bf_lo(qr[d0].y), bf_hi(qr[d0].y), bf_lo(qr[d0].z), bf_hi(qr[d0].z), bf_lo(qr[d0].w), bf_hi(qr[d0].w)};
          u32x4 o; o.x = cvt_pk_bf16(v[0] * rn * g1[0], v[1] * rn * g1[1]); o.y = cvt_pk_bf16(v[2] * rn * g1[2], v[3] * rn * g1[3]);
          o.z = cvt_pk_bf16(v[4] * rn * g1[4], v[5] * rn * g1[5]); o.w = cvt_pk_bf16(v[6] * rn * g1[6], v[7] * rn * g1[7]);
          qf[d0] = __builtin_bit_cast(bf16x8, o); } }
    int rs = rq - 4; rs = rs < 0 ? 0 : (rs > GROWS - 8 ? GROWS - 8 : rs);
    int cs = c - 8; cs = cs < 0 ? 0 : (cs > GW - 16 ? GW - 16 : cs);
    int klo = r0 - 4; klo = klo < 0 ? 0 : (klo > GROWS - 8 ? GROWS - 8 : klo);
    int khi = r0 + 3 - 4; khi = (khi < 0 ? 0 : (khi > GROWS - 8 ? GROWS - 8 : khi)) + 7;
    const int nst = khi - klo + 1;
    const unsigned char* kbase = (const unsigned char*)(KC + ((size_t)(b * 8 + h) * SEQ + klo * GW) * 128);
    const unsigned char* vbase = (const unsigned char*)(VT + ((size_t)(b * 16 + h) * 64 + klo) * 128 * 64);
    unsigned koff[2], voff[2];
#pragma unroll
    for (int i = 0; i < 2; ++i) {
        const int piece = w * 2 + i;
        { const int row = piece * 4 + (lane >> 4), ph = lane & 15, ch = ph ^ (row & 15); koff[i] = (unsigned)(row * 128 + ch * 8) * 2u; }
        { const int row = piece * 8 + (lane >> 3), ph = lane & 7, ch = ph ^ ((row >> 1) & 7); voff[i] = (unsigned)(row * 64 + ch * 8) * 2u; }
    }
#define NA_DMA(t, stg) do { const unsigned char* kb_ = kbase + (size_t)(t) * 16384; const unsigned char* vb_ = vbase + (size_t)(t) * 16384; _Pragma("unroll") for (int _i = 0; _i < 2; ++_i) { \
        __builtin_amdgcn_global_load_lds((const unsigned*)(kb_ + koff[_i]), (LAS unsigned*)(lds + (stg) * 32768 + (w * 2 + _i) * 1024), 16, 0, 0); \
        __builtin_amdgcn_global_load_lds((const unsigned*)(vb_ + voff[_i]), (LAS unsigned*)(lds + (stg) * 32768 + 16384 + (w * 2 + _i) * 1024), 16, 0, 0); } } while (0)
    int kofs[8], vofs[4];
#pragma unroll
    for (int d0 = 0; d0 < 8; ++d0) kofs[d0] = q * 256 + (((2 * d0 + hi) ^ (q & 15)) * 16);
#pragma unroll
    for (int g = 0; g < 4; ++g) vofs[g] = 16384 + q * 128 + (((2 * g + hi) ^ ((q >> 1) & 7)) * 16);
    f32x16 o[4];
#pragma unroll
    for (int i = 0; i < 4; ++i) o[i] = (f32x16){};
    float l = 0.f;
    LAS float* btab = (LAS float*)(lds + 131072 + 1024);
    for (int i = tid; i < 15 * 31; i += NTHREADS) btab[i] = rpb[h * 15 * 31 + i] * LOG2E - M2;
    asm volatile("s_waitcnt vmcnt(0) lgkmcnt(0)" ::: "memory");
    __builtin_amdgcn_s_barrier();
    asm volatile("" ::: "memory");
    NA_DMA(0, 0); NA_DMA(1, 1);
    asm volatile("s_waitcnt vmcnt(4)" ::: "memory");
    __builtin_amdgcn_s_barrier();
    asm volatile("" ::: "memory");
    for (int t = 0; t < nst; ++t) {
        if (t + 2 < nst) NA_DMA(t + 2, (t + 2) & 3);
        const int krow = klo + t;
        if (krow >= rs && krow < rs + 8) {
            const LAS unsigned char* St = lds + (t & 3) * 32768;
            const LAS float* brow = btab + (krow - rq + 7) * 31;
#pragma unroll
            for (int kb = 0; kb < 2; ++kb) {
                f32x16 s = (f32x16){};
#pragma unroll
                for (int d0 = 0; d0 < 8; ++d0) { const bf16x8 kf = *(const LAS bf16x8*)(St + kofs[d0] + kb * 8192); s = __builtin_amdgcn_mfma_f32_32x32x16_bf16(kf, qf[d0], s, 0, 0, 0); }
                bf16x8 vf[2][4];
#pragma unroll
                for (int jj = 0; jj < 2; ++jj)
#pragma unroll
                    for (int db = 0; db < 4; ++db) vf[jj][db] = *(const LAS bf16x8*)(St + (kb ? vofs[2 + jj] : vofs[jj]) + db * 4096);
                float pv[16];
                const LAS float* bp = brow + (4 * hi - c + 15 + 32 * kb);
                const int wa = 4 * hi - cs + 32 * kb;
#pragma unroll
                for (int i = 0; i < 16; ++i) { const int e0 = (i & 3) + 8 * (i >> 2); const float bias = bp[e0]; const float e = __builtin_amdgcn_exp2f(s[i] + bias);
                    pv[i] = ((unsigned)(wa + e0) < 16u) ? e : 0.f; l += pv[i]; }
                u32x4 w0, w1;
                w0.x = cvt_pk_bf16(pv[0], pv[1]); w0.y = cvt_pk_bf16(pv[2], pv[3]); w0.z = cvt_pk_bf16(pv[4], pv[5]); w0.w = cvt_pk_bf16(pv[6], pv[7]);
                w1.x = cvt_pk_bf16(pv[8], pv[9]); w1.y = cvt_pk_bf16(pv[10], pv[11]); w1.z = cvt_pk_bf16(pv[12], pv[13]); w1.w = cvt_pk_bf16(pv[14], pv[15]);
                const bf16x8 p0 = __builtin_bit_cast(bf16x8, w0), p1 = __builtin_bit_cast(bf16x8, w1);
#pragma unroll
                for (int db = 0; db < 4; ++db) o[db] = __builtin_amdgcn_mfma_f32_32x32x16_bf16(vf[0][db], p0, o[db], 0, 0, 0);
#pragma unroll
                for (int db = 0; db < 4; ++db) o[db] = __builtin_amdgcn_mfma_f32_32x32x16_bf16(vf[1][db], p1, o[db], 0, 0, 0);
            }
        }
        if (t + 2 < nst) asm volatile("s_waitcnt vmcnt(4) lgkmcnt(0)" ::: "memory"); else asm volatile("s_waitcnt vmcnt(0) lgkmcnt(0)" ::: "memory");
        __builtin_amdgcn_s_barrier();
        asm volatile("" ::: "memory");
    }
#undef NA_DMA
    l += __shfl_xor(l, 32);
    const float rl = 1.0f / l;
    bf16* op = NAO + tokq * 2048 + h * NA_DH + 4 * hi;
#pragma unroll
    for (int db = 0; db < 4; ++db)
#pragma unroll
        for (int g = 0; g < 4; ++g) { u32x2 wv; wv.x = cvt_pk_bf16(o[db][4 * g] * rl, o[db][4 * g + 1] * rl); wv.y = cvt_pk_bf16(o[db][4 * g + 2] * rl, o[db][4 * g + 3] * rl);
            *(u32x2*)(op + 32 * db + 8 * g) = wv; }
}
template <int TB>
__device__ __forceinline__ void qknorm_batch(bf16* QKG, bf16* KCna, bf16* KCdf, int m0, int mstride, const float* gnk, const float* gdk, const f32x2* rope, int lane) {
    u32x4 na[TB][2], da[TB], db[TB];
#pragma unroll
    for (int t = 0; t < TB; ++t) { int mt = m0 + t * mstride; if (mt >= M) mt = M - 1; const bf16* row = QKG + (size_t)mt * NQKG;
#pragma unroll
        for (int j = 0; j < 2; ++j) na[t][j] = *(const u32x4*)(row + QC_NAK + 512 * j + 8 * lane);
        const bf16* p1 = row + QC_DFK + 64 * (lane >> 2) + 8 * (lane & 3); da[t] = *(const u32x4*)p1; db[t] = *(const u32x4*)(p1 + 32); }
#pragma unroll
    for (int t = 0; t < TB; ++t) { const int mt = m0 + t * mstride; if (mt >= M) break; const int pos = mt & (SEQ - 1);
#pragma unroll
        for (int j = 0; j < 2; ++j) {
            const u32x4 w = na[t][j];
            float v[8] = {bf_lo(w.x), bf_hi(w.x), bf_lo(w.y), bf_hi(w.y), bf_lo(w.z), bf_hi(w.z), bf_lo(w.w), bf_hi(w.w)};
            float ss = 0.f;
#pragma unroll
            for (int i = 0; i < 8; ++i) ss += v[i] * v[i];
            ss += __shfl_xor(ss, 1); ss += __shfl_xor(ss, 2); ss += __shfl_xor(ss, 4); ss += __shfl_xor(ss, 8);
            const float rs = __builtin_amdgcn_rsqf(ss * (1.0f / 128.0f) + EPS);
            const float* g = gnk + 8 * (lane & 15);
#pragma unroll
            for (int i = 0; i < 8; ++i) v[i] = v[i] * rs * g[i];
            u32x4 o; o.x = cvt_pk_bf16(v[0], v[1]); o.y = cvt_pk_bf16(v[2], v[3]); o.z = cvt_pk_bf16(v[4], v[5]); o.w = cvt_pk_bf16(v[6], v[7]);
            const int x = 512 * j + 8 * lane;
            *(u32x4*)(KCna + ((size_t)((mt >> 12) * 8 + (x >> 7)) * SEQ + pos) * 128 + (x & 127)) = o;
        }
        {
            const u32x4 wa = da[t], wb = db[t];
            float a[8] = {bf_lo(wa.x), bf_hi(wa.x), bf_lo(wa.y), bf_hi(wa.y), bf_lo(wa.z), bf_hi(wa.z), bf_lo(wa.w), bf_hi(wa.w)};
            float c[8] = {bf_lo(wb.x), bf_hi(wb.x), bf_lo(wb.y), bf_hi(wb.y), bf_lo(wb.z), bf_hi(wb.z), bf_lo(wb.w), bf_hi(wb.w)};
            float ss = 0.f;
#pragma unroll
            for (int i = 0; i < 8; ++i) ss += a[i] * a[i] + c[i] * c[i];
            ss += __shfl_xor(ss, 1); ss += __shfl_xor(ss, 2);
            const float rs = __builtin_amdgcn_rsqf(ss * (1.0f / 64.0f) + EPS);
            const float* g = gdk + 8 * (lane & 3);
            const f32x2* rp = rope + pos * 32 + 8 * (lane & 3);
            float o1[8], o2[8];
#pragma unroll
            for (int i = 0; i < 8; ++i) { const float x1 = a[i] * rs * g[i], x2 = c[i] * rs * g[32 + i]; const f32x2 cs = rp[i]; o1[i] = x1 * cs.x - x2 * cs.y; o2[i] = x1 * cs.y + x2 * cs.x; }
            u32x4 oa, ob; oa.x = cvt_pk_bf16(o1[0], o1[1]); oa.y = cvt_pk_bf16(o1[2], o1[3]); oa.z = cvt_pk_bf16(o1[4], o1[5]); oa.w = cvt_pk_bf16(o1[6], o1[7]);
            ob.x = cvt_pk_bf16(o2[0], o2[1]); ob.y = cvt_pk_bf16(o2[2], o2[3]); ob.z = cvt_pk_bf16(o2[4], o2[5]); ob.w = cvt_pk_bf16(o2[6], o2[7]);
            const int x = 64 * (lane >> 2) + 8 * (lane & 3); bf16* kp = KCdf + ((size_t)((mt >> 12) * 8 + (x >> 7)) * SEQ + pos) * 128 + (x & 127);
            *(u32x4*)kp = oa; *(u32x4*)(kp + 32) = ob;
        }
    }
}

__device__ __forceinline__ void grid_barrier(unsigned* cnt, unsigned target) {
    asm volatile("s_waitcnt vmcnt(0) lgkmcnt(0)" ::: "memory");
    __syncthreads();
    if (threadIdx.x == 0) {
        __builtin_amdgcn_fence(__ATOMIC_RELEASE, "agent");
        asm volatile("s_waitcnt vmcnt(0)" ::: "memory");
        __hip_atomic_fetch_add(cnt, 1u, __ATOMIC_RELAXED, __HIP_MEMORY_SCOPE_AGENT);
        while (__hip_atomic_load(cnt, __ATOMIC_RELAXED, __HIP_MEMORY_SCOPE_AGENT) < target) __builtin_amdgcn_s_sleep(2);
        __builtin_amdgcn_fence(__ATOMIC_ACQUIRE, "agent");
        asm volatile("s_waitcnt vmcnt(0)" ::: "memory");
    }
    __syncthreads();
}
constexpr int I_IN = 32 * 320, I_NA = 16 * 64, I_O = 32 * 64, I_G = 32 * 176, I_DN = 88 * 64, I_PP = 4 * 64;
constexpr int N_EARLY = I_IN + 2 * I_NA + I_O + 2 * I_G + I_PP, NITEMS = N_EARLY + I_DN + I_O;
#define P0_DECODE(it_, d_) do { int r = (it_); \
            if (r < I_IN) { d_ = P0Item{ap->w_in, W1t, nullptr, D, 10240, 1, r, D, 0}; break; } r -= I_IN; \
            if (r < I_NA) { d_ = P0Item{ap->w_na_out, Wna, nullptr, 1024, D, 0, r, 2048, 0}; break; } r -= I_NA; \
            if (r < I_NA) { d_ = P0Item{ap->w_df_out, Wna, nullptr, 1024, D, 0, r, 2048, 1024}; break; } r -= I_NA; \
            if (r < I_O) { d_ = P0Item{ap->w_o, Wo, nullptr, D, D, 0, r, D, 0}; break; } r -= I_O; \
            if (r < I_G) { d_ = P0Item{ap->w_gate, Wgu, ap->g_ffn, D, FF, 2, r, D, 0}; break; } r -= I_G; \
            if (r < I_G) { d_ = P0Item{ap->w_up, Wgu, ap->g_ffn, D, FF, 3, r, D, 0}; break; } r -= I_G; \
            if (r < I_PP) { d_ = P0Item{ap->w_ple_proj, Wpp, nullptr, PLE, D, 0, r, PLE, 0}; break; } r -= I_PP; \
            if (r < I_DN) { d_ = P0Item{ap->w_down, Wdn, nullptr, FF, D, 0, r, FF, 0}; break; } r -= I_DN; \
            d_ = P0Item{ap->w_ple_gate, Wpg, ap->g_ple, D, D, 0, r, D, 0}; } while (0)
constexpr int NPHASE = 9;
__global__ void __launch_bounds__(NTHREADS, 2) fwd_megakernel(Args a) {
    extern __shared__ __attribute__((aligned(16))) unsigned char lds_raw[];
    LAS unsigned char* lds = (LAS unsigned char*)lds_raw;
    cg::grid_group grid = cg::this_grid();
    const int G = gridDim.x, bx = blockIdx.x;
    const int vcu = (G % 8 == 0) ? (bx % 8) * (G / 8) + bx / 8 : bx;
    const int NGW = G * NWAVES;
typedef __attribute__((opencl_constant)) const Args* CArgsP;
#define FRESH_ARGS() auto kp_ = __builtin_amdgcn_kernarg_segment_ptr(); asm volatile("" : "+s"(kp_)); const CArgsP ap = (CArgsP)kp_
#define FRESH_TID() int tid_ = threadIdx.x; asm volatile("" : "+v"(tid_)); const int tid = tid_, lane = tid & 63, wave = __builtin_amdgcn_readfirstlane(tid >> 6), gw = vcu * NWAVES + wave; (void)lane; (void)gw
    unsigned char* ws = a.ws;
    float* RS1 = (float*)(ws + WS_RS1); float* RS2 = (float*)(ws + WS_RS2); f32x2* ROPE = (f32x2*)(ws + WS_ROPE);
    bf16 *W1t = (bf16*)(ws + WS_W1), *Wna = (bf16*)(ws + WS_WNA), *Wdf = (bf16*)(ws + WS_WDF), *Wo = (bf16*)(ws + WS_WO), *Wgu = (bf16*)(ws + WS_WGU), *Wdn = (bf16*)(ws + WS_WDN), *Wpg = (bf16*)(ws + WS_WPG), *Wpp = (bf16*)(ws + WS_WPP);
    bf16 *QKG = (bf16*)(ws + WS_A), *HB = (bf16*)(ws + WS_A);
    bf16 *XN = (bf16*)(ws + WS_B), *AO = (bf16*)(ws + WS_B), *X1B = (bf16*)(ws + WS_B), *X2B = (bf16*)(ws + WS_B);
    bf16 *VT = (bf16*)(ws + WS_C), *MRG = (bf16*)(ws + WS_C), *T2B = (bf16*)(ws + WS_C), *PB = (bf16*)(ws + WS_PB);
    bf16* KCna = (bf16*)a.out; bf16* KCdf = KCna + (size_t)M * 1024;
    const int lo = a.ph_lo, hi_ph = a.ph_hi;
    if (lo < 0) grid.sync();
    { volatile LAS unsigned* st0 = (volatile LAS unsigned*)(lds + 131072 + 768); if (threadIdx.x < 2) st0[threadIdx.x] = 0u; __syncthreads(); }
    XcdBarrier xbar = xcd_barrier_post((unsigned*)(ws + 8192), (volatile LAS unsigned*)(lds + 131072 + 768));
#ifndef PHASE_MASK
#define PHASE_MASK 0x1ff
#endif
#define IN(k) (((PHASE_MASK >> (k)) & 1) && lo <= (k) && (k) < hi_ph)
#ifdef PROBE_TS
#define STAMP(k) do { if (bx == 0 && threadIdx.x == 0) ((volatile unsigned long long*)(ws + 2048))[k] = __builtin_amdgcn_s_memrealtime(); } while (0)
#else
#define STAMP(k) do {} while (0)
#endif
#define GBAR(idx) xcd_barrier(xbar)
#define SEAM(k) do { if (IN(k) && IN((k) + 1)) GBAR(k); STAMP((k) + 1); } while (0)
#ifndef PROBE_DUP
#define PROBE_DUP 0
#endif
#define NREP(k) (((PROBE_DUP >> (k)) & 1) ? 2 : 1)

    STAMP(0);
    for (int rep_ = 0; rep_ < NREP(0); ++rep_) {
    if (IN(0)) {
        FRESH_ARGS();
        FRESH_TID();
        if (bx == 0) {
        LAS float* red = (LAS float*)(lds + 131072);
        float mq = 0.f, mk = 0.f, mdq = 0.f, mdk = 0.f, mb = 0.f;
        if (tid < 128) { mq = fabsf(ap->g_na_q[tid]); mk = fabsf(ap->g_na_k[tid]); }
        if (tid < 64) { mdq = fabsf(ap->g_df_q[tid]); mdk = fabsf(ap->g_df_k[tid]); }
        for (int i = tid; i < NA_H * 15 * 31; i += NTHREADS) mb = fmaxf(mb, ap->na_rpb[i]);
        mq = wave_max(mq); mk = wave_max(mk); mdq = wave_max(mdq); mdk = wave_max(mdk); mb = wave_max(mb);
        float d1 = 0.f, d2 = 0.f;
        if (wave == 0) { d1 = wave_sum(ap->lam_q1[lane] * ap->lam_k1[lane]); d2 = wave_sum(ap->lam_q2[lane] * ap->lam_k2[lane]); }
        if (lane == 0) { red[wave * 8 + 0] = mq; red[wave * 8 + 1] = mk; red[wave * 8 + 2] = mdq; red[wave * 8 + 3] = mdk; red[wave * 8 + 4] = mb; red[wave * 8 + 5] = d1; red[wave * 8 + 6] = d2; }
        __syncthreads();
        mq = 0.f; mk = 0.f; mdq = 0.f; mdk = 0.f; mb = 0.f;
#pragma unroll
        for (int w = 0; w < 8; ++w) { mq = fmaxf(mq, red[w * 8]); mk = fmaxf(mk, red[w * 8 + 1]); mdq = fmaxf(mdq, red[w * 8 + 2]); mdk = fmaxf(mdk, red[w * 8 + 3]); mb = fmaxf(mb, red[w * 8 + 4]); }
        if (tid == 0) { float* PARw = (float*)(ws + 3072); PARw[0] = expf(red[5]) - expf(red[6]) + LAM_INIT; PARw[1] = (11.313708498984761f * mq * mk + mb) * LOG2E + 0.125f; PARw[2] = (8.0f * mdq * mdk) * LOG2E + 0.125f; }
        __syncthreads();
        }
        LAS float* scr = (LAS float*)(lds + wave * 16384);
        {
            float cur[32], nxt[32]; P0Item dc, dn;
            int it = gw;
            if (it < N_EARLY) { P0_DECODE(it, dc); p0_item_load(dc, cur, lane); }
            for (; it < N_EARLY; it += NGW) {
                const int nit = it + NGW; const bool more = nit < N_EARLY;
                if (more) { P0_DECODE(nit, dn); p0_item_load(dn, nxt, lane); }
                p0_item_store(dc, cur, scr, lane);
                if (more) { dc = dn;
#pragma unroll
                    for (int i = 0; i < 32; ++i) cur[i] = nxt[i]; }
            }
        }
        for (int m = gw; m < M; m += NGW) {
            const f32x4* xr = (const f32x4*)(ap->x + (size_t)m * D) + lane; const f32x4* gr = (const f32x4*)ap->g_mix + lane;
            f32x4 v[8]; float s = 0.f;
#pragma unroll
            for (int j = 0; j < 8; ++j) { v[j] = __builtin_nontemporal_load(xr + 64 * j); s += (v[j].x * v[j].x + v[j].y * v[j].y) + (v[j].z * v[j].z + v[j].w * v[j].w); }
            const float rs = __builtin_amdgcn_rsqf(wave_sum(s) * (1.0f / D) + EPS);
            u32x2* o8 = (u32x2*)(XN + (size_t)m * D) + lane;
#pragma unroll
            for (int j = 0; j < 8; ++j) { const f32x4 g = gr[64 * j]; u32x2 w; w.x = cvt_pk_bf16(v[j].x * rs * g.x, v[j].y * rs * g.y); w.y = cvt_pk_bf16(v[j].z * rs * g.z, v[j].w * rs * g.w); o8[64 * j] = w; }
        }
        const int gt = vcu * NTHREADS + tid, NGT = G * NTHREADS;
        for (int i = gt; i < M * PLE / 8; i += NGT) { const f32x4 p0 = __builtin_nontemporal_load((const f32x4*)ap->p + 2 * i), p1 = __builtin_nontemporal_load((const f32x4*)ap->p + 2 * i + 1);
            u32x4 w; w.x = cvt_pk_bf16(p0.x, p0.y); w.y = cvt_pk_bf16(p0.z, p0.w); w.z = cvt_pk_bf16(p1.x, p1.y); w.w = cvt_pk_bf16(p1.z, p1.w); ((u32x4*)PB)[i] = w; }
        for (int i = gt; i < SEQ * 32; i += NGT) { const int pos = i >> 5, k = i & 31;
            const float inv = (float)(1.0 / pow(10000.0, (double)k / 32.0)); const float ang = (float)pos * inv;
            f32x2 cs; cs.x = (float)cos((double)ang); cs.y = (float)sin((double)ang); ROPE[i] = cs; }
        for (int i = gt; i < M; i += NGT) { RS1[i] = 0.f; RS2[i] = 0.f; }
    }
    }
    SEAM(0);
    for (int rep_ = 0; rep_ < NREP(1); ++rep_) {
    if (IN(1)) {
        FRESH_ARGS();
        { pg8::Gemm g{XN, W1t, M, NQKG, D}; pg8::StaticOrder S; S.init(M, NQKG, G, bx); pg8::EpiQKG E{QKG, NQKG};
          pg8::gemm_phase<pg8::EpiQKG, pg8::StaticOrder, true, true>(lds, g, S, E); }
        { pg8::Gemm g{W1t + (size_t)NQKG * D, XN, 2048, M, D}; pg8::StaticOrder S; S.init(2048, M, G, bx); pg8::EpiVT E{VT, M};
          pg8::gemm_phase<pg8::EpiVT, pg8::StaticOrder, true, true>(lds, g, S, E); }
    }
    }
    SEAM(1);
    if (IN(2)) {
        FRESH_ARGS();
        FRESH_TID();
        for (int m0 = gw; m0 < M; m0 += 4 * NGW) qknorm_batch<4>(QKG, KCna, KCdf, m0, NGW, ap->g_na_k, ap->g_df_k, ROPE, lane);
    }
    SEAM(2);
    for (int rep_ = 0; rep_ < NREP(3); ++rep_) {
    if (IN(3)) {
        FRESH_ARGS();
        FRESH_TID();
        const float* PAR = (const float*)(ws + 3072);
        const float lam = PAR[0], M2na = PAR[1], M2df = PAR[2];
#ifndef NO_DF
        for (int uu = 2 * vcu; uu < BATCH * DF_H * (SEQ / 128); uu += 2 * G)
            for (int i2 = 0; i2 < 2; ++i2) { const int uidx = uu + i2, bh = uidx >> 5, qb = uidx & 31;
#ifdef PROBE_DFWAIT
                unsigned long long dfw_ = 0;
                df_unit(lds, QKG, KCdf, VT, AO + 1024, ap->g_df_sub, ap->g_df_q, ROPE, lam, M2df, bh >> 3, bh & 7, qb, &dfw_);
                if (bx == 0 && threadIdx.x == 0) { volatile unsigned long long* TS = (volatile unsigned long long*)(ws + 2048); TS[11] = (i2 ? TS[11] : 0ull) + dfw_; TS[12] = 0ull; }
#else
                df_unit(lds, QKG, KCdf, VT, AO + 1024, ap->g_df_sub, ap->g_df_q, ROPE, lam, M2df, bh >> 3, bh & 7, qb);
#endif
            }
#endif
        STAMP(10);
#ifdef PROBE_TS
        if (threadIdx.x == 0) { atomicMax((unsigned long long*)(ws + 2048) + 14, (unsigned long long)__builtin_amdgcn_s_memrealtime()); atomicMin((unsigned long long*)(ws + 2048) + 16, (unsigned long long)__builtin_amdgcn_s_memrealtime()); }
#endif
#ifndef NO_NA
        for (int uidx = vcu; uidx < BATCH * NA_H * (GROWS / 4); uidx += G) {
            const int bh = uidx >> 4, rg = uidx & 15;
            na_unit(lds, QKG, KCna, VT, ap->na_rpb, ap->g_na_q, AO, M2na, bh >> 3, bh & 7, rg * 4);
        }
        STAMP(13);
#ifdef PROBE_TS
        if (threadIdx.x == 0) atomicMax((unsigned long long*)(ws + 2048) + 15, (unsigned long long)__builtin_amdgcn_s_memrealtime());
#endif
#endif
    }
    }
    SEAM(3);
    for (int rep_ = 0; rep_ < NREP(4); ++rep_) {
    if (IN(4)) {
        FRESH_ARGS();
        { pg8::Gemm g{AO, Wna, M, D, 2048, 16}; pg8::PairOrder S; S.S.init(M, D, G, bx); S.kob = 1024 * 2; pg8::EpiMerge E{QKG + QC_GA, QKG + QC_GB, NQKG, MRG, D, 16};
          pg8::gemm_phase<pg8::EpiMerge, pg8::PairOrder, true, true>(lds, g, S, E); }
    }
    }
    SEAM(4);
    if (IN(5)) {
        FRESH_ARGS();
        pg8::Gemm g{MRG, Wo, M, D, D}; pg8::StaticOrder S; S.init(M, D, G, bx); pg8::EpiResid<false> E{ap->x, X1B, RS1, D};
        pg8::gemm_phase<pg8::EpiResid<false>, pg8::StaticOrder, true, true>(lds, g, S, E);
    }
    SEAM(5);
    for (int rep_ = 0; rep_ < NREP(6); ++rep_) {
    if (IN(6)) {
        FRESH_ARGS();
        pg8::Gemm g{X1B, Wgu, M, 2 * FF, D}; pg8::StaticOrder S; S.init(M, 2 * FF, G, bx); pg8::EpiSwiGLU E{RS1, HB, FF, 1.0f / D, EPS};
        pg8::gemm_phase<pg8::EpiSwiGLU, pg8::StaticOrder, true, true>(lds, g, S, E);
        { constexpr int NU6 = (M / 256) * (2 * FF / 256), NU8 = (M / 256) * (D / 256);
          const int rem = NU6 % G, nshort = rem ? G - rem : G;
          pg8::TailOrder T; T.first = (rem == 0) ? bx : (bx >= rem ? bx - rem : -1); T.stride = nshort; T.total = NU8;
          int kple = PLE; asm volatile("" : "+s"(kple));
          pg8::Gemm g2{PB, Wpp, M, D, kple}; pg8::EpiStoreBf16 E2{T2B, D};
          pg8::gemm_phase<pg8::EpiStoreBf16, pg8::TailOrder, true, true>(lds, g2, T, E2);
          if (T.first >= 0) { FRESH_TID();
              LAS float* scr = (LAS float*)(lds + wave * 16384);
              const int sw = ((rem == 0) ? bx : bx - rem) * NWAVES + wave, nsw = nshort * NWAVES;
              float cur[32], nxt[32]; P0Item dc, dn;
              int it = N_EARLY + sw;
              if (it < NITEMS) { P0_DECODE(it, dc); p0_item_load(dc, cur, lane); }
              for (; it < NITEMS; it += nsw) {
                  const int nit = it + nsw; const bool more = nit < NITEMS;
                  if (more) { P0_DECODE(nit, dn); p0_item_load(dn, nxt, lane); }
                  p0_item_store(dc, cur, scr, lane);
                  if (more) { dc = dn;
#pragma unroll
                      for (int i = 0; i < 32; ++i) cur[i] = nxt[i]; }
              } } }
    }
    }
    SEAM(6);
    if (IN(7)) {
        FRESH_ARGS();
        pg8::Gemm g{HB, Wdn, M, D, FF}; pg8::StaticOrder S; S.init(M, D, G, bx); pg8::EpiResid<true> E{X1B, X2B, RS2, D};
        pg8::gemm_phase<pg8::EpiResid<true>, pg8::StaticOrder, true, true>(lds, g, S, E);
    }
    SEAM(7);
    if (IN(8)) {
        FRESH_ARGS();
#ifndef NO_P8B
        { pg8::Gemm g{X2B, Wpg, M, D, D}; pg8::StaticOrder S; S.init(M, D, G, bx); pg8::EpiPle E{RS2, T2B, X2B, ap->out, D, 1.0f / D, EPS};
          pg8::gemm_phase<pg8::EpiPle, pg8::StaticOrder, true, true>(lds, g, S, E); }
#endif
    }
#ifdef PROBE_TS
    STAMP(9);
    GBAR(8);
    { const unsigned long long* TS = (const unsigned long long*)(ws + 2048);
      const unsigned long long ta = __hip_atomic_load(TS + PROBE_A, __ATOMIC_RELAXED, __HIP_MEMORY_SCOPE_AGENT), tb = __hip_atomic_load(TS + PROBE_B, __ATOMIC_RELAXED, __HIP_MEMORY_SCOPE_AGENT);
      const int K = PROBE_CONST ? PROBE_CONST : (int)((tb - ta) / 8);
      FRESH_ARGS();
      for (int i = vcu * NTHREADS + (int)threadIdx.x; i < K && i < 42000; i += G * NTHREADS) ap->out[(size_t)i * 397] += 0.125f; }
#endif
#undef IN
#undef SEAM
}

#ifndef MK_SPLIT
#define MK_SPLIT 0
#endif
extern "C" void kernel_launch(void* const* d_in, const int* in_sizes, int n_in, void* d_out, int out_size, void* d_ws, size_t ws_size, hipStream_t stream) {
    static int grid = 0;
    if (grid == 0) {
        if (n_in != 24 || in_sizes[0] != M * D || out_size != M * D || ws_size < WS_END) { fprintf(stderr, "kernel_launch: unexpected shapes (n_in %d, in0 %d, out %d, ws %zu); nothing launched\n", n_in, n_in > 0 ? in_sizes[0] : -1, out_size, ws_size); grid = -1; return; }
        int dev = 0, cus = 0, per_cu = 0;
        hipGetDevice(&dev); hipDeviceGetAttribute(&cus, hipDeviceAttributeMultiprocessorCount, dev);
        hipFuncSetAttribute((const void*)fwd_megakernel, hipFuncAttributeMaxDynamicSharedMemorySize, LDS_BYTES);
        hipOccupancyMaxActiveBlocksPerMultiprocessor(&per_cu, (const void*)fwd_megakernel, NTHREADS, LDS_BYTES);
        if (per_cu < 1) per_cu = 1;
        grid = cus * per_cu;
        (void)hipGetLastError();
    }
    if (grid < 0) return;
    Args a{};
    const float** ap = (const float**)&a;
    for (int i = 0; i < 24; ++i) ap[i] = (const float*)d_in[i];
    a.out = (float*)d_out; a.ws = (unsigned char*)d_ws; a.rep3 = NREP(3); a.pad = 0;
#if MK_SPLIT
    for (int ph = 0; ph < NPHASE; ++ph) { a.ph_lo = ph; a.ph_hi = ph + 1; hipLaunchKernelGGL(fwd_megakernel, dim3(grid), dim3(NTHREADS), LDS_BYTES, stream, a); }
#else
    a.ph_lo = 0; a.ph_hi = NPHASE;
    (void)hipMemsetAsync((unsigned char*)d_ws + 4096, 0, 20480, stream);
#ifdef PROBE_TS
    (void)hipMemsetAsync((unsigned char*)d_ws + 2048 + 14 * 8, 0, 16, stream); (void)hipMemsetAsync((unsigned char*)d_ws + 2048 + 16 * 8, 0x7f, 8, stream);
#endif
    void* args[] = {&a};
    hipError_t e = hipLaunchCooperativeKernel((const void*)fwd_megakernel, dim3(grid), dim3(NTHREADS), args, LDS_BYTES, stream);
    if (e != hipSuccess) fprintf(stderr, "cooperative launch failed: %s (grid %d)\n", hipGetErrorString(e), grid);
#endif
}
```

```cpp
#include <hip/hip_runtime.h>
#include <hip/hip_cooperative_groups.h>
#include <cstdio>
#include <cstdint>
namespace cg = cooperative_groups;
namespace pg8 {
#define PG8_LAS __attribute__((address_space(3)))
typedef unsigned short bf16_t;
typedef short bf16x8 __attribute__((ext_vector_type(8)));
typedef float f32x4 __attribute__((ext_vector_type(4)));
typedef unsigned u32x4 __attribute__((ext_vector_type(4)));
constexpr int BM = 256, BK = 64, HALF = 128, HTB = HALF * BK * 2  , STAGE_BYTES = 8 * HTB, NXCD = 8, WGM = 8;

__host__ __device__ __forceinline__ int lds_byte(int r, int c) { const int st = (r >> 4) * 2 + (c >> 5), rr = r & 15, cc = c & 31, ob = rr * 64 + cc * 2; return st * 1024 + (ob ^ (((ob >> 9) & 1) << 5)); }
__host__ __device__ __forceinline__ void stage_rc(int b, int& R, int& C) { const int st = b / 1024, sb = b % 1024, swz = sb ^ (((sb >> 9) & 1) << 5); R = (st >> 1) * 16 + swz / 64; C = (st & 1) * 32 + (swz % 64) / 2; }
__host__ __device__ __forceinline__ int perm32(int rho) { const int n = rho >> 4, i = rho & 15; return 8 * (i >> 2) + 4 * n + (i & 3); }

struct Unit { int pm, pn; int ko = 0; };
struct Gemm { const bf16_t* A; const bf16_t* Bt; int M, N, K; int nt = 0; };

struct StaticOrder {
    int nM, nN, nwg, G, c;
    __host__ __device__ void init(int M, int N, int G_, int c_) { nM = M / BM; nN = N / BM; nwg = nM * nN; G = G_; c = c_; }
    __host__ __device__ bool next(int i, Unit& u) const {
        const long L = (long)i * G + c; if (L >= nwg) return false;
        int wgid = (int)L; { const int q = nwg / NXCD, r = nwg % NXCD, xcd = wgid % NXCD, off = wgid / NXCD; wgid = (xcd < r ? xcd * (q + 1) : r * (q + 1) + (xcd - r) * q) + off; }
        const int nig = WGM * nN, gid = wgid / nig, fm = gid * WGM, gsz = (nM - fm) < WGM ? (nM - fm) : WGM;
        u.pm = fm + ((wgid % nig) % gsz); u.pn = (wgid % nig) / gsz; return true;
    }
    __device__ __forceinline__ void a_ready(const Unit&) const {}
    __device__ __forceinline__ void done(const Unit&) const {}
};


struct TailOrder {
    int first, stride, total;
    __host__ __device__ bool next(int i, Unit& u) const { if (first < 0) return false; const int j = first + i * stride; if (j >= total) return false; u.pm = j >> 3; u.pn = j & 7; return true; }
    __device__ __forceinline__ void a_ready(const Unit&) const {}
    __device__ __forceinline__ void done(const Unit&) const {}
};

struct PairOrder {
    StaticOrder S; int kob;
    __host__ __device__ bool next(int i, Unit& u) const { if (!S.next(i >> 1, u)) return false; u.ko = (i & 1) * kob; return true; }
    __device__ __forceinline__ void a_ready(const Unit&) const {}
    __device__ __forceinline__ void done(const Unit&) const {}
};
typedef float cvt_f32x2_t __attribute__((ext_vector_type(2))); typedef __bf16 cvt_bf16x2_t __attribute__((ext_vector_type(2)));
__device__ __forceinline__ unsigned cvt_pk_bf16(float lo, float hi) { return __builtin_bit_cast(unsigned, __builtin_convertvector((cvt_f32x2_t){lo, hi}, cvt_bf16x2_t)); }
__device__ __forceinline__ float bf_lo(unsigned w) { return __uint_as_float(w << 16); }
__device__ __forceinline__ float bf_hi(unsigned w) { return __uint_as_float(w & 0xffff0000u); }
__device__ __forceinline__ float sigmoidf_(float x) { return __builtin_amdgcn_rcpf(1.0f + __expf(-x)); }
typedef unsigned u32x2 __attribute__((ext_vector_type(2)));
#define EPI_FENCE() do { if (m & 1) asm volatile("" ::: "memory"); } while (0)
#define EPI_ROWS(...) _Pragma("unroll") for (int ai = 0; ai < 2; ++ai) _Pragma("unroll") for (int m = 0; m < 4; ++m) { const int row = u.pm * BM + ai * HALF + wr * 64 + m * 16 + fr; __VA_ARGS__ }

struct EpiQKG {
    static constexpr bool PERM = true, AFTER_DRAIN = false, MIDK = false;
    bf16_t* O; int ldc;
    __device__ __forceinline__ void operator()(const f32x4 (&acc)[2][2][4][2], const Unit& u, int wr, int wc, int fr, int fq) const {
        const bool gate = u.pn >= 16; const int col0 = u.pn * BM + wc * 32 + 8 * fq;
        EPI_ROWS(
            bf16_t* rowp = O + (size_t)row * ldc + col0;
            _Pragma("unroll") for (int bj = 0; bj < 2; ++bj) { f32x4 v0 = acc[ai][bj][m][0], v1 = acc[ai][bj][m][1];
                if (gate) { _Pragma("unroll") for (int j = 0; j < 4; ++j) { v0[j] = sigmoidf_(v0[j]); v1[j] = sigmoidf_(v1[j]); } }
                u32x4 w; w.x = cvt_pk_bf16(v0[0], v0[1]); w.y = cvt_pk_bf16(v0[2], v0[3]); w.z = cvt_pk_bf16(v1[0], v1[1]); w.w = cvt_pk_bf16(v1[2], v1[3]);
                *(u32x4*)(rowp + bj * HALF) = w; }
            EPI_FENCE();
        )
    }
};
struct EpiVT {
    static constexpr bool PERM = true, AFTER_DRAIN = false, MIDK = false;
    bf16_t* O; int ldc;
    __device__ __forceinline__ void operator()(const f32x4 (&acc)[2][2][4][2], const Unit& u, int wr, int wc, int fr, int fq) const {
        const int cbase = u.pn * BM + wc * 32 + 16 * (fq >> 1) + 4 * (fq & 1);
        EPI_ROWS(
            const int hv = row >> 7, dd = row & 127;
            _Pragma("unroll") for (int bj = 0; bj < 2; ++bj) _Pragma("unroll") for (int n = 0; n < 2; ++n) { const f32x4 v = acc[ai][bj][m][n];
                const int col = cbase + bj * HALF + 8 * n, bb = col >> 12, kt = (col >> 6) & 63, pos = col & 63;
                u32x2 w; w.x = cvt_pk_bf16(v[0], v[1]); w.y = cvt_pk_bf16(v[2], v[3]);
                *(u32x2*)(O + ((((size_t)(bb * 16 + hv)) * 64 + kt) * 128 + dd) * 64 + pos) = w; }
            EPI_FENCE();
        )
    }
};
struct EpiMerge {
    static constexpr bool PERM = true, AFTER_DRAIN = false, MIDK = true;
    const bf16_t* GA; const bf16_t* GB; int ldg; bf16_t* O; int ldc; int midk;
    __device__ __forceinline__ void mid(f32x4 (&acc)[2][2][4][2], const Unit& u, int wr, int wc, int fr, int fq) const {
        const int col0 = u.pn * BM + wc * 32 + 8 * fq;
        EPI_ROWS(
            _Pragma("unroll") for (int bj = 0; bj < 2; ++bj) { const size_t off = (size_t)row * ldg + col0 + bj * HALF;
                const u32x4 a = *(const u32x4*)(GA + off), b = *(const u32x4*)(GB + off);
                float r[8];
                r[0] = bf_lo(a.x) * __builtin_amdgcn_rcpf(fmaxf(bf_lo(b.x), 1e-30f)); r[1] = bf_hi(a.x) * __builtin_amdgcn_rcpf(fmaxf(bf_hi(b.x), 1e-30f));
                r[2] = bf_lo(a.y) * __builtin_amdgcn_rcpf(fmaxf(bf_lo(b.y), 1e-30f)); r[3] = bf_hi(a.y) * __builtin_amdgcn_rcpf(fmaxf(bf_hi(b.y), 1e-30f));
                r[4] = bf_lo(a.z) * __builtin_amdgcn_rcpf(fmaxf(bf_lo(b.z), 1e-30f)); r[5] = bf_hi(a.z) * __builtin_amdgcn_rcpf(fmaxf(bf_hi(b.z), 1e-30f));
                r[6] = bf_lo(a.w) * __builtin_amdgcn_rcpf(fmaxf(bf_lo(b.w), 1e-30f)); r[7] = bf_hi(a.w) * __builtin_amdgcn_rcpf(fmaxf(bf_hi(b.w), 1e-30f));
                _Pragma("unroll") for (int j = 0; j < 4; ++j) { acc[ai][bj][m][0][j] *= r[j]; acc[ai][bj][m][1][j] *= r[4 + j]; } }
            EPI_FENCE();
        )
    }
    __device__ __forceinline__ void operator()(const f32x4 (&acc)[2][2][4][2], const Unit& u, int wr, int wc, int fr, int fq) const {
        const int col0 = u.pn * BM + wc * 32 + 8 * fq;
        EPI_ROWS(
            _Pragma("unroll") for (int bj = 0; bj < 2; ++bj) { const u32x4 b = *(const u32x4*)(GB + (size_t)row * ldg + col0 + bj * HALF);
                f32x4 v0 = acc[ai][bj][m][0], v1 = acc[ai][bj][m][1];
                v0[0] *= fmaxf(bf_lo(b.x), 1e-30f); v0[1] *= fmaxf(bf_hi(b.x), 1e-30f); v0[2] *= fmaxf(bf_lo(b.y), 1e-30f); v0[3] *= fmaxf(bf_hi(b.y), 1e-30f);
                v1[0] *= fmaxf(bf_lo(b.z), 1e-30f); v1[1] *= fmaxf(bf_hi(b.z), 1e-30f); v1[2] *= fmaxf(bf_lo(b.w), 1e-30f); v1[3] *= fmaxf(bf_hi(b.w), 1e-30f);
                u32x4 w; w.x = cvt_pk_bf16(v0[0], v0[1]); w.y = cvt_pk_bf16(v0[2], v0[3]); w.z = cvt_pk_bf16(v1[0], v1[1]); w.w = cvt_pk_bf16(v1[2], v1[3]);
                *(u32x4*)(O + (size_t)row * ldc + col0 + bj * HALF) = w; }
            EPI_FENCE();
        )
    }
};
template <bool BASE_BF16> struct EpiResid {
    static constexpr bool PERM = true, AFTER_DRAIN = false, MIDK = false;
    const void* base; bf16_t* ob; float* rowss; int ldc;
    __device__ __forceinline__ void operator()(const f32x4 (&acc)[2][2][4][2], const Unit& u, int wr, int wc, int fr, int fq) const {
        const int col0 = u.pn * BM + wc * 32 + 8 * fq;
        EPI_ROWS(
            float ss = 0.f;
            _Pragma("unroll") for (int bj = 0; bj < 2; ++bj) { const size_t off = (size_t)row * ldc + col0 + bj * HALF;
                f32x4 b0, b1;
                if (BASE_BF16) { const u32x4 bw = *(const u32x4*)((const bf16_t*)base + off); b0 = (f32x4){bf_lo(bw.x), bf_hi(bw.x), bf_lo(bw.y), bf_hi(bw.y)}; b1 = (f32x4){bf_lo(bw.z), bf_hi(bw.z), bf_lo(bw.w), bf_hi(bw.w)}; }
                else { b0 = __builtin_nontemporal_load((const f32x4*)((const float*)base + off)); b1 = __builtin_nontemporal_load((const f32x4*)((const float*)base + off + 4)); }
                const f32x4 v0 = acc[ai][bj][m][0] + b0, v1 = acc[ai][bj][m][1] + b1;
                ss += (v0[0] * v0[0] + v0[1] * v0[1]) + (v0[2] * v0[2] + v0[3] * v0[3]) + (v1[0] * v1[0] + v1[1] * v1[1]) + (v1[2] * v1[2] + v1[3] * v1[3]);
                u32x4 w; w.x = cvt_pk_bf16(v0[0], v0[1]); w.y = cvt_pk_bf16(v0[2], v0[3]); w.z = cvt_pk_bf16(v1[0], v1[1]); w.w = cvt_pk_bf16(v1[2], v1[3]);
                *(u32x4*)(ob + off) = w; }
            ss += __shfl_xor(ss, 16); ss += __shfl_xor(ss, 32);
            if (fq == 0) atomicAdd(rowss + row, ss);
            EPI_FENCE();
        )
    }
};
struct EpiSwiGLU {
    static constexpr bool PERM = true, AFTER_DRAIN = false, MIDK = false;
    const float* rowss; bf16_t* H; int ldh; float inv_d, eps;
    __device__ __forceinline__ void operator()(const f32x4 (&acc)[2][2][4][2], const Unit& u, int wr, int wc, int fr, int fq) const {
        const int col0 = u.pn * HALF + wc * 32 + 8 * fq;
        EPI_ROWS(
            const float rs = __builtin_amdgcn_rsqf(rowss[row] * inv_d + eps);
            float hv[8];
            _Pragma("unroll") for (int n = 0; n < 2; ++n) _Pragma("unroll") for (int j = 0; j < 4; ++j) { const float g = acc[ai][0][m][n][j] * rs, up = acc[ai][1][m][n][j] * rs; hv[n * 4 + j] = g * sigmoidf_(g) * up; }
            u32x4 w; w.x = cvt_pk_bf16(hv[0], hv[1]); w.y = cvt_pk_bf16(hv[2], hv[3]); w.z = cvt_pk_bf16(hv[4], hv[5]); w.w = cvt_pk_bf16(hv[6], hv[7]);
            *(u32x4*)(H + (size_t)row * ldh + col0) = w;
            EPI_FENCE();
        )
    }
};
struct EpiStoreBf16 {
    static constexpr bool PERM = true, AFTER_DRAIN = false, MIDK = false;
    bf16_t* T; int ldc;
    __device__ __forceinline__ void operator()(const f32x4 (&acc)[2][2][4][2], const Unit& u, int wr, int wc, int fr, int fq) const {
        const int col0 = u.pn * BM + wc * 32 + 8 * fq;
        EPI_ROWS(
            _Pragma("unroll") for (int bj = 0; bj < 2; ++bj) { const f32x4 v0 = acc[ai][bj][m][0], v1 = acc[ai][bj][m][1];
                u32x4 w; w.x = cvt_pk_bf16(v0[0], v0[1]); w.y = cvt_pk_bf16(v0[2], v0[3]); w.z = cvt_pk_bf16(v1[0], v1[1]); w.w = cvt_pk_bf16(v1[2], v1[3]);
                *(u32x4*)(T + (size_t)row * ldc + col0 + bj * HALF) = w; }
            EPI_FENCE();
        )
    }
};
struct EpiPle {
    static constexpr bool PERM = true, AFTER_DRAIN = false, MIDK = false;
    const float* rowss; const bf16_t* T; const bf16_t* X; float* out; int ldc; float inv_d, eps;
    __device__ __forceinline__ void operator()(const f32x4 (&acc)[2][2][4][2], const Unit& u, int wr, int wc, int fr, int fq) const {
        const int col0 = u.pn * BM + wc * 32 + 8 * fq;
        EPI_ROWS(
            const float rs = __builtin_amdgcn_rsqf(rowss[row] * inv_d + eps);
            _Pragma("unroll") for (int bj = 0; bj < 2; ++bj) { const size_t off = (size_t)row * ldc + col0 + bj * HALF;
                const u32x4 tw = *(const u32x4*)(T + off), xw = *(const u32x4*)(X + off);
                const float t[8] = {bf_lo(tw.x), bf_hi(tw.x), bf_lo(tw.y), bf_hi(tw.y), bf_lo(tw.z), bf_hi(tw.z), bf_lo(tw.w), bf_hi(tw.w)};
                const float x[8] = {bf_lo(xw.x), bf_hi(xw.x), bf_lo(xw.y), bf_hi(xw.y), bf_lo(xw.z), bf_hi(xw.z), bf_lo(xw.w), bf_hi(xw.w)};
                f32x4 o0, o1;
                _Pragma("unroll") for (int j = 0; j < 4; ++j) { o0[j] = x[j] + sigmoidf_(acc[ai][bj][m][0][j] * rs) * t[j]; o1[j] = x[4 + j] + sigmoidf_(acc[ai][bj][m][1][j] * rs) * t[4 + j]; }
                __builtin_nontemporal_store(o0, (f32x4*)(out + off)); __builtin_nontemporal_store(o1, (f32x4*)(out + off + 4)); }
            EPI_FENCE();
        )
    }
};
template <class Epi, class Sched, bool ALIGN_EPI = false, bool SP2 = false>
__device__ __forceinline__ void gemm_phase(PG8_LAS unsigned char* lds, const Gemm g, const Sched& S, const Epi& E) {
    int tid_ = threadIdx.x; asm volatile("" : "+v"(tid_));
    const int tid = tid_, wid = __builtin_amdgcn_readfirstlane(tid >> 6), lane = tid & 63, wr = wid >> 2, wc = wid & 3, fr = lane & 15, fq = lane >> 4;
    const int K = g.K, nt = g.nt ? g.nt : K / BK;
    unsigned voffA[2], voffB[2];
#pragma unroll
    for (int i = 0; i < 2; ++i) { int R, C; stage_rc(tid * 16 + i * 8192, R, C); const int Rb = Epi::PERM ? ((R & ~31) + perm32(R & 31)) : R;
        voffA[i] = (unsigned)(R * K + C) * 2u; voffB[i] = (unsigned)(Rb * K + C) * 2u; }
    const size_t kstep = (size_t)(BK * 2);
    const size_t hstep = (size_t)HALF * K * 2;
    const size_t tstep = 2 * hstep;
    const unsigned ldsw = (unsigned)wid * 1024u;
    const int aoff = lds_byte(wr * 64 + fr, fq * 8), boff = lds_byte(wc * 32 + fr, fq * 8);
#define PG8_SA(b, h) (((b) * 2 + (h)) * HTB)
#define PG8_SB(b, h) ((4 + (b) * 2 + (h)) * HTB)
#define PG8_STAGE(bufoff, gbase, voff) do { _Pragma("unroll") for (int _i = 0; _i < 2; ++_i) \
        __builtin_amdgcn_global_load_lds((const unsigned*)((const char*)(gbase) + (voff)[_i]), (PG8_LAS unsigned*)(lds + (bufoff) + ldsw + _i * 8192), 16, 0, 0); } while (0)
#define PG8_LDA(dst, b, h) do { _Pragma("unroll") for (int m = 0; m < 4; ++m) _Pragma("unroll") for (int k = 0; k < 2; ++k) dst[m][k] = *(const PG8_LAS bf16x8*)(lds + PG8_SA(b, h) + aoff + m * 2048 + k * 1024); } while (0)
#define PG8_LDB(dst, b, h) do { _Pragma("unroll") for (int n = 0; n < 2; ++n) _Pragma("unroll") for (int k = 0; k < 2; ++k) dst[n][k] = *(const PG8_LAS bf16x8*)(lds + PG8_SB(b, h) + boff + n * 2048 + k * 1024); } while (0)
#define PG8_MMA(ai, bj, At, Bt) do { __builtin_amdgcn_s_setprio(1); _Pragma("unroll") for (int m = 0; m < 4; ++m) _Pragma("unroll") for (int n = 0; n < 2; ++n) _Pragma("unroll") for (int k = 0; k < 2; ++k) \
        acc[ai][bj][m][n] = __builtin_amdgcn_mfma_f32_16x16x32_bf16(Bt[n][k], At[m][k], acc[ai][bj][m][n], 0, 0, 0); __builtin_amdgcn_s_setprio(0); } while (0)
#define PG8_WAIT_V(n) asm volatile("s_waitcnt vmcnt(" #n ")" ::: "memory")
#define PG8_WAIT_L(n) asm volatile("s_waitcnt lgkmcnt(" #n ")" ::: "memory")
#define PG8_BAR __builtin_amdgcn_s_barrier()
#define PG8_SCHED __builtin_amdgcn_sched_barrier(0)
    Unit cur, nxt; int ui = 0;
    if (!S.next(0, cur)) return;
    f32x4 acc[2][2][4][2];
#pragma unroll
    for (int a = 0; a < 2; ++a)
#pragma unroll
        for (int b = 0; b < 2; ++b)
#pragma unroll
            for (int m = 0; m < 4; ++m)
#pragma unroll
                for (int n = 0; n < 2; ++n) acc[a][b][m][n] = (f32x4){0.f, 0.f, 0.f, 0.f};
    bf16x8 At[4][2], B0[2][2], B1[2][2];
    const char* cA = (const char*)g.A + (size_t)cur.pm * tstep + cur.ko; const char* cB = (const char*)g.Bt + (size_t)cur.pn * tstep + cur.ko;
    S.a_ready(cur);
    if constexpr (SP2) {
        PG8_STAGE(PG8_SB(0, 0), cB, voffB); PG8_STAGE(PG8_SB(0, 1), cB + hstep, voffB); PG8_STAGE(PG8_SA(0, 0), cA, voffA); PG8_STAGE(PG8_SA(0, 1), cA + hstep, voffA);
        if (wr == 1) PG8_BAR;
        PG8_WAIT_V(2); PG8_BAR;
        PG8_STAGE(PG8_SB(1, 0), cB + kstep, voffB); PG8_STAGE(PG8_SA(1, 0), cA + kstep, voffA); PG8_STAGE(PG8_SB(1, 1), cB + hstep + kstep, voffB);
        PG8_WAIT_V(6); PG8_BAR;
    } else {
        PG8_STAGE(PG8_SB(0, 0), cB, voffB); PG8_STAGE(PG8_SA(0, 0), cA, voffA); PG8_STAGE(PG8_SB(0, 1), cB + hstep, voffB); PG8_STAGE(PG8_SA(0, 1), cA + hstep, voffA);
        if (wr == 1) PG8_BAR;
        PG8_WAIT_V(4); PG8_BAR;
        PG8_STAGE(PG8_SB(1, 0), cB + kstep, voffB); PG8_STAGE(PG8_SA(1, 0), cA + kstep, voffA); PG8_STAGE(PG8_SB(1, 1), cB + hstep + kstep, voffB);
        PG8_WAIT_V(6); PG8_BAR;
    }
    for (;;) {
        const bool has_next = S.next(ui + 1, nxt);
        const char* nA = has_next ? (const char*)g.A + (size_t)nxt.pm * tstep + nxt.ko : cA; const char* nB = has_next ? (const char*)g.Bt + (size_t)nxt.pn * tstep + nxt.ko : cB;
        for (int t = 0; t < nt; t += 2) {
            const bool last = (t == nt - 2);
            const char* a1 = cA + (size_t)(t + 1) * kstep;
            const char* a2 = last ? nA : cA + (size_t)(t + 2) * kstep; const char* b2 = last ? nB : cB + (size_t)(t + 2) * kstep;
            const char* a3 = a2 + kstep; const char* b3 = b2 + kstep;
            if (last && has_next) S.a_ready(nxt);
            if constexpr (SP2) {
            PG8_LDB(B0, 0, 0); PG8_LDB(B1, 0, 1); PG8_SCHED; PG8_LDA(At, 0, 0); PG8_STAGE(PG8_SA(1, 1), a1 + hstep, voffA);
            PG8_WAIT_V(8); PG8_WAIT_L(0); PG8_BAR; PG8_MMA(0, 0, At, B0); PG8_MMA(0, 1, At, B1); PG8_BAR; PG8_SCHED;
            PG8_LDA(At, 0, 1); PG8_STAGE(PG8_SB(0, 0), b2, voffB); PG8_STAGE(PG8_SB(0, 1), b2 + hstep, voffB); PG8_STAGE(PG8_SA(0, 0), a2, voffA);
            PG8_WAIT_V(8); PG8_WAIT_L(0); PG8_BAR; PG8_MMA(1, 0, At, B0); PG8_MMA(1, 1, At, B1); PG8_BAR; PG8_SCHED;
            PG8_LDB(B0, 1, 0); PG8_LDB(B1, 1, 1); PG8_SCHED; PG8_LDA(At, 1, 0); PG8_STAGE(PG8_SA(0, 1), a2 + hstep, voffA);
            PG8_WAIT_V(8); PG8_WAIT_L(0); PG8_BAR; PG8_MMA(0, 0, At, B0); PG8_MMA(0, 1, At, B1); PG8_BAR; PG8_SCHED;
            PG8_LDA(At, 1, 1); PG8_STAGE(PG8_SB(1, 0), b3, voffB); PG8_STAGE(PG8_SB(1, 1), b3 + hstep, voffB); PG8_STAGE(PG8_SA(1, 0), a3, voffA);
            PG8_WAIT_V(8); PG8_WAIT_L(0); PG8_BAR; PG8_MMA(1, 0, At, B0); PG8_MMA(1, 1, At, B1); PG8_BAR; PG8_SCHED;
            } else {
            PG8_LDB(B0, 0, 0); PG8_SCHED; PG8_LDA(At, 0, 0); PG8_STAGE(PG8_SA(1, 1), a1 + hstep, voffA);
            PG8_WAIT_L(8); PG8_BAR; PG8_WAIT_L(0); PG8_MMA(0, 0, At, B0); PG8_BAR; PG8_SCHED;
            PG8_LDB(B1, 0, 1); PG8_STAGE(PG8_SB(0, 0), b2, voffB);
            PG8_BAR; PG8_WAIT_L(0); PG8_MMA(0, 1, At, B1); PG8_BAR;
            PG8_LDA(At, 0, 1); PG8_STAGE(PG8_SA(0, 0), a2, voffA);
            PG8_BAR; PG8_WAIT_L(0); PG8_MMA(1, 0, At, B0); PG8_BAR; PG8_SCHED;
            PG8_STAGE(PG8_SB(0, 1), b2 + hstep, voffB);
            PG8_WAIT_V(6); PG8_BAR; PG8_MMA(1, 1, At, B1); PG8_BAR;
            PG8_LDB(B0, 1, 0); PG8_SCHED; PG8_LDA(At, 1, 0); PG8_STAGE(PG8_SA(0, 1), a2 + hstep, voffA);
            PG8_WAIT_L(8); PG8_BAR; PG8_WAIT_L(0); PG8_MMA(0, 0, At, B0); PG8_BAR; PG8_SCHED;
            PG8_LDB(B1, 1, 1); PG8_STAGE(PG8_SB(1, 0), b3, voffB);
            PG8_BAR; PG8_WAIT_L(0); PG8_MMA(0, 1, At, B1); PG8_BAR;
            PG8_LDA(At, 1, 1); PG8_STAGE(PG8_SA(1, 0), a3, voffA);
            PG8_BAR; PG8_WAIT_L(0); PG8_MMA(1, 0, At, B0); PG8_BAR; PG8_SCHED;
            PG8_STAGE(PG8_SB(1, 1), b3 + hstep, voffB);
            PG8_WAIT_V(6); PG8_BAR; PG8_MMA(1, 1, At, B1); PG8_BAR;
            }
        }
        if constexpr (ALIGN_EPI) { if (wr == 0) PG8_BAR; }
        bool keep_acc = false;
        if constexpr (Epi::MIDK) { if (cur.ko == 0) { E.mid(acc, cur, wr, wc, fr, fq); keep_acc = true; } else E(acc, cur, wr, wc, fr, fq); }
        else if constexpr (!Epi::AFTER_DRAIN) { E(acc, cur, wr, wc, fr, fq); S.done(cur); }
        if (!has_next) break;
        if (!keep_acc) {
#pragma unroll
        for (int a = 0; a < 2; ++a)
#pragma unroll
            for (int b = 0; b < 2; ++b)
#pragma unroll
                for (int m = 0; m < 4; ++m)
#pragma unroll
                    for (int n = 0; n < 2; ++n) acc[a][b][m][n] = (f32x4){0.f, 0.f, 0.f, 0.f};
        }
        cur = nxt; cA = nA; cB = nB; ++ui;
        if constexpr (ALIGN_EPI) { if (wr == 1) PG8_BAR; }
    }
    PG8_WAIT_V(0);
    if constexpr (!ALIGN_EPI) { if (wr == 0) PG8_BAR; }
    PG8_BAR;
    if constexpr (Epi::AFTER_DRAIN) { E.fused(acc, cur, wr, wc, fr, fq, lds, wid, lane); S.done(cur); }
#undef PG8_SA
#undef PG8_SB
#undef PG8_STAGE
#undef PG8_LDA
#undef PG8_LDB
#undef PG8_MMA
#undef PG8_WAIT_V
#undef PG8_WAIT_L
#undef PG8_BAR
#undef PG8_SCHED
}
}
constexpr int D = 2048, BATCH = 2, SEQ = 4096, M = BATCH * SEQ, GW = 64, GROWS = SEQ / GW, FF = 5632, PLE = 256;
constexpr int NA_H = 8, NA_DH = 128, DF_H = 8, DF_DQ = 64, DF_DV = 128;
constexpr int NQKG = 8192;
constexpr int QC_NAQ = 0, QC_NAK = 1024, QC_DFQ = 2048, QC_DFK = 3072, QC_GA = 4096, QC_GB = 6144;
constexpr float EPS = 1e-6f, LOG2E = 1.4426950408889634f;
constexpr float LAM_INIT = 0.2f;
constexpr int NWAVES = 8, NTHREADS = 512;
constexpr size_t MiB = 1u << 20;
constexpr size_t WS_RS1 = 64 * 1024, WS_RS2 = 128 * 1024, WS_ROPE = 1 * MiB;
constexpr size_t WS_W1 = 2 * MiB, WS_WNA = 42 * MiB, WS_WDF = 46 * MiB, WS_WO = 50 * MiB, WS_WGU = 58 * MiB, WS_WDN = 102 * MiB, WS_WPG = 124 * MiB, WS_WPP = 132 * MiB;
constexpr size_t WS_A = 133 * MiB;
constexpr size_t WS_B = 261 * MiB;
constexpr size_t WS_C = 293 * MiB;
constexpr size_t WS_PB = 325 * MiB;
constexpr size_t WS_END = 329 * MiB;
constexpr int LDS_BYTES = 147456;
#define LAS __attribute__((address_space(3)))
typedef unsigned short bf16;
typedef unsigned u32x4 __attribute__((ext_vector_type(4)));
typedef unsigned u32x2 __attribute__((ext_vector_type(2)));
typedef float f32x4 __attribute__((ext_vector_type(4)));
typedef float f32x2 __attribute__((ext_vector_type(2)));
typedef float f32x16 __attribute__((ext_vector_type(16)));
typedef short bf16x8 __attribute__((ext_vector_type(8)));
using pg8::cvt_pk_bf16; using pg8::bf_lo; using pg8::bf_hi;

__device__ __forceinline__ float wave_sum(float v) {
#pragma unroll
    for (int o = 1; o < 64; o <<= 1) v += __shfl_xor(v, o);
    return v;
}
__device__ __forceinline__ float wave_max(float v) {
#pragma unroll
    for (int o = 1; o < 64; o <<= 1) v = fmaxf(v, __shfl_xor(v, o));
    return v;
}
__device__ __forceinline__ int crow(int r, int hi) { return (r & 3) + 8 * (r >> 2) + 4 * hi; }

__device__ __forceinline__ int rowmap(int mode, int n0) {
    if (mode == 0) return n0;
    if (mode == 1) {
        if (n0 < 2048) return n0;
        if (n0 < 3072) return 8192 + (n0 - 2048);
        if (n0 < 4096) return 2048 + (n0 - 3072);
        if (n0 < 5120) return 3072 + (n0 - 4096);
        if (n0 < 6144) return 9216 + (n0 - 5120);
        return 4096 + (n0 - 6144);
    }
    return 256 * (n0 >> 7) + (n0 & 127) + (mode == 3 ? 128 : 0);
}
struct P0Item { const float* W; bf16* WT; const float* gk; int K, N, mode, item, Kd, kofs; };
__device__ __forceinline__ void p0_item_load(const P0Item& d, float (&v)[32], int lane) {
    const int nblk = d.N / 32, kb = d.item / nblk, nb = d.item % nblk, k0 = 64 * kb, n0 = 32 * nb;
    const float* src = d.W + (size_t)(k0 + (lane >> 5)) * d.N + n0 + (lane & 31);
#pragma unroll
    for (int i = 0; i < 32; ++i) v[i] = __builtin_nontemporal_load(src + (size_t)(2 * i) * d.N);
}
__device__ __forceinline__ void p0_item_store(const P0Item& d, const float (&v)[32], LAS float* scr, int lane) {
    const int nblk = d.N / 32, kb = d.item / nblk, nb = d.item % nblk, k0 = 64 * kb, n0 = 32 * nb;
    const int r0 = rowmap(d.mode, n0);
    if (d.gk) {
#pragma unroll
        for (int i = 0; i < 32; ++i) { const int kk = 2 * i + (lane >> 5); scr[kk * 33 + (lane & 31)] = v[i] * d.gk[k0 + kk]; }
    } else {
#pragma unroll
        for (int i = 0; i < 32; ++i) { const int kk = 2 * i + (lane >> 5); scr[kk * 33 + (lane & 31)] = v[i]; }
    }
    asm volatile("s_waitcnt lgkmcnt(0)" ::: "memory");
    const int c = lane & 7;
#pragma unroll
    for (int j = 0; j < 4; ++j) { const int n = (lane >> 3) + 8 * j; const LAS float* s = scr + (8 * c) * 33 + n;
        u32x4 o; o.x = cvt_pk_bf16(s[0 * 33], s[1 * 33]); o.y = cvt_pk_bf16(s[2 * 33], s[3 * 33]); o.z = cvt_pk_bf16(s[4 * 33], s[5 * 33]); o.w = cvt_pk_bf16(s[6 * 33], s[7 * 33]);
        *(u32x4*)(d.WT + (size_t)(r0 + n) * d.Kd + d.kofs + k0 + 8 * c) = o; }
    asm volatile("s_waitcnt lgkmcnt(0)" ::: "memory");
}
#define RLX_AGENT __ATOMIC_RELAXED, __HIP_MEMORY_SCOPE_AGENT
#define XB_TMO      128
#define XB_XCNT(j)  (256  + 64 * (j))
#define XB_XSUB(j)  (1280 + 64 * (j))
#define XB_XGEN(j)  (2304 + 64 * (j))
#define XB_TOP      3328
#define XB_TOPGEN   3392
#define XCD_BAR_WORDS 3456
#define XB_SPIN_CAP (1u << 18)

__device__ __forceinline__ unsigned xb_ld(unsigned* p)              { return __hip_atomic_load(p, __ATOMIC_RELAXED, __HIP_MEMORY_SCOPE_AGENT); }
__device__ __forceinline__ unsigned xb_add(unsigned* p, unsigned v) { return __hip_atomic_fetch_add(p, v, __ATOMIC_RELAXED, __HIP_MEMORY_SCOPE_AGENT); }
__device__ __forceinline__ unsigned xb_xcc_id() { return (unsigned)__builtin_amdgcn_s_getreg((3 << 11) | 20) & 0xFu; }
#define XB_SPIN(cond, bar) do { unsigned _sp = 0; while (cond) { __builtin_amdgcn_s_sleep(1); \
    if ((++_sp & 255u) == 0u) { if (xb_ld(&(bar)[XB_TMO])) break; if (_sp > XB_SPIN_CAP) { atomicAdd(&(bar)[XB_TMO], 1u); break; } } } } while (0)

struct XcdBarrier {
    unsigned* bar; unsigned x;
    volatile LAS unsigned* st;
};

__device__ __forceinline__ XcdBarrier xcd_barrier_post(unsigned* bar, volatile LAS unsigned* st) {
    XcdBarrier b; b.bar = bar; b.x = xb_xcc_id(); b.st = st;
    if (threadIdx.x == 0) (void)xb_add(&bar[XB_XCNT(b.x)], 1u);
    return b;
}
__device__ __forceinline__ void xcd_barrier_complete(unsigned* bar, unsigned x, unsigned& nloc, unsigned& nx) {
    const unsigned G = gridDim.x * gridDim.y * gridDim.z;
    unsigned sum, cnt, mine, sp = 0u;
    for (;;) {
        sum = 0u; cnt = 0u; mine = 0u;
#pragma unroll
        for (unsigned j = 0; j < 16; ++j) { const unsigned c = xb_ld(&bar[XB_XCNT(j)]); sum += c; cnt += (c > 0u) ? 1u : 0u; mine = (j == x) ? c : mine; }
        if (sum == G) break;
        __builtin_amdgcn_s_sleep(1);
        if ((++sp & 255u) == 0u) { if (xb_ld(&bar[XB_TMO])) break; if (sp > XB_SPIN_CAP) { atomicAdd(&bar[XB_TMO], 1u); break; } }
    }
    nloc = mine > 0u ? mine : 1u; nx = cnt > 0u ? cnt : 1u;
}

__device__ __forceinline__ void xcd_barrier(const XcdBarrier& b) {
    asm volatile("s_waitcnt vmcnt(0)" ::: "memory");
    __syncthreads();
    if (threadIdx.x == 0) {
        unsigned* bar = b.bar;
        __builtin_amdgcn_s_waitcnt(0);
        unsigned nloc = b.st[0], nx = b.st[1];
        if (nloc == 0u) { xcd_barrier_complete(bar, b.x, nloc, nx); b.st[0] = nloc; b.st[1] = nx; }
        const unsigned old = xb_add(&bar[XB_XSUB(b.x)], 1u);
        const unsigned gen = old / nloc;
        if (old + 1u == (gen + 1u) * nloc) {
            __builtin_amdgcn_fence(__ATOMIC_RELEASE, "agent");
            asm volatile("s_waitcnt vmcnt(0)" ::: "memory");
            const unsigned og = xb_add(&bar[XB_TOP], 1u);
            const unsigned tg = og / nx;
            if (og + 1u == (tg + 1u) * nx) xb_add(&bar[XB_TOPGEN], 1u);
            else XB_SPIN(xb_ld(&bar[XB_TOPGEN]) == tg, bar);
            __builtin_amdgcn_fence(__ATOMIC_ACQUIRE, "agent");
            xb_add(&bar[XB_XGEN(b.x)], 1u);
            asm volatile("s_waitcnt vmcnt(0)" ::: "memory");
        } else {
            XB_SPIN(xb_ld(&bar[XB_XGEN(b.x)]) == gen, bar);
            __builtin_amdgcn_fence(__ATOMIC_ACQUIRE, "agent");
            asm volatile("s_waitcnt vmcnt(0)" ::: "memory");
        }
    }
    __syncthreads();
}
struct Args {
    const float *x, *p, *g_mix, *w_in, *g_na_q, *g_na_k, *na_rpb, *g_df_q, *g_df_k, *lam_q1, *lam_k1, *lam_q2, *lam_k2, *g_df_sub,
                *w_na_out, *w_df_out, *w_o, *g_ffn, *w_gate, *w_up, *w_down, *g_ple, *w_ple_gate, *w_ple_proj;
    float* out; unsigned char* ws; int ph_lo, ph_hi, rep3, pad;
};

__device__ __forceinline__ void na_wave_unit(const bf16* QKG, const bf16* VT, const float* rpb, bf16* NAO, float M2, int b, int h, int r, int half) {
    int tid_ = threadIdx.x; asm volatile("" : "+v"(tid_)); const int lane = tid_ & 63;
    const int q = lane & 31, hi = lane >> 5, c = 32 * half + q;
    const size_t tokq = (size_t)b * SEQ + r * GW + c;
    bf16x8 qf[8];
#pragma unroll
    for (int d0 = 0; d0 < 8; ++d0) qf[d0] = *(const bf16x8*)(QKG + tokq * NQKG + QC_NAQ + h * NA_DH + 16 * d0 + 8 * hi);
    int rs = r - 4; rs = rs < 0 ? 0 : (rs > GROWS - 8 ? GROWS - 8 : rs);
    int cs = c - 8; cs = cs < 0 ? 0 : (cs > GW - 16 ? GW - 16 : cs);
    f32x16 o[4];
#pragma unroll
    for (int i = 0; i < 4; ++i) o[i] = (f32x16){};
    float l = 0.f;
    for (int kr = 0; kr < 8; ++kr) {
        const int krow = rs + kr, dr = krow - r + 7;
        const float* brow = rpb + (h * 15 + dr) * 31;
#pragma unroll
        for (int kb = 0; kb < 2; ++kb) {
            f32x16 s = (f32x16){};
            const bf16* kp = QKG + ((size_t)b * SEQ + krow * GW + 32 * kb + q) * NQKG + QC_NAK + h * NA_DH + 8 * hi;
#pragma unroll
            for (int d0 = 0; d0 < 8; ++d0) { const bf16x8 kf = *(const bf16x8*)(kp + 16 * d0); s = __builtin_amdgcn_mfma_f32_32x32x16_bf16(kf, qf[d0], s, 0, 0, 0); }
            float pv[16];
#pragma unroll
            for (int i = 0; i < 16; ++i) { const int kc = 32 * kb + crow(i, hi); const bool in = (kc >= cs) && (kc < cs + 16); const int dc = in ? (kc - c + 15) : 0;
                const float bias = brow[dc] * LOG2E - M2; const float e = __builtin_amdgcn_exp2f(s[i] + bias); pv[i] = in ? e : 0.f; l += pv[i]; }
            u32x4 w0, w1;
            w0.x = cvt_pk_bf16(pv[0], pv[1]); w0.y = cvt_pk_bf16(pv[2], pv[3]); w0.z = cvt_pk_bf16(pv[4], pv[5]); w0.w = cvt_pk_bf16(pv[6], pv[7]);
            w1.x = cvt_pk_bf16(pv[8], pv[9]); w1.y = cvt_pk_bf16(pv[10], pv[11]); w1.z = cvt_pk_bf16(pv[12], pv[13]); w1.w = cvt_pk_bf16(pv[14], pv[15]);
            const bf16x8 p0 = __builtin_bit_cast(bf16x8, w0), p1 = __builtin_bit_cast(bf16x8, w1);
            const bf16* vp = VT + (size_t)(h * NA_DH + q) * M + (size_t)b * SEQ + krow * GW + 32 * kb + 8 * hi;
#pragma unroll
            for (int db = 0; db < 4; ++db) {
                const bf16x8 v0 = *(const bf16x8*)(vp + (size_t)(32 * db) * M), v1 = *(const bf16x8*)(vp + (size_t)(32 * db) * M + 16);
                o[db] = __builtin_amdgcn_mfma_f32_32x32x16_bf16(v0, p0, o[db], 0, 0, 0);
                o[db] = __builtin_amdgcn_mfma_f32_32x32x16_bf16(v1, p1, o[db], 0, 0, 0);
            }
        }
    }
    l += __shfl_xor(l, 32);
    const float rl = 1.0f / l;
    bf16* op = NAO + tokq * 2048 + h * NA_DH + 4 * hi;
#pragma unroll
    for (int db = 0; db < 4; ++db)
#pragma unroll
        for (int g = 0; g < 4; ++g) { u32x2 w; w.x = cvt_pk_bf16(o[db][4 * g] * rl, o[db][4 * g + 1] * rl); w.y = cvt_pk_bf16(o[db][4 * g + 2] * rl, o[db][4 * g + 3] * rl);
            *(u32x2*)(op + 32 * db + 8 * g) = w; }
}

__device__ __forceinline__ void df_unit(LAS unsigned char* lds, const bf16* QKG, const bf16* KC, const bf16* VT, bf16* DFO, const float* g_sub, const float* gq, const f32x2* rope, float lam, float M2, int b, int h, int qb, unsigned long long* df_wait = nullptr) {
    int tid_ = threadIdx.x; asm volatile("" : "+v"(tid_));
    const int tid = tid_, lane = tid & 63, w = __builtin_amdgcn_readfirstlane(tid >> 6), q = lane & 31, hi = lane >> 5;
    const int mm = w & 1, qg = w >> 1;
    const int q0 = qb * 128 + qg * 32;
    bf16x8 qf[4];
    {
      u32x4 qr[4]; float ss = 0.f; float xv[4][8];
#pragma unroll
      for (int d0 = 0; d0 < 4; ++d0) { qr[d0] = *(const u32x4*)(QKG + ((size_t)b * SEQ + q0 + q) * NQKG + QC_DFQ + h * 128 + mm * 64 + 16 * d0 + 8 * hi);
          xv[d0][0] = bf_lo(qr[d0].x); xv[d0][1] = bf_hi(qr[d0].x); xv[d0][2] = bf_lo(qr[d0].y); xv[d0][3] = bf_hi(qr[d0].y); xv[d0][4] = bf_lo(qr[d0].z); xv[d0][5] = bf_hi(qr[d0].z); xv[d0][6] = bf_lo(qr[d0].w); xv[d0][7] = bf_hi(qr[d0].w);
#pragma unroll
          for (int j = 0; j < 8; ++j) ss += xv[d0][j] * xv[d0][j]; }
      ss += __shfl_xor(ss, 32);
      const float rs = __builtin_amdgcn_rsqf(ss * (1.0f / 64.0f) + EPS);
      const float QS = 0.125f * LOG2E;
      const f32x2* rp = rope + (size_t)(q0 + q) * 32;
#pragma unroll
      for (int d0 = 0; d0 < 2; ++d0) { float o1[8], o2[8];
#pragma unroll
          for (int j = 0; j < 8; ++j) { const int i = 16 * d0 + 8 * hi + j; const f32x2 cs = rp[i];
              const float x1 = xv[d0][j] * rs * gq[i], x2 = xv[d0 + 2][j] * rs * gq[32 + i];
              o1[j] = (x1 * cs.x - x2 * cs.y) * QS; o2[j] = (x1 * cs.y + x2 * cs.x) * QS; }
          u32x4 wa, wb; wa.x = cvt_pk_bf16(o1[0], o1[1]); wa.y = cvt_pk_bf16(o1[2], o1[3]); wa.z = cvt_pk_bf16(o1[4], o1[5]); wa.w = cvt_pk_bf16(o1[6], o1[7]);
          wb.x = cvt_pk_bf16(o2[0], o2[1]); wb.y = cvt_pk_bf16(o2[2], o2[3]); wb.z = cvt_pk_bf16(o2[4], o2[5]); wb.w = cvt_pk_bf16(o2[6], o2[7]);
          qf[d0] = __builtin_bit_cast(bf16x8, wa); qf[d0 + 2] = __builtin_bit_cast(bf16x8, wb); } }
    const unsigned char* kbase = (const unsigned char*)(KC + ((size_t)(b * 8 + h) * SEQ) * 128);
    const unsigned char* vbase = (const unsigned char*)(VT + ((size_t)(b * 16 + 8 + h) * 64) * 128 * 64);
    unsigned koff[2], voff[2];
#pragma unroll
    for (int i = 0; i < 2; ++i) {
        const int piece = w * 2 + i;
        { const int row = piece * 4 + (lane >> 4), ph = lane & 15, ch = ph ^ (row & 15); koff[i] = (unsigned)(row * 128 + ch * 8) * 2u; }
        { const int row = piece * 8 + (lane >> 3), ph = lane & 7, ch = ph ^ ((row >> 1) & 7); voff[i] = (unsigned)(row * 64 + ch * 8) * 2u; }
    }
#define DF_DMA(kt, stg) do { const unsigned char* kb_ = kbase + (size_t)(kt) * 16384; const unsigned char* vb_ = vbase + (size_t)(kt) * 16384; _Pragma("unroll") for (int _i = 0; _i < 2; ++_i) { \
        __builtin_amdgcn_global_load_lds((const unsigned*)(kb_ + koff[_i]), (LAS unsigned*)(lds + (stg) * 32768 + (w * 2 + _i) * 1024), 16, 0, 0); \
        __builtin_amdgcn_global_load_lds((const unsigned*)(vb_ + voff[_i]), (LAS unsigned*)(lds + (stg) * 32768 + 16384 + (w * 2 + _i) * 1024), 16, 0, 0); } } while (0)
    int kofs[4], vofs[4];
#pragma unroll
    for (int d0 = 0; d0 < 4; ++d0) kofs[d0] = q * 256 + (((mm * 8 + 2 * d0 + hi) ^ (q & 15)) * 16);
#pragma unroll
    for (int g = 0; g < 4; ++g) vofs[g] = 16384 + q * 128 + (((2 * g + hi) ^ ((q >> 1) & 7)) * 16);
    f32x16 o[4];
#pragma unroll
    for (int i = 0; i < 4; ++i) o[i] = (f32x16){};
    float l = 0.f;
    const float shift = (M2 > 60.0f) ? M2 : 0.0f;
    constexpr int NT = SEQ / 64;
    typedef float f32x2_t __attribute__((ext_vector_type(2))); typedef __bf16 bf16x2_t __attribute__((ext_vector_type(2)));
#define CVTPK(lo, hi) __builtin_bit_cast(unsigned, __builtin_convertvector((f32x2_t){(lo), (hi)}, bf16x2_t))
#define DF_S(dst, St_, kb_) do { bf16x8 kf_[4]; _Pragma("unroll") for (int d0 = 0; d0 < 4; ++d0) kf_[d0] = *(const LAS bf16x8*)((St_) + kofs[d0] + (kb_) * 8192); \
        dst = (f32x16){}; _Pragma("unroll") for (int d0 = 0; d0 < 4; ++d0) dst = __builtin_amdgcn_mfma_f32_32x32x16_bf16(kf_[d0], qf[d0], dst, 0, 0, 0); } while (0)
#define DF_TILE(Stile, sv0, sv1, SH) do { _Pragma("unroll") for (int kb = 0; kb < 2; ++kb) { \
            bf16x8 vf[2][4]; \
            _Pragma("unroll") for (int jj = 0; jj < 2; ++jj) _Pragma("unroll") for (int db = 0; db < 4; ++db) vf[jj][db] = *(const LAS bf16x8*)((Stile) + vofs[2 * kb + jj] + db * 4096); \
            f32x16 s = kb ? sv1 : sv0; \
            if (SH) { _Pragma("unroll") for (int i = 0; i < 16; ++i) s[i] -= shift; } \
            float ls = 0.f; \
            _Pragma("unroll") for (int i = 0; i < 16; ++i) { s[i] = __builtin_amdgcn_exp2f(s[i]); ls += s[i]; } \
            l += ls; \
            u32x4 w0, w1; \
            w0.x = CVTPK(s[0], s[1]); w0.y = CVTPK(s[2], s[3]); w0.z = CVTPK(s[4], s[5]); w0.w = CVTPK(s[6], s[7]); \
            w1.x = CVTPK(s[8], s[9]); w1.y = CVTPK(s[10], s[11]); w1.z = CVTPK(s[12], s[13]); w1.w = CVTPK(s[14], s[15]); \
            const bf16x8 p0 = __builtin_bit_cast(bf16x8, w0), p1 = __builtin_bit_cast(bf16x8, w1); \
            _Pragma("unroll") for (int db = 0; db < 4; ++db) o[db] = __builtin_amdgcn_mfma_f32_32x32x16_bf16(vf[0][db], p0, o[db], 0, 0, 0); \
            _Pragma("unroll") for (int db = 0; db < 4; ++db) o[db] = __builtin_amdgcn_mfma_f32_32x32x16_bf16(vf[1][db], p1, o[db], 0, 0, 0); } } while (0)
    constexpr int NTS = NT / 2;
    DF_DMA(0, 0); DF_DMA(1, 1);
    asm volatile("s_waitcnt vmcnt(0)" ::: "memory");
    __builtin_amdgcn_s_barrier();
    asm volatile("" ::: "memory");
#define DF_LOOP(SH_)     for (int st = 0; st < NTS; ++st) { \
        const int sb = (st & 1) * 2; \
        if (st + 1 < NTS) { DF_DMA(2 * st + 2, sb ^ 2); DF_DMA(2 * st + 3, (sb ^ 2) + 1); } \
        const LAS unsigned char* T0 = lds + sb * 32768; \
        const LAS unsigned char* T1 = T0 + 32768; \
        f32x16 a0, a1, b0, b1; \
        DF_S(a0, T0, 0); DF_S(a1, T0, 1); \
        DF_S(b0, T1, 0); DF_S(b1, T1, 1); \
        DF_TILE(T0, a0, a1, SH_); \
        DF_TILE(T1, b0, b1, SH_); \
        asm volatile("s_waitcnt vmcnt(0) lgkmcnt(0)" ::: "memory"); \
        __builtin_amdgcn_s_barrier(); \
        asm volatile("" ::: "memory"); \
    }
    if (shift != 0.f) { DF_LOOP(1) } else { DF_LOOP(0) }
#undef DF_LOOP
#undef DF_TILE
#undef DF_S
#undef CVTPK
#undef DF_DMA
    LAS float* xch = (LAS float*)lds;
    { float lt = l; lt += __shfl_xor(lt, 32);
      const float sc = (mm == 1 ? lam : 1.0f) / lt;
#pragma unroll
      for (int db = 0; db < 4; ++db)
#pragma unroll
          for (int i = 0; i < 16; ++i) o[db][i] *= sc; }
    if (mm == 1) {
#pragma unroll
        for (int db = 0; db < 4; ++db)
#pragma unroll
            for (int i = 0; i < 16; ++i) xch[(qg * 64 + db * 16 + i) * 64 + lane] = o[db][i];
    }
    __syncthreads();
    if (mm == 0) {
        float ss = 0.f;
#pragma unroll
        for (int db = 0; db < 4; ++db)
#pragma unroll
            for (int i = 0; i < 16; ++i) { const float v = o[db][i] - xch[(qg * 64 + db * 16 + i) * 64 + lane]; o[db][i] = v; ss += v * v; }
        ss += __shfl_xor(ss, 32);
        const float rn = __builtin_amdgcn_rsqf(ss * (1.0f / 128.0f) + EPS) * (1.0f - LAM_INIT);
        bf16* op = DFO + ((size_t)b * SEQ + q0 + q) * 2048 + h * 128 + 4 * hi;
#pragma unroll
        for (int db = 0; db < 4; ++db)
#pragma unroll
            for (int g = 0; g < 4; ++g) { const f32x4 gs = *(const f32x4*)(g_sub + 32 * db + 8 * g + 4 * hi);
                u32x2 wv; wv.x = cvt_pk_bf16(o[db][4 * g] * rn * gs[0], o[db][4 * g + 1] * rn * gs[1]); wv.y = cvt_pk_bf16(o[db][4 * g + 2] * rn * gs[2], o[db][4 * g + 3] * rn * gs[3]);
                *(u32x2*)(op + 32 * db + 8 * g) = wv; }
    }
    __syncthreads();
}

__device__ __forceinline__ void na_unit(LAS unsigned char* lds, const bf16* QKG, const bf16* KC, const bf16* VT, const float* rpb, const float* gq, bf16* NAO, float M2, int b, int h, int r0) {
    int tid_ = threadIdx.x; asm volatile("" : "+v"(tid_));
    const int tid = tid_, lane = tid & 63, w = __builtin_amdgcn_readfirstlane(tid >> 6), q = lane & 31, hi = lane >> 5;
    const int rq = r0 + (w >> 1), half = w & 1, c = 32 * half + q;
    const size_t tokq = (size_t)b * SEQ + rq * GW + c;
    bf16x8 qf[8];
    {
      u32x4 qr[8]; float ss = 0.f;
#pragma unroll
      for (int d0 = 0; d0 < 8; ++d0) { qr[d0] = *(const u32x4*)(QKG + tokq * NQKG + QC_NAQ + h * NA_DH + 16 * d0 + 8 * hi);
          const float v[8] = {bf_lo(qr[d0].x), bf_hi(qr[d0].x), bf_lo(qr[d0].y), bf_hi(qr[d0].y), bf_lo(qr[d0].z), bf_hi(qr[d0].z), bf_lo(qr[d0].w), bf_hi(qr[d0].w)};
#pragma unroll
          for (int j = 0; j < 8; ++j) ss += v[j] * v[j]; }
      ss += __shfl_xor(ss, 32);
      const float rn = __builtin_amdgcn_rsqf(ss * (1.0f / 128.0f) + EPS) * (0.08838834764831845f * LOG2E);
#pragma unroll
      for (int d0 = 0; d0 < 8; ++d0) { const float* g1 = gq + 16 * d0 + 8 * hi;
          const float v[8] = {bf_lo(qr[d0].x), bf_hi(qr[d0].x), bf_lo(qr[d0].y), bf_hi(qr[d0].y), bf_lo(qr[d0].z), bf_hi(qr[d0].z), bf_lo(qr[d0].w), bf_hi(qr[d0].w)};
          u32x4 o; o.x = cvt_pk_bf16(v[0] * rn * g1[0], v[1] * rn * g1[1]); o.y = cvt_pk_bf16(v[2] * rn * g1[2], v[3] * rn * g1[3]);
          o.z = cvt_pk_bf16(v[4] * rn * g1[4], v[5] * rn * g1[5]); o.w = cvt_pk_bf16(v[6] * rn * g1[6], v[7] * rn * g1[7]);
          qf[d0] = __builtin_bit_cast(bf16x8, o); } }
    int rs = rq - 4; rs = rs < 0 ? 0 : (rs > GROWS - 8 ? GROWS - 8 : rs);
    int cs = c - 8; cs = cs < 0 ? 0 : (cs > GW - 16 ? GW - 16 : cs);
    int klo = r0 - 4; klo = klo < 0 ? 0 : (klo > GROWS - 8 ? GROWS - 8 : klo);
    int khi = r0 + 3 - 4; khi = (khi < 0 ? 0 : (khi > GROWS - 8 ? GROWS - 8 : khi)) + 7;
    const int nst = khi - klo + 1;
    const unsigned char* kbase = (const unsigned char*)(KC + ((size_t)(b * 8 + h) * SEQ + klo * GW) * 128);
    const unsigned char* vbase = (const unsigned char*)(VT + ((size_t)(b * 16 + h) * 64 + klo) * 128 * 64);
    unsigned koff[2], voff[2];
#pragma unroll
    for (int i = 0; i < 2; ++i) {
        const int piece = w * 2 + i;
        { const int row = piece * 4 + (lane >> 4), ph = lane & 15, ch = ph ^ (row & 15); koff[i] = (unsigned)(row * 128 + ch * 8) * 2u; }
        { const int row = piece * 8 + (lane >> 3), ph = lane & 7, ch = ph ^ ((row >> 1) & 7); voff[i] = (unsigned)(row * 64 + ch * 8) * 2u; }
    }
#define NA_DMA(t, stg) do { const unsigned char* kb_ = kbase + (size_t)(t) * 16384; const unsigned char* vb_ = vbase + (size_t)(t) * 16384; _Pragma("unroll") for (int _i = 0; _i < 2; ++_i) { \
        __builtin_amdgcn_global_load_lds((const unsigned*)(kb_ + koff[_i]), (LAS unsigned*)(lds + (stg) * 32768 + (w * 2 + _i) * 1024), 16, 0, 0); \
        __builtin_amdgcn_global_load_lds((const unsigned*)(vb_ + voff[_i]), (LAS unsigned*)(lds + (stg) * 32768 + 16384 + (w * 2 + _i) * 1024), 16, 0, 0); } } while (0)
    int kofs[8], vofs[4];
#pragma unroll
    for (int d0 = 0; d0 < 8; ++d0) kofs[d0] = q * 256 + (((2 * d0 + hi) ^ (q & 15)) * 16);
#pragma unroll
    for (int g = 0; g < 4; ++g) vofs[g] = 16384 + q * 128 + (((2 * g + hi) ^ ((q >> 1) & 7)) * 16);
    f32x16 o[4];
#pragma unroll
    for (int i = 0; i < 4; ++i) o[i] = (f32x16){};
    float l = 0.f;
    LAS float* btab = (LAS float*)(lds + 131072 + 1024);
    for (int i = tid; i < 15 * 31; i += NTHREADS) btab[i] = rpb[h * 15 * 31 + i] * LOG2E - M2;
    asm volatile("s_waitcnt vmcnt(0) lgkmcnt(0)" ::: "memory");
    __builtin_amdgcn_s_barrier();
    asm volatile("" ::: "memory");
    NA_DMA(0, 0); NA_DMA(1, 1);
    asm volatile("s_waitcnt vmcnt(4)" ::: "memory");
    __builtin_amdgcn_s_barrier();
    asm volatile("" ::: "memory");
    for (int t = 0; t < nst; ++t) {
        if (t + 2 < nst) NA_DMA(t + 2, (t + 2) & 3);
        const int krow = klo + t;
        if (krow >= rs && krow < rs + 8) {
            const LAS unsigned char* St = lds + (t & 3) * 32768;
            const LAS float* brow = btab + (krow - rq + 7) * 31;
#pragma unroll
            for (int kb = 0; kb < 2; ++kb) {
                f32x16 s = (f32x16){};
#pragma unroll
                for (int d0 = 0; d0 < 8; ++d0) { const bf16x8 kf = *(const LAS bf16x8*)(St + kofs[d0] + kb * 8192); s = __builtin_amdgcn_mfma_f32_32x32x16_bf16(kf, qf[d0], s, 0, 0, 0); }
                bf16x8 vf[2][4];
#pragma unroll
                for (int jj = 0; jj < 2; ++jj)
#pragma unroll
                    for (int db = 0; db < 4; ++db) vf[jj][db] = *(const LAS bf16x8*)(St + (kb ? vofs[2 + jj] : vofs[jj]) + db * 4096);
                float pv[16];
                const LAS float* bp = brow + (4 * hi - c + 15 + 32 * kb);
                const int wa = 4 * hi - cs + 32 * kb;
#pragma unroll
                for (int i = 0; i < 16; ++i) { const int e0 = (i & 3) + 8 * (i >> 2); const float bias = bp[e0]; const float e = __builtin_amdgcn_exp2f(s[i] + bias);
                    pv[i] = ((unsigned)(wa + e0) < 16u) ? e : 0.f; l += pv[i]; }
                u32x4 w0, w1;
                w0.x = cvt_pk_bf16(pv[0], pv[1]); w0.y = cvt_pk_bf16(pv[2], pv[3]); w0.z = cvt_pk_bf16(pv[4], pv[5]); w0.w = cvt_pk_bf16(pv[6], pv[7]);
                w1.x = cvt_pk_bf16(pv[8], pv[9]); w1.y = cvt_pk_bf16(pv[10], pv[11]); w1.z = cvt_pk_bf16(pv[12], pv[13]); w1.w = cvt_pk_bf16(pv[14], pv[15]);
                const bf16x8 p0 = __builtin_bit_cast(bf16x8, w0), p1 = __builtin_bit_cast(bf16x8, w1);
#pragma unroll
                for (int db = 0; db < 4; ++db) o[db] = __builtin_amdgcn_mfma_f32_32x32x16_bf16(vf[0][db], p0, o[db], 0, 0, 0);
#pragma unroll
                for (int db = 0; db < 4; ++db) o[db] = __builtin_amdgcn_mfma_f32_32x32x16_bf16(vf[1][db], p1, o[db], 0, 0, 0);
            }
        }
        if (t + 2 < nst) asm volatile("s_waitcnt vmcnt(4) lgkmcnt(0)" ::: "memory"); else asm volatile("s_waitcnt vmcnt(0) lgkmcnt(0)" ::: "memory");
        __builtin_amdgcn_s_barrier();
        asm volatile("" ::: "memory");
    }
#undef NA_DMA
    l += __shfl_xor(l, 32);
    const float rl = 1.0f / l;
    bf16* op = NAO + tokq * 2048 + h * NA_DH + 4 * hi;
#pragma unroll
    for (int db = 0; db < 4; ++db)
#pragma unroll
        for (int g = 0; g < 4; ++g) { u32x2 wv; wv.x = cvt_pk_bf16(o[db][4 * g] * rl, o[db][4 * g + 1] * rl); wv.y = cvt_pk_bf16(o[db][4 * g + 2] * rl, o[db][4 * g + 3] * rl);
            *(u32x2*)(op + 32 * db + 8 * g) = wv; }
}
template <int TB>
__device__ __forceinline__ void qknorm_batch(bf16* QKG, bf16* KCna, bf16* KCdf, int m0, int mstride, const float* gnk, const float* gdk, const f32x2* rope, int lane) {
    u32x4 na[TB][2], da[TB], db[TB];
#pragma unroll
    for (int t = 0; t < TB; ++t) { int mt = m0 + t * mstride; if (mt >= M) mt = M - 1; const bf16* row = QKG + (size_t)mt * NQKG;
#pragma unroll
        for (int j = 0; j < 2; ++j) na[t][j] = *(const u32x4*)(row + QC_NAK + 512 * j + 8 * lane);
        const bf16* p1 = row + QC_DFK + 64 * (lane >> 2) + 8 * (lane & 3); da[t] = *(const u32x4*)p1; db[t] = *(const u32x4*)(p1 + 32); }
#pragma unroll
    for (int t = 0; t < TB; ++t) { const int mt = m0 + t * mstride; if (mt >= M) break; const int pos = mt & (SEQ - 1);
#pragma unroll
        for (int j = 0; j < 2; ++j) {
            const u32x4 w = na[t][j];
            float v[8] = {bf_lo(w.x), bf_hi(w.x), bf_lo(w.y), bf_hi(w.y), bf_lo(w.z), bf_hi(w.z), bf_lo(w.w), bf_hi(w.w)};
            float ss = 0.f;
#pragma unroll
            for (int i = 0; i < 8; ++i) ss += v[i] * v[i];
            ss += __shfl_xor(ss, 1); ss += __shfl_xor(ss, 2); ss += __shfl_xor(ss, 4); ss += __shfl_xor(ss, 8);
            const float rs = __builtin_amdgcn_rsqf(ss * (1.0f / 128.0f) + EPS);
            const float* g = gnk + 8 * (lane & 15);
#pragma unroll
            for (int i = 0; i < 8; ++i) v[i] = v[i] * rs * g[i];
            u32x4 o; o.x = cvt_pk_bf16(v[0], v[1]); o.y = cvt_pk_bf16(v[2], v[3]); o.z = cvt_pk_bf16(v[4], v[5]); o.w = cvt_pk_bf16(v[6], v[7]);
            const int x = 512 * j + 8 * lane;
            *(u32x4*)(KCna + ((size_t)((mt >> 12) * 8 + (x >> 7)) * SEQ + pos) * 128 + (x & 127)) = o;
        }
        {
            const u32x4 wa = da[t], wb = db[t];
            float a[8] = {bf_lo(wa.x), bf_hi(wa.x), bf_lo(wa.y), bf_hi(wa.y), bf_lo(wa.z), bf_hi(wa.z), bf_lo(wa.w), bf_hi(wa.w)};
            float c[8] = {bf_lo(wb.x), bf_hi(wb.x), bf_lo(wb.y), bf_hi(wb.y), bf_lo(wb.z), bf_hi(wb.z), bf_lo(wb.w), bf_hi(wb.w)};
            float ss = 0.f;
#pragma unroll
            for (int i = 0; i < 8; ++i) ss += a[i] * a[i] + c[i] * c[i];
            ss += __shfl_xor(ss, 1); ss += __shfl_xor(ss, 2);
            const float rs = __builtin_amdgcn_rsqf(ss * (1.0f / 64.0f) + EPS);
            const float* g = gdk + 8 * (lane & 3);
            const f32x2* rp = rope + pos * 32 + 8 * (lane & 3);
            float o1[8], o2[8];
#pragma unroll
            for (int i = 0; i < 8; ++i) { const float x1 = a[i] * rs * g[i], x2 = c[i] * rs * g[32 + i]; const f32x2 cs = rp[i]; o1[i] = x1 * cs.x - x2 * cs.y; o2[i] = x1 * cs.y + x2 * cs.x; }
            u32x4 oa, ob; oa.x = cvt_pk_bf16(o1[0], o1[1]); oa.y = cvt_pk_bf16(o1[2], o1[3]); oa.z = cvt_pk_bf16(o1[4], o1[5]); oa.w = cvt_pk_bf16(o1[6], o1[7]);
            ob.x = cvt_pk_bf16(o2[0], o2[1]); ob.y = cvt_pk_bf16(o2[2], o2[3]); ob.z = cvt_pk_bf16(o2[4], o2[5]); ob.w = cvt_pk_bf16(o2[6], o2[7]);
            const int x = 64 * (lane >> 2) + 8 * (lane & 3); bf16* kp = KCdf + ((size_t)((mt >> 12) * 8 + (x >> 7)) * SEQ + pos) * 128 + (x & 127);
            *(u32x4*)kp = oa; *(u32x4*)(kp + 32) = ob;
        }
    }
}

__device__ __forceinline__ void grid_barrier(unsigned* cnt, unsigned target) {
    asm volatile("s_waitcnt vmcnt(0) lgkmcnt(0)" ::: "memory");
    __syncthreads();
    if (threadIdx.x == 0) {
        __builtin_amdgcn_fence(__ATOMIC_RELEASE, "agent");
        asm volatile("s_waitcnt vmcnt(0)" ::: "memory");
        __hip_atomic_fetch_add(cnt, 1u, __ATOMIC_RELAXED, __HIP_MEMORY_SCOPE_AGENT);
        while (__hip_atomic_load(cnt, __ATOMIC_RELAXED, __HIP_MEMORY_SCOPE_AGENT) < target) __builtin_amdgcn_s_sleep(2);
        __builtin_amdgcn_fence(__ATOMIC_ACQUIRE, "agent");
        asm volatile("s_waitcnt vmcnt(0)" ::: "memory");
    }
    __syncthreads();
}
constexpr int I_IN = 32 * 320, I_NA = 16 * 64, I_O = 32 * 64, I_G = 32 * 176, I_DN = 88 * 64, I_PP = 4 * 64;
constexpr int N_EARLY = I_IN + 2 * I_NA + I_O + 2 * I_G + I_PP, NITEMS = N_EARLY + I_DN + I_O;
#define P0_DECODE(it_, d_) do { int r = (it_); \
            if (r < I_IN) { d_ = P0Item{ap->w_in, W1t, nullptr, D, 10240, 1, r, D, 0}; break; } r -= I_IN; \
            if (r < I_NA) { d_ = P0Item{ap->w_na_out, Wna, nullptr, 1024, D, 0, r, 2048, 0}; break; } r -= I_NA; \
            if (r < I_NA) { d_ = P0Item{ap->w_df_out, Wna, nullptr, 1024, D, 0, r, 2048, 1024}; break; } r -= I_NA; \
            if (r < I_O) { d_ = P0Item{ap->w_o, Wo, nullptr, D, D, 0, r, D, 0}; break; } r -= I_O; \
            if (r < I_G) { d_ = P0Item{ap->w_gate, Wgu, ap->g_ffn, D, FF, 2, r, D, 0}; break; } r -= I_G; \
            if (r < I_G) { d_ = P0Item{ap->w_up, Wgu, ap->g_ffn, D, FF, 3, r, D, 0}; break; } r -= I_G; \
            if (r < I_PP) { d_ = P0Item{ap->w_ple_proj, Wpp, nullptr, PLE, D, 0, r, PLE, 0}; break; } r -= I_PP; \
            if (r < I_DN) { d_ = P0Item{ap->w_down, Wdn, nullptr, FF, D, 0, r, FF, 0}; break; } r -= I_DN; \
            d_ = P0Item{ap->w_ple_gate, Wpg, ap->g_ple, D, D, 0, r, D, 0}; } while (0)
constexpr int NPHASE = 9;
__global__ void __launch_bounds__(NTHREADS, 2) fwd_megakernel(Args a) {
    extern __shared__ __attribute__((aligned(16))) unsigned char lds_raw[];
    LAS unsigned char* lds = (LAS unsigned char*)lds_raw;
    cg::grid_group grid = cg::this_grid();
    const int G = gridDim.x, bx = blockIdx.x;
    const int vcu = (G % 8 == 0) ? (bx % 8) * (G / 8) + bx / 8 : bx;
    const int NGW = G * NWAVES;
typedef __attribute__((opencl_constant)) const Args* CArgsP;
#define FRESH_ARGS() auto kp_ = __builtin_amdgcn_kernarg_segment_ptr(); asm volatile("" : "+s"(kp_)); const CArgsP ap = (CArgsP)kp_
#define FRESH_TID() int tid_ = threadIdx.x; asm volatile("" : "+v"(tid_)); const int tid = tid_, lane = tid & 63, wave = __builtin_amdgcn_readfirstlane(tid >> 6), gw = vcu * NWAVES + wave; (void)lane; (void)gw
    unsigned char* ws = a.ws;
    float* RS1 = (float*)(ws + WS_RS1); float* RS2 = (float*)(ws + WS_RS2); f32x2* ROPE = (f32x2*)(ws + WS_ROPE);
    bf16 *W1t = (bf16*)(ws + WS_W1), *Wna = (bf16*)(ws + WS_WNA), *Wdf = (bf16*)(ws + WS_WDF), *Wo = (bf16*)(ws + WS_WO), *Wgu = (bf16*)(ws + WS_WGU), *Wdn = (bf16*)(ws + WS_WDN), *Wpg = (bf16*)(ws + WS_WPG), *Wpp = (bf16*)(ws + WS_WPP);
    bf16 *QKG = (bf16*)(ws + WS_A), *HB = (bf16*)(ws + WS_A);
    bf16 *XN = (bf16*)(ws + WS_B), *AO = (bf16*)(ws + WS_B), *X1B = (bf16*)(ws + WS_B), *X2B = (bf16*)(ws + WS_B);
    bf16 *VT = (bf16*)(ws + WS_C), *MRG = (bf16*)(ws + WS_C), *T2B = (bf16*)(ws + WS_C), *PB = (bf16*)(ws + WS_PB);
    bf16* KCna = (bf16*)a.out; bf16* KCdf = KCna + (size_t)M * 1024;
    const int lo = a.ph_lo, hi_ph = a.ph_hi;
    if (lo < 0) grid.sync();
    { volatile LAS unsigned* st0 = (volatile LAS unsigned*)(lds + 131072 + 768); if (threadIdx.x < 2) st0[threadIdx.x] = 0u; __syncthreads(); }
    XcdBarrier xbar = xcd_barrier_post((unsigned*)(ws + 8192), (volatile LAS unsigned*)(lds + 131072 + 768));
#ifndef PHASE_MASK
#define PHASE_MASK 0x1ff
#endif
#define IN(k) (((PHASE_MASK >> (k)) & 1) && lo <= (k) && (k) < hi_ph)
#ifdef PROBE_TS
#define STAMP(k) do { if (bx == 0 && threadIdx.x == 0) ((volatile unsigned long long*)(ws + 2048))[k] = __builtin_amdgcn_s_memrealtime(); } while (0)
#else
#define STAMP(k) do {} while (0)
#endif
#define GBAR(idx) xcd_barrier(xbar)
#define SEAM(k) do { if (IN(k) && IN((k) + 1)) GBAR(k); STAMP((k) + 1); } while (0)
#ifndef PROBE_DUP
#define PROBE_DUP 0
#endif
#define NREP(k) (((PROBE_DUP >> (k)) & 1) ? 2 : 1)

    STAMP(0);
    for (int rep_ = 0; rep_ < NREP(0); ++rep_) {
    if (IN(0)) {
        FRESH_ARGS();
        FRESH_TID();
        if (bx == 0) {
        LAS float* red = (LAS float*)(lds + 131072);
        float mq = 0.f, mk = 0.f, mdq = 0.f, mdk = 0.f, mb = 0.f;
        if (tid < 128) { mq = fabsf(ap->g_na_q[tid]); mk = fabsf(ap->g_na_k[tid]); }
        if (tid < 64) { mdq = fabsf(ap->g_df_q[tid]); mdk = fabsf(ap->g_df_k[tid]); }
        for (int i = tid; i < NA_H * 15 * 31; i += NTHREADS) mb = fmaxf(mb, ap->na_rpb[i]);
        mq = wave_max(mq); mk = wave_max(mk); mdq = wave_max(mdq); mdk = wave_max(mdk); mb = wave_max(mb);
        float d1 = 0.f, d2 = 0.f;
        if (wave == 0) { d1 = wave_sum(ap->lam_q1[lane] * ap->lam_k1[lane]); d2 = wave_sum(ap->lam_q2[lane] * ap->lam_k2[lane]); }
        if (lane == 0) { red[wave * 8 + 0] = mq; red[wave * 8 + 1] = mk; red[wave * 8 + 2] = mdq; red[wave * 8 + 3] = mdk; red[wave * 8 + 4] = mb; red[wave * 8 + 5] = d1; red[wave * 8 + 6] = d2; }
        __syncthreads();
        mq = 0.f; mk = 0.f; mdq = 0.f; mdk = 0.f; mb = 0.f;
#pragma unroll
        for (int w = 0; w < 8; ++w) { mq = fmaxf(mq, red[w * 8]); mk = fmaxf(mk, red[w * 8 + 1]); mdq = fmaxf(mdq, red[w * 8 + 2]); mdk = fmaxf(mdk, red[w * 8 + 3]); mb = fmaxf(mb, red[w * 8 + 4]); }
        if (tid == 0) { float* PARw = (float*)(ws + 3072); PARw[0] = expf(red[5]) - expf(red[6]) + LAM_INIT; PARw[1] = (11.313708498984761f * mq * mk + mb) * LOG2E + 0.125f; PARw[2] = (8.0f * mdq * mdk) * LOG2E + 0.125f; }
        __syncthreads();
        }
        LAS float* scr = (LAS float*)(lds + wave * 16384);
        {
            float cur[32], nxt[32]; P0Item dc, dn;
            int it = gw;
            if (it < N_EARLY) { P0_DECODE(it, dc); p0_item_load(dc, cur, lane); }
            for (; it < N_EARLY; it += NGW) {
                const int nit = it + NGW; const bool more = nit < N_EARLY;
                if (more) { P0_DECODE(nit, dn); p0_item_load(dn, nxt, lane); }
                p0_item_store(dc, cur, scr, lane);
                if (more) { dc = dn;
#pragma unroll
                    for (int i = 0; i < 32; ++i) cur[i] = nxt[i]; }
            }
        }
        for (int m = gw; m < M; m += NGW) {
            const f32x4* xr = (const f32x4*)(ap->x + (size_t)m * D) + lane; const f32x4* gr = (const f32x4*)ap->g_mix + lane;
            f32x4 v[8]; float s = 0.f;
#pragma unroll
            for (int j = 0; j < 8; ++j) { v[j] = __builtin_nontemporal_load(xr + 64 * j); s += (v[j].x * v[j].x + v[j].y * v[j].y) + (v[j].z * v[j].z + v[j].w * v[j].w); }
            const float rs = __builtin_amdgcn_rsqf(wave_sum(s) * (1.0f / D) + EPS);
            u32x2* o8 = (u32x2*)(XN + (size_t)m * D) + lane;
#pragma unroll
            for (int j = 0; j < 8; ++j) { const f32x4 g = gr[64 * j]; u32x2 w; w.x = cvt_pk_bf16(v[j].x * rs * g.x, v[j].y * rs * g.y); w.y = cvt_pk_bf16(v[j].z * rs * g.z, v[j].w * rs * g.w); o8[64 * j] = w; }
        }
        const int gt = vcu * NTHREADS + tid, NGT = G * NTHREADS;
        for (int i = gt; i < M * PLE / 8; i += NGT) { const f32x4 p0 = __builtin_nontemporal_load((const f32x4*)ap->p + 2 * i), p1 = __builtin_nontemporal_load((const f32x4*)ap->p + 2 * i + 1);
            u32x4 w; w.x = cvt_pk_bf16(p0.x, p0.y); w.y = cvt_pk_bf16(p0.z, p0.w); w.z = cvt_pk_bf16(p1.x, p1.y); w.w = cvt_pk_bf16(p1.z, p1.w); ((u32x4*)PB)[i] = w; }
        for (int i = gt; i < SEQ * 32; i += NGT) { const int pos = i >> 5, k = i & 31;
            const float inv = (float)(1.0 / pow(10000.0, (double)k / 32.0)); const float ang = (float)pos * inv;
            f32x2 cs; cs.x = (float)cos((double)ang); cs.y = (float)sin((double)ang); ROPE[i] = cs; }
        for (int i = gt; i < M; i += NGT) { RS1[i] = 0.f; RS2[i] = 0.f; }
    }
    }
    SEAM(0);
    for (int rep_ = 0; rep_ < NREP(1); ++rep_) {
    if (IN(1)) {
        FRESH_ARGS();
        { pg8::Gemm g{XN, W1t, M, NQKG, D}; pg8::StaticOrder S; S.init(M, NQKG, G, bx); pg8::EpiQKG E{QKG, NQKG};
          pg8::gemm_phase<pg8::EpiQKG, pg8::StaticOrder, true, true>(lds, g, S, E); }
        { pg8::Gemm g{W1t + (size_t)NQKG * D, XN, 2048, M, D}; pg8::StaticOrder S; S.init(2048, M, G, bx); pg8::EpiVT E{VT, M};
          pg8::gemm_phase<pg8::EpiVT, pg8::StaticOrder, true, true>(lds, g, S, E); }
    }
    }
    SEAM(1);
    if (IN(2)) {
        FRESH_ARGS();
        FRESH_TID();
        for (int m0 = gw; m0 < M; m0 += 4 * NGW) qknorm_batch<4>(QKG, KCna, KCdf, m0, NGW, ap->g_na_k, ap->g_df_k, ROPE, lane);
    }
    SEAM(2);
    for (int rep_ = 0; rep_ < NREP(3); ++rep_) {
    if (IN(3)) {
        FRESH_ARGS();
        FRESH_TID();
        const float* PAR = (const float*)(ws + 3072);
        const float lam = PAR[0], M2na = PAR[1], M2df = PAR[2];
#ifndef NO_DF
        for (int uu = 2 * vcu; uu < BATCH * DF_H * (SEQ / 128); uu += 2 * G)
            for (int i2 = 0; i2 < 2; ++i2) { const int uidx = uu + i2, bh = uidx >> 5, qb = uidx & 31;
#ifdef PROBE_DFWAIT
                unsigned long long dfw_ = 0;
                df_unit(lds, QKG, KCdf, VT, AO + 1024, ap->g_df_sub, ap->g_df_q, ROPE, lam, M2df, bh >> 3, bh & 7, qb, &dfw_);
                if (bx == 0 && threadIdx.x == 0) { volatile unsigned long long* TS = (volatile unsigned long long*)(ws + 2048); TS[11] = (i2 ? TS[11] : 0ull) + dfw_; TS[12] = 0ull; }
#else
                df_unit(lds, QKG, KCdf, VT, AO + 1024, ap->g_df_sub, ap->g_df_q, ROPE, lam, M2df, bh >> 3, bh & 7, qb);
#endif
            }
#endif
        STAMP(10);
#ifdef PROBE_TS
        if (threadIdx.x == 0) { atomicMax((unsigned long long*)(ws + 2048) + 14, (unsigned long long)__builtin_amdgcn_s_memrealtime()); atomicMin((unsigned long long*)(ws + 2048) + 16, (unsigned long long)__builtin_amdgcn_s_memrealtime()); }
#endif
#ifndef NO_NA
        for (int uidx = vcu; uidx < BATCH * NA_H * (GROWS / 4); uidx += G) {
            const int bh = uidx >> 4, rg = uidx & 15;
            na_unit(lds, QKG, KCna, VT, ap->na_rpb, ap->g_na_q, AO, M2na, bh >> 3, bh & 7, rg * 4);
        }
        STAMP(13);
#ifdef PROBE_TS
        if (threadIdx.x == 0) atomicMax((unsigned long long*)(ws + 2048) + 15, (unsigned long long)__builtin_amdgcn_s_memrealtime());
#endif
#endif
    }
    }
    SEAM(3);
    for (int rep_ = 0; rep_ < NREP(4); ++rep_) {
    if (IN(4)) {
        FRESH_ARGS();
        { pg8::Gemm g{AO, Wna, M, D, 2048, 16}; pg8::PairOrder S; S.S.init(M, D, G, bx); S.kob = 1024 * 2; pg8::EpiMerge E{QKG + QC_GA, QKG + QC_GB, NQKG, MRG, D, 16};
          pg8::gemm_phase<pg8::EpiMerge, pg8::PairOrder, true, true>(lds, g, S, E); }
    }
    }
    SEAM(4);
    if (IN(5)) {
        FRESH_ARGS();
        pg8::Gemm g{MRG, Wo, M, D, D}; pg8::StaticOrder S; S.init(M, D, G, bx); pg8::EpiResid<false> E{ap->x, X1B, RS1, D};
        pg8::gemm_phase<pg8::EpiResid<false>, pg8::StaticOrder, true, true>(lds, g, S, E);
    }
    SEAM(5);
    for (int rep_ = 0; rep_ < NREP(6); ++rep_) {
    if (IN(6)) {
        FRESH_ARGS();
        pg8::Gemm g{X1B, Wgu, M, 2 * FF, D}; pg8::StaticOrder S; S.init(M, 2 * FF, G, bx); pg8::EpiSwiGLU E{RS1, HB, FF, 1.0f / D, EPS};
        pg8::gemm_phase<pg8::EpiSwiGLU, pg8::StaticOrder, true, true>(lds, g, S, E);
        { constexpr int NU6 = (M / 256) * (2 * FF / 256), NU8 = (M / 256) * (D / 256);
          const int rem = NU6 % G, nshort = rem ? G - rem : G;
          pg8::TailOrder T; T.first = (rem == 0) ? bx : (bx >= rem ? bx - rem : -1); T.stride = nshort; T.total = NU8;
          int kple = PLE; asm volatile("" : "+s"(kple));
          pg8::Gemm g2{PB, Wpp, M, D, kple}; pg8::EpiStoreBf16 E2{T2B, D};
          pg8::gemm_phase<pg8::EpiStoreBf16, pg8::TailOrder, true, true>(lds, g2, T, E2);
          if (T.first >= 0) { FRESH_TID();
              LAS float* scr = (LAS float*)(lds + wave * 16384);
              const int sw = ((rem == 0) ? bx : bx - rem) * NWAVES + wave, nsw = nshort * NWAVES;
              float cur[32], nxt[32]; P0Item dc, dn;
              int it = N_EARLY + sw;
              if (it < NITEMS) { P0_DECODE(it, dc); p0_item_load(dc, cur, lane); }
              for (; it < NITEMS; it += nsw) {
                  const int nit = it + nsw; const bool more = nit < NITEMS;
                  if (more) { P0_DECODE(nit, dn); p0_item_load(dn, nxt, lane); }
                  p0_item_store(dc, cur, scr, lane);
                  if (more) { dc = dn;
#pragma unroll
                      for (int i = 0; i < 32; ++i) cur[i] = nxt[i]; }
              } } }
    }
    }
    SEAM(6);
    if (IN(7)) {
        FRESH_ARGS();
        pg8::Gemm g{HB, Wdn, M, D, FF}; pg8::StaticOrder S; S.init(M, D, G, bx); pg8::EpiResid<true> E{X1B, X2B, RS2, D};
        pg8::gemm_phase<pg8::EpiResid<true>, pg8::StaticOrder, true, true>(lds, g, S, E);
    }
    SEAM(7);
    if (IN(8)) {
        FRESH_ARGS();
#ifndef NO_P8B
        { pg8::Gemm g{X2B, Wpg, M, D, D}; pg8::StaticOrder S; S.init(M, D, G, bx); pg8::EpiPle E{RS2, T2B, X2B, ap->out, D, 1.0f / D, EPS};
          pg8::gemm_phase<pg8::EpiPle, pg8::StaticOrder, true, true>(lds, g, S, E); }
#endif
    }
#ifdef PROBE_TS
    STAMP(9);
    GBAR(8);
    { const unsigned long long* TS = (const unsigned long long*)(ws + 2048);
      const unsigned long long ta = __hip_atomic_load(TS + PROBE_A, __ATOMIC_RELAXED, __HIP_MEMORY_SCOPE_AGENT), tb = __hip_atomic_load(TS + PROBE_B, __ATOMIC_RELAXED, __HIP_MEMORY_SCOPE_AGENT);
      const int K = PROBE_CONST ? PROBE_CONST : (int)((tb - ta) / 8);
      FRESH_ARGS();
      for (int i = vcu * NTHREADS + (int)threadIdx.x; i < K && i < 42000; i += G * NTHREADS) ap->out[(size_t)i * 397] += 0.125f; }
#endif
#undef IN
#undef SEAM
}

#ifndef MK_SPLIT
#define MK_SPLIT 0
#endif
extern "C" void kernel_launch(void* const* d_in, const int* in_sizes, int n_in, void* d_out, int out_size, void* d_ws, size_t ws_size, hipStream_t stream) {
    static int grid = 0;
    if (grid == 0) {
        if (n_in != 24 || in_sizes[0] != M * D || out_size != M * D || ws_size < WS_END) { fprintf(stderr, "kernel_launch: unexpected shapes (n_in %d, in0 %d, out %d, ws %zu); nothing launched\n", n_in, n_in > 0 ? in_sizes[0] : -1, out_size, ws_size); grid = -1; return; }
        int dev = 0, cus = 0, per_cu = 0;
        hipGetDevice(&dev); hipDeviceGetAttribute(&cus, hipDeviceAttributeMultiprocessorCount, dev);
        hipFuncSetAttribute((const void*)fwd_megakernel, hipFuncAttributeMaxDynamicSharedMemorySize, LDS_BYTES);
        hipOccupancyMaxActiveBlocksPerMultiprocessor(&per_cu, (const void*)fwd_megakernel, NTHREADS, LDS_BYTES);
        if (per_cu < 1) per_cu = 1;
        grid = cus * per_cu;
        (void)hipGetLastError();
    }
    if (grid < 0) return;
    Args a{};
    const float** ap = (const float**)&a;
    for (int i = 0; i < 24; ++i) ap[i] = (const float*)d_in[i];
    a.out = (float*)d_out; a.ws = (unsigned char*)d_ws; a.rep3 = NREP(3); a.pad = 0;
#if MK_SPLIT
    for (int ph = 0; ph < NPHASE; ++ph) { a.ph_lo = ph; a.ph_hi = ph + 1; hipLaunchKernelGGL(fwd_megakernel, dim3(grid), dim3(NTHREADS), LDS_BYTES, stream, a); }
#else
    a.ph_lo = 0; a.ph_hi = NPHASE;
    (void)hipMemsetAsync((unsigned char*)d_ws + 4096, 0, 20480, stream);
#ifdef PROBE_TS
    (void)hipMemsetAsync((unsigned char*)d_ws + 2048 + 14 * 8, 0, 16, stream); (void)hipMemsetAsync((unsigned char*)d_ws + 2048 + 16 * 8, 0x7f, 8, stream);
#endif
    void* args[] = {&a};
    hipError_t e = hipLaunchCooperativeKernel((const void*)fwd_megakernel, dim3(grid), dim3(NTHREADS), args, LDS_BYTES, stream);
    if (e != hipSuccess) fprintf(stderr, "cooperative launch failed: %s (grid %d)\n", hipGetErrorString(e), grid);
#endif
}
```
